# Optimizing an MI355X kernel written in HIP

```python
import jax, jax.numpy as jnp
from jax import lax
import numpy as np

D_MODEL = 1024
BATCH = 32
SEQ = 2048
DEPTH = 1

CTX_LEN = 256
GRID_W = 64
N_SUB = 3
N_MOD = 3 * N_SUB
FFN_HIDDEN = 2816
GLA_HEADS = 4
GLA_DK = 128
GLA_DV = 256
GLA_KEY = GLA_HEADS * GLA_DK
GLA_VAL = GLA_HEADS * GLA_DV
GLA_RANK = 16
GLA_TAU = 16.0
GLA_CHUNK = 64
LRU_WIDTH = 1024
LRU_BLOCKS = 8
LRU_BW = LRU_WIDTH // LRU_BLOCKS
LRU_C = 8.0
CONV_K = 4
EPS = 1e-6
IN_SIZES = (GLA_KEY, GLA_KEY, GLA_VAL, GLA_VAL, GLA_RANK, GLA_RANK,
            LRU_WIDTH, LRU_WIDTH, D_MODEL, D_MODEL)
IN_WIDTH = 2 * GLA_KEY + 2 * GLA_VAL + 2 * GLA_RANK + 2 * LRU_WIDTH + 2 * D_MODEL

kernel_name = "hybrid_gla_rglru_macaron_prefix_block"


def rmsnorm(x, w):
    xf = x.astype(jnp.float32)
    y = xf * lax.rsqrt(jnp.mean(xf * xf, axis=-1, keepdims=True) + EPS)
    return (y * w.astype(jnp.float32)).astype(x.dtype)


def modulate(h, w, shift, scale):
    return rmsnorm(h, w) * (1.0 + scale) + shift


def swiglu(u, wi, wo):
    gate, up = jnp.split(u @ wi, 2, axis=-1)
    return (jax.nn.silu(gate) * up) @ wo


def ffn_half(t, m, s, nw, wi, wo):
    u = modulate(t, nw, m[3 * s], m[3 * s + 1])
    return t + 0.5 * m[3 * s + 2] * swiglu(u, wi, wo)


def flip(t):
    return jnp.flip(t, axis=1)


def dwconv_centred(t, w, b):
    L = t.shape[1]
    left = CONV_K // 2
    tp = jnp.pad(t, ((0, 0), (left, CONV_K - 1 - left), (0, 0)))
    out = b
    for j in range(CONV_K):
        out = out + tp[:, j:j + L] * w[j]
    return out


def gla_chunk(q, k, v, log_a, s0, strict):
    Bn, T, H, DK = q.shape
    DV = v.shape[-1]
    n = T // GLA_CHUNK
    q = q.reshape(Bn, n, GLA_CHUNK, H, DK)
    k = k.reshape(Bn, n, GLA_CHUNK, H, DK)
    v = v.reshape(Bn, n, GLA_CHUNK, H, DV)
    b = jnp.cumsum(log_a.reshape(Bn, n, GLA_CHUNK, H, DK), axis=2)
    b_last = b[:, :, -1:]
    q_dec = q * jnp.exp(b)
    k_inv = k * jnp.exp(-b)
    k_end = k * jnp.exp(b_last - b)
    scores = jnp.einsum('bnihd,bnjhd->bnhij', q_dec, k_inv)
    mask = jnp.tril(jnp.ones((GLA_CHUNK, GLA_CHUNK), dtype=bool), -1 if strict else 0)
    scores = jnp.where(mask, scores, 0.0)
    o_intra = jnp.einsum('bnhij,bnjhe->bnihe', scores, v)

    def step(s, inp):
        qd, ke, vv, bl = inp
        o = jnp.einsum('bihd,bhde->bihe', qd, s)
        s = s * jnp.exp(bl)[..., None] + jnp.einsum('bjhd,bjhe->bhde', ke, vv)
        return s, o

    xs = (jnp.moveaxis(q_dec, 1, 0), jnp.moveaxis(k_end, 1, 0),
          jnp.moveaxis(v, 1, 0), jnp.moveaxis(b_last[:, :, 0], 1, 0))
    s_fin, o_inter = lax.scan(step, s0, xs)
    o = o_intra + jnp.moveaxis(o_inter, 0, 1)
    return o.reshape(Bn, T, H, DV), s_fin


def rglru_scan(xc, w_r, b_r, w_i, b_i, lam, h0):
    Bn, T, W = xc.shape
    xb = xc.reshape(Bn, T, LRU_BLOCKS, LRU_BW)
    r = jax.nn.sigmoid(jnp.einsum('btnc,ncd->btnd', xb, w_r).reshape(Bn, T, W) + b_r)
    i = jax.nn.sigmoid(jnp.einsum('btnc,ncd->btnd', xb, w_i).reshape(Bn, T, W) + b_i)
    log_a = -LRU_C * r * jax.nn.softplus(-lam)
    a = jnp.exp(log_a)
    u = jnp.sqrt(-jnp.expm1(2.0 * log_a)) * (i * xc)

    def combine(e1, e2):
        a1, b1 = e1
        a2, b2 = e2
        return a1 * a2, a2 * b1 + b2

    a_cum, h_zero = lax.associative_scan(combine, (a, u), axis=1)
    h = a_cum * h0[:, None] + h_zero
    return h, h[:, -1]


def token_mixer(proj, conv_fn, init, lp, need_out):
    (fup, fb, gnorm_w, conv_w, conv_b, lru_wr, lru_br, lru_wi, lru_bi, lru_lam,
     w_out_gla, w_out_lru, w_o) = lp
    dt = proj.dtype
    split_idx = [int(s) for s in np.cumsum(IN_SIZES)[:-1]]
    q, k, v, g, fd_f, fd_b, xl, yl, ga, gb = jnp.split(proj, split_idx, axis=-1)
    Bn, T, _ = proj.shape
    f32 = jnp.float32

    def heads(t, d):
        return t.astype(f32).reshape(Bn, T, GLA_HEADS, d)

    qh = heads(q, GLA_DK) * (GLA_DK ** -0.5)
    kh = heads(k, GLA_DK)
    vh = heads(v, GLA_DV)
    la_f = heads(jax.nn.log_sigmoid(fd_f @ fup[0] + fb[0]), GLA_DK) / GLA_TAU
    la_b = heads(jax.nn.log_sigmoid(fd_b @ fup[1] + fb[1]), GLA_DK) / GLA_TAU
    s_f0, s_b0, h_f0, h_b0 = init
    o_f, s_f = gla_chunk(qh, kh, vh, la_f, s_f0, False)
    o_b, s_b = gla_chunk(flip(qh), flip(kh), flip(vh), flip(la_b), s_b0, True)

    xc = conv_fn(xl, conv_w, conv_b).astype(f32)
    hf, h_f = rglru_scan(xc, lru_wr[0], lru_br[0], lru_wi[0], lru_bi[0], lru_lam[0], h_f0)
    hb, h_b = rglru_scan(flip(xc), lru_wr[1], lru_br[1], lru_wi[1], lru_bi[1], lru_lam[1], h_b0)
    states = (s_f, s_b, h_f, h_b)
    if not need_out:
        return None, states

    o = o_f + flip(o_b)
    o = rmsnorm(o, gnorm_w) * jax.nn.silu(heads(g, GLA_DV))
    y_gla = o.reshape(Bn, T, GLA_VAL).astype(dt) @ w_out_gla
    y_lru = ((hf + flip(hb)).astype(dt) * jax.nn.gelu(yl)) @ w_out_lru
    merged = jax.nn.sigmoid(ga) * y_gla + jax.nn.sigmoid(gb) * y_lru
    return merged @ w_o, states


def setup_inputs(seed: int = 0) -> dict:
    key = jax.random.key(seed)
    ks = jax.random.split(key, 32)
    nrm = jax.random.normal
    D = D_MODEL
    p = (jax.random.uniform(ks[25], (DEPTH, 2, LRU_WIDTH), minval=0.9, maxval=0.999)) ** (1.0 / LRU_C)
    return {
        "x": nrm(ks[0], (BATCH, SEQ, D)),
        "c": nrm(ks[1], (BATCH, D)),
        "ctx": nrm(ks[2], (BATCH, CTX_LEN, D)),
        "c_ctx": nrm(ks[3], (D,)),
        "w_ada": nrm(ks[4], (DEPTH, D, N_MOD * D)) * (0.5 * D ** -0.5),
        "b_ada": nrm(ks[5], (DEPTH, N_MOD * D)) * 0.02,
        "norm_w": 1.0 + 0.05 * nrm(ks[6], (DEPTH, N_SUB, D)),
        "ffn1_wi": nrm(ks[7], (DEPTH, D, 2 * FFN_HIDDEN)) * D ** -0.5,
        "ffn1_wo": nrm(ks[8], (DEPTH, FFN_HIDDEN, D)) * FFN_HIDDEN ** -0.5,
        "ffn2_wi": nrm(ks[9], (DEPTH, D, 2 * FFN_HIDDEN)) * D ** -0.5,
        "ffn2_wo": nrm(ks[10], (DEPTH, FFN_HIDDEN, D)) * FFN_HIDDEN ** -0.5,
        "w_in": nrm(ks[11], (DEPTH, D, IN_WIDTH)) * D ** -0.5,
        "gla_fup": nrm(ks[12], (DEPTH, 2, GLA_RANK, GLA_KEY)) * GLA_RANK ** -0.5,
        "gla_fb": nrm(ks[13], (DEPTH, 2, GLA_KEY)) * 0.1,
        "gla_norm_w": 1.0 + 0.05 * nrm(ks[14], (DEPTH, GLA_DV)),
        "conv_w": nrm(ks[15], (DEPTH, CONV_K, LRU_WIDTH)) * CONV_K ** -0.5,
        "conv_b": nrm(ks[16], (DEPTH, LRU_WIDTH)) * 0.02,
        "lru_wr": nrm(ks[17], (DEPTH, 2, LRU_BLOCKS, LRU_BW, LRU_BW)) * LRU_BW ** -0.5,
        "lru_br": nrm(ks[18], (DEPTH, 2, LRU_WIDTH)) * 0.02,
        "lru_wi": nrm(ks[19], (DEPTH, 2, LRU_BLOCKS, LRU_BW, LRU_BW)) * LRU_BW ** -0.5,
        "lru_bi": nrm(ks[20], (DEPTH, 2, LRU_WIDTH)) * 0.02,
        "lru_lam": jnp.log(p) - jnp.log1p(-p),
        "w_out_gla": nrm(ks[21], (DEPTH, GLA_VAL, D)) * GLA_VAL ** -0.5,
        "w_out_lru": nrm(ks[22], (DEPTH, LRU_WIDTH, D)) * LRU_WIDTH ** -0.5,
        "w_o": nrm(ks[23], (DEPTH, D, D)) * D ** -0.5,
        "final_norm_w": 1.0 + 0.05 * nrm(ks[24], (D,)),
    }


def reference(x, c, ctx, c_ctx, w_ada, b_ada, norm_w, ffn1_wi, ffn1_wo, ffn2_wi, ffn2_wo,
              w_in, gla_fup, gla_fb, gla_norm_w, conv_w, conv_b, lru_wr, lru_br, lru_wi,
              lru_bi, lru_lam, w_out_gla, w_out_lru, w_o, final_norm_w):
    Bn, T, _ = x.shape
    rows = T // GRID_W

    def lat_conv(t, w, b):
        return dwconv_centred(t.reshape(Bn * rows, GRID_W, t.shape[-1]), w, b).reshape(Bn, T, t.shape[-1])

    f32 = jnp.float32
    zero_init = (jnp.zeros((Bn, GLA_HEADS, GLA_DK, GLA_DV), f32),
                 jnp.zeros((Bn, GLA_HEADS, GLA_DK, GLA_DV), f32),
                 jnp.zeros((Bn, LRU_WIDTH), f32),
                 jnp.zeros((Bn, LRU_WIDTH), f32))
    h, hc = x, ctx
    for l in range(DEPTH):
        last = l == DEPTH - 1
        mod = (jax.nn.silu(c) @ w_ada[l] + b_ada[l]).reshape(Bn, N_MOD, 1, D_MODEL)
        mod_c = (jax.nn.silu(c_ctx) @ w_ada[l] + b_ada[l]).reshape(N_MOD, D_MODEL)
        lat_m = [mod[:, j] for j in range(N_MOD)]
        ctx_m = [mod_c[j] for j in range(N_MOD)]
        lp = (gla_fup[l], gla_fb[l], gla_norm_w[l], conv_w[l], conv_b[l], lru_wr[l], lru_br[l],
              lru_wi[l], lru_bi[l], lru_lam[l], w_out_gla[l], w_out_lru[l], w_o[l])

        h = ffn_half(h, lat_m, 0, norm_w[l, 0], ffn1_wi[l], ffn1_wo[l])
        hc = ffn_half(hc, ctx_m, 0, norm_w[l, 0], ffn1_wi[l], ffn1_wo[l])

        uc = modulate(hc, norm_w[l, 1], ctx_m[3], ctx_m[4]) @ w_in[l]
        yc, ctx_states = token_mixer(uc, dwconv_centred, zero_init, lp, not last)
        u = modulate(h, norm_w[l, 1], lat_m[3], lat_m[4]) @ w_in[l]
        y, _ = token_mixer(u, lat_conv, ctx_states, lp, True)
        h = h + lat_m[5] * y

        h = ffn_half(h, lat_m, 2, norm_w[l, 2], ffn2_wi[l], ffn2_wo[l])
        if not last:
            hc = hc + ctx_m[5] * yc
            hc = ffn_half(hc, ctx_m, 2, norm_w[l, 2], ffn2_wi[l], ffn2_wo[l])
    return rmsnorm(h, final_norm_w)
```

```cpp
#include <hip/hip_runtime.h>
#include <hip/hip_cooperative_groups.h>
#include <cstdio>
#include <cstdint>
namespace cg = cooperative_groups;

#ifndef ONE_LAUNCH
#define ONE_LAUNCH 0
#endif

#ifndef PHMASK
#define PHMASK 0x1fffff
#endif
#define PHON(n) (((PHMASK) >> (n)) & 1)
#define LAS __attribute__((address_space(3)))
typedef unsigned short bf16_t;
typedef short bf16x8 __attribute__((ext_vector_type(8)));
typedef float f32x4 __attribute__((ext_vector_type(4)));
typedef float f32x2 __attribute__((ext_vector_type(2)));
typedef unsigned u32x4 __attribute__((ext_vector_type(4)));
typedef unsigned u32x2 __attribute__((ext_vector_type(2)));

constexpr int D = 1024, NB = 32, T = 2048, CL = 256, FH = 2816, INW = 7200, PN = 7424, NMOD = 9216;
constexpr int NG = 4, BG = NB / NG;
constexpr int RL = BG * T, RC = BG * CL, RG = RL + RC;
constexpr int NCH = 36;
constexpr float EPS = 1e-6f;
constexpr int PQ = 0, PK = 512, PV = 1024, PGG = 2048, PXL = 3072, PYL = 4096, PGA = 5120, PGB = 6144, PFD = 7168;

constexpr size_t al(size_t x) { return (x + 4095) & ~(size_t)4095; }
constexpr size_t WS_WI1 = 1 << 20;
constexpr size_t WS_WO1 = WS_WI1 + al((size_t)2 * FH * D * 2);
constexpr size_t WS_WI2 = WS_WO1 + al((size_t)D * FH * 2);
constexpr size_t WS_WO2 = WS_WI2 + al((size_t)2 * FH * D * 2);
constexpr size_t WS_WIN = WS_WO2 + al((size_t)D * FH * 2);
constexpr size_t WS_WOG = WS_WIN + al((size_t)PN * D * 2);
constexpr size_t WS_WOL = WS_WOG + al((size_t)D * D * 2);
constexpr size_t WS_WOO = WS_WOL + al((size_t)D * D * 2);
constexpr size_t WS_WLG = WS_WOO + al((size_t)D * D * 2);
constexpr size_t WS_MODP = WS_WLG + al((size_t)4096 * 128 * 2);
constexpr size_t WS_MOD = WS_MODP + al((size_t)16 * 33 * NMOD * 4);
constexpr size_t WS_GC = WS_MOD + al((size_t)33 * NMOD * 4);
constexpr size_t WS_H1 = WS_GC + al((size_t)6 * D * 4);
constexpr size_t WS_U = WS_H1 + al((size_t)RG * D * 4);
constexpr size_t WS_BIG = WS_U + al((size_t)RG * D * 2);
constexpr size_t WS_XC = WS_BIG + al((size_t)RG * PN * 2);
constexpr size_t WS_LA = WS_XC + al((size_t)RG * D * 2);
constexpr size_t WS_UU = WS_LA + al((size_t)2 * RG * D * 2);
constexpr size_t WS_HFB = WS_UU + al((size_t)2 * RG * D * 2);
constexpr size_t WS_OFB = WS_HFB + al((size_t)2 * RL * D * 2);
constexpr size_t GT = (size_t)2 * BG * NCH * 4;
constexpr size_t WS_QD = WS_OFB + al((size_t)2 * RL * D * 2);
constexpr size_t WS_KI = WS_QD + al(GT * 8192 * 2);
constexpr size_t WS_KET = WS_KI + al(GT * 8192 * 2);
constexpr size_t WS_VT = WS_KET + al(GT * 8192 * 2);
constexpr size_t WS_BL = WS_VT + al((size_t)BG * NCH * 4 * 16384 * 2);
constexpr size_t WS_END = WS_BL + al(GT * 128 * 4);
static_assert(WS_END <= (size_t)1073741824, "workspace map exceeds 1 GiB");

constexpr int LDS_BYTES = 163840, PTAB = LDS_BYTES - 512;

typedef __bf16 bf16x2_t __attribute__((ext_vector_type(2)));
__device__ __forceinline__ unsigned cvt_pk_bf16(float lo, float hi) { const f32x2 v = {lo, hi}; return __builtin_bit_cast(unsigned, __builtin_convertvector(v, bf16x2_t)); }
__device__ __forceinline__ bf16_t f2bf(float f) { return (bf16_t)(cvt_pk_bf16(f, 0.f) & 0xffffu); }
__device__ __forceinline__ float bf2f(bf16_t h) { return __uint_as_float(((unsigned)h) << 16); }
__device__ __forceinline__ float bflo(unsigned w) { return __uint_as_float(w << 16); }
__device__ __forceinline__ float bfhi(unsigned w) { return __uint_as_float(w & 0xffff0000u); }
__device__ __forceinline__ float sigmoidf_(float x) { return __builtin_amdgcn_rcpf(1.0f + __expf(-x)); }
__device__ __forceinline__ float siluf_(float x) { return x * __builtin_amdgcn_rcpf(1.0f + __expf(-x)); }
__device__ __forceinline__ float geluf_(float x) { const float z = 0.7978845608028654f * (x + 0.044715f * x * x * x); return x * (1.0f - __builtin_amdgcn_rcpf(1.0f + __expf(2.0f * z))); }
__device__ __forceinline__ float logsigf_(float x) { return fminf(x, 0.f) - log1pf(__expf(-fabsf(x))); }
__device__ __forceinline__ float one_minus_exp(float x) {
    const float ser = -x * (1.0f + x * (0.5f + x * (0.16666667f + x * (0.041666668f + x * (0.0083333338f + x * (0.0013888889f + x * 0.0001984127f))))));
    return x > -0.3f ? ser : 1.0f - __expf(x);
}
__device__ __forceinline__ float wave_sum(float v) {
#pragma unroll
    for (int o = 1; o < 64; o <<= 1) v += __shfl_xor(v, o);
    return v;
}
__device__ __forceinline__ void unpack8(const u32x4 w, float (&f)[8]) {
    f[0] = bflo(w.x); f[1] = bfhi(w.x); f[2] = bflo(w.y); f[3] = bfhi(w.y); f[4] = bflo(w.z); f[5] = bfhi(w.z); f[6] = bflo(w.w); f[7] = bfhi(w.w);
}
__device__ __forceinline__ u32x4 pack8(const float (&f)[8]) {
    u32x4 w; w.x = cvt_pk_bf16(f[0], f[1]); w.y = cvt_pk_bf16(f[2], f[3]); w.z = cvt_pk_bf16(f[4], f[5]); w.w = cvt_pk_bf16(f[6], f[7]); return w;
}

namespace pg8 {
constexpr int BM = 256, BK = 64, HALF = 128, HTB = HALF * BK * 2, STAGE_BYTES = 8 * HTB, NXCD = 8, WGM = 8;
__host__ __device__ __forceinline__ int lds_byte(int r, int c) { const int st = (r >> 4) * 2 + (c >> 5), rr = r & 15, cc = c & 31, ob = rr * 64 + cc * 2; return st * 1024 + (ob ^ (((ob >> 9) & 1) << 5)); }
__host__ __device__ __forceinline__ void stage_rc(int b, int& R, int& C) { const int st = b / 1024, sb = b % 1024, swz = sb ^ (((sb >> 9) & 1) << 5); R = (st >> 1) * 16 + swz / 64; C = (st & 1) * 32 + (swz % 64) / 2; }
__host__ __device__ __forceinline__ int perm32(int rho) { const int n = rho >> 4, i = rho & 15; return 8 * (i >> 2) + 4 * n + (i & 3); }
struct Unit { int pm, pn; };
struct Gemm { const bf16_t* A; const bf16_t* Bt; int M, N, K, lda, ldb, a_pn_shift, a_pn_bytes; };
struct StaticOrder {
    int nM, nN, nwg, G, c;
    __device__ void init(int M, int N, int G_, int c_) { nM = M / BM; nN = N / BM; nwg = nM * nN; G = G_; c = c_; }
    __device__ bool next(int i, Unit& u) const {
        const long L = (long)i * G + c; if (L >= nwg) return false;
        int wgid = (int)L; { const int q = nwg / NXCD, r = nwg % NXCD, xcd = wgid % NXCD, off = wgid / NXCD; wgid = (xcd < r ? xcd * (q + 1) : r * (q + 1) + (xcd - r) * q) + off; }
        const int nig = WGM * nN, gid = wgid / nig, fm = gid * WGM, gsz = (nM - fm) < WGM ? (nM - fm) : WGM;
        u.pm = fm + ((wgid % nig) % gsz); u.pn = (wgid % nig) / gsz; return true;
    }
};
template <class Epi, bool ALIGN_EPI>
__device__ __forceinline__ void gemm_phase(const int tid, LAS unsigned char* lds, const Gemm g, const StaticOrder& S, const Epi& E) {
    const int wid = __builtin_amdgcn_readfirstlane(tid >> 6), lane = tid & 63, wr = wid >> 2, wc = wid & 3, fr = lane & 15, fq = lane >> 4;
    const int K = g.K, nt = K / BK;
    unsigned voffA[2], voffB[2];
#pragma unroll
    for (int i = 0; i < 2; ++i) { int R, C; stage_rc(tid * 16 + i * 8192, R, C); const int Rb = Epi::PERM ? ((R & ~31) + perm32(R & 31)) : R;
        voffA[i] = (unsigned)(R * g.lda + C) * 2u; voffB[i] = (unsigned)(Rb * g.ldb + C) * 2u; }
    const size_t kstep = (size_t)(BK * 2);
    const size_t hstepA = (size_t)HALF * g.lda * 2, hstepB = (size_t)HALF * g.ldb * 2;
    const size_t tstepA = 2 * hstepA, tstepB = 2 * hstepB;
    const unsigned ldsw = (unsigned)wid * 1024u;
    const int aoff = lds_byte(wr * 64 + fr, fq * 8), boff = lds_byte(wc * 32 + fr, fq * 8);
#define PG8_SA(b, h) (((b) * 2 + (h)) * HTB)
#define PG8_SB(b, h) ((4 + (b) * 2 + (h)) * HTB)
#define PG8_STAGE(bufoff, gbase, voff) do { _Pragma("unroll") for (int _i = 0; _i < 2; ++_i) \
        __builtin_amdgcn_global_load_lds((const unsigned*)((const char*)(gbase) + (voff)[_i]), (LAS unsigned*)(lds + (bufoff) + ldsw + _i * 8192), 16, 0, 0); } while (0)
#define PG8_LDA(dst, b, h) do { _Pragma("unroll") for (int m = 0; m < 4; ++m) _Pragma("unroll") for (int k = 0; k < 2; ++k) dst[m][k] = *(const LAS bf16x8*)(lds + PG8_SA(b, h) + aoff + m * 2048 + k * 1024); } while (0)
#define PG8_LDB(dst, b, h) do { _Pragma("unroll") for (int n = 0; n < 2; ++n) _Pragma("unroll") for (int k = 0; k < 2; ++k) dst[n][k] = *(const LAS bf16x8*)(lds + PG8_SB(b, h) + boff + n * 2048 + k * 1024); } while (0)
#define PG8_MMA(ai, bj, At, Bt) do { __builtin_amdgcn_s_setprio(1); _Pragma("unroll") for (int m = 0; m < 4; ++m) _Pragma("unroll") for (int n = 0; n < 2; ++n) _Pragma("unroll") for (int k = 0; k < 2; ++k) \
        acc[ai][bj][m][n] = __builtin_amdgcn_mfma_f32_16x16x32_bf16(Bt[n][k], At[m][k], acc[ai][bj][m][n], 0, 0, 0); __builtin_amdgcn_s_setprio(0); } while (0)
#define PG8_WAIT_V(n) asm volatile("s_waitcnt vmcnt(" #n ")" ::: "memory")
#define PG8_WAIT_L(n) asm volatile("s_waitcnt lgkmcnt(" #n ")" ::: "memory")
#define PG8_BAR __builtin_amdgcn_s_barrier()
#define PG8_SCHED __builtin_amdgcn_sched_barrier(0)
    Unit cur, nxt; int ui = 0;
    if (!S.next(0, cur)) return;
    f32x4 acc[2][2][4][2];
#pragma unroll
    for (int a = 0; a < 2; ++a)
#pragma unroll
        for (int b = 0; b < 2; ++b)
#pragma unroll
            for (int m = 0; m < 4; ++m)
#pragma unroll
                for (int n = 0; n < 2; ++n) acc[a][b][m][n] = (f32x4){0.f, 0.f, 0.f, 0.f};
    bf16x8 At[4][2], B0[2][2], B1[2][2];
    const char* cA = (const char*)g.A + (size_t)cur.pm * tstepA + (size_t)((cur.pn >> g.a_pn_shift) * g.a_pn_bytes);
    const char* cB = (const char*)g.Bt + (size_t)cur.pn * tstepB;
    PG8_STAGE(PG8_SB(0, 0), cB, voffB); PG8_STAGE(PG8_SB(0, 1), cB + hstepB, voffB); PG8_STAGE(PG8_SA(0, 0), cA, voffA); PG8_STAGE(PG8_SA(0, 1), cA + hstepA, voffA);
    if (wr == 1) PG8_BAR;
    PG8_WAIT_V(2); PG8_BAR;
    PG8_STAGE(PG8_SB(1, 0), cB + kstep, voffB); PG8_STAGE(PG8_SA(1, 0), cA + kstep, voffA); PG8_STAGE(PG8_SB(1, 1), cB + hstepB + kstep, voffB);
    PG8_WAIT_V(6); PG8_BAR;
    for (;;) {
        const bool has_next = S.next(ui + 1, nxt);
        const char* nA = has_next ? (const char*)g.A + (size_t)nxt.pm * tstepA + (size_t)((nxt.pn >> g.a_pn_shift) * g.a_pn_bytes) : cA;
        const char* nB = has_next ? (const char*)g.Bt + (size_t)nxt.pn * tstepB : cB;
        for (int t = 0; t < nt; t += 2) {
            const bool last = (t == nt - 2);
            const char* a1 = cA + (size_t)(t + 1) * kstep;
            const char* a2 = last ? nA : cA + (size_t)(t + 2) * kstep; const char* b2 = last ? nB : cB + (size_t)(t + 2) * kstep;
            const char* a3 = a2 + kstep; const char* b3 = b2 + kstep;
            PG8_LDB(B0, 0, 0); PG8_LDB(B1, 0, 1); PG8_SCHED; PG8_LDA(At, 0, 0); PG8_STAGE(PG8_SA(1, 1), a1 + hstepA, voffA);
            PG8_WAIT_V(8); PG8_WAIT_L(0); PG8_BAR; PG8_MMA(0, 0, At, B0); PG8_MMA(0, 1, At, B1); PG8_BAR; PG8_SCHED;
            PG8_LDA(At, 0, 1); PG8_STAGE(PG8_SB(0, 0), b2, voffB); PG8_STAGE(PG8_SB(0, 1), b2 + hstepB, voffB); PG8_STAGE(PG8_SA(0, 0), a2, voffA);
            PG8_WAIT_V(8); PG8_WAIT_L(0); PG8_BAR; PG8_MMA(1, 0, At, B0); PG8_MMA(1, 1, At, B1); PG8_BAR; PG8_SCHED;
            PG8_LDB(B0, 1, 0); PG8_LDB(B1, 1, 1); PG8_SCHED; PG8_LDA(At, 1, 0); PG8_STAGE(PG8_SA(0, 1), a2 + hstepA, voffA);
            PG8_WAIT_V(8); PG8_WAIT_L(0); PG8_BAR; PG8_MMA(0, 0, At, B0); PG8_MMA(0, 1, At, B1); PG8_BAR; PG8_SCHED;
            PG8_LDA(At, 1, 1); PG8_STAGE(PG8_SB(1, 0), b3, voffB); PG8_STAGE(PG8_SB(1, 1), b3 + hstepB, voffB); PG8_STAGE(PG8_SA(1, 0), a3, voffA);
            PG8_WAIT_V(8); PG8_WAIT_L(0); PG8_BAR; PG8_MMA(1, 0, At, B0); PG8_MMA(1, 1, At, B1); PG8_BAR; PG8_SCHED;
        }
        if constexpr (ALIGN_EPI) { if (wr == 0) PG8_BAR; }
        { int fr_ = fr, fq_ = fq; asm volatile("" : "+v"(fr_), "+v"(fq_)); E(acc, cur, wr, wc, fr_, fq_); }
        if (!has_next) break;
#pragma unroll
        for (int a = 0; a < 2; ++a)
#pragma unroll
            for (int b = 0; b < 2; ++b)
#pragma unroll
                for (int m = 0; m < 4; ++m)
#pragma unroll
                    for (int n = 0; n < 2; ++n) acc[a][b][m][n] = (f32x4){0.f, 0.f, 0.f, 0.f};
        cur = nxt; cA = nA; cB = nB; ++ui;
        if constexpr (ALIGN_EPI) { if (wr == 1) PG8_BAR; }
    }
    PG8_WAIT_V(0);
    if constexpr (!ALIGN_EPI) { if (wr == 0) PG8_BAR; }
    PG8_BAR;
#undef PG8_SA
#undef PG8_SB
#undef PG8_STAGE
#undef PG8_LDA
#undef PG8_LDB
#undef PG8_MMA
#undef PG8_WAIT_V
#undef PG8_WAIT_L
#undef PG8_BAR
#undef PG8_SCHED
}

struct EpiBf16 {
    static constexpr bool PERM = true;
    bf16_t* O; int ldc;
    __device__ __forceinline__ void operator()(const f32x4 (&acc)[2][2][4][2], const Unit& u, int wr, int wc, int fr, int fq) const {
        const int row0 = u.pm * BM + wr * 64 + fr, col0 = u.pn * BM + wc * 32 + 8 * fq;
#pragma unroll
        for (int ai = 0; ai < 2; ++ai)
#pragma unroll
            for (int m = 0; m < 4; ++m) { bf16_t* rowp = O + (size_t)(row0 + ai * HALF + m * 16) * ldc + col0;
#pragma unroll
                for (int bj = 0; bj < 2; ++bj) { const f32x4 v0 = acc[ai][bj][m][0], v1 = acc[ai][bj][m][1];
                    u32x4 w; w.x = cvt_pk_bf16(v0[0], v0[1]); w.y = cvt_pk_bf16(v0[2], v0[3]); w.z = cvt_pk_bf16(v1[0], v1[1]); w.w = cvt_pk_bf16(v1[2], v1[3]);
                    *(u32x4*)(rowp + bj * HALF) = w; } }
    }
};
struct EpiSwiglu {
    static constexpr bool PERM = true;
    bf16_t* O; int ldc;
    __device__ __forceinline__ void operator()(const f32x4 (&acc)[2][2][4][2], const Unit& u, int wr, int wc, int fr, int fq) const {
        const int row0 = u.pm * BM + wr * 64 + fr, col0 = u.pn * HALF + wc * 32 + 8 * fq;
#pragma unroll
        for (int ai = 0; ai < 2; ++ai)
#pragma unroll
            for (int m = 0; m < 4; ++m) { bf16_t* rowp = O + (size_t)(row0 + ai * HALF + m * 16) * ldc + col0;
                float o[8];
#pragma unroll
                for (int n = 0; n < 2; ++n)
#pragma unroll
                    for (int j = 0; j < 4; ++j) o[4 * n + j] = siluf_(acc[ai][0][m][n][j]) * acc[ai][1][m][n][j];
                *(u32x4*)rowp = pack8(o); }
    }
};
struct EpiResid {
    static constexpr bool PERM = false;
    const float* baseL; const float* baseC; float* outL; float* outC; const float* modL; const float* modC; float scale; int nlat;
    __device__ __forceinline__ void operator()(const f32x4 (&acc)[2][2][4][2], const Unit& u, int wr, int wc, int fr, int fq) const {
        const bool lat = u.pm < nlat;
        const size_t toff = (size_t)(lat ? u.pm : u.pm - nlat) * BM * D + (size_t)(wr * 64 + fr) * D + u.pn * BM + wc * 32 + 4 * fq;
        const float* base = (lat ? baseL : baseC) + toff;
        float* out = (lat ? outL : outC) + toff;
        const float* mg = (lat ? modL + (size_t)(u.pm >> 3) * NMOD : modC) + u.pn * BM + wc * 32 + 4 * fq;
#pragma unroll
        for (int bj = 0; bj < 2; ++bj)
#pragma unroll
            for (int n = 0; n < 2; ++n) { const f32x4 gv = *(const f32x4*)(mg + bj * HALF + n * 16) * scale;
#pragma unroll
                for (int ai = 0; ai < 2; ++ai)
#pragma unroll
                    for (int m = 0; m < 4; ++m) { const size_t off = (size_t)(ai * HALF + m * 16) * D + bj * HALF + n * 16;
                        const f32x4 bs = *(const f32x4*)(base + off); *(f32x4*)(out + off) = bs + gv * acc[ai][bj][m][n]; } }
    }
};
__device__ __forceinline__ float one_minus_exp(float x) {
    const float ser = -x * (1.0f + x * (0.5f + x * (0.16666667f + x * (0.041666668f + x * (0.0083333338f + x * (0.0013888889f + x * 0.0001984127f))))));
    return x > -0.3f ? ser : 1.0f - __expf(x);
}
struct EpiGate {
    static constexpr bool PERM = true;
    bf16_t* LA; bf16_t* UU;
    __device__ __forceinline__ void operator()(const f32x4 (&acc)[2][2][4][2], const Unit& u, int wr, int wc, int fr, int fq) const {
        const int blk = u.pn >> 1, dir = u.pn & 1, ch0 = blk * HALF + wc * 32 + 8 * fq, row0 = u.pm * BM + wr * 64 + fr;
#pragma unroll
        for (int ai = 0; ai < 2; ++ai)
#pragma unroll
            for (int m = 0; m < 4; ++m) { const size_t off = (size_t)dir * RG * D + (size_t)(row0 + ai * HALF + m * 16) * D + ch0;
#pragma unroll
                for (int bj = 0; bj < 2; ++bj) { const f32x4 v0 = acc[ai][bj][m][0], v1 = acc[ai][bj][m][1];
                    u32x4 w; w.x = cvt_pk_bf16(v0[0], v0[1]); w.y = cvt_pk_bf16(v0[2], v0[3]); w.z = cvt_pk_bf16(v1[0], v1[1]); w.w = cvt_pk_bf16(v1[2], v1[3]);
                    *(u32x4*)((bj ? UU : LA) + off) = w; } }
    }
};
template <bool ACCUM> struct EpiMix {
    static constexpr bool PERM = true;
    const bf16_t* PROJ; int gcol; bf16_t* MG;
    __device__ __forceinline__ void operator()(const f32x4 (&acc)[2][2][4][2], const Unit& u, int wr, int wc, int fr, int fq) const {
        const int row0 = u.pm * BM + wr * 64 + fr, col0 = u.pn * BM + wc * 32 + 8 * fq;
#pragma unroll
        for (int ai = 0; ai < 2; ++ai)
#pragma unroll
            for (int m = 0; m < 4; ++m) { const size_t row = (size_t)(row0 + ai * HALF + m * 16);
#pragma unroll
                for (int bj = 0; bj < 2; ++bj) { float gt[8], o[8]; unpack8(*(const u32x4*)(PROJ + row * PN + gcol + col0 + bj * HALF), gt);
                    bf16_t* dst = MG + row * D + col0 + bj * HALF;
                    if (ACCUM) unpack8(*(const u32x4*)dst, o); else {
#pragma unroll
                        for (int i = 0; i < 8; ++i) o[i] = 0.f; }
#pragma unroll
                    for (int n = 0; n < 2; ++n)
#pragma unroll
                        for (int j = 0; j < 4; ++j) o[4 * n + j] += sigmoidf_(gt[4 * n + j]) * acc[ai][bj][m][n][j];
                    *(u32x4*)dst = pack8(o); } }
    }
};
}

struct Args {
    const float* in[26]; float* out; unsigned char* ws; int lo, hi;
};
enum { I_X = 0, I_C, I_CTX, I_CCTX, I_WADA, I_BADA, I_NORMW, I_F1WI, I_F1WO, I_F2WI, I_F2WO, I_WIN, I_FUP, I_FB, I_GNW, I_CONVW, I_CONVB, I_WR, I_BR, I_WI, I_BI, I_LAM, I_WOG, I_WOL, I_WOO, I_FNW };

#define NTHR 512
__device__ __forceinline__ const float* inp(const LAS unsigned char* lds, int i) { const LAS unsigned* t = (const LAS unsigned*)(lds + PTAB) + 2 * i;
    const unsigned lo = __builtin_amdgcn_readfirstlane(t[0]), hi = __builtin_amdgcn_readfirstlane(t[1]); return (const float*)(((unsigned long long)hi << 32) | lo); }
#define AIN(i) inp(lds, (i))
struct Ctx { int tid, bid, G; };
#define GW() (cx.bid * 8 + (cx.tid >> 6))
#define NGW() (cx.G * 8)

__device__ __forceinline__ void transpose_item(const float* W, int ldw, int K, int k0, int n0, bf16_t* WT, int drow, LAS float* scr, int lane) {
#pragma unroll 8
    for (int i = 0; i < 32; ++i) { const int kk = 2 * i + (lane >> 5); scr[kk * 33 + (lane & 31)] = W[(size_t)(k0 + kk) * ldw + n0 + (lane & 31)]; }
    asm volatile("s_waitcnt lgkmcnt(0)" ::: "memory");
    const int c = lane & 7;
#pragma unroll
    for (int j = 0; j < 4; ++j) { const int n = (lane >> 3) + 8 * j; const LAS float* s = scr + (8 * c) * 33 + n;
        u32x4 o; o.x = cvt_pk_bf16(s[0 * 33], s[1 * 33]); o.y = cvt_pk_bf16(s[2 * 33], s[3 * 33]); o.z = cvt_pk_bf16(s[4 * 33], s[5 * 33]); o.w = cvt_pk_bf16(s[6 * 33], s[7 * 33]);
        *(u32x4*)(WT + (size_t)(drow + n) * K + k0 + 8 * c) = o; }
    asm volatile("s_waitcnt lgkmcnt(0)" ::: "memory");
}
__device__ __forceinline__ int wi_drow(int n0) { return n0 < FH ? (n0 >> 7) * 256 + (n0 & 127) : ((n0 - FH) >> 7) * 256 + 128 + ((n0 - FH) & 127); }
__device__ __forceinline__ int win_drow(int n0) { return n0 < 3072 ? n0 : (n0 == 3072 ? PFD : n0 - 32); }

__device__ __forceinline__ void phase_weights(const Ctx cx, const Args& a, LAS unsigned char* lds) {
    const int lane = cx.tid & 63, wave = cx.tid >> 6;
    LAS float* scr = (LAS float*)(lds + wave * 16384);
    unsigned char* ws = a.ws;
    constexpr int I_WI_ = (D / 64) * (2 * FH / 32), I_WO_ = (FH / 64) * (D / 32), I_IN_ = (D / 64) * (INW / 32), I_SQ_ = (D / 64) * (D / 32), I_LG_ = 32 * 8;
    constexpr int NIT = 2 * I_WI_ + 2 * I_WO_ + I_IN_ + 3 * I_SQ_ + I_LG_;
    if (PHON(19)) for (int it = GW(); it < NIT; it += NGW()) {
        int r = it;
        if (r < 2 * I_WI_) { const int w = r / I_WI_; r %= I_WI_; const int nb = 2 * FH / 32, kb = r / nb, n0 = (r % nb) * 32;
            transpose_item(AIN(w ? I_F2WI : I_F1WI), 2 * FH, D, kb * 64, n0, (bf16_t*)(ws + (w ? WS_WI2 : WS_WI1)), wi_drow(n0), scr, lane); continue; }
        r -= 2 * I_WI_;
        if (r < 2 * I_WO_) { const int w = r / I_WO_; r %= I_WO_; const int nb = D / 32, kb = r / nb, n0 = (r % nb) * 32;
            transpose_item(AIN(w ? I_F2WO : I_F1WO), D, FH, kb * 64, n0, (bf16_t*)(ws + (w ? WS_WO2 : WS_WO1)), n0, scr, lane); continue; }
        r -= 2 * I_WO_;
        if (r < I_IN_) { const int nb = INW / 32, kb = r / nb, n0 = (r % nb) * 32;
            transpose_item(AIN(I_WIN), INW, D, kb * 64, n0, (bf16_t*)(ws + WS_WIN), win_drow(n0), scr, lane); continue; }
        r -= I_IN_;
        if (r < 3 * I_SQ_) { const int w = r / I_SQ_; r %= I_SQ_; const int nb = D / 32, kb = r / nb, n0 = (r % nb) * 32;
            transpose_item(AIN(w == 0 ? I_WOG : (w == 1 ? I_WOL : I_WOO)), D, D, kb * 64, n0, (bf16_t*)(ws + (w == 0 ? WS_WOG : (w == 1 ? WS_WOL : WS_WOO))), n0, scr, lane); continue; }
        r -= 3 * I_SQ_;
        { const int mat = r >> 3, sub = r & 7, gate = mat >> 4, dir = (mat >> 3) & 1, blk = mat & 7;
          const float* src = AIN(gate ? I_WI : I_WR) + (size_t)(dir * 8 + blk) * 128 * 128;
          const int kb = sub >> 2, n0 = (sub & 3) * 32;
          transpose_item(src, 128, 128, kb * 64, n0, (bf16_t*)(ws + WS_WLG), ((blk * 2 + dir) * 2 + gate) * 128 + n0, scr, lane); }
    }
    { u32x4* z = (u32x4*)(ws + WS_WIN + (size_t)INW * D * 2); const int n16 = (PN - INW) * D * 2 / 16;
      for (int i = cx.bid * NTHR + cx.tid; i < n16; i += cx.G * NTHR) z[i] = (u32x4){0u, 0u, 0u, 0u}; }
    __syncthreads();
    LAS float* sl = (LAS float*)lds;
    float* MODP = (float*)(ws + WS_MODP);
    if (PHON(20)) for (int item = cx.bid; item < 18 * 16; item += cx.G) {
        const int cb = item % 18, ks = item / 18, col = cb * 512 + cx.tid;
        for (int idx = cx.tid; idx < 33 * 64; idx += NTHR) { const int b = idx >> 6, k = idx & 63; const float cv = b < 32 ? AIN(I_C)[b * D + ks * 64 + k] : AIN(I_CCTX)[ks * 64 + k]; sl[idx] = siluf_(cv); }
        __syncthreads();
        float acc[33];
#pragma unroll
        for (int b = 0; b < 33; ++b) acc[b] = 0.f;
        const float* wp = AIN(I_WADA) + (size_t)(ks * 64) * NMOD + col;
#pragma unroll 4
        for (int k = 0; k < 64; ++k) { const float w = wp[(size_t)k * NMOD];
#pragma unroll
            for (int b = 0; b < 33; ++b) acc[b] += sl[b * 64 + k] * w; }
#pragma unroll
        for (int b = 0; b < 33; ++b) MODP[(size_t)(ks * 33 + b) * NMOD + col] = acc[b];
        __syncthreads();
    }
}
__device__ __forceinline__ void phase_modreduce(const Ctx cx, const Args& a, LAS unsigned char* lds) {
    const float* MODP = (const float*)(a.ws + WS_MODP); float* MOD = (float*)(a.ws + WS_MOD);
    for (int idx = cx.bid * NTHR + cx.tid; idx < 33 * NMOD; idx += cx.G * NTHR) {
        float s = AIN(I_BADA)[idx % NMOD];
#pragma unroll
        for (int ks = 0; ks < 16; ++ks) s += MODP[(size_t)ks * 33 * NMOD + idx];
        MOD[idx] = s;
    }
    float* GC = (float*)(a.ws + WS_GC);
    for (int idx = cx.bid * NTHR + cx.tid; idx < 2 * D; idx += cx.G * NTHR) { GC[idx] = AIN(I_BR)[idx]; GC[2 * D + idx] = AIN(I_BI)[idx]; GC[4 * D + idx] = 8.0f * log1pf(__expf(-AIN(I_LAM)[idx])); }
}

__device__ __forceinline__ void phase_normmod(const Ctx cx, const Args& a, LAS unsigned char* lds, int g, int mode, int nrows, int sub) {
    const int lane = cx.tid & 63;
    const float* MOD = (const float*)(a.ws + WS_MOD); const float* nw = AIN(I_NORMW) + sub * D;
    const float* H1 = (const float*)(a.ws + WS_H1); bf16_t* U = (bf16_t*)(a.ws + WS_U);
    for (int r = GW(); r < nrows; r += NGW()) {
        const float* src = mode ? H1 + (size_t)r * D : (r < RL ? AIN(I_X) + ((size_t)g * RL + r) * D : AIN(I_CTX) + ((size_t)g * RC + (r - RL)) * D);
        const int mrow = r < RL ? g * BG + r / T : 32;
        const float* sh = MOD + (size_t)mrow * NMOD + (3 * sub) * D; const float* sc = sh + D;
        f32x4 v[4]; float ss = 0.f;
#pragma unroll
        for (int j = 0; j < 4; ++j) { v[j] = ((const f32x4*)src)[lane + 64 * j]; ss += (v[j].x * v[j].x + v[j].y * v[j].y) + (v[j].z * v[j].z + v[j].w * v[j].w); }
        const float rstd = 1.0f / sqrtf(wave_sum(ss) * (1.0f / D) + EPS);
#pragma unroll
        for (int j = 0; j < 4; ++j) { const int c4 = lane + 64 * j; const f32x4 w = ((const f32x4*)nw)[c4], s4 = ((const f32x4*)sh)[c4], c1 = ((const f32x4*)sc)[c4];
            const f32x4 o = v[j] * rstd * w * (c1 + 1.0f) + s4;
            u32x2 p; p.x = cvt_pk_bf16(o.x, o.y); p.y = cvt_pk_bf16(o.z, o.w); ((u32x2*)(U + (size_t)r * D))[c4] = p; }
    }
}
__device__ __forceinline__ void phase_final(const Ctx cx, const Args& a, LAS unsigned char* lds, int g) {
    const int lane = cx.tid & 63; const float* fw = AIN(I_FNW);
    for (int r = GW(); r < RL; r += NGW()) {
        float* row = a.out + ((size_t)g * RL + r) * D;
        f32x4 v[4]; float ss = 0.f;
#pragma unroll
        for (int j = 0; j < 4; ++j) { v[j] = ((const f32x4*)row)[lane + 64 * j]; ss += (v[j].x * v[j].x + v[j].y * v[j].y) + (v[j].z * v[j].z + v[j].w * v[j].w); }
        const float rstd = 1.0f / sqrtf(wave_sum(ss) * (1.0f / D) + EPS);
#pragma unroll
        for (int j = 0; j < 4; ++j) { const int c4 = lane + 64 * j; ((f32x4*)row)[c4] = v[j] * rstd * ((const f32x4*)fw)[c4]; }
    }
}

template <int DIR>
__device__ __forceinline__ void gla_prep_dir(const Ctx cx, const Args& a, LAS unsigned char* lds, const bf16_t* PROJ, int b, int c, int row0, LAS float* fdl, LAS float* lal) {
    const int col = cx.tid, h = col >> 7, d = col & 127;
    float fw[16];
#pragma unroll
    for (int r = 0; r < 16; ++r) fw[r] = AIN(I_FUP)[(size_t)(DIR * 16 + r) * 512 + col];
    const float fbv = AIN(I_FB)[DIR * 512 + col];
    float tot = 0.f;
    for (int i = 0; i < 64; ++i) { float dot = fbv;
#pragma unroll
        for (int r = 0; r < 16; ++r) dot += fdl[i * 32 + DIR * 16 + r] * fw[r];
        const float la = logsigf_(dot) * (1.0f / 16.0f); lal[i * 512] = la; tot += la; }
    const size_t tb = (((size_t)DIR * BG + b) * NCH + c) * 4 + h;
    bf16_t* QD = (bf16_t*)(a.ws + WS_QD) + tb * 8192; bf16_t* KI = (bf16_t*)(a.ws + WS_KI) + tb * 8192; bf16_t* KET = (bf16_t*)(a.ws + WS_KET) + tb * 8192;
    ((float*)(a.ws + WS_BL))[tb * 128 + d] = tot;
    const bool lat = c >= 4;
    float run = 0.f;
    for (int gg = 0; gg < 8; ++gg) { const int gi = DIR ? 7 - gg : gg; float ke[8];
#pragma unroll
        for (int jj = 0; jj < 8; ++jj) { const int ii = DIR ? 7 - jj : jj, i = 8 * gi + ii;
            run += lal[i * 512];
            const float kv = bf2f(PROJ[(size_t)(row0 + i) * PN + PK + col]);
            if (lat) { const float qv = bf2f(PROJ[(size_t)(row0 + i) * PN + PQ + col]);
                QD[i * 128 + d] = f2bf(qv * 0.08838834764831845f * __expf(run)); KI[i * 128 + d] = f2bf(kv * __expf(-run)); }
            ke[ii] = kv * __expf(tot - run); }
        *(u32x4*)(KET + d * 64 + 8 * gi) = pack8(ke); }
}
__device__ __forceinline__ void phase_prep(const Ctx cx, const Args& a, int g, LAS unsigned char* lds) {
    const bf16_t* PROJ = (const bf16_t*)(a.ws + WS_BIG);
    LAS float* fdl = (LAS float*)lds; LAS float* lal = (LAS float*)(lds + 8192) + cx.tid;
    for (int item = cx.bid; item < BG * NCH; item += cx.G) {
        const int b = item / NCH, c = item % NCH;
        const int row0 = c < 4 ? RL + b * CL + c * 64 : b * T + (c - 4) * 64;
        for (int idx = cx.tid; idx < 64 * 32; idx += NTHR) fdl[idx] = bf2f(PROJ[(size_t)(row0 + (idx >> 5)) * PN + PFD + (idx & 31)]);
        __syncthreads();
        gla_prep_dir<0>(cx, a, lds, PROJ, b, c, row0, fdl, lal);
        gla_prep_dir<1>(cx, a, lds, PROJ, b, c, row0, fdl, lal);
        { const int e = cx.tid & 255, hh = cx.tid >> 8;
          for (int h2 = hh; h2 < 4; h2 += 2) { bf16_t* VT = (bf16_t*)(a.ws + WS_VT) + ((((size_t)b * NCH + c) * 4 + h2) * 256 + e) * 64;
              for (int jg = 0; jg < 8; ++jg) { float v[8];
#pragma unroll
                  for (int jj = 0; jj < 8; ++jj) v[jj] = bf2f(PROJ[(size_t)(row0 + 8 * jg + jj) * PN + PV + h2 * 256 + e]);
                  *(u32x4*)(VT + 8 * jg) = pack8(v); } } }
        __syncthreads();
    }
    bf16_t* XC = (bf16_t*)(a.ws + WS_XC);
    for (int idx = cx.bid * NTHR + cx.tid; idx < RG * 128; idx += cx.G * NTHR) {
        const int row = idx >> 7, c8 = (idx & 127) * 8;
        const int pos = row < RL ? (row & 63) : ((row - RL) & 255), len = row < RL ? 64 : 256;
        float acc[8];
#pragma unroll
        for (int i = 0; i < 8; ++i) acc[i] = AIN(I_CONVB)[c8 + i];
#pragma unroll
        for (int j = 0; j < 4; ++j) { const int p = pos + j - 2;
            if (p >= 0 && p < len) { float xv[8]; unpack8(*(const u32x4*)(PROJ + (size_t)(row + j - 2) * PN + PXL + c8), xv);
#pragma unroll
                for (int i = 0; i < 8; ++i) acc[i] += AIN(I_CONVW)[j * D + c8 + i] * xv[i]; } }
        *(u32x4*)(XC + (size_t)row * D + c8) = pack8(acc);
    }
}


__device__ __forceinline__ void phase_gatefix(const Ctx cx, const Args& a, LAS unsigned char* lds) {
    bf16_t* LA = (bf16_t*)(a.ws + WS_LA); bf16_t* UU = (bf16_t*)(a.ws + WS_UU); const bf16_t* XC = (const bf16_t*)(a.ws + WS_XC); const float* GC = (const float*)(a.ws + WS_GC);
    for (int idx = cx.bid * NTHR + cx.tid; idx < 2 * RG * 128; idx += cx.G * NTHR) {
        const int dir = idx >= RG * 128, rem = idx - dir * RG * 128, row = rem >> 7, c8 = (rem & 127) * 8;
        const size_t off = (size_t)dir * RG * D + (size_t)row * D + c8;
        float r[8], ig[8], xc[8]; unpack8(*(const u32x4*)(LA + off), r); unpack8(*(const u32x4*)(UU + off), ig); unpack8(*(const u32x4*)(XC + (size_t)row * D + c8), xc);
#pragma unroll
        for (int i = 0; i < 8; ++i) { const float l = -GC[(4 + dir) * D + c8 + i] * sigmoidf_(r[i] + GC[dir * D + c8 + i]);
            const float gi = sigmoidf_(ig[i] + GC[(2 + dir) * D + c8 + i]);
            r[i] = l; ig[i] = __builtin_amdgcn_sqrtf(fmaxf(one_minus_exp(2.0f * l), 0.f)) * gi * xc[i]; }
        *(u32x4*)(LA + off) = pack8(r); *(u32x4*)(UU + off) = pack8(ig);
    }
}

__device__ __forceinline__ int img_off(int nkg, int row, int kcol) { const int ob = (row & 15) * 64 + (kcol & 31) * 2; return ((row >> 4) * nkg + (kcol >> 5)) * 1024 + (ob ^ (((ob >> 9) & 1) << 5)); }
__device__ __forceinline__ bf16x8 ldfrag(const LAS unsigned char* img, int nkg, int row, int kcol) { return *(const LAS bf16x8*)(img + img_off(nkg, row, kcol)); }
#define MFMA16(a, b, c) __builtin_amdgcn_mfma_f32_16x16x32_bf16((a), (b), (c), 0, 0, 0)

__device__ __forceinline__ void phase_gla_scan(const Ctx cx, const Args& a, int g, LAS unsigned char* lds) {
    constexpr int XB = 57344, OFF_KI = 16384, OFF_KET = 32768, OFF_VT = 49152, OFF_P = 2 * XB, OFF_ST = OFF_P + 8192, OFF_BL = OFF_ST + 2 * 16384;
    static_assert(OFF_BL + 1024 <= LDS_BYTES, "gla scan LDS");
    const int tid = cx.tid, lane = tid & 63, w = tid >> 6, fr = lane & 15, fq = lane >> 4;
    const bf16_t* QDg = (const bf16_t*)(a.ws + WS_QD); const bf16_t* KIg = (const bf16_t*)(a.ws + WS_KI); const bf16_t* KETg = (const bf16_t*)(a.ws + WS_KET);
    const bf16_t* VTg = (const bf16_t*)(a.ws + WS_VT); const float* BLg = (const float*)(a.ws + WS_BL);
    bf16_t* Og = (bf16_t*)(a.ws + WS_OFB);
    for (int item = cx.bid; item < BG * 32; item += cx.G) {
        const int dvq = item & 3, dir = (item >> 2) & 1, h = (item >> 3) & 3, b = item >> 5;
        { u32x4 z = {0u, 0u, 0u, 0u}; *(LAS u32x4*)(lds + OFF_ST + tid * 32) = z; *(LAS u32x4*)(lds + OFF_ST + tid * 32 + 16) = z; }
        f32x4 accS[4];
#pragma unroll
        for (int t = 0; t < 4; ++t) accS[t] = (f32x4){0.f, 0.f, 0.f, 0.f};
        u32x4 pq[2], pk[2], pe[2], pv; float pbl = 0.f;
#define GLA_LOAD(s_) do { const int c_ = dir == 0 ? (s_) : ((s_) < 4 ? 3 - (s_) : 39 - (s_)); \
            const size_t tb_ = (((size_t)dir * BG + b) * NCH + c_) * 4 + h; \
            if (c_ >= 4) { pq[0] = ((const u32x4*)(QDg + tb_ * 8192))[tid]; pq[1] = ((const u32x4*)(QDg + tb_ * 8192))[tid + 512]; \
                           pk[0] = ((const u32x4*)(KIg + tb_ * 8192))[tid]; pk[1] = ((const u32x4*)(KIg + tb_ * 8192))[tid + 512]; } \
            pe[0] = ((const u32x4*)(KETg + tb_ * 8192))[tid]; pe[1] = ((const u32x4*)(KETg + tb_ * 8192))[tid + 512]; \
            pv = ((const u32x4*)(VTg + ((((size_t)b * NCH + c_) * 4 + h) * 256 + dvq * 64) * 64))[tid]; \
            if (tid < 128) pbl = BLg[tb_ * 128 + tid]; } while (0)
#define GLA_STORE(buf_) do { LAS unsigned char* X_ = lds + (buf_) * XB; \
            _Pragma("unroll") for (int i_ = 0; i_ < 2; ++i_) { const int p_ = tid + 512 * i_; \
                *(LAS u32x4*)(X_ + img_off(4, p_ >> 4, (p_ & 15) * 8)) = pq[i_]; *(LAS u32x4*)(X_ + OFF_KI + img_off(4, p_ >> 4, (p_ & 15) * 8)) = pk[i_]; \
                *(LAS u32x4*)(X_ + OFF_KET + img_off(2, p_ >> 3, (p_ & 7) * 8)) = pe[i_]; } \
            *(LAS u32x4*)(X_ + OFF_VT + img_off(2, tid >> 3, (tid & 7) * 8)) = pv; \
            if (tid < 128) ((LAS float*)(lds + OFF_BL + (buf_) * 512))[tid] = pbl; } while (0)
        pq[0] = pq[1] = pk[0] = pk[1] = (u32x4){0u, 0u, 0u, 0u};
        GLA_LOAD(0); GLA_STORE(0);
        __syncthreads();
        for (int s = 0; s < NCH; ++s) {
            const int cur = s & 1; const bool lat = s >= 4;
            const LAS unsigned char* X = lds + cur * XB;
#ifndef GLA_SAFE
            if (s + 1 < NCH) GLA_LOAD(s + 1);
#endif
            if (lat) {
                const int ti = w >> 1, tj0 = (w & 1) * 2;
                f32x4 sc[2] = {(f32x4){0.f, 0.f, 0.f, 0.f}, (f32x4){0.f, 0.f, 0.f, 0.f}};
#pragma unroll
                for (int kk = 0; kk < 4; ++kk) { const bf16x8 qa = ldfrag(X, 4, 16 * ti + fr, kk * 32 + fq * 8);
#pragma unroll
                    for (int t = 0; t < 2; ++t) { const bf16x8 kb = ldfrag(X + OFF_KI, 4, 16 * (tj0 + t) + fr, kk * 32 + fq * 8); sc[t] = MFMA16(qa, kb, sc[t]); } }
#pragma unroll
                for (int t = 0; t < 2; ++t)
#pragma unroll
                    for (int jj = 0; jj < 4; ++jj) { const int i = 16 * ti + 4 * fq + jj, j = 16 * (tj0 + t) + fr;
                        const bool keep = dir == 0 ? (j <= i) : (j > i);
                        *(LAS bf16_t*)(lds + OFF_P + img_off(2, i, j)) = f2bf(keep ? sc[t][jj] : 0.f); }
            }
            __syncthreads();
            const int te = w >> 1;
            if (lat) {
                const int c = dir == 0 ? s : 39 - s;
                const LAS unsigned char* STc = lds + OFF_ST + cur * 16384;
                f32x4 oc[2] = {(f32x4){0.f, 0.f, 0.f, 0.f}, (f32x4){0.f, 0.f, 0.f, 0.f}};
#pragma unroll
                for (int kk = 0; kk < 2; ++kk) { const bf16x8 va = ldfrag(X + OFF_VT, 2, 16 * te + fr, kk * 32 + fq * 8);
#pragma unroll
                    for (int t = 0; t < 2; ++t) { const bf16x8 pb = ldfrag(lds + OFF_P, 2, 16 * ((w & 1) * 2 + t) + fr, kk * 32 + fq * 8); oc[t] = MFMA16(va, pb, oc[t]); } }
#pragma unroll
                for (int kk = 0; kk < 4; ++kk) { const bf16x8 sa = ldfrag(STc, 4, 16 * te + fr, kk * 32 + fq * 8);
#pragma unroll
                    for (int t = 0; t < 2; ++t) { const bf16x8 qb = ldfrag(X, 4, 16 * ((w & 1) * 2 + t) + fr, kk * 32 + fq * 8); oc[t] = MFMA16(sa, qb, oc[t]); } }
#pragma unroll
                for (int t = 0; t < 2; ++t) { const int i = 16 * ((w & 1) * 2 + t) + fr; const size_t row = (size_t)b * T + (size_t)(c - 4) * 64 + i;
                    u32x2 o2; o2.x = cvt_pk_bf16(oc[t][0], oc[t][1]); o2.y = cvt_pk_bf16(oc[t][2], oc[t][3]);
                    *(u32x2*)(Og + ((size_t)dir * RL + row) * D + h * 256 + dvq * 64 + 16 * te + 4 * fq) = o2; }
            }
#ifdef GLA_SAFE
            __syncthreads();
#endif
            {
                const LAS float* blp = (const LAS float*)(lds + OFF_BL + cur * 512);
                LAS unsigned char* STn = lds + OFF_ST + (cur ^ 1) * 16384;
                bf16x8 vb[2];
#pragma unroll
                for (int kk = 0; kk < 2; ++kk) vb[kk] = ldfrag(X + OFF_VT, 2, 16 * te + fr, kk * 32 + fq * 8);
#pragma unroll
                for (int t = 0; t < 4; ++t) { const int td = (w & 1) * 4 + t;
#pragma unroll
                    for (int jj = 0; jj < 4; ++jj) accS[t][jj] *= __expf(blp[16 * td + 4 * fq + jj]);
#pragma unroll
                    for (int kk = 0; kk < 2; ++kk) { const bf16x8 ka = ldfrag(X + OFF_KET, 2, 16 * td + fr, kk * 32 + fq * 8); accS[t] = MFMA16(ka, vb[kk], accS[t]); }
                    u32x2 s2; s2.x = cvt_pk_bf16(accS[t][0], accS[t][1]); s2.y = cvt_pk_bf16(accS[t][2], accS[t][3]);
                    *(LAS u32x2*)(STn + img_off(4, 16 * te + fr, 16 * td + 4 * fq)) = s2; }
            }
#ifdef GLA_SAFE
            __syncthreads();
            if (s + 1 < NCH) { GLA_LOAD(s + 1); GLA_STORE(cur ^ 1); }
#else
            if (s + 1 < NCH) GLA_STORE(cur ^ 1);
#endif
            __syncthreads();
        }
#undef GLA_LOAD
#undef GLA_STORE
    }
}

__device__ __forceinline__ void phase_lru_scan(const Ctx cx, const Args& a, int g, LAS unsigned char* lds) {
    const int lane = cx.tid & 63, w = cx.tid >> 6;
    LAS f32x2* agg = (LAS f32x2*)lds;
    for (int item = cx.bid; item < BG * 32; item += cx.G) {
        const int cgp = item & 15, dir = (item >> 4) & 1, b = item >> 5, ch = cgp * 64 + lane;
        const bf16_t* LA = (const bf16_t*)(a.ws + WS_LA) + (size_t)dir * RG * D + ch; const bf16_t* UU = (const bf16_t*)(a.ws + WS_UU) + (size_t)dir * RG * D + ch;
        bf16_t* Hd = (bf16_t*)(a.ws + WS_HFB) + (size_t)dir * RL * D + ch;
#define LRU_ROW(s_) ((s_) < CL ? RL + b * CL + (dir ? CL - 1 - (s_) : (s_)) : b * T + (dir ? T - 1 - ((s_) - CL) : (s_) - CL))
        float A = 1.f, Z = 0.f;
        for (int blk = 0; blk < 9; ++blk) { const int s0 = 288 * w + 32 * blk; bf16_t la[32], uu[32];
#pragma unroll
            for (int k = 0; k < 32; ++k) { const size_t r = (size_t)LRU_ROW(s0 + k); la[k] = LA[r * D]; uu[k] = UU[r * D]; }
#pragma unroll
            for (int k = 0; k < 32; ++k) { const float av = __expf(bf2f(la[k])); Z = av * Z + bf2f(uu[k]); A *= av; } }
        agg[w * 64 + lane] = (f32x2){A, Z};
        __syncthreads();
        float hst = 0.f;
#pragma unroll
        for (int w2 = 0; w2 < 7; ++w2) { const f32x2 p = agg[w2 * 64 + lane]; if (w2 < w) hst = p.x * hst + p.y; }
        for (int blk = 0; blk < 9; ++blk) { const int s0 = 288 * w + 32 * blk; bf16_t la[32], uu[32];
#pragma unroll
            for (int k = 0; k < 32; ++k) { const size_t r = (size_t)LRU_ROW(s0 + k); la[k] = LA[r * D]; uu[k] = UU[r * D]; }
#pragma unroll
            for (int k = 0; k < 32; ++k) { const float av = __expf(bf2f(la[k])); hst = av * hst + bf2f(uu[k]);
                if (s0 + k >= CL) Hd[(size_t)LRU_ROW(s0 + k) * D] = f2bf(hst); } }
        __syncthreads();
#undef LRU_ROW
    }
}

__device__ __forceinline__ void phase_post(const Ctx cx, const Args& a, LAS unsigned char* lds, int g) {
    const int lane = cx.tid & 63;
    const bf16_t* PROJ = (const bf16_t*)(a.ws + WS_BIG);
    bf16_t* O0 = (bf16_t*)(a.ws + WS_OFB); const bf16_t* O1 = O0 + (size_t)RL * D;
    bf16_t* H0 = (bf16_t*)(a.ws + WS_HFB); const bf16_t* H1b = H0 + (size_t)RL * D;
    const float* gnw = AIN(I_GNW);
    for (int r = GW(); r < RL; r += NGW()) {
        const size_t off = (size_t)r * D + lane * 16;
        float o[16], t[8]; float ss = 0.f;
#pragma unroll
        for (int hf = 0; hf < 2; ++hf) { float x0[8], x1[8]; unpack8(*(const u32x4*)(O0 + off + 8 * hf), x0); unpack8(*(const u32x4*)(O1 + off + 8 * hf), x1);
#pragma unroll
            for (int i = 0; i < 8; ++i) { o[8 * hf + i] = x0[i] + x1[i]; ss += o[8 * hf + i] * o[8 * hf + i]; } }
        ss += __shfl_xor(ss, 1); ss += __shfl_xor(ss, 2); ss += __shfl_xor(ss, 4); ss += __shfl_xor(ss, 8);
        const float rstd = 1.0f / sqrtf(ss * (1.0f / 256.0f) + EPS);
#pragma unroll
        for (int hf = 0; hf < 2; ++hf) { float gg[8]; unpack8(*(const u32x4*)(PROJ + (size_t)r * PN + PGG + lane * 16 + 8 * hf), gg);
#pragma unroll
            for (int i = 0; i < 8; ++i) t[i] = o[8 * hf + i] * rstd * gnw[(lane & 15) * 16 + 8 * hf + i] * siluf_(gg[i]);
            *(u32x4*)(O0 + off + 8 * hf) = pack8(t); }
#pragma unroll
        for (int hf = 0; hf < 2; ++hf) { float x0[8], x1[8], yl[8]; unpack8(*(const u32x4*)(H0 + off + 8 * hf), x0); unpack8(*(const u32x4*)(H1b + off + 8 * hf), x1);
            unpack8(*(const u32x4*)(PROJ + (size_t)r * PN + PYL + lane * 16 + 8 * hf), yl);
#pragma unroll
            for (int i = 0; i < 8; ++i) t[i] = (x0[i] + x1[i]) * geluf_(yl[i]);
            *(u32x4*)(H0 + off + 8 * hf) = pack8(t); }
    }
}


#define XB_TMO      128
#define XB_XCNT(j)  (256  + 64 * (j))
#define XB_XSUB(j)  (1280 + 64 * (j))
#define XB_XGEN(j)  (2304 + 64 * (j))
#define XB_TOP      3328
#define XB_TOPGEN   3392
#define XCD_BAR_WORDS 3456
#define XB_SPIN_CAP (1u << 22)
__device__ __forceinline__ unsigned xb_ld(unsigned* p)              { return __hip_atomic_load(p, __ATOMIC_RELAXED, __HIP_MEMORY_SCOPE_AGENT); }
__device__ __forceinline__ unsigned xb_add(unsigned* p, unsigned v) { return __hip_atomic_fetch_add(p, v, __ATOMIC_RELAXED, __HIP_MEMORY_SCOPE_AGENT); }
__device__ __forceinline__ unsigned xb_xcc_id() { return (unsigned)__builtin_amdgcn_s_getreg((3 << 11) | 20) & 0xFu; }
#define XB_SPIN(cond, bar) do { unsigned _sp = 0; while (cond) { __builtin_amdgcn_s_sleep(1); \
    if ((++_sp & 255u) == 0u) { if (xb_ld(&(bar)[XB_TMO])) break; if (_sp > XB_SPIN_CAP) { atomicAdd(&(bar)[XB_TMO], 1u); break; } } } } while (0)
__device__ __forceinline__ void xcd_barrier_complete(unsigned* bar, unsigned x, unsigned G, unsigned& nloc, unsigned& nx) {
    unsigned sum, cnt, mine, sp = 0u;
    for (;;) {
        sum = 0u; cnt = 0u; mine = 0u;
#pragma unroll
        for (unsigned j = 0; j < 16; ++j) { const unsigned c = xb_ld(&bar[XB_XCNT(j)]); sum += c; cnt += (c > 0u) ? 1u : 0u; mine = (j == x) ? c : mine; }
        if (sum == G) break;
        __builtin_amdgcn_s_sleep(1);
        if ((++sp & 255u) == 0u) { if (xb_ld(&bar[XB_TMO])) break; if (sp > XB_SPIN_CAP) { atomicAdd(&bar[XB_TMO], 1u); break; } }
    }
    nloc = mine > 0u ? mine : 1u; nx = cnt > 0u ? cnt : 1u;
}
__device__ __forceinline__ void xcd_barrier(unsigned* bar, volatile LAS unsigned* st, int tid, unsigned G) {
    asm volatile("s_waitcnt vmcnt(0)" ::: "memory");
    __syncthreads();
    if (tid == 0) {
        __builtin_amdgcn_s_waitcnt(0);
        const unsigned x = xb_xcc_id();
        unsigned nloc = st[0], nx = st[1];
        if (nloc == 0u) { xcd_barrier_complete(bar, x, G, nloc, nx); st[0] = nloc; st[1] = nx; }
        const unsigned old = xb_add(&bar[XB_XSUB(x)], 1u);
        const unsigned gen = old / nloc;
        if (old + 1u == (gen + 1u) * nloc) {
            __builtin_amdgcn_fence(__ATOMIC_RELEASE, "agent");
            asm volatile("s_waitcnt vmcnt(0)" ::: "memory");
            const unsigned og = xb_add(&bar[XB_TOP], 1u);
            const unsigned tg = og / nx;
            if (og + 1u == (tg + 1u) * nx) xb_add(&bar[XB_TOPGEN], 1u);
            else XB_SPIN(xb_ld(&bar[XB_TOPGEN]) == tg, bar);
            __builtin_amdgcn_fence(__ATOMIC_ACQUIRE, "agent");
            xb_add(&bar[XB_XGEN(x)], 1u);
            asm volatile("s_waitcnt vmcnt(0)" ::: "memory");
        } else {
            XB_SPIN(xb_ld(&bar[XB_XGEN(x)]) == gen, bar);
            __builtin_amdgcn_fence(__ATOMIC_ACQUIRE, "agent");
            asm volatile("s_waitcnt vmcnt(0)" ::: "memory");
        }
    }
    __syncthreads();
}

constexpr int NPH = 17;
#ifndef USE_CG_ALL
#define USE_CG_ALL 0
#endif
#if ONE_LAUNCH
#define GRID_SYNC(k) do { if ((k) == 1 || USE_CG_ALL) cg::this_grid().sync(); else xcd_barrier((unsigned*)ws + 4096, (volatile LAS unsigned*)(lds + PTAB + 256), cx.tid, (unsigned)cx.G); } while (0)
#else
#define GRID_SYNC(k) do {} while (0)
#endif
#define STEP_BEGIN(k) if (a.lo <= (k) && (k) < a.hi) { \
        Ctx cx; { int t_ = wave_s * 64 + (int)__builtin_amdgcn_mbcnt_hi(~0u, __builtin_amdgcn_mbcnt_lo(~0u, 0u)), b_ = blockIdx.x, g_ = gridDim.x; asm volatile("" : "+v"(t_)); asm volatile("" : "+s"(b_), "+s"(g_)); cx.tid = t_; cx.bid = b_; cx.G = g_; } \
        const int G = cx.G, cidx = cx.bid; (void)G; (void)cidx; \
        unsigned char* ws = a.ws; asm volatile("" : "+s"(ws)); \
        if ((k) > a.lo) GRID_SYNC(k); \
        const float* MOD = (const float*)(ws + WS_MOD); float* H1 = (float*)(ws + WS_H1); bf16_t* U = (bf16_t*)(ws + WS_U); bf16_t* BIG = (bf16_t*)(ws + WS_BIG); bf16_t* XC = (bf16_t*)(ws + WS_XC); \
        (void)MOD; (void)H1; (void)U; (void)BIG; (void)XC; pg8::StaticOrder S; (void)S;
#define STEP_END }

template <int g>
__device__ __forceinline__ void run_group(const Args& a, LAS unsigned char* lds, const int wave_s) {
    constexpr int s0 = 2 + g * NPH;
    STEP_BEGIN(s0 + 0) if (PHON(0)) phase_normmod(cx, a, lds, g, 0, RG, 0); STEP_END
    STEP_BEGIN(s0 + 1) if (PHON(1)) { pg8::Gemm gm{U, (const bf16_t*)(ws + WS_WI1), RG, 2 * FH, D, D, D, 0, 0}; S.init(RG, 2 * FH, G, cidx);
                  pg8::EpiSwiglu E{BIG, FH}; pg8::gemm_phase<pg8::EpiSwiglu, true>(cx.tid, lds, gm, S, E); } STEP_END
    STEP_BEGIN(s0 + 2) if (PHON(2)) { pg8::Gemm gm{BIG, (const bf16_t*)(ws + WS_WO1), RG, D, FH, FH, FH, 0, 0}; S.init(RG, D, G, cidx);
                  pg8::EpiResid E{AIN(I_X) + (size_t)g * RL * D, AIN(I_CTX) + (size_t)g * RC * D, H1, H1 + (size_t)RL * D,
                                  MOD + (size_t)(g * BG) * NMOD + 2 * D, MOD + (size_t)32 * NMOD + 2 * D, 0.5f, RL / 256};
                  pg8::gemm_phase<pg8::EpiResid, true>(cx.tid, lds, gm, S, E); } STEP_END
    STEP_BEGIN(s0 + 3) if (PHON(3)) phase_normmod(cx, a, lds, g, 1, RG, 1); STEP_END
    STEP_BEGIN(s0 + 4) if (PHON(4)) { pg8::Gemm gm{U, (const bf16_t*)(ws + WS_WIN), RG, PN, D, D, D, 0, 0}; S.init(RG, PN, G, cidx);
                  pg8::EpiBf16 E{BIG, PN}; pg8::gemm_phase<pg8::EpiBf16, true>(cx.tid, lds, gm, S, E); } STEP_END
    STEP_BEGIN(s0 + 5) if (PHON(5)) phase_prep(cx, a, g, lds); STEP_END
    STEP_BEGIN(s0 + 6) if (PHON(6)) { pg8::Gemm gm{XC, (const bf16_t*)(ws + WS_WLG), RG, 4096, 128, D, 128, 1, 256}; S.init(RG, 4096, G, cidx);
                  pg8::EpiGate E{(bf16_t*)(ws + WS_LA), (bf16_t*)(ws + WS_UU)};
                  pg8::gemm_phase<pg8::EpiGate, true>(cx.tid, lds, gm, S, E); } STEP_END
    STEP_BEGIN(s0 + 7) if (PHON(7)) { phase_gatefix(cx, a, lds); phase_gla_scan(cx, a, g, lds); } STEP_END
    STEP_BEGIN(s0 + 8) if (PHON(8)) phase_lru_scan(cx, a, g, lds); STEP_END
    STEP_BEGIN(s0 + 9) if (PHON(9)) phase_post(cx, a, lds, g); STEP_END
    STEP_BEGIN(s0 + 10) if (PHON(10)) { pg8::Gemm gm{(const bf16_t*)(ws + WS_OFB), (const bf16_t*)(ws + WS_WOG), RL, D, D, D, D, 0, 0}; S.init(RL, D, G, cidx);
                   pg8::EpiMix<false> E{BIG, PGA, XC}; pg8::gemm_phase<pg8::EpiMix<false>, true>(cx.tid, lds, gm, S, E); } STEP_END
    STEP_BEGIN(s0 + 11) if (PHON(11)) { pg8::Gemm gm{(const bf16_t*)(ws + WS_HFB), (const bf16_t*)(ws + WS_WOL), RL, D, D, D, D, 0, 0}; S.init(RL, D, G, cidx);
                   pg8::EpiMix<true> E{BIG, PGB, XC}; pg8::gemm_phase<pg8::EpiMix<true>, true>(cx.tid, lds, gm, S, E); } STEP_END
    STEP_BEGIN(s0 + 12) if (PHON(12)) { pg8::Gemm gm{XC, (const bf16_t*)(ws + WS_WOO), RL, D, D, D, D, 0, 0}; S.init(RL, D, G, cidx);
                   pg8::EpiResid E{H1, H1, H1, H1, MOD + (size_t)(g * BG) * NMOD + 5 * D, MOD, 1.0f, RL / 256};
                   pg8::gemm_phase<pg8::EpiResid, true>(cx.tid, lds, gm, S, E); } STEP_END
    STEP_BEGIN(s0 + 13) if (PHON(13)) phase_normmod(cx, a, lds, g, 1, RL, 2); STEP_END
    STEP_BEGIN(s0 + 14) if (PHON(14)) { pg8::Gemm gm{U, (const bf16_t*)(ws + WS_WI2), RL, 2 * FH, D, D, D, 0, 0}; S.init(RL, 2 * FH, G, cidx);
                   pg8::EpiSwiglu E{BIG, FH}; pg8::gemm_phase<pg8::EpiSwiglu, true>(cx.tid, lds, gm, S, E); } STEP_END
    STEP_BEGIN(s0 + 15) if (PHON(15)) { pg8::Gemm gm{BIG, (const bf16_t*)(ws + WS_WO2), RL, D, FH, FH, FH, 0, 0}; S.init(RL, D, G, cidx);
                   float* og = a.out + (size_t)g * RL * D;
                   pg8::EpiResid E{H1, H1, og, og, MOD + (size_t)(g * BG) * NMOD + 8 * D, MOD, 0.5f, RL / 256};
                   pg8::gemm_phase<pg8::EpiResid, true>(cx.tid, lds, gm, S, E); } STEP_END
    STEP_BEGIN(s0 + 16) if (PHON(16)) phase_final(cx, a, lds, g); STEP_END
}

__global__ void __launch_bounds__(NTHR, 2) fwd_kernel(Args a) {
    extern __shared__ __attribute__((aligned(16))) unsigned char lds_raw[];
    LAS unsigned char* lds = (LAS unsigned char*)lds_raw;
    if (threadIdx.x < 26) ((LAS unsigned long long*)(lds + PTAB))[threadIdx.x] = (unsigned long long)a.in[threadIdx.x];
    if (threadIdx.x == 32) { ((LAS unsigned*)(lds + PTAB + 256))[0] = 0u; ((LAS unsigned*)(lds + PTAB + 256))[1] = 0u; }
#if ONE_LAUNCH
    if (threadIdx.x == 0) (void)xb_add((unsigned*)a.ws + 4096 + XB_XCNT(xb_xcc_id()), 1u);
#endif
    const int wave_s = __builtin_amdgcn_readfirstlane(threadIdx.x >> 6);
    __syncthreads();
    STEP_BEGIN(0) if (PHON(17)) phase_weights(cx, a, lds); STEP_END
    STEP_BEGIN(1) if (PHON(18)) phase_modreduce(cx, a, lds); STEP_END
    run_group<0>(a, lds, wave_s);
    run_group<1>(a, lds, wave_s);
    run_group<2>(a, lds, wave_s);
    run_group<3>(a, lds, wave_s);
}


#ifdef PROBE_STEP
__global__ void probe_kernel(const unsigned char* ws, float* out) {
    const size_t n = (size_t)65536 * 1024, q = n / 4;
    const bf16_t* r0 = (const bf16_t*)(ws + PROBE_R0); const bf16_t* r1 = (const bf16_t*)(ws + PROBE_R1); const bf16_t* r2 = (const bf16_t*)(ws + PROBE_R2); const bf16_t* r3 = (const bf16_t*)(ws + PROBE_R3);
    for (size_t i = (size_t)blockIdx.x * blockDim.x + threadIdx.x; i < q; i += (size_t)gridDim.x * blockDim.x) {
        out[i] = bf2f(r0[i]); out[q + i] = bf2f(r1[i]); out[2 * q + i] = bf2f(r2[i]); out[3 * q + i] = bf2f(r3[i]); }
}
#endif
extern "C" void kernel_launch(void* const* d_in, const int* in_sizes, int n_in, void* d_out, int out_size, void* d_ws, size_t ws_size, hipStream_t stream) {
    static int grid = 0;
    if (grid == 0) {
        if (n_in != 26 || ws_size < WS_END) { fprintf(stderr, "kernel_launch: unexpected inputs (n_in %d, ws %zu, need %zu)\n", n_in, ws_size, (size_t)WS_END); grid = -1; return; }
        int dev = 0, cus = 0, per_cu = 0;
        hipGetDevice(&dev); hipDeviceGetAttribute(&cus, hipDeviceAttributeMultiprocessorCount, dev);
        if (hipFuncSetAttribute((const void*)fwd_kernel, hipFuncAttributeMaxDynamicSharedMemorySize, LDS_BYTES) != hipSuccess) { fprintf(stderr, "kernel_launch: hipFuncSetAttribute failed\n"); grid = -1; return; }
        hipOccupancyMaxActiveBlocksPerMultiprocessor(&per_cu, (const void*)fwd_kernel, NTHR, LDS_BYTES);
        (void)hipGetLastError();
        if (per_cu < 1) per_cu = 1;
        grid = cus * 1;
    }
    if (grid < 0) return;
    Args a{};
    for (int i = 0; i < 26; ++i) a.in[i] = (const float*)d_in[i];
    a.out = (float*)d_out; a.ws = (unsigned char*)d_ws;
    const int nsteps = 2 + NG * NPH;
#if ONE_LAUNCH
    (void)hipMemsetAsync(d_ws, 0, 65536, stream);
    a.lo = 0; a.hi = nsteps;
    void* args[] = {&a};
    hipError_t e = hipLaunchCooperativeKernel((const void*)fwd_kernel, dim3(grid), dim3(NTHR), args, LDS_BYTES, stream);
    if (e != hipSuccess) fprintf(stderr, "cooperative launch failed: %s (grid %d)\n", hipGetErrorString(e), grid);
#else
#ifdef PROBE_STEP
    for (int s = 0; s <= PROBE_STEP; ++s) { a.lo = s; a.hi = s + 1; hipLaunchKernelGGL(fwd_kernel, dim3(grid), dim3(NTHR), LDS_BYTES, stream, a); }
    hipLaunchKernelGGL(probe_kernel, dim3(2048), dim3(256), 0, stream, (const unsigned char*)d_ws, (float*)d_out);
#else
    for (int s = 0; s < nsteps; ++s) { a.lo = s; a.hi = s + 1; hipLaunchKernelGGL(fwd_kernel, dim3(grid), dim3(NTHR), LDS_BYTES, stream, a); }
#endif
#endif
}
```

```cpp
#include <hip/hip_runtime.h>
#include <hip/hip_cooperative_groups.h>
#include <cstdio>
#include <cstdint>
namespace cg = cooperative_groups;

#ifndef ONE_LAUNCH
#define ONE_LAUNCH 1
#endif

#ifndef PHMASK
#define PHMASK 0x1fffff
#endif
#define PHON(n) (((PHMASK) >> (n)) & 1)
#define LAS __attribute__((address_space(3)))
typedef unsigned short bf16_t;
typedef short bf16x8 __attribute__((ext_vector_type(8)));
typedef float f32x4 __attribute__((ext_vector_type(4)));
typedef float f32x2 __attribute__((ext_vector_type(2)));
typedef unsigned u32x4 __attribute__((ext_vector_type(4)));
typedef unsigned u32x2 __attribute__((ext_vector_type(2)));

constexpr int D = 1024, NB = 32, T = 2048, CL = 256, FH = 2816, INW = 7200, PN = 7424, NMOD = 9216;
constexpr int NG = 4, BG = NB / NG;
constexpr int RL = BG * T, RC = BG * CL, RG = RL + RC;
constexpr int NCH = 36;
constexpr float EPS = 1e-6f;
constexpr int PQ = 0, PK = 512, PV = 1024, PGG = 2048, PXL = 3072, PYL = 4096, PGA = 5120, PGB = 6144, PFD = 7168;

constexpr size_t al(size_t x) { return (x + 4095) & ~(size_t)4095; }
constexpr size_t WS_WI1 = 1 << 20;
constexpr size_t WS_WO1 = WS_WI1 + al((size_t)2 * FH * D * 2);
constexpr size_t WS_WI2 = WS_WO1 + al((size_t)D * FH * 2);
constexpr size_t WS_WO2 = WS_WI2 + al((size_t)2 * FH * D * 2);
constexpr size_t WS_WIN = WS_WO2 + al((size_t)D * FH * 2);
constexpr size_t WS_WOG = WS_WIN + al((size_t)PN * D * 2);
constexpr size_t WS_WOL = WS_WOG + al((size_t)D * D * 2);
constexpr size_t WS_WOO = WS_WOL + al((size_t)D * D * 2);
constexpr size_t WS_WLG = WS_WOO + al((size_t)D * D * 2);
constexpr size_t WS_MODP = WS_WLG + al((size_t)4096 * 128 * 2);
constexpr size_t WS_MOD = WS_MODP + al((size_t)16 * 33 * NMOD * 4);
constexpr size_t WS_GC = WS_MOD + al((size_t)33 * NMOD * 4);
constexpr size_t WS_H1 = WS_GC + al((size_t)6 * D * 4);
constexpr size_t WS_U = WS_H1 + al((size_t)RG * D * 4);
constexpr size_t WS_BIG = WS_U + al((size_t)RG * D * 2);
constexpr size_t WS_XC = WS_BIG + al((size_t)RG * PN * 2);
constexpr size_t WS_LA = WS_XC + al((size_t)RG * D * 2);
constexpr size_t WS_UU = WS_LA + al((size_t)2 * RG * D * 2);
constexpr size_t WS_HFB = WS_UU + al((size_t)2 * RG * D * 2);
constexpr size_t WS_OFB = WS_HFB + al((size_t)2 * RL * D * 2);
constexpr size_t GT = (size_t)2 * BG * NCH * 4;
constexpr size_t WS_QD = WS_OFB + al((size_t)2 * RL * D * 2);
constexpr size_t WS_KI = WS_QD + al(GT * 8192 * 2);
constexpr size_t WS_KET = WS_KI + al(GT * 8192 * 2);
constexpr size_t WS_VT = WS_KET + al(GT * 8192 * 2);
constexpr size_t WS_BL = WS_VT + al((size_t)BG * NCH * 4 * 16384 * 2);
constexpr size_t WS_END = WS_BL + al(GT * 128 * 4);
static_assert(WS_END <= (size_t)1073741824, "workspace map exceeds 1 GiB");

constexpr int LDS_BYTES = 163840, PTAB = LDS_BYTES - 512;

typedef __bf16 bf16x2_t __attribute__((ext_vector_type(2)));
__device__ __forceinline__ unsigned cvt_pk_bf16(float lo, float hi) { const f32x2 v = {lo, hi}; return __builtin_bit_cast(unsigned, __builtin_convertvector(v, bf16x2_t)); }
__device__ __forceinline__ bf16_t f2bf(float f) { return (bf16_t)(cvt_pk_bf16(f, 0.f) & 0xffffu); }
__device__ __forceinline__ float bf2f(bf16_t h) { return __uint_as_float(((unsigned)h) << 16); }
__device__ __forceinline__ float bflo(unsigned w) { return __uint_as_float(w << 16); }
__device__ __forceinline__ float bfhi(unsigned w) { return __uint_as_float(w & 0xffff0000u); }
__device__ __forceinline__ float sigmoidf_(float x) { return __builtin_amdgcn_rcpf(1.0f + __expf(-x)); }
__device__ __forceinline__ float siluf_(float x) { return x * __builtin_amdgcn_rcpf(1.0f + __expf(-x)); }
__device__ __forceinline__ float geluf_(float x) { const float z = 0.7978845608028654f * (x + 0.044715f * x * x * x); return x * (1.0f - __builtin_amdgcn_rcpf(1.0f + __expf(2.0f * z))); }
__device__ __forceinline__ float logsigf_(float x) { return fminf(x, 0.f) - log1pf(__expf(-fabsf(x))); }
__device__ __forceinline__ float one_minus_exp(float x) {
    const float ser = -x * (1.0f + x * (0.5f + x * (0.16666667f + x * (0.041666668f + x * (0.0083333338f + x * (0.0013888889f + x * 0.0001984127f))))));
    return x > -0.3f ? ser : 1.0f - __expf(x);
}
__device__ __forceinline__ float wave_sum(float v) {
#pragma unroll
    for (int o = 1; o < 64; o <<= 1) v += __shfl_xor(v, o);
    return v;
}
__device__ __forceinline__ void unpack8(const u32x4 w, float (&f)[8]) {
    f[0] = bflo(w.x); f[1] = bfhi(w.x); f[2] = bflo(w.y); f[3] = bfhi(w.y); f[4] = bflo(w.z); f[5] = bfhi(w.z); f[6] = bflo(w.w); f[7] = bfhi(w.w);
}
__device__ __forceinline__ u32x4 pack8(const float (&f)[8]) {
    u32x4 w; w.x = cvt_pk_bf16(f[0], f[1]); w.y = cvt_pk_bf16(f[2], f[3]); w.z = cvt_pk_bf16(f[4], f[5]); w.w = cvt_pk_bf16(f[6], f[7]); return w;
}

namespace pg8 {
constexpr int BM = 256, BK = 64, HALF = 128, HTB = HALF * BK * 2, STAGE_BYTES = 8 * HTB, NXCD = 8, WGM = 8;
__host__ __device__ __forceinline__ int lds_byte(int r, int c) { const int st = (r >> 4) * 2 + (c >> 5), rr = r & 15, cc = c & 31, ob = rr * 64 + cc * 2; return st * 1024 + (ob ^ (((ob >> 9) & 1) << 5)); }
__host__ __device__ __forceinline__ void stage_rc(int b, int& R, int& C) { const int st = b / 1024, sb = b % 1024, swz = sb ^ (((sb >> 9) & 1) << 5); R = (st >> 1) * 16 + swz / 64; C = (st & 1) * 32 + (swz % 64) / 2; }
__host__ __device__ __forceinline__ int perm32(int rho) { const int n = rho >> 4, i = rho & 15; return 8 * (i >> 2) + 4 * n + (i & 3); }
struct Unit { int pm, pn; };
struct Gemm { const bf16_t* A; const bf16_t* Bt; int M, N, K, lda, ldb, a_pn_shift, a_pn_bytes; };
struct StaticOrder {
    int nM, nN, nwg, G, c;
    __device__ void init(int M, int N, int G_, int c_) { nM = M / BM; nN = N / BM; nwg = nM * nN; G = G_; c = c_; }
    __device__ bool next(int i, Unit& u) const {
        const long L = (long)i * G + c; if (L >= nwg) return false;
        int wgid = (int)L; { const int q = nwg / NXCD, r = nwg % NXCD, xcd = wgid % NXCD, off = wgid / NXCD; wgid = (xcd < r ? xcd * (q + 1) : r * (q + 1) + (xcd - r) * q) + off; }
        const int nig = WGM * nN, gid = wgid / nig, fm = gid * WGM, gsz = (nM - fm) < WGM ? (nM - fm) : WGM;
        u.pm = fm + ((wgid % nig) % gsz); u.pn = (wgid % nig) / gsz; return true;
    }
};
template <class Epi, bool ALIGN_EPI>
__device__ __forceinline__ void gemm_phase(const int tid, LAS unsigned char* lds, const Gemm g, const StaticOrder& S, const Epi& E) {
    const int wid = __builtin_amdgcn_readfirstlane(tid >> 6), lane = tid & 63, wr = wid >> 2, wc = wid & 3, fr = lane & 15, fq = lane >> 4;
    const int K = g.K, nt = K / BK;
    unsigned voffA[2], voffB[2];
#pragma unroll
    for (int i = 0; i < 2; ++i) { int R, C; stage_rc(tid * 16 + i * 8192, R, C); const int Rb = Epi::PERM ? ((R & ~31) + perm32(R & 31)) : R;
        voffA[i] = (unsigned)(R * g.lda + C) * 2u; voffB[i] = (unsigned)(Rb * g.ldb + C) * 2u; }
    const size_t kstep = (size_t)(BK * 2);
    const size_t hstepA = (size_t)HALF * g.lda * 2, hstepB = (size_t)HALF * g.ldb * 2;
    const size_t tstepA = 2 * hstepA, tstepB = 2 * hstepB;
    const unsigned ldsw = (unsigned)wid * 1024u;
    const int aoff = lds_byte(wr * 64 + fr, fq * 8), boff = lds_byte(wc * 32 + fr, fq * 8);
#define PG8_SA(b, h) (((b) * 2 + (h)) * HTB)
#define PG8_SB(b, h) ((4 + (b) * 2 + (h)) * HTB)
#define PG8_STAGE(bufoff, gbase, voff) do { _Pragma("unroll") for (int _i = 0; _i < 2; ++_i) \
        __builtin_amdgcn_global_load_lds((const unsigned*)((const char*)(gbase) + (voff)[_i]), (LAS unsigned*)(lds + (bufoff) + ldsw + _i * 8192), 16, 0, 0); } while (0)
#define PG8_LDA(dst, b, h) do { _Pragma("unroll") for (int m = 0; m < 4; ++m) _Pragma("unroll") for (int k = 0; k < 2; ++k) dst[m][k] = *(const LAS bf16x8*)(lds + PG8_SA(b, h) + aoff + m * 2048 + k * 1024); } while (0)
#define PG8_LDB(dst, b, h) do { _Pragma("unroll") for (int n = 0; n < 2; ++n) _Pragma("unroll") for (int k = 0; k < 2; ++k) dst[n][k] = *(const LAS bf16x8*)(lds + PG8_SB(b, h) + boff + n * 2048 + k * 1024); } while (0)
#define PG8_MMA(ai, bj, At, Bt) do { __builtin_amdgcn_s_setprio(1); _Pragma("unroll") for (int m = 0; m < 4; ++m) _Pragma("unroll") for (int n = 0; n < 2; ++n) _Pragma("unroll") for (int k = 0; k < 2; ++k) \
        acc[ai][bj][m][n] = __builtin_amdgcn_mfma_f32_16x16x32_bf16(Bt[n][k], At[m][k], acc[ai][bj][m][n], 0, 0, 0); __builtin_amdgcn_s_setprio(0); } while (0)
#define PG8_WAIT_V(n) asm volatile("s_waitcnt vmcnt(" #n ")" ::: "memory")
#define PG8_WAIT_L(n) asm volatile("s_waitcnt lgkmcnt(" #n ")" ::: "memory")
#define PG8_BAR __builtin_amdgcn_s_barrier()
#define PG8_SCHED __builtin_amdgcn_sched_barrier(0)
    Unit cur, nxt; int ui = 0;
    if (!S.next(0, cur)) return;
    f32x4 acc[2][2][4][2];
#pragma unroll
    for (int a = 0; a < 2; ++a)
#pragma unroll
        for (int b = 0; b < 2; ++b)
#pragma unroll
            for (int m = 0; m < 4; ++m)
#pragma unroll
                for (int n = 0; n < 2; ++n) acc[a][b][m][n] = (f32x4){0.f, 0.f, 0.f, 0.f};
    bf16x8 At[4][2], B0[2][2], B1[2][2];
    const char* cA = (const char*)g.A + (size_t)cur.pm * tstepA + (size_t)((cur.pn >> g.a_pn_shift) * g.a_pn_bytes);
    const char* cB = (const char*)g.Bt + (size_t)cur.pn * tstepB;
    PG8_STAGE(PG8_SB(0, 0), cB, voffB); PG8_STAGE(PG8_SB(0, 1), cB + hstepB, voffB); PG8_STAGE(PG8_SA(0, 0), cA, voffA); PG8_STAGE(PG8_SA(0, 1), cA + hstepA, voffA);
    if (wr == 1) PG8_BAR;
    PG8_WAIT_V(2); PG8_BAR;
    PG8_STAGE(PG8_SB(1, 0), cB + kstep, voffB); PG8_STAGE(PG8_SA(1, 0), cA + kstep, voffA); PG8_STAGE(PG8_SB(1, 1), cB + hstepB + kstep, voffB);
    PG8_WAIT_V(6); PG8_BAR;
    for (;;) {
        const bool has_next = S.next(ui + 1, nxt);
        const char* nA = has_next ? (const char*)g.A + (size_t)nxt.pm * tstepA + (size_t)((nxt.pn >> g.a_pn_shift) * g.a_pn_bytes) : cA;
        const char* nB = has_next ? (const char*)g.Bt + (size_t)nxt.pn * tstepB : cB;
        for (int t = 0; t < nt; t += 2) {
            const bool last = (t == nt - 2);
            const char* a1 = cA + (size_t)(t + 1) * kstep;
            const char* a2 = last ? nA : cA + (size_t)(t + 2) * kstep; const char* b2 = last ? nB : cB + (size_t)(t + 2) * kstep;
            const char* a3 = a2 + kstep; const char* b3 = b2 + kstep;
            PG8_LDB(B0, 0, 0); PG8_LDB(B1, 0, 1); PG8_SCHED; PG8_LDA(At, 0, 0); PG8_STAGE(PG8_SA(1, 1), a1 + hstepA, voffA);
            PG8_WAIT_V(8); PG8_WAIT_L(0); PG8_BAR; PG8_MMA(0, 0, At, B0); PG8_MMA(0, 1, At, B1); PG8_BAR; PG8_SCHED;
            PG8_LDA(At, 0, 1); PG8_STAGE(PG8_SB(0, 0), b2, voffB); PG8_STAGE(PG8_SB(0, 1), b2 + hstepB, voffB); PG8_STAGE(PG8_SA(0, 0), a2, voffA);
            PG8_WAIT_V(8); PG8_WAIT_L(0); PG8_BAR; PG8_MMA(1, 0, At, B0); PG8_MMA(1, 1, At, B1); PG8_BAR; PG8_SCHED;
            PG8_LDB(B0, 1, 0); PG8_LDB(B1, 1, 1); PG8_SCHED; PG8_LDA(At, 1, 0); PG8_STAGE(PG8_SA(0, 1), a2 + hstepA, voffA);
            PG8_WAIT_V(8); PG8_WAIT_L(0); PG8_BAR; PG8_MMA(0, 0, At, B0); PG8_MMA(0, 1, At, B1); PG8_BAR; PG8_SCHED;
            PG8_LDA(At, 1, 1); PG8_STAGE(PG8_SB(1, 0), b3, voffB); PG8_STAGE(PG8_SB(1, 1), b3 + hstepB, voffB); PG8_STAGE(PG8_SA(1, 0), a3, voffA);
            PG8_WAIT_V(8); PG8_WAIT_L(0); PG8_BAR; PG8_MMA(1, 0, At, B0); PG8_MMA(1, 1, At, B1); PG8_BAR; PG8_SCHED;
        }
        if constexpr (ALIGN_EPI) { if (wr == 0) PG8_BAR; }
        { int fr_ = fr, fq_ = fq; asm volatile("" : "+v"(fr_), "+v"(fq_)); E(acc, cur, wr, wc, fr_, fq_); }
        if (!has_next) break;
#pragma unroll
        for (int a = 0; a < 2; ++a)
#pragma unroll
            for (int b = 0; b < 2; ++b)
#pragma unroll
                for (int m = 0; m < 4; ++m)
#pragma unroll
                    for (int n = 0; n < 2; ++n) acc[a][b][m][n] = (f32x4){0.f, 0.f, 0.f, 0.f};
        cur = nxt; cA = nA; cB = nB; ++ui;
        if constexpr (ALIGN_EPI) { if (wr == 1) PG8_BAR; }
    }
    PG8_WAIT_V(0);
    if constexpr (!ALIGN_EPI) { if (wr == 0) PG8_BAR; }
    PG8_BAR;
#undef PG8_SA
#undef PG8_SB
#undef PG8_STAGE
#undef PG8_LDA
#undef PG8_LDB
#undef PG8_MMA
#undef PG8_WAIT_V
#undef PG8_WAIT_L
#undef PG8_BAR
#undef PG8_SCHED
}

struct EpiBf16 {
    static constexpr bool PERM = true;
    bf16_t* O; int ldc;
    __device__ __forceinline__ void operator()(const f32x4 (&acc)[2][2][4][2], const Unit& u, int wr, int wc, int fr, int fq) const {
        const int row0 = u.pm * BM + wr * 64 + fr, col0 = u.pn * BM + wc * 32 + 8 * fq;
#pragma unroll
        for (int ai = 0; ai < 2; ++ai)
#pragma unroll
            for (int m = 0; m < 4; ++m) { bf16_t* rowp = O + (size_t)(row0 + ai * HALF + m * 16) * ldc + col0;
#pragma unroll
                for (int bj = 0; bj < 2; ++bj) { const f32x4 v0 = acc[ai][bj][m][0], v1 = acc[ai][bj][m][1];
                    u32x4 w; w.x = cvt_pk_bf16(v0[0], v0[1]); w.y = cvt_pk_bf16(v0[2], v0[3]); w.z = cvt_pk_bf16(v1[0], v1[1]); w.w = cvt_pk_bf16(v1[2], v1[3]);
                    *(u32x4*)(rowp + bj * HALF) = w; } }
    }
};
struct EpiSwiglu {
    static constexpr bool PERM = true;
    bf16_t* O; int ldc;
    __device__ __forceinline__ void operator()(const f32x4 (&acc)[2][2][4][2], const Unit& u, int wr, int wc, int fr, int fq) const {
        const int row0 = u.pm * BM + wr * 64 + fr, col0 = u.pn * HALF + wc * 32 + 8 * fq;
#pragma unroll
        for (int ai = 0; ai < 2; ++ai)
#pragma unroll
            for (int m = 0; m < 4; ++m) { bf16_t* rowp = O + (size_t)(row0 + ai * HALF + m * 16) * ldc + col0;
                float o[8];
#pragma unroll
                for (int n = 0; n < 2; ++n)
#pragma unroll
                    for (int j = 0; j < 4; ++j) o[4 * n + j] = siluf_(acc[ai][0][m][n][j]) * acc[ai][1][m][n][j];
                *(u32x4*)rowp = pack8(o); }
    }
};
struct EpiResid {
    static constexpr bool PERM = false;
    const float* baseL; const float* baseC; float* outL; float* outC; const float* modL; const float* modC; float scale; int nlat;
    __device__ __forceinline__ void operator()(const f32x4 (&acc)[2][2][4][2], const Unit& u, int wr, int wc, int fr, int fq) const {
        const bool lat = u.pm < nlat;
        const size_t toff = (size_t)(lat ? u.pm : u.pm - nlat) * BM * D + (size_t)(wr * 64 + fr) * D + u.pn * BM + wc * 32 + 4 * fq;
        const float* base = (lat ? baseL : baseC) + toff;
        float* out = (lat ? outL : outC) + toff;
        const float* mg = (lat ? modL + (size_t)(u.pm >> 3) * NMOD : modC) + u.pn * BM + wc * 32 + 4 * fq;
#pragma unroll
        for (int bj = 0; bj < 2; ++bj)
#pragma unroll
            for (int n = 0; n < 2; ++n) { const f32x4 gv = *(const f32x4*)(mg + bj * HALF + n * 16) * scale;
#pragma unroll
                for (int ai = 0; ai < 2; ++ai)
#pragma unroll
                    for (int m = 0; m < 4; ++m) { const size_t off = (size_t)(ai * HALF + m * 16) * D + bj * HALF + n * 16;
                        const f32x4 bs = *(const f32x4*)(base + off); *(f32x4*)(out + off) = bs + gv * acc[ai][bj][m][n]; } }
    }
};
__device__ __forceinline__ float one_minus_exp(float x) {
    const float ser = -x * (1.0f + x * (0.5f + x * (0.16666667f + x * (0.041666668f + x * (0.0083333338f + x * (0.0013888889f + x * 0.0001984127f))))));
    return x > -0.3f ? ser : 1.0f - __expf(x);
}
struct EpiGate {
    static constexpr bool PERM = true;
    bf16_t* LA; bf16_t* UU;
    __device__ __forceinline__ void operator()(const f32x4 (&acc)[2][2][4][2], const Unit& u, int wr, int wc, int fr, int fq) const {
        const int blk = u.pn >> 1, dir = u.pn & 1, ch0 = blk * HALF + wc * 32 + 8 * fq, row0 = u.pm * BM + wr * 64 + fr;
#pragma unroll
        for (int ai = 0; ai < 2; ++ai)
#pragma unroll
            for (int m = 0; m < 4; ++m) { const size_t off = (size_t)dir * RG * D + (size_t)(row0 + ai * HALF + m * 16) * D + ch0;
#pragma unroll
                for (int bj = 0; bj < 2; ++bj) { const f32x4 v0 = acc[ai][bj][m][0], v1 = acc[ai][bj][m][1];
                    u32x4 w; w.x = cvt_pk_bf16(v0[0], v0[1]); w.y = cvt_pk_bf16(v0[2], v0[3]); w.z = cvt_pk_bf16(v1[0], v1[1]); w.w = cvt_pk_bf16(v1[2], v1[3]);
                    *(u32x4*)((bj ? UU : LA) + off) = w; } }
    }
};
template <bool ACCUM> struct EpiMix {
    static constexpr bool PERM = true;
    const bf16_t* PROJ; int gcol; bf16_t* MG;
    __device__ __forceinline__ void operator()(const f32x4 (&acc)[2][2][4][2], const Unit& u, int wr, int wc, int fr, int fq) const {
        const int row0 = u.pm * BM + wr * 64 + fr, col0 = u.pn * BM + wc * 32 + 8 * fq;
#pragma unroll
        for (int ai = 0; ai < 2; ++ai)
#pragma unroll
            for (int m = 0; m < 4; ++m) { const size_t row = (size_t)(row0 + ai * HALF + m * 16);
#pragma unroll
                for (int bj = 0; bj < 2; ++bj) { float gt[8], o[8]; unpack8(*(const u32x4*)(PROJ + row * PN + gcol + col0 + bj * HALF), gt);
                    bf16_t* dst = MG + row * D + col0 + bj * HALF;
                    if (ACCUM) unpack8(*(const u32x4*)dst, o); else {
#pragma unroll
                        for (int i = 0; i < 8; ++i) o[i] = 0.f; }
#pragma unroll
                    for (int n = 0; n < 2; ++n)
#pragma unroll
                        for (int j = 0; j < 4; ++j) o[4 * n + j] += sigmoidf_(gt[4 * n + j]) * acc[ai][bj][m][n][j];
                    *(u32x4*)dst = pack8(o); } }
    }
};
}

struct Args {
    const float* in[26]; float* out; unsigned char* ws; int lo, hi;
};
enum { I_X = 0, I_C, I_CTX, I_CCTX, I_WADA, I_BADA, I_NORMW, I_F1WI, I_F1WO, I_F2WI, I_F2WO, I_WIN, I_FUP, I_FB, I_GNW, I_CONVW, I_CONVB, I_WR, I_BR, I_WI, I_BI, I_LAM, I_WOG, I_WOL, I_WOO, I_FNW };

#define NTHR 512
__device__ __forceinline__ const float* inp(const LAS unsigned char* lds, int i) { const LAS unsigned* t = (const LAS unsigned*)(lds + PTAB) + 2 * i;
    const unsigned lo = __builtin_amdgcn_readfirstlane(t[0]), hi = __builtin_amdgcn_readfirstlane(t[1]); return (const float*)(((unsigned long long)hi << 32) | lo); }
#define AIN(i) inp(lds, (i))
struct Ctx { int tid, bid, G; };
#define GW() (cx.bid * 8 + (cx.tid >> 6))
#define NGW() (cx.G * 8)

__device__ __forceinline__ void transpose_item(const float* W, int ldw, int K, int k0, int n0, bf16_t* WT, int drow, LAS float* scr, int lane) {
#pragma unroll 8
    for (int i = 0; i < 32; ++i) { const int kk = 2 * i + (lane >> 5); scr[kk * 33 + (lane & 31)] = W[(size_t)(k0 + kk) * ldw + n0 + (lane & 31)]; }
    asm volatile("s_waitcnt lgkmcnt(0)" ::: "memory");
    const int c = lane & 7;
#pragma unroll
    for (int j = 0; j < 4; ++j) { const int n = (lane >> 3) + 8 * j; const LAS float* s = scr + (8 * c) * 33 + n;
        u32x4 o; o.x = cvt_pk_bf16(s[0 * 33], s[1 * 33]); o.y = cvt_pk_bf16(s[2 * 33], s[3 * 33]); o.z = cvt_pk_bf16(s[4 * 33], s[5 * 33]); o.w = cvt_pk_bf16(s[6 * 33], s[7 * 33]);
        *(u32x4*)(WT + (size_t)(drow + n) * K + k0 + 8 * c) = o; }
    asm volatile("s_waitcnt lgkmcnt(0)" ::: "memory");
}
__device__ __forceinline__ int wi_drow(int n0) { return n0 < FH ? (n0 >> 7) * 256 + (n0 & 127) : ((n0 - FH) >> 7) * 256 + 128 + ((n0 - FH) & 127); }
__device__ __forceinline__ int win_drow(int n0) { return n0 < 3072 ? n0 : (n0 == 3072 ? PFD : n0 - 32); }

__device__ __forceinline__ void phase_weights(const Ctx cx, const Args& a, LAS unsigned char* lds) {
    const int lane = cx.tid & 63, wave = cx.tid >> 6;
    LAS float* scr = (LAS float*)(lds + wave * 16384);
    unsigned char* ws = a.ws;
    constexpr int I_WI_ = (D / 64) * (2 * FH / 32), I_WO_ = (FH / 64) * (D / 32), I_IN_ = (D / 64) * (INW / 32), I_SQ_ = (D / 64) * (D / 32), I_LG_ = 32 * 8;
    constexpr int NIT = 2 * I_WI_ + 2 * I_WO_ + I_IN_ + 3 * I_SQ_ + I_LG_;
    if (PHON(19)) for (int it = GW(); it < NIT; it += NGW()) {
        int r = it;
        if (r < 2 * I_WI_) { const int w = r / I_WI_; r %= I_WI_; const int nb = 2 * FH / 32, kb = r / nb, n0 = (r % nb) * 32;
            transpose_item(AIN(w ? I_F2WI : I_F1WI), 2 * FH, D, kb * 64, n0, (bf16_t*)(ws + (w ? WS_WI2 : WS_WI1)), wi_drow(n0), scr, lane); continue; }
        r -= 2 * I_WI_;
        if (r < 2 * I_WO_) { const int w = r / I_WO_; r %= I_WO_; const int nb = D / 32, kb = r / nb, n0 = (r % nb) * 32;
            transpose_item(AIN(w ? I_F2WO : I_F1WO), D, FH, kb * 64, n0, (bf16_t*)(ws + (w ? WS_WO2 : WS_WO1)), n0, scr, lane); continue; }
        r -= 2 * I_WO_;
        if (r < I_IN_) { const int nb = INW / 32, kb = r / nb, n0 = (r % nb) * 32;
            transpose_item(AIN(I_WIN), INW, D, kb * 64, n0, (bf16_t*)(ws + WS_WIN), win_drow(n0), scr, lane); continue; }
        r -= I_IN_;
        if (r < 3 * I_SQ_) { const int w = r / I_SQ_; r %= I_SQ_; const int nb = D / 32, kb = r / nb, n0 = (r % nb) * 32;
            transpose_item(AIN(w == 0 ? I_WOG : (w == 1 ? I_WOL : I_WOO)), D, D, kb * 64, n0, (bf16_t*)(ws + (w == 0 ? WS_WOG : (w == 1 ? WS_WOL : WS_WOO))), n0, scr, lane); continue; }
        r -= 3 * I_SQ_;
        { const int mat = r >> 3, sub = r & 7, gate = mat >> 4, dir = (mat >> 3) & 1, blk = mat & 7;
          const float* src = AIN(gate ? I_WI : I_WR) + (size_t)(dir * 8 + blk) * 128 * 128;
          const int kb = sub >> 2, n0 = (sub & 3) * 32;
          transpose_item(src, 128, 128, kb * 64, n0, (bf16_t*)(ws + WS_WLG), ((blk * 2 + dir) * 2 + gate) * 128 + n0, scr, lane); }
    }
    { u32x4* z = (u32x4*)(ws + WS_WIN + (size_t)INW * D * 2); const int n16 = (PN - INW) * D * 2 / 16;
      for (int i = cx.bid * NTHR + cx.tid; i < n16; i += cx.G * NTHR) z[i] = (u32x4){0u, 0u, 0u, 0u}; }
    __syncthreads();
    LAS float* sl = (LAS float*)lds;
    float* MODP = (float*)(ws + WS_MODP);
    if (PHON(20)) for (int item = cx.bid; item < 18 * 16; item += cx.G) {
        const int cb = item % 18, ks = item / 18, col = cb * 512 + cx.tid;
        for (int idx = cx.tid; idx < 33 * 64; idx += NTHR) { const int b = idx >> 6, k = idx & 63; const float cv = b < 32 ? AIN(I_C)[b * D + ks * 64 + k] : AIN(I_CCTX)[ks * 64 + k]; sl[idx] = siluf_(cv); }
        __syncthreads();
        float acc[33];
#pragma unroll
        for (int b = 0; b < 33; ++b) acc[b] = 0.f;
        const float* wp = AIN(I_WADA) + (size_t)(ks * 64) * NMOD + col;
#pragma unroll 4
        for (int k = 0; k < 64; ++k) { const float w = wp[(size_t)k * NMOD];
#pragma unroll
            for (int b = 0; b < 33; ++b) acc[b] += sl[b * 64 + k] * w; }
#pragma unroll
        for (int b = 0; b < 33; ++b) MODP[(size_t)(ks * 33 + b) * NMOD + col] = acc[b];
        __syncthreads();
    }
}
__device__ __forceinline__ void phase_modreduce(const Ctx cx, const Args& a, LAS unsigned char* lds) {
    const float* MODP = (const float*)(a.ws + WS_MODP); float* MOD = (float*)(a.ws + WS_MOD);
    for (int idx = cx.bid * NTHR + cx.tid; idx < 33 * NMOD; idx += cx.G * NTHR) {
        float s = AIN(I_BADA)[idx % NMOD];
#pragma unroll
        for (int ks = 0; ks < 16; ++ks) s += MODP[(size_t)ks * 33 * NMOD + idx];
        MOD[idx] = s;
    }
    float* GC = (float*)(a.ws + WS_GC);
    for (int idx = cx.bid * NTHR + cx.tid; idx < 2 * D; idx += cx.G * NTHR) { GC[idx] = AIN(I_BR)[idx]; GC[2 * D + idx] = AIN(I_BI)[idx]; GC[4 * D + idx] = 8.0f * log1pf(__expf(-AIN(I_LAM)[idx])); }
}

__device__ __forceinline__ void phase_normmod(const Ctx cx, const Args& a, LAS unsigned char* lds, int g, int mode, int nrows, int sub) {
    const int lane = cx.tid & 63;
    const float* MOD = (const float*)(a.ws + WS_MOD); const float* nw = AIN(I_NORMW) + sub * D;
    const float* H1 = (const float*)(a.ws + WS_H1); bf16_t* U = (bf16_t*)(a.ws + WS_U);
    for (int r = GW(); r < nrows; r += NGW()) {
        const float* src = mode ? H1 + (size_t)r * D : (r < RL ? AIN(I_X) + ((size_t)g * RL + r) * D : AIN(I_CTX) + ((size_t)g * RC + (r - RL)) * D);
        const int mrow = r < RL ? g * BG + r / T : 32;
        const float* sh = MOD + (size_t)mrow * NMOD + (3 * sub) * D; const float* sc = sh + D;
        f32x4 v[4]; float ss = 0.f;
#pragma unroll
        for (int j = 0; j < 4; ++j) { v[j] = ((const f32x4*)src)[lane + 64 * j]; ss += (v[j].x * v[j].x + v[j].y * v[j].y) + (v[j].z * v[j].z + v[j].w * v[j].w); }
        const float rstd = 1.0f / sqrtf(wave_sum(ss) * (1.0f / D) + EPS);
#pragma unroll
        for (int j = 0; j < 4; ++j) { const int c4 = lane + 64 * j; const f32x4 w = ((const f32x4*)nw)[c4], s4 = ((const f32x4*)sh)[c4], c1 = ((const f32x4*)sc)[c4];
            const f32x4 o = v[j] * rstd * w * (c1 + 1.0f) + s4;
            u32x2 p; p.x = cvt_pk_bf16(o.x, o.y); p.y = cvt_pk_bf16(o.z, o.w); ((u32x2*)(U + (size_t)r * D))[c4] = p; }
    }
}
__device__ __forceinline__ void phase_final(const Ctx cx, const Args& a, LAS unsigned char* lds, int g) {
    const int lane = cx.tid & 63; const float* fw = AIN(I_FNW);
    for (int r = GW(); r < RL; r += NGW()) {
        float* row = a.out + ((size_t)g * RL + r) * D;
        f32x4 v[4]; float ss = 0.f;
#pragma unroll
        for (int j = 0; j < 4; ++j) { v[j] = ((const f32x4*)row)[lane + 64 * j]; ss += (v[j].x * v[j].x + v[j].y * v[j].y) + (v[j].z * v[j].z + v[j].w * v[j].w); }
        const float rstd = 1.0f / sqrtf(wave_sum(ss) * (1.0f / D) + EPS);
#pragma unroll
        for (int j = 0; j < 4; ++j) { const int c4 = lane + 64 * j; ((f32x4*)row)[c4] = v[j] * rstd * ((const f32x4*)fw)[c4]; }
    }
}

template <int DIR>
__device__ __forceinline__ void gla_prep_dir(const Ctx cx, const Args& a, LAS unsigned char* lds, const bf16_t* PROJ, int b, int c, int row0, LAS float* fdl, LAS float* lal) {
    const int col = cx.tid, h = col >> 7, d = col & 127;
    float fw[16];
#pragma unroll
    for (int r = 0; r < 16; ++r) fw[r] = AIN(I_FUP)[(size_t)(DIR * 16 + r) * 512 + col];
    const float fbv = AIN(I_FB)[DIR * 512 + col];
    float tot = 0.f;
    for (int i = 0; i < 64; ++i) { float dot = fbv;
#pragma unroll
        for (int r = 0; r < 16; ++r) dot += fdl[i * 32 + DIR * 16 + r] * fw[r];
        const float la = logsigf_(dot) * (1.0f / 16.0f); lal[i * 512] = la; tot += la; }
    const size_t tb = (((size_t)DIR * BG + b) * NCH + c) * 4 + h;
    bf16_t* QD = (bf16_t*)(a.ws + WS_QD) + tb * 8192; bf16_t* KI = (bf16_t*)(a.ws + WS_KI) + tb * 8192; bf16_t* KET = (bf16_t*)(a.ws + WS_KET) + tb * 8192;
    ((float*)(a.ws + WS_BL))[tb * 128 + d] = tot;
    const bool lat = c >= 4;
    float run = 0.f;
    for (int gg = 0; gg < 8; ++gg) { const int gi = DIR ? 7 - gg : gg; float ke[8];
#pragma unroll
        for (int jj = 0; jj < 8; ++jj) { const int ii = DIR ? 7 - jj : jj, i = 8 * gi + ii;
            run += lal[i * 512];
            const float kv = bf2f(PROJ[(size_t)(row0 + i) * PN + PK + col]);
            if (lat) { const float qv = bf2f(PROJ[(size_t)(row0 + i) * PN + PQ + col]);
                QD[i * 128 + d] = f2bf(qv * 0.08838834764831845f * __expf(run)); KI[i * 128 + d] = f2bf(kv * __expf(-run)); }
            ke[ii] = kv * __expf(tot - run); }
        *(u32x4*)(KET + d * 64 + 8 * gi) = pack8(ke); }
}
__device__ __forceinline__ void phase_prep(const Ctx cx, const Args& a, int g, LAS unsigned char* lds) {
    const bf16_t* PROJ = (const bf16_t*)(a.ws + WS_BIG);
    LAS float* fdl = (LAS float*)lds; LAS float* lal = (LAS float*)(lds + 8192) + cx.tid;
    for (int item = cx.bid; item < BG * NCH; item += cx.G) {
        const int b = item / NCH, c = item % NCH;
        const int row0 = c < 4 ? RL + b * CL + c * 64 : b * T + (c - 4) * 64;
        for (int idx = cx.tid; idx < 64 * 32; idx += NTHR) fdl[idx] = bf2f(PROJ[(size_t)(row0 + (idx >> 5)) * PN + PFD + (idx & 31)]);
        __syncthreads();
        gla_prep_dir<0>(cx, a, lds, PROJ, b, c, row0, fdl, lal);
        gla_prep_dir<1>(cx, a, lds, PROJ, b, c, row0, fdl, lal);
        { const int e = cx.tid & 255, hh = cx.tid >> 8;
          for (int h2 = hh; h2 < 4; h2 += 2) { bf16_t* VT = (bf16_t*)(a.ws + WS_VT) + ((((size_t)b * NCH + c) * 4 + h2) * 256 + e) * 64;
              for (int jg = 0; jg < 8; ++jg) { float v[8];
#pragma unroll
                  for (int jj = 0; jj < 8; ++jj) v[jj] = bf2f(PROJ[(size_t)(row0 + 8 * jg + jj) * PN + PV + h2 * 256 + e]);
                  *(u32x4*)(VT + 8 * jg) = pack8(v); } } }
        __syncthreads();
    }
    bf16_t* XC = (bf16_t*)(a.ws + WS_XC);
    for (int idx = cx.bid * NTHR + cx.tid; idx < RG * 128; idx += cx.G * NTHR) {
        const int row = idx >> 7, c8 = (idx & 127) * 8;
        const int pos = row < RL ? (row & 63) : ((row - RL) & 255), len = row < RL ? 64 : 256;
        float acc[8];
#pragma unroll
        for (int i = 0; i < 8; ++i) acc[i] = AIN(I_CONVB)[c8 + i];
#pragma unroll
        for (int j = 0; j < 4; ++j) { const int p = pos + j - 2;
            if (p >= 0 && p < len) { float xv[8]; unpack8(*(const u32x4*)(PROJ + (size_t)(row + j - 2) * PN + PXL + c8), xv);
#pragma unroll
                for (int i = 0; i < 8; ++i) acc[i] += AIN(I_CONVW)[j * D + c8 + i] * xv[i]; } }
        *(u32x4*)(XC + (size_t)row * D + c8) = pack8(acc);
    }
}


__device__ __forceinline__ void phase_gatefix(const Ctx cx, const Args& a, LAS unsigned char* lds) {
    bf16_t* LA = (bf16_t*)(a.ws + WS_LA); bf16_t* UU = (bf16_t*)(a.ws + WS_UU); const bf16_t* XC = (const bf16_t*)(a.ws + WS_XC); const float* GC = (const float*)(a.ws + WS_GC);
    for (int idx = cx.bid * NTHR + cx.tid; idx < 2 * RG * 128; idx += cx.G * NTHR) {
        const int dir = idx >= RG * 128, rem = idx - dir * RG * 128, row = rem >> 7, c8 = (rem & 127) * 8;
        const size_t off = (size_t)dir * RG * D + (size_t)row * D + c8;
        float r[8], ig[8], xc[8]; unpack8(*(const u32x4*)(LA + off), r); unpack8(*(const u32x4*)(UU + off), ig); unpack8(*(const u32x4*)(XC + (size_t)row * D + c8), xc);
#pragma unroll
        for (int i = 0; i < 8; ++i) { const float l = -GC[(4 + dir) * D + c8 + i] * sigmoidf_(r[i] + GC[dir * D + c8 + i]);
            const float gi = sigmoidf_(ig[i] + GC[(2 + dir) * D + c8 + i]);
            r[i] = l; ig[i] = __builtin_amdgcn_sqrtf(fmaxf(one_minus_exp(2.0f * l), 0.f)) * gi * xc[i]; }
        *(u32x4*)(LA + off) = pack8(r); *(u32x4*)(UU + off) = pack8(ig);
    }
}

__device__ __forceinline__ int img_off(int nkg, int row, int kcol) { const int ob = (row & 15) * 64 + (kcol & 31) * 2; return ((row >> 4) * nkg + (kcol >> 5)) * 1024 + (ob ^ (((ob >> 9) & 1) << 5)); }
__device__ __forceinline__ bf16x8 ldfrag(const LAS unsigned char* img, int nkg, int row, int kcol) { return *(const LAS bf16x8*)(img + img_off(nkg, row, kcol)); }
#define MFMA16(a, b, c) __builtin_amdgcn_mfma_f32_16x16x32_bf16((a), (b), (c), 0, 0, 0)

__device__ __forceinline__ void phase_gla_scan(const Ctx cx, const Args& a, int g, LAS unsigned char* lds) {
    constexpr int XB = 57344, OFF_KI = 16384, OFF_KET = 32768, OFF_VT = 49152, OFF_P = 2 * XB, OFF_ST = OFF_P + 8192, OFF_BL = OFF_ST + 2 * 16384;
    static_assert(OFF_BL + 1024 <= LDS_BYTES, "gla scan LDS");
    const int tid = cx.tid, lane = tid & 63, w = tid >> 6, fr = lane & 15, fq = lane >> 4;
    const bf16_t* QDg = (const bf16_t*)(a.ws + WS_QD); const bf16_t* KIg = (const bf16_t*)(a.ws + WS_KI); const bf16_t* KETg = (const bf16_t*)(a.ws + WS_KET);
    const bf16_t* VTg = (const bf16_t*)(a.ws + WS_VT); const float* BLg = (const float*)(a.ws + WS_BL);
    bf16_t* Og = (bf16_t*)(a.ws + WS_OFB);
    for (int item = cx.bid; item < BG * 32; item += cx.G) {
        const int dvq = item & 3, dir = (item >> 2) & 1, h = (item >> 3) & 3, b = item >> 5;
        { u32x4 z = {0u, 0u, 0u, 0u}; *(LAS u32x4*)(lds + OFF_ST + tid * 32) = z; *(LAS u32x4*)(lds + OFF_ST + tid * 32 + 16) = z; }
        f32x4 accS[4];
#pragma unroll
        for (int t = 0; t < 4; ++t) accS[t] = (f32x4){0.f, 0.f, 0.f, 0.f};
        u32x4 pq[2], pk[2], pe[2], pv; float pbl = 0.f;
#define GLA_LOAD(s_) do { const int c_ = dir == 0 ? (s_) : ((s_) < 4 ? 3 - (s_) : 39 - (s_)); \
            const size_t tb_ = (((size_t)dir * BG + b) * NCH + c_) * 4 + h; \
            if (c_ >= 4) { pq[0] = ((const u32x4*)(QDg + tb_ * 8192))[tid]; pq[1] = ((const u32x4*)(QDg + tb_ * 8192))[tid + 512]; \
                           pk[0] = ((const u32x4*)(KIg + tb_ * 8192))[tid]; pk[1] = ((const u32x4*)(KIg + tb_ * 8192))[tid + 512]; } \
            pe[0] = ((const u32x4*)(KETg + tb_ * 8192))[tid]; pe[1] = ((const u32x4*)(KETg + tb_ * 8192))[tid + 512]; \
            pv = ((const u32x4*)(VTg + ((((size_t)b * NCH + c_) * 4 + h) * 256 + dvq * 64) * 64))[tid]; \
            if (tid < 128) pbl = BLg[tb_ * 128 + tid]; } while (0)
#define GLA_STORE(buf_) do { LAS unsigned char* X_ = lds + (buf_) * XB; \
            _Pragma("unroll") for (int i_ = 0; i_ < 2; ++i_) { const int p_ = tid + 512 * i_; \
                *(LAS u32x4*)(X_ + img_off(4, p_ >> 4, (p_ & 15) * 8)) = pq[i_]; *(LAS u32x4*)(X_ + OFF_KI + img_off(4, p_ >> 4, (p_ & 15) * 8)) = pk[i_]; \
                *(LAS u32x4*)(X_ + OFF_KET + img_off(2, p_ >> 3, (p_ & 7) * 8)) = pe[i_]; } \
            *(LAS u32x4*)(X_ + OFF_VT + img_off(2, tid >> 3, (tid & 7) * 8)) = pv; \
            if (tid < 128) ((LAS float*)(lds + OFF_BL + (buf_) * 512))[tid] = pbl; } while (0)
        pq[0] = pq[1] = pk[0] = pk[1] = (u32x4){0u, 0u, 0u, 0u};
        GLA_LOAD(0); GLA_STORE(0);
        __syncthreads();
        for (int s = 0; s < NCH; ++s) {
            const int cur = s & 1; const bool lat = s >= 4;
            const LAS unsigned char* X = lds + cur * XB;
#ifndef GLA_SAFE
            if (s + 1 < NCH) GLA_LOAD(s + 1);
#endif
            if (lat) {
                const int ti = w >> 1, tj0 = (w & 1) * 2;
                f32x4 sc[2] = {(f32x4){0.f, 0.f, 0.f, 0.f}, (f32x4){0.f, 0.f, 0.f, 0.f}};
#pragma unroll
                for (int kk = 0; kk < 4; ++kk) { const bf16x8 qa = ldfrag(X, 4, 16 * ti + fr, kk * 32 + fq * 8);
#pragma unroll
                    for (int t = 0; t < 2; ++t) { const bf16x8 kb = ldfrag(X + OFF_KI, 4, 16 * (tj0 + t) + fr, kk * 32 + fq * 8); sc[t] = MFMA16(qa, kb, sc[t]); } }
#pragma unroll
                for (int t = 0; t < 2; ++t)
#pragma unroll
                    for (int jj = 0; jj < 4; ++jj) { const int i = 16 * ti + 4 * fq + jj, j = 16 * (tj0 + t) + fr;
                        const bool keep = dir == 0 ? (j <= i) : (j > i);
                        *(LAS bf16_t*)(lds + OFF_P + img_off(2, i, j)) = f2bf(keep ? sc[t][jj] : 0.f); }
            }
            __syncthreads();
            const int te = w >> 1;
            if (lat) {
                const int c = dir == 0 ? s : 39 - s;
                const LAS unsigned char* STc = lds + OFF_ST + cur * 16384;
                f32x4 oc[2] = {(f32x4){0.f, 0.f, 0.f, 0.f}, (f32x4){0.f, 0.f, 0.f, 0.f}};
#pragma unroll
                for (int kk = 0; kk < 2; ++kk) { const bf16x8 va = ldfrag(X + OFF_VT, 2, 16 * te + fr, kk * 32 + fq * 8);
#pragma unroll
                    for (int t = 0; t < 2; ++t) { const bf16x8 pb = ldfrag(lds + OFF_P, 2, 16 * ((w & 1) * 2 + t) + fr, kk * 32 + fq * 8); oc[t] = MFMA16(va, pb, oc[t]); } }
#pragma unroll
                for (int kk = 0; kk < 4; ++kk) { const bf16x8 sa = ldfrag(STc, 4, 16 * te + fr, kk * 32 + fq * 8);
#pragma unroll
                    for (int t = 0; t < 2; ++t) { const bf16x8 qb = ldfrag(X, 4, 16 * ((w & 1) * 2 + t) + fr, kk * 32 + fq * 8); oc[t] = MFMA16(sa, qb, oc[t]); } }
#pragma unroll
                for (int t = 0; t < 2; ++t) { const int i = 16 * ((w & 1) * 2 + t) + fr; const size_t row = (size_t)b * T + (size_t)(c - 4) * 64 + i;
                    u32x2 o2; o2.x = cvt_pk_bf16(oc[t][0], oc[t][1]); o2.y = cvt_pk_bf16(oc[t][2], oc[t][3]);
                    *(u32x2*)(Og + ((size_t)dir * RL + row) * D + h * 256 + dvq * 64 + 16 * te + 4 * fq) = o2; }
            }
#ifdef GLA_SAFE
            __syncthreads();
#endif
            {
                const LAS float* blp = (const LAS float*)(lds + OFF_BL + cur * 512);
                LAS unsigned char* STn = lds + OFF_ST + (cur ^ 1) * 16384;
                bf16x8 vb[2];
#pragma unroll
                for (int kk = 0; kk < 2; ++kk) vb[kk] = ldfrag(X + OFF_VT, 2, 16 * te + fr, kk * 32 + fq * 8);
#pragma unroll
                for (int t = 0; t < 4; ++t) { const int td = (w & 1) * 4 + t;
#pragma unroll
                    for (int jj = 0; jj < 4; ++jj) accS[t][jj] *= __expf(blp[16 * td + 4 * fq + jj]);
#pragma unroll
                    for (int kk = 0; kk < 2; ++kk) { const bf16x8 ka = ldfrag(X + OFF_KET, 2, 16 * td + fr, kk * 32 + fq * 8); accS[t] = MFMA16(ka, vb[kk], accS[t]); }
                    u32x2 s2; s2.x = cvt_pk_bf16(accS[t][0], accS[t][1]); s2.y = cvt_pk_bf16(accS[t][2], accS[t][3]);
                    *(LAS u32x2*)(STn + img_off(4, 16 * te + fr, 16 * td + 4 * fq)) = s2; }
            }
#ifdef GLA_SAFE
            __syncthreads();
            if (s + 1 < NCH) { GLA_LOAD(s + 1); GLA_STORE(cur ^ 1); }
#else
            if (s + 1 < NCH) GLA_STORE(cur ^ 1);
#endif
            __syncthreads();
        }
#undef GLA_LOAD
#undef GLA_STORE
    }
}

__device__ __forceinline__ void phase_lru_scan(const Ctx cx, const Args& a, int g, LAS unsigned char* lds) {
    const int lane = cx.tid & 63, w = cx.tid >> 6;
    LAS f32x2* agg = (LAS f32x2*)lds;
    for (int item = cx.bid; item < BG * 32; item += cx.G) {
        const int cgp = item & 15, dir = (item >> 4) & 1, b = item >> 5, ch = cgp * 64 + lane;
        const bf16_t* LA = (const bf16_t*)(a.ws + WS_LA) + (size_t)dir * RG * D + ch; const bf16_t* UU = (const bf16_t*)(a.ws + WS_UU) + (size_t)dir * RG * D + ch;
        bf16_t* Hd = (bf16_t*)(a.ws + WS_HFB) + (size_t)dir * RL * D + ch;
#define LRU_ROW(s_) ((s_) < CL ? RL + b * CL + (dir ? CL - 1 - (s_) : (s_)) : b * T + (dir ? T - 1 - ((s_) - CL) : (s_) - CL))
        float A = 1.f, Z = 0.f;
        for (int blk = 0; blk < 9; ++blk) { const int s0 = 288 * w + 32 * blk; bf16_t la[32], uu[32];
#pragma unroll
            for (int k = 0; k < 32; ++k) { const size_t r = (size_t)LRU_ROW(s0 + k); la[k] = LA[r * D]; uu[k] = UU[r * D]; }
#pragma unroll
            for (int k = 0; k < 32; ++k) { const float av = __expf(bf2f(la[k])); Z = av * Z + bf2f(uu[k]); A *= av; } }
        agg[w * 64 + lane] = (f32x2){A, Z};
        __syncthreads();
        float hst = 0.f;
#pragma unroll
        for (int w2 = 0; w2 < 7; ++w2) { const f32x2 p = agg[w2 * 64 + lane]; if (w2 < w) hst = p.x * hst + p.y; }
        for (int blk = 0; blk < 9; ++blk) { const int s0 = 288 * w + 32 * blk; bf16_t la[32], uu[32];
#pragma unroll
            for (int k = 0; k < 32; ++k) { const size_t r = (size_t)LRU_ROW(s0 + k); la[k] = LA[r * D]; uu[k] = UU[r * D]; }
#pragma unroll
            for (int k = 0; k < 32; ++k) { const float av = __expf(bf2f(la[k])); hst = av * hst + bf2f(uu[k]);
                if (s0 + k >= CL) Hd[(size_t)LRU_ROW(s0 + k) * D] = f2bf(hst); } }
        __syncthreads();
#undef LRU_ROW
    }
}

__device__ __forceinline__ void phase_post(const Ctx cx, const Args& a, LAS unsigned char* lds, int g) {
    const int lane = cx.tid & 63;
    const bf16_t* PROJ = (const bf16_t*)(a.ws + WS_BIG);
    bf16_t* O0 = (bf16_t*)(a.ws + WS_OFB); const bf16_t* O1 = O0 + (size_t)RL * D;
    bf16_t* H0 = (bf16_t*)(a.ws + WS_HFB); const bf16_t* H1b = H0 + (size_t)RL * D;
    const float* gnw = AIN(I_GNW);
    for (int r = GW(); r < RL; r += NGW()) {
        const size_t off = (size_t)r * D + lane * 16;
        float o[16], t[8]; float ss = 0.f;
#pragma unroll
        for (int hf = 0; hf < 2; ++hf) { float x0[8], x1[8]; unpack8(*(const u32x4*)(O0 + off + 8 * hf), x0); unpack8(*(const u32x4*)(O1 + off + 8 * hf), x1);
#pragma unroll
            for (int i = 0; i < 8; ++i) { o[8 * hf + i] = x0[i] + x1[i]; ss += o[8 * hf + i] * o[8 * hf + i]; } }
        ss += __shfl_xor(ss, 1); ss += __shfl_xor(ss, 2); ss += __shfl_xor(ss, 4); ss += __shfl_xor(ss, 8);
        const float rstd = 1.0f / sqrtf(ss * (1.0f / 256.0f) + EPS);
#pragma unroll
        for (int hf = 0; hf < 2; ++hf) { float gg[8]; unpack8(*(const u32x4*)(PROJ + (size_t)r * PN + PGG + lane * 16 + 8 * hf), gg);
#pragma unroll
            for (int i = 0; i < 8; ++i) t[i] = o[8 * hf + i] * rstd * gnw[(lane & 15) * 16 + 8 * hf + i] * siluf_(gg[i]);
            *(u32x4*)(O0 + off + 8 * hf) = pack8(t); }
#pragma unroll
        for (int hf = 0; hf < 2; ++hf) { float x0[8], x1[8], yl[8]; unpack8(*(const u32x4*)(H0 + off + 8 * hf), x0); unpack8(*(const u32x4*)(H1b + off + 8 * hf), x1);
            unpack8(*(const u32x4*)(PROJ + (size_t)r * PN + PYL + lane * 16 + 8 * hf), yl);
#pragma unroll
            for (int i = 0; i < 8; ++i) t[i] = (x0[i] + x1[i]) * geluf_(yl[i]);
            *(u32x4*)(H0 + off + 8 * hf) = pack8(t); }
    }
}


#define XB_TMO      128
#define XB_XCNT(j)  (256  + 64 * (j))
#define XB_XSUB(j)  (1280 + 64 * (j))
#define XB_XGEN(j)  (2304 + 64 * (j))
#define XB_TOP      3328
#define XB_TOPGEN   3392
#define XCD_BAR_WORDS 3456
#define XB_SPIN_CAP (1u << 22)
__device__ __forceinline__ unsigned xb_ld(unsigned* p)              { return __hip_atomic_load(p, __ATOMIC_RELAXED, __HIP_MEMORY_SCOPE_AGENT); }
__device__ __forceinline__ unsigned xb_add(unsigned* p, unsigned v) { return __hip_atomic_fetch_add(p, v, __ATOMIC_RELAXED, __HIP_MEMORY_SCOPE_AGENT); }
__device__ __forceinline__ unsigned xb_xcc_id() { return (unsigned)__builtin_amdgcn_s_getreg((3 << 11) | 20) & 0xFu; }
#define XB_SPIN(cond, bar) do { unsigned _sp = 0; while (cond) { __builtin_amdgcn_s_sleep(1); \
    if ((++_sp & 255u) == 0u) { if (xb_ld(&(bar)[XB_TMO])) break; if (_sp > XB_SPIN_CAP) { atomicAdd(&(bar)[XB_TMO], 1u); break; } } } } while (0)
__device__ __forceinline__ void xcd_barrier_complete(unsigned* bar, unsigned x, unsigned G, unsigned& nloc, unsigned& nx) {
    unsigned sum, cnt, mine, sp = 0u;
    for (;;) {
        sum = 0u; cnt = 0u; mine = 0u;
#pragma unroll
        for (unsigned j = 0; j < 16; ++j) { const unsigned c = xb_ld(&bar[XB_XCNT(j)]); sum += c; cnt += (c > 0u) ? 1u : 0u; mine = (j == x) ? c : mine; }
        if (sum == G) break;
        __builtin_amdgcn_s_sleep(1);
        if ((++sp & 255u) == 0u) { if (xb_ld(&bar[XB_TMO])) break; if (sp > XB_SPIN_CAP) { atomicAdd(&bar[XB_TMO], 1u); break; } }
    }
    nloc = mine > 0u ? mine : 1u; nx = cnt > 0u ? cnt : 1u;
}
__device__ __forceinline__ void xcd_barrier(unsigned* bar, volatile LAS unsigned* st, int tid, unsigned G) {
    asm volatile("s_waitcnt vmcnt(0)" ::: "memory");
    __syncthreads();
    if (tid == 0) {
        __builtin_amdgcn_s_waitcnt(0);
        const unsigned x = xb_xcc_id();
        unsigned nloc = st[0], nx = st[1];
        if (nloc == 0u) { xcd_barrier_complete(bar, x, G, nloc, nx); st[0] = nloc; st[1] = nx; }
        const unsigned old = xb_add(&bar[XB_XSUB(x)], 1u);
        const unsigned gen = old / nloc;
        if (old + 1u == (gen + 1u) * nloc) {
            __builtin_amdgcn_fence(__ATOMIC_RELEASE, "agent");
            asm volatile("s_waitcnt vmcnt(0)" ::: "memory");
            const unsigned og = xb_add(&bar[XB_TOP], 1u);
            const unsigned tg = og / nx;
            if (og + 1u == (tg + 1u) * nx) xb_add(&bar[XB_TOPGEN], 1u);
            else XB_SPIN(xb_ld(&bar[XB_TOPGEN]) == tg, bar);
            __builtin_amdgcn_fence(__ATOMIC_ACQUIRE, "agent");
            xb_add(&bar[XB_XGEN(x)], 1u);
            asm volatile("s_waitcnt vmcnt(0)" ::: "memory");
        } else {
            XB_SPIN(xb_ld(&bar[XB_XGEN(x)]) == gen, bar);
            __builtin_amdgcn_fence(__ATOMIC_ACQUIRE, "agent");
            asm volatile("s_waitcnt vmcnt(0)" ::: "memory");
        }
    }
    __syncthreads();
}

constexpr int NPH = 17;
#ifndef USE_CG_ALL
#define USE_CG_ALL 0
#endif
#if ONE_LAUNCH
#define GRID_SYNC(k) do { if ((k) == 1 || USE_CG_ALL) cg::this_grid().sync(); else xcd_barrier((unsigned*)ws + 4096, (volatile LAS unsigned*)(lds + PTAB + 256), cx.tid, (unsigned)cx.G); } while (0)
#else
#define GRID_SYNC(k) do {} while (0)
#endif
#define STEP_BEGIN(k) if (a.lo <= (k) && (k) < a.hi) { \
        Ctx cx; { int t_ = wave_s * 64 + (int)__builtin_amdgcn_mbcnt_hi(~0u, __builtin_amdgcn_mbcnt_lo(~0u, 0u)), b_ = blockIdx.x, g_ = gridDim.x; asm volatile("" : "+v"(t_)); asm volatile("" : "+s"(b_), "+s"(g_)); cx.tid = t_; cx.bid = b_; cx.G = g_; } \
        const int G = cx.G, cidx = cx.bid; (void)G; (void)cidx; \
        unsigned char* ws = a.ws; asm volatile("" : "+s"(ws)); \
        if ((k) > a.lo) GRID_SYNC(k); \
        const float* MOD = (const float*)(ws + WS_MOD); float* H1 = (float*)(ws + WS_H1); bf16_t* U = (bf16_t*)(ws + WS_U); bf16_t* BIG = (bf16_t*)(ws + WS_BIG); bf16_t* XC = (bf16_t*)(ws + WS_XC); \
        (void)MOD; (void)H1; (void)U; (void)BIG; (void)XC; pg8::StaticOrder S; (void)S;
#define STEP_END }

template <int g>
__device__ __forceinline__ void run_group(const Args& a, LAS unsigned char* lds, const int wave_s) {
    constexpr int s0 = 2 + g * NPH;
    STEP_BEGIN(s0 + 0) if (PHON(0)) phase_normmod(cx, a, lds, g, 0, RG, 0); STEP_END
    STEP_BEGIN(s0 + 1) if (PHON(1)) { pg8::Gemm gm{U, (const bf16_t*)(ws + WS_WI1), RG, 2 * FH, D, D, D, 0, 0}; S.init(RG, 2 * FH, G, cidx);
                  pg8::EpiSwiglu E{BIG, FH}; pg8::gemm_phase<pg8::EpiSwiglu, true>(cx.tid, lds, gm, S, E); } STEP_END
    STEP_BEGIN(s0 + 2) if (PHON(2)) { pg8::Gemm gm{BIG, (const bf16_t*)(ws + WS_WO1), RG, D, FH, FH, FH, 0, 0}; S.init(RG, D, G, cidx);
                  pg8::EpiResid E{AIN(I_X) + (size_t)g * RL * D, AIN(I_CTX) + (size_t)g * RC * D, H1, H1 + (size_t)RL * D,
                                  MOD + (size_t)(g * BG) * NMOD + 2 * D, MOD + (size_t)32 * NMOD + 2 * D, 0.5f, RL / 256};
                  pg8::gemm_phase<pg8::EpiResid, true>(cx.tid, lds, gm, S, E); } STEP_END
    STEP_BEGIN(s0 + 3) if (PHON(3)) phase_normmod(cx, a, lds, g, 1, RG, 1); STEP_END
    STEP_BEGIN(s0 + 4) if (PHON(4)) { pg8::Gemm gm{U, (const bf16_t*)(ws + WS_WIN), RG, PN, D, D, D, 0, 0}; S.init(RG, PN, G, cidx);
                  pg8::EpiBf16 E{BIG, PN}; pg8::gemm_phase<pg8::EpiBf16, true>(cx.tid, lds, gm, S, E); } STEP_END
    STEP_BEGIN(s0 + 5) if (PHON(5)) phase_prep(cx, a, g, lds); STEP_END
    STEP_BEGIN(s0 + 6) if (PHON(6)) { pg8::Gemm gm{XC, (const bf16_t*)(ws + WS_WLG), RG, 4096, 128, D, 128, 1, 256}; S.init(RG, 4096, G, cidx);
                  pg8::EpiGate E{(bf16_t*)(ws + WS_LA), (bf16_t*)(ws + WS_UU)};
                  pg8::gemm_phase<pg8::EpiGate, true>(cx.tid, lds, gm, S, E); } STEP_END
    STEP_BEGIN(s0 + 7) if (PHON(7)) { phase_gatefix(cx, a, lds); phase_gla_scan(cx, a, g, lds); } STEP_END
    STEP_BEGIN(s0 + 8) if (PHON(8)) phase_lru_scan(cx, a, g, lds); STEP_END
    STEP_BEGIN(s0 + 9) if (PHON(9)) phase_post(cx, a, lds, g); STEP_END
    STEP_BEGIN(s0 + 10) if (PHON(10)) { pg8::Gemm gm{(const bf16_t*)(ws + WS_OFB), (const bf16_t*)(ws + WS_WOG), RL, D, D, D, D, 0, 0}; S.init(RL, D, G, cidx);
                   pg8::EpiMix<false> E{BIG, PGA, XC}; pg8::gemm_phase<pg8::EpiMix<false>, true>(cx.tid, lds, gm, S, E); } STEP_END
    STEP_BEGIN(s0 + 11) if (PHON(11)) { pg8::Gemm gm{(const bf16_t*)(ws + WS_HFB), (const bf16_t*)(ws + WS_WOL), RL, D, D, D, D, 0, 0}; S.init(RL, D, G, cidx);
                   pg8::EpiMix<true> E{BIG, PGB, XC}; pg8::gemm_phase<pg8::EpiMix<true>, true>(cx.tid, lds, gm, S, E); } STEP_END
    STEP_BEGIN(s0 + 12) if (PHON(12)) { pg8::Gemm gm{XC, (const bf16_t*)(ws + WS_WOO), RL, D, D, D, D, 0, 0}; S.init(RL, D, G, cidx);
                   pg8::EpiResid E{H1, H1, H1, H1, MOD + (size_t)(g * BG) * NMOD + 5 * D, MOD, 1.0f, RL / 256};
                   pg8::gemm_phase<pg8::EpiResid, true>(cx.tid, lds, gm, S, E); } STEP_END
    STEP_BEGIN(s0 + 13) if (PHON(13)) phase_normmod(cx, a, lds, g, 1, RL, 2); STEP_END
    STEP_BEGIN(s0 + 14) if (PHON(14)) { pg8::Gemm gm{U, (const bf16_t*)(ws + WS_WI2), RL, 2 * FH, D, D, D, 0, 0}; S.init(RL, 2 * FH, G, cidx);
                   pg8::EpiSwiglu E{BIG, FH}; pg8::gemm_phase<pg8::EpiSwiglu, true>(cx.tid, lds, gm, S, E); } STEP_END
    STEP_BEGIN(s0 + 15) if (PHON(15)) { pg8::Gemm gm{BIG, (const bf16_t*)(ws + WS_WO2), RL, D, FH, FH, FH, 0, 0}; S.init(RL, D, G, cidx);
                   float* og = a.out + (size_t)g * RL * D;
                   pg8::EpiResid E{H1, H1, og, og, MOD + (size_t)(g * BG) * NMOD + 8 * D, MOD, 0.5f, RL / 256};
                   pg8::gemm_phase<pg8::EpiResid, true>(cx.tid, lds, gm, S, E); } STEP_END
    STEP_BEGIN(s0 + 16) if (PHON(16)) phase_final(cx, a, lds, g); STEP_END
}

__global__ void __launch_bounds__(NTHR, 2) fwd_kernel(Args a) {
    extern __shared__ __attribute__((aligned(16))) unsigned char lds_raw[];
    LAS unsigned char* lds = (LAS unsigned char*)lds_raw;
    if (threadIdx.x < 26) ((LAS unsigned long long*)(lds + PTAB))[threadIdx.x] = (unsigned long long)a.in[threadIdx.x];
    if (threadIdx.x == 32) { ((LAS unsigned*)(lds + PTAB + 256))[0] = 0u; ((LAS unsigned*)(lds + PTAB + 256))[1] = 0u; }
#if ONE_LAUNCH
    if (threadIdx.x == 0) (void)xb_add((unsigned*)a.ws + 4096 + XB_XCNT(xb_xcc_id()), 1u);
#endif
    const int wave_s = __builtin_amdgcn_readfirstlane(threadIdx.x >> 6);
    __syncthreads();
    STEP_BEGIN(0) if (PHON(17)) phase_weights(cx, a, lds); STEP_END
    STEP_BEGIN(1) if (PHON(18)) phase_modreduce(cx, a, lds); STEP_END
    run_group<0>(a, lds, wave_s);
    run_group<1>(a, lds, wave_s);
    run_group<2>(a, lds, wave_s);
    run_group<3>(a, lds, wave_s);
}


#ifdef PROBE_STEP
__global__ void probe_kernel(const unsigned char* ws, float* out) {
    const size_t n = (size_t)65536 * 1024, q = n / 4;
    const bf16_t* r0 = (const bf16_t*)(ws + PROBE_R0); const bf16_t* r1 = (const bf16_t*)(ws + PROBE_R1); const bf16_t* r2 = (const bf16_t*)(ws + PROBE_R2); const bf16_t* r3 = (const bf16_t*)(ws + PROBE_R3);
    for (size_t i = (size_t)blockIdx.x * blockDim.x + threadIdx.x; i < q; i += (size_t)gridDim.x * blockDim.x) {
        out[i] = bf2f(r0[i]); out[q + i] = bf2f(r1[i]); out[2 * q + i] = bf2f(r2[i]); out[3 * q + i] = bf2f(r3[i]); }
}
#endif
extern "C" void kernel_launch(void* const* d_in, const int* in_sizes, int n_in, void* d_out, int out_size, void* d_ws, size_t ws_size, hipStream_t stream) {
    static int grid = 0;
    if (grid == 0) {
        if (n_in != 26 || ws_size < WS_END) { fprintf(stderr, "kernel_launch: unexpected inputs (n_in %d, ws %zu, need %zu)\n", n_in, ws_size, (size_t)WS_END); grid = -1; return; }
        int dev = 0, cus = 0, per_cu = 0;
        hipGetDevice(&dev); hipDeviceGetAttribute(&cus, hipDeviceAttributeMultiprocessorCount, dev);
        if (hipFuncSetAttribute((const void*)fwd_kernel, hipFuncAttributeMaxDynamicSharedMemorySize, LDS_BYTES) != hipSuccess) { fprintf(stderr, "kernel_launch: hipFuncSetAttribute failed\n"); grid = -1; return; }
        hipOccupancyMaxActiveBlocksPerMultiprocessor(&per_cu, (const void*)fwd_kernel, NTHR, LDS_BYTES);
        (void)hipGetLastError();
        if (per_cu < 1) per_cu = 1;
        grid = cus * 1;
    }
    if (grid < 0) return;
    Args a{};
    for (int i = 0; i < 26; ++i) a.in[i] = (const float*)d_in[i];
    a.out = (float*)d_out; a.ws = (unsigned char*)d_ws;
    const int nsteps = 2 + NG * NPH;
#if ONE_LAUNCH
    (void)hipMemsetAsync(d_ws, 0, 65536, stream);
    a.lo = 0; a.hi = nsteps;
    void* args[] = {&a};
    hipError_t e = hipLaunchCooperativeKernel((const void*)fwd_kernel, dim3(grid), dim3(NTHR), args, LDS_BYTES, stream);
    if (e != hipSuccess) fprintf(stderr, "cooperative launch failed: %s (grid %d)\n", hipGetErrorString(e), grid);
#else
#ifdef PROBE_STEP
    for (int s = 0; s <= PROBE_STEP; ++s) { a.lo = s; a.hi = s + 1; hipLaunchKernelGGL(fwd_kernel, dim3(grid), dim3(NTHR), LDS_BYTES, stream, a); }
    hipLaunchKernelGGL(probe_kernel, dim3(2048), dim3(256), 0, stream, (const unsigned char*)d_ws, (float*)d_out);
#else
    for (int s = 0; s < nsteps; ++s) { a.lo = s; a.hi = s + 1; hipLaunchKernelGGL(fwd_kernel, dim3(grid), dim3(NTHR), LDS_BYTES, stream, a); }
#endif
#endif
}
```

```cpp
#include <hip/hip_runtime.h>
#include <hip/hip_cooperative_groups.h>
#include <cstdio>
#include <cstdint>
namespace cg = cooperative_groups;

#ifndef ONE_LAUNCH
#define ONE_LAUNCH 1
#endif

#ifndef PHMASK
#define PHMASK 0x1fffff
#endif
#define PHON(n) (((PHMASK) >> (n)) & 1)
#define LAS __attribute__((address_space(3)))
typedef unsigned short bf16_t;
typedef short bf16x8 __attribute__((ext_vector_type(8)));
typedef float f32x4 __attribute__((ext_vector_type(4)));
typedef float f32x2 __attribute__((ext_vector_type(2)));
typedef unsigned u32x4 __attribute__((ext_vector_type(4)));
typedef unsigned u32x2 __attribute__((ext_vector_type(2)));

constexpr int D = 1024, NB = 32, T = 2048, CL = 256, FH = 2816, INW = 7200, PN = 7424, NMOD = 9216;
constexpr int NG = 4, BG = NB / NG;
constexpr int RL = BG * T, RC = BG * CL, RG = RL + RC;
constexpr int NCH = 36;
constexpr float EPS = 1e-6f;
constexpr int PQ = 0, PK = 512, PV = 1024, PGG = 2048, PXL = 3072, PYL = 4096, PGA = 5120, PGB = 6144, PFD = 7168;

constexpr size_t al(size_t x) { return (x + 4095) & ~(size_t)4095; }
constexpr size_t WS_WI1 = 1 << 20;
constexpr size_t WS_WO1 = WS_WI1 + al((size_t)2 * FH * D * 2);
constexpr size_t WS_WI2 = WS_WO1 + al((size_t)D * FH * 2);
constexpr size_t WS_WO2 = WS_WI2 + al((size_t)2 * FH * D * 2);
constexpr size_t WS_WIN = WS_WO2 + al((size_t)D * FH * 2);
constexpr size_t WS_WOG = WS_WIN + al((size_t)PN * D * 2);
constexpr size_t WS_WOL = WS_WOG + al((size_t)D * D * 2);
constexpr size_t WS_WOO = WS_WOL + al((size_t)D * D * 2);
constexpr size_t WS_WLG = WS_WOO + al((size_t)D * D * 2);
constexpr size_t WS_MODP = WS_WLG + al((size_t)4096 * 128 * 2);
constexpr size_t WS_MOD = WS_MODP + al((size_t)16 * 33 * NMOD * 4);
constexpr size_t WS_GC = WS_MOD + al((size_t)33 * NMOD * 4);
constexpr size_t WS_H1 = WS_GC + al((size_t)6 * D * 4);
constexpr size_t WS_U = WS_H1 + al((size_t)RG * D * 4);
constexpr size_t WS_BIG = WS_U + al((size_t)RG * D * 2);
constexpr size_t WS_XC = WS_BIG + al((size_t)RG * PN * 2);
constexpr size_t WS_LA = WS_XC + al((size_t)RG * D * 2);
constexpr size_t WS_UU = WS_LA + al((size_t)2 * RG * D * 2);
constexpr size_t WS_HFB = WS_UU + al((size_t)2 * RG * D * 2);
constexpr size_t WS_OFB = WS_HFB + al((size_t)2 * RL * D * 2);
constexpr size_t GT = (size_t)2 * BG * NCH * 4;
constexpr size_t WS_QD = WS_OFB + al((size_t)2 * RL * D * 2);
constexpr size_t WS_KI = WS_QD + al(GT * 8192 * 2);
constexpr size_t WS_KET = WS_KI + al(GT * 8192 * 2);
constexpr size_t WS_VT = WS_KET + al(GT * 8192 * 2);
constexpr size_t WS_BL = WS_VT + al((size_t)BG * NCH * 4 * 16384 * 2);
constexpr size_t WS_END = WS_BL + al(GT * 128 * 4);
static_assert(WS_END <= (size_t)1073741824, "workspace map exceeds 1 GiB");

constexpr int LDS_BYTES = 163840, PTAB = LDS_BYTES - 512;

typedef __bf16 bf16x2_t __attribute__((ext_vector_type(2)));
__device__ __forceinline__ unsigned cvt_pk_bf16(float lo, float hi) { const f32x2 v = {lo, hi}; return __builtin_bit_cast(unsigned, __builtin_convertvector(v, bf16x2_t)); }
__device__ __forceinline__ bf16_t f2bf(float f) { return (bf16_t)(cvt_pk_bf16(f, 0.f) & 0xffffu); }
__device__ __forceinline__ float bf2f(bf16_t h) { return __uint_as_float(((unsigned)h) << 16); }
__device__ __forceinline__ float bflo(unsigned w) { return __uint_as_float(w << 16); }
__device__ __forceinline__ float bfhi(unsigned w) { return __uint_as_float(w & 0xffff0000u); }
__device__ __forceinline__ float sigmoidf_(float x) { return __builtin_amdgcn_rcpf(1.0f + __expf(-x)); }
__device__ __forceinline__ float siluf_(float x) { return x * __builtin_amdgcn_rcpf(1.0f + __expf(-x)); }
__device__ __forceinline__ float geluf_(float x) { const float z = 0.7978845608028654f * (x + 0.044715f * x * x * x); return x * (1.0f - __builtin_amdgcn_rcpf(1.0f + __expf(2.0f * z))); }
__device__ __forceinline__ float logsigf_(float x) { return fminf(x, 0.f) - log1pf(__expf(-fabsf(x))); }
__device__ __forceinline__ float one_minus_exp(float x) {
    const float ser = -x * (1.0f + x * (0.5f + x * (0.16666667f + x * (0.041666668f + x * (0.0083333338f + x * (0.0013888889f + x * 0.0001984127f))))));
    return x > -0.3f ? ser : 1.0f - __expf(x);
}
__device__ __forceinline__ float wave_sum(float v) {
#pragma unroll
    for (int o = 1; o < 64; o <<= 1) v += __shfl_xor(v, o);
    return v;
}
__device__ __forceinline__ void unpack8(const u32x4 w, float (&f)[8]) {
    f[0] = bflo(w.x); f[1] = bfhi(w.x); f[2] = bflo(w.y); f[3] = bfhi(w.y); f[4] = bflo(w.z); f[5] = bfhi(w.z); f[6] = bflo(w.w); f[7] = bfhi(w.w);
}
__device__ __forceinline__ u32x4 pack8(const float (&f)[8]) {
    u32x4 w; w.x = cvt_pk_bf16(f[0], f[1]); w.y = cvt_pk_bf16(f[2], f[3]); w.z = cvt_pk_bf16(f[4], f[5]); w.w = cvt_pk_bf16(f[6], f[7]); return w;
}

namespace pg8 {
constexpr int BM = 256, BK = 64, HALF = 128, HTB = HALF * BK * 2, STAGE_BYTES = 8 * HTB, NXCD = 8, WGM = 8;
__host__ __device__ __forceinline__ int lds_byte(int r, int c) { const int st = (r >> 4) * 2 + (c >> 5), rr = r & 15, cc = c & 31, ob = rr * 64 + cc * 2; return st * 1024 + (ob ^ (((ob >> 9) & 1) << 5)); }
__host__ __device__ __forceinline__ void stage_rc(int b, int& R, int& C) { const int st = b / 1024, sb = b % 1024, swz = sb ^ (((sb >> 9) & 1) << 5); R = (st >> 1) * 16 + swz / 64; C = (st & 1) * 32 + (swz % 64) / 2; }
__host__ __device__ __forceinline__ int perm32(int rho) { const int n = rho >> 4, i = rho & 15; return 8 * (i >> 2) + 4 * n + (i & 3); }
struct Unit { int pm, pn; };
struct Gemm { const bf16_t* A; const bf16_t* Bt; int M, N, K, lda, ldb, a_pn_shift, a_pn_bytes; };
struct StaticOrder {
    int nM, nN, nwg, G, c;
    __device__ void init(int M, int N, int G_, int c_) { nM = M / BM; nN = N / BM; nwg = nM * nN; G = G_; c = c_; }
    __device__ bool next(int i, Unit& u) const {
        const long L = (long)i * G + c; if (L >= nwg) return false;
        int wgid = (int)L; { const int q = nwg / NXCD, r = nwg % NXCD, xcd = wgid % NXCD, off = wgid / NXCD; wgid = (xcd < r ? xcd * (q + 1) : r * (q + 1) + (xcd - r) * q) + off; }
        const int nig = WGM * nN, gid = wgid / nig, fm = gid * WGM, gsz = (nM - fm) < WGM ? (nM - fm) : WGM;
        u.pm = fm + ((wgid % nig) % gsz); u.pn = (wgid % nig) / gsz; return true;
    }
};
template <class Epi, bool ALIGN_EPI>
__device__ __forceinline__ void gemm_phase(const int tid, LAS unsigned char* lds, const Gemm g, const StaticOrder& S, const Epi& E) {
    const int wid = __builtin_amdgcn_readfirstlane(tid >> 6), lane = tid & 63, wr = wid >> 2, wc = wid & 3, fr = lane & 15, fq = lane >> 4;
    const int K = g.K, nt = K / BK;
    unsigned voffA[2], voffB[2];
#pragma unroll
    for (int i = 0; i < 2; ++i) { int R, C; stage_rc(tid * 16 + i * 8192, R, C); const int Rb = Epi::PERM ? ((R & ~31) + perm32(R & 31)) : R;
        voffA[i] = (unsigned)(R * g.lda + C) * 2u; voffB[i] = (unsigned)(Rb * g.ldb + C) * 2u; }
    const size_t kstep = (size_t)(BK * 2);
    const size_t hstepA = (size_t)HALF * g.lda * 2, hstepB = (size_t)HALF * g.ldb * 2;
    const size_t tstepA = 2 * hstepA, tstepB = 2 * hstepB;
    const unsigned ldsw = (unsigned)wid * 1024u;
    const int aoff = lds_byte(wr * 64 + fr, fq * 8), boff = lds_byte(wc * 32 + fr, fq * 8);
#define PG8_SA(b, h) (((b) * 2 + (h)) * HTB)
#define PG8_SB(b, h) ((4 + (b) * 2 + (h)) * HTB)
#define PG8_STAGE(bufoff, gbase, voff) do { _Pragma("unroll") for (int _i = 0; _i < 2; ++_i) \
        __builtin_amdgcn_global_load_lds((const unsigned*)((const char*)(gbase) + (voff)[_i]), (LAS unsigned*)(lds + (bufoff) + ldsw + _i * 8192), 16, 0, 0); } while (0)
#define PG8_LDA(dst, b, h) do { _Pragma("unroll") for (int m = 0; m < 4; ++m) _Pragma("unroll") for (int k = 0; k < 2; ++k) dst[m][k] = *(const LAS bf16x8*)(lds + PG8_SA(b, h) + aoff + m * 2048 + k * 1024); } while (0)
#define PG8_LDB(dst, b, h) do { _Pragma("unroll") for (int n = 0; n < 2; ++n) _Pragma("unroll") for (int k = 0; k < 2; ++k) dst[n][k] = *(const LAS bf16x8*)(lds + PG8_SB(b, h) + boff + n * 2048 + k * 1024); } while (0)
#define PG8_MMA(ai, bj, At, Bt) do { __builtin_amdgcn_s_setprio(1); _Pragma("unroll") for (int m = 0; m < 4; ++m) _Pragma("unroll") for (int n = 0; n < 2; ++n) _Pragma("unroll") for (int k = 0; k < 2; ++k) \
        acc[ai][bj][m][n] = __builtin_amdgcn_mfma_f32_16x16x32_bf16(Bt[n][k], At[m][k], acc[ai][bj][m][n], 0, 0, 0); __builtin_amdgcn_s_setprio(0); } while (0)
#define PG8_WAIT_V(n) asm volatile("s_waitcnt vmcnt(" #n ")" ::: "memory")
#define PG8_WAIT_L(n) asm volatile("s_waitcnt lgkmcnt(" #n ")" ::: "memory")
#define PG8_BAR __builtin_amdgcn_s_barrier()
#define PG8_SCHED __builtin_amdgcn_sched_barrier(0)
    Unit cur, nxt; int ui = 0;
    if (!S.next(0, cur)) return;
    f32x4 acc[2][2][4][2];
#pragma unroll
    for (int a = 0; a < 2; ++a)
#pragma unroll
        for (int b = 0; b < 2; ++b)
#pragma unroll
            for (int m = 0; m < 4; ++m)
#pragma unroll
                for (int n = 0; n < 2; ++n) acc[a][b][m][n] = (f32x4){0.f, 0.f, 0.f, 0.f};
    bf16x8 At[4][2], B0[2][2], B1[2][2];
    const char* cA = (const char*)g.A + (size_t)cur.pm * tstepA + (size_t)((cur.pn >> g.a_pn_shift) * g.a_pn_bytes);
    const char* cB = (const char*)g.Bt + (size_t)cur.pn * tstepB;
    PG8_STAGE(PG8_SB(0, 0), cB, voffB); PG8_STAGE(PG8_SB(0, 1), cB + hstepB, voffB); PG8_STAGE(PG8_SA(0, 0), cA, voffA); PG8_STAGE(PG8_SA(0, 1), cA + hstepA, voffA);
    if (wr == 1) PG8_BAR;
    PG8_WAIT_V(2); PG8_BAR;
    PG8_STAGE(PG8_SB(1, 0), cB + kstep, voffB); PG8_STAGE(PG8_SA(1, 0), cA + kstep, voffA); PG8_STAGE(PG8_SB(1, 1), cB + hstepB + kstep, voffB);
    PG8_WAIT_V(6); PG8_BAR;
    for (;;) {
        const bool has_next = S.next(ui + 1, nxt);
        const char* nA = has_next ? (const char*)g.A + (size_t)nxt.pm * tstepA + (size_t)((nxt.pn >> g.a_pn_shift) * g.a_pn_bytes) : cA;
        const char* nB = has_next ? (const char*)g.Bt + (size_t)nxt.pn * tstepB : cB;
        for (int t = 0; t < nt; t += 2) {
            const bool last = (t == nt - 2);
            const char* a1 = cA + (size_t)(t + 1) * kstep;
            const char* a2 = last ? nA : cA + (size_t)(t + 2) * kstep; const char* b2 = last ? nB : cB + (size_t)(t + 2) * kstep;
            const char* a3 = a2 + kstep; const char* b3 = b2 + kstep;
            PG8_LDB(B0, 0, 0); PG8_LDB(B1, 0, 1); PG8_SCHED; PG8_LDA(At, 0, 0); PG8_STAGE(PG8_SA(1, 1), a1 + hstepA, voffA);
            PG8_WAIT_V(8); PG8_WAIT_L(0); PG8_BAR; PG8_MMA(0, 0, At, B0); PG8_MMA(0, 1, At, B1); PG8_BAR; PG8_SCHED;
            PG8_LDA(At, 0, 1); PG8_STAGE(PG8_SB(0, 0), b2, voffB); PG8_STAGE(PG8_SB(0, 1), b2 + hstepB, voffB); PG8_STAGE(PG8_SA(0, 0), a2, voffA);
            PG8_WAIT_V(8); PG8_WAIT_L(0); PG8_BAR; PG8_MMA(1, 0, At, B0); PG8_MMA(1, 1, At, B1); PG8_BAR; PG8_SCHED;
            PG8_LDB(B0, 1, 0); PG8_LDB(B1, 1, 1); PG8_SCHED; PG8_LDA(At, 1, 0); PG8_STAGE(PG8_SA(0, 1), a2 + hstepA, voffA);
            PG8_WAIT_V(8); PG8_WAIT_L(0); PG8_BAR; PG8_MMA(0, 0, At, B0); PG8_MMA(0, 1, At, B1); PG8_BAR; PG8_SCHED;
            PG8_LDA(At, 1, 1); PG8_STAGE(PG8_SB(1, 0), b3, voffB); PG8_STAGE(PG8_SB(1, 1), b3 + hstepB, voffB); PG8_STAGE(PG8_SA(1, 0), a3, voffA);
            PG8_WAIT_V(8); PG8_WAIT_L(0); PG8_BAR; PG8_MMA(1, 0, At, B0); PG8_MMA(1, 1, At, B1); PG8_BAR; PG8_SCHED;
        }
        if constexpr (ALIGN_EPI) { if (wr == 0) PG8_BAR; }
        { int fr_ = fr, fq_ = fq; asm volatile("" : "+v"(fr_), "+v"(fq_)); E(acc, cur, wr, wc, fr_, fq_); }
        if (!has_next) break;
#pragma unroll
        for (int a = 0; a < 2; ++a)
#pragma unroll
            for (int b = 0; b < 2; ++b)
#pragma unroll
                for (int m = 0; m < 4; ++m)
#pragma unroll
                    for (int n = 0; n < 2; ++n) acc[a][b][m][n] = (f32x4){0.f, 0.f, 0.f, 0.f};
        cur = nxt; cA = nA; cB = nB; ++ui;
        if constexpr (ALIGN_EPI) { if (wr == 1) PG8_BAR; }
    }
    PG8_WAIT_V(0);
    if constexpr (!ALIGN_EPI) { if (wr == 0) PG8_BAR; }
    PG8_BAR;
#undef PG8_SA
#undef PG8_SB
#undef PG8_STAGE
#undef PG8_LDA
#undef PG8_LDB
#undef PG8_MMA
#undef PG8_WAIT_V
#undef PG8_WAIT_L
#undef PG8_BAR
#undef PG8_SCHED
}

struct EpiBf16 {
    static constexpr bool PERM = true;
    bf16_t* O; int ldc;
    __device__ __forceinline__ void operator()(const f32x4 (&acc)[2][2][4][2], const Unit& u, int wr, int wc, int fr, int fq) const {
        const int row0 = u.pm * BM + wr * 64 + fr, col0 = u.pn * BM + wc * 32 + 8 * fq;
#pragma unroll
        for (int ai = 0; ai < 2; ++ai)
#pragma unroll
            for (int m = 0; m < 4; ++m) { bf16_t* rowp = O + (size_t)(row0 + ai * HALF + m * 16) * ldc + col0;
#pragma unroll
                for (int bj = 0; bj < 2; ++bj) { const f32x4 v0 = acc[ai][bj][m][0], v1 = acc[ai][bj][m][1];
                    u32x4 w; w.x = cvt_pk_bf16(v0[0], v0[1]); w.y = cvt_pk_bf16(v0[2], v0[3]); w.z = cvt_pk_bf16(v1[0], v1[1]); w.w = cvt_pk_bf16(v1[2], v1[3]);
                    *(u32x4*)(rowp + bj * HALF) = w; } }
    }
};
struct EpiSwiglu {
    static constexpr bool PERM = true;
    bf16_t* O; int ldc;
    __device__ __forceinline__ void operator()(const f32x4 (&acc)[2][2][4][2], const Unit& u, int wr, int wc, int fr, int fq) const {
        const int row0 = u.pm * BM + wr * 64 + fr, col0 = u.pn * HALF + wc * 32 + 8 * fq;
#pragma unroll
        for (int ai = 0; ai < 2; ++ai)
#pragma unroll
            for (int m = 0; m < 4; ++m) { bf16_t* rowp = O + (size_t)(row0 + ai * HALF + m * 16) * ldc + col0;
                float o[8];
#pragma unroll
                for (int n = 0; n < 2; ++n)
#pragma unroll
                    for (int j = 0; j < 4; ++j) o[4 * n + j] = siluf_(acc[ai][0][m][n][j]) * acc[ai][1][m][n][j];
                *(u32x4*)rowp = pack8(o); }
    }
};
struct EpiResid {
    static constexpr bool PERM = false;
    const float* baseL; const float* baseC; float* outL; float* outC; const float* modL; const float* modC; float scale; int nlat;
    __device__ __forceinline__ void operator()(const f32x4 (&acc)[2][2][4][2], const Unit& u, int wr, int wc, int fr, int fq) const {
        const bool lat = u.pm < nlat;
        const size_t toff = (size_t)(lat ? u.pm : u.pm - nlat) * BM * D + (size_t)(wr * 64 + fr) * D + u.pn * BM + wc * 32 + 4 * fq;
        const float* base = (lat ? baseL : baseC) + toff;
        float* out = (lat ? outL : outC) + toff;
        const float* mg = (lat ? modL + (size_t)(u.pm >> 3) * NMOD : modC) + u.pn * BM + wc * 32 + 4 * fq;
#pragma unroll
        for (int bj = 0; bj < 2; ++bj)
#pragma unroll
            for (int n = 0; n < 2; ++n) { const f32x4 gv = *(const f32x4*)(mg + bj * HALF + n * 16) * scale;
#pragma unroll
                for (int ai = 0; ai < 2; ++ai)
#pragma unroll
                    for (int m = 0; m < 4; ++m) { const size_t off = (size_t)(ai * HALF + m * 16) * D + bj * HALF + n * 16;
                        const f32x4 bs = *(const f32x4*)(base + off); *(f32x4*)(out + off) = bs + gv * acc[ai][bj][m][n]; } }
    }
};
__device__ __forceinline__ float one_minus_exp(float x) {
    const float ser = -x * (1.0f + x * (0.5f + x * (0.16666667f + x * (0.041666668f + x * (0.0083333338f + x * (0.0013888889f + x * 0.0001984127f))))));
    return x > -0.3f ? ser : 1.0f - __expf(x);
}
struct EpiGate {
    static constexpr bool PERM = true;
    bf16_t* LA; bf16_t* UU;
    __device__ __forceinline__ void operator()(const f32x4 (&acc)[2][2][4][2], const Unit& u, int wr, int wc, int fr, int fq) const {
        const int blk = u.pn >> 1, dir = u.pn & 1, ch0 = blk * HALF + wc * 32 + 8 * fq, row0 = u.pm * BM + wr * 64 + fr;
#pragma unroll
        for (int ai = 0; ai < 2; ++ai)
#pragma unroll
            for (int m = 0; m < 4; ++m) { const size_t off = (size_t)dir * RG * D + (size_t)(row0 + ai * HALF + m * 16) * D + ch0;
#pragma unroll
                for (int bj = 0; bj < 2; ++bj) { const f32x4 v0 = acc[ai][bj][m][0], v1 = acc[ai][bj][m][1];
                    u32x4 w; w.x = cvt_pk_bf16(v0[0], v0[1]); w.y = cvt_pk_bf16(v0[2], v0[3]); w.z = cvt_pk_bf16(v1[0], v1[1]); w.w = cvt_pk_bf16(v1[2], v1[3]);
                    *(u32x4*)((bj ? UU : LA) + off) = w; } }
    }
};
template <bool ACCUM> struct EpiMix {
    static constexpr bool PERM = true;
    const bf16_t* PROJ; int gcol; bf16_t* MG;
    __device__ __forceinline__ void operator()(const f32x4 (&acc)[2][2][4][2], const Unit& u, int wr, int wc, int fr, int fq) const {
        const int row0 = u.pm * BM + wr * 64 + fr, col0 = u.pn * BM + wc * 32 + 8 * fq;
#pragma unroll
        for (int ai = 0; ai < 2; ++ai)
#pragma unroll
            for (int m = 0; m < 4; ++m) { const size_t row = (size_t)(row0 + ai * HALF + m * 16);
#pragma unroll
                for (int bj = 0; bj < 2; ++bj) { float gt[8], o[8]; unpack8(*(const u32x4*)(PROJ + row * PN + gcol + col0 + bj * HALF), gt);
                    bf16_t* dst = MG + row * D + col0 + bj * HALF;
                    if (ACCUM) unpack8(*(const u32x4*)dst, o); else {
#pragma unroll
                        for (int i = 0; i < 8; ++i) o[i] = 0.f; }
#pragma unroll
                    for (int n = 0; n < 2; ++n)
#pragma unroll
                        for (int j = 0; j < 4; ++j) o[4 * n + j] += sigmoidf_(gt[4 * n + j]) * acc[ai][bj][m][n][j];
                    *(u32x4*)dst = pack8(o); } }
    }
};
}

struct Args {
    const float* in[26]; float* out; unsigned char* ws; int lo, hi;
};
enum { I_X = 0, I_C, I_CTX, I_CCTX, I_WADA, I_BADA, I_NORMW, I_F1WI, I_F1WO, I_F2WI, I_F2WO, I_WIN, I_FUP, I_FB, I_GNW, I_CONVW, I_CONVB, I_WR, I_BR, I_WI, I_BI, I_LAM, I_WOG, I_WOL, I_WOO, I_FNW };

#define NTHR 512
__device__ __forceinline__ const float* inp(const LAS unsigned char* lds, int i) { const LAS unsigned* t = (const LAS unsigned*)(lds + PTAB) + 2 * i;
    const unsigned lo = __builtin_amdgcn_readfirstlane(t[0]), hi = __builtin_amdgcn_readfirstlane(t[1]); return (const float*)(((unsigned long long)hi << 32) | lo); }
#define AIN(i) inp(lds, (i))
struct Ctx { int tid, bid, G; };
#define GW() (cx.bid * 8 + (cx.tid >> 6))
#define NGW() (cx.G * 8)

__device__ __forceinline__ void transpose_item(const float* W, int ldw, int K, int k0, int n0, bf16_t* WT, int drow, LAS float* scr, int lane) {
#pragma unroll 8
    for (int i = 0; i < 32; ++i) { const int kk = 2 * i + (lane >> 5); scr[kk * 33 + (lane & 31)] = W[(size_t)(k0 + kk) * ldw + n0 + (lane & 31)]; }
    asm volatile("s_waitcnt lgkmcnt(0)" ::: "memory");
    const int c = lane & 7;
#pragma unroll
    for (int j = 0; j < 4; ++j) { const int n = (lane >> 3) + 8 * j; const LAS float* s = scr + (8 * c) * 33 + n;
        u32x4 o; o.x = cvt_pk_bf16(s[0 * 33], s[1 * 33]); o.y = cvt_pk_bf16(s[2 * 33], s[3 * 33]); o.z = cvt_pk_bf16(s[4 * 33], s[5 * 33]); o.w = cvt_pk_bf16(s[6 * 33], s[7 * 33]);
        *(u32x4*)(WT + (size_t)(drow + n) * K + k0 + 8 * c) = o; }
    asm volatile("s_waitcnt lgkmcnt(0)" ::: "memory");
}
__device__ __forceinline__ int wi_drow(int n0) { return n0 < FH ? (n0 >> 7) * 256 + (n0 & 127) : ((n0 - FH) >> 7) * 256 + 128 + ((n0 - FH) & 127); }
__device__ __forceinline__ int win_drow(int n0) { return n0 < 3072 ? n0 : (n0 == 3072 ? PFD : n0 - 32); }

__device__ __forceinline__ void phase_weights(const Ctx cx, const Args& a, LAS unsigned char* lds) {
    const int lane = cx.tid & 63, wave = cx.tid >> 6;
    LAS float* scr = (LAS float*)(lds + wave * 16384);
    unsigned char* ws = a.ws;
    constexpr int I_WI_ = (D / 64) * (2 * FH / 32), I_WO_ = (FH / 64) * (D / 32), I_IN_ = (D / 64) * (INW / 32), I_SQ_ = (D / 64) * (D / 32), I_LG_ = 32 * 8;
    constexpr int NIT = 2 * I_WI_ + 2 * I_WO_ + I_IN_ + 3 * I_SQ_ + I_LG_;
    if (PHON(19)) for (int it = GW(); it < NIT; it += NGW()) {
        int r = it;
        if (r < 2 * I_WI_) { const int w = r / I_WI_; r %= I_WI_; const int nb = 2 * FH / 32, kb = r / nb, n0 = (r % nb) * 32;
            transpose_item(AIN(w ? I_F2WI : I_F1WI), 2 * FH, D, kb * 64, n0, (bf16_t*)(ws + (w ? WS_WI2 : WS_WI1)), wi_drow(n0), scr, lane); continue; }
        r -= 2 * I_WI_;
        if (r < 2 * I_WO_) { const int w = r / I_WO_; r %= I_WO_; const int nb = D / 32, kb = r / nb, n0 = (r % nb) * 32;
            transpose_item(AIN(w ? I_F2WO : I_F1WO), D, FH, kb * 64, n0, (bf16_t*)(ws + (w ? WS_WO2 : WS_WO1)), n0, scr, lane); continue; }
        r -= 2 * I_WO_;
        if (r < I_IN_) { const int nb = INW / 32, kb = r / nb, n0 = (r % nb) * 32;
            transpose_item(AIN(I_WIN), INW, D, kb * 64, n0, (bf16_t*)(ws + WS_WIN), win_drow(n0), scr, lane); continue; }
        r -= I_IN_;
        if (r < 3 * I_SQ_) { const int w = r / I_SQ_; r %= I_SQ_; const int nb = D / 32, kb = r / nb, n0 = (r % nb) * 32;
            transpose_item(AIN(w == 0 ? I_WOG : (w == 1 ? I_WOL : I_WOO)), D, D, kb * 64, n0, (bf16_t*)(ws + (w == 0 ? WS_WOG : (w == 1 ? WS_WOL : WS_WOO))), n0, scr, lane); continue; }
        r -= 3 * I_SQ_;
        { const int mat = r >> 3, sub = r & 7, gate = mat >> 4, dir = (mat >> 3) & 1, blk = mat & 7;
          const float* src = AIN(gate ? I_WI : I_WR) + (size_t)(dir * 8 + blk) * 128 * 128;
          const int kb = sub >> 2, n0 = (sub & 3) * 32;
          transpose_item(src, 128, 128, kb * 64, n0, (bf16_t*)(ws + WS_WLG), ((blk * 2 + dir) * 2 + gate) * 128 + n0, scr, lane); }
    }
    { u32x4* z = (u32x4*)(ws + WS_WIN + (size_t)INW * D * 2); const int n16 = (PN - INW) * D * 2 / 16;
      for (int i = cx.bid * NTHR + cx.tid; i < n16; i += cx.G * NTHR) z[i] = (u32x4){0u, 0u, 0u, 0u}; }
    __syncthreads();
    LAS float* sl = (LAS float*)lds;
    float* MODP = (float*)(ws + WS_MODP);
    if (PHON(20)) for (int item = cx.bid; item < 18 * 16; item += cx.G) {
        const int cb = item % 18, ks = item / 18, col = cb * 512 + cx.tid;
        for (int idx = cx.tid; idx < 33 * 64; idx += NTHR) { const int b = idx >> 6, k = idx & 63; const float cv = b < 32 ? AIN(I_C)[b * D + ks * 64 + k] : AIN(I_CCTX)[ks * 64 + k]; sl[idx] = siluf_(cv); }
        __syncthreads();
        float acc[33];
#pragma unroll
        for (int b = 0; b < 33; ++b) acc[b] = 0.f;
        const float* wp = AIN(I_WADA) + (size_t)(ks * 64) * NMOD + col;
#pragma unroll 4
        for (int k = 0; k < 64; ++k) { const float w = wp[(size_t)k * NMOD];
#pragma unroll
            for (int b = 0; b < 33; ++b) acc[b] += sl[b * 64 + k] * w; }
#pragma unroll
        for (int b = 0; b < 33; ++b) MODP[(size_t)(ks * 33 + b) * NMOD + col] = acc[b];
        __syncthreads();
    }
}
__device__ __forceinline__ void phase_modreduce(const Ctx cx, const Args& a, LAS unsigned char* lds) {
    const float* MODP = (const float*)(a.ws + WS_MODP); float* MOD = (float*)(a.ws + WS_MOD);
    for (int idx = cx.bid * NTHR + cx.tid; idx < 33 * NMOD; idx += cx.G * NTHR) {
        float s = AIN(I_BADA)[idx % NMOD];
#pragma unroll
        for (int ks = 0; ks < 16; ++ks) s += MODP[(size_t)ks * 33 * NMOD + idx];
        MOD[idx] = s;
    }
    float* GC = (float*)(a.ws + WS_GC);
    for (int idx = cx.bid * NTHR + cx.tid; idx < 2 * D; idx += cx.G * NTHR) { GC[idx] = AIN(I_BR)[idx]; GC[2 * D + idx] = AIN(I_BI)[idx]; GC[4 * D + idx] = 8.0f * log1pf(__expf(-AIN(I_LAM)[idx])); }
}

__device__ __forceinline__ void phase_normmod(const Ctx cx, const Args& a, LAS unsigned char* lds, int g, int mode, int nrows, int sub) {
    const int lane = cx.tid & 63;
    const float* MOD = (const float*)(a.ws + WS_MOD); const float* nw = AIN(I_NORMW) + sub * D;
    const float* H1 = (const float*)(a.ws + WS_H1); bf16_t* U = (bf16_t*)(a.ws + WS_U);
    for (int r = GW(); r < nrows; r += NGW()) {
        const float* src = mode ? H1 + (size_t)r * D : (r < RL ? AIN(I_X) + ((size_t)g * RL + r) * D : AIN(I_CTX) + ((size_t)g * RC + (r - RL)) * D);
        const int mrow = r < RL ? g * BG + r / T : 32;
        const float* sh = MOD + (size_t)mrow * NMOD + (3 * sub) * D; const float* sc = sh + D;
        f32x4 v[4]; float ss = 0.f;
#pragma unroll
        for (int j = 0; j < 4; ++j) { v[j] = ((const f32x4*)src)[lane + 64 * j]; ss += (v[j].x * v[j].x + v[j].y * v[j].y) + (v[j].z * v[j].z + v[j].w * v[j].w); }
        const float rstd = 1.0f / sqrtf(wave_sum(ss) * (1.0f / D) + EPS);
#pragma unroll
        for (int j = 0; j < 4; ++j) { const int c4 = lane + 64 * j; const f32x4 w = ((const f32x4*)nw)[c4], s4 = ((const f32x4*)sh)[c4], c1 = ((const f32x4*)sc)[c4];
            const f32x4 o = v[j] * rstd * w * (c1 + 1.0f) + s4;
            u32x2 p; p.x = cvt_pk_bf16(o.x, o.y); p.y = cvt_pk_bf16(o.z, o.w); ((u32x2*)(U + (size_t)r * D))[c4] = p; }
    }
}
__device__ __forceinline__ void phase_final(const Ctx cx, const Args& a, LAS unsigned char* lds, int g) {
    const int lane = cx.tid & 63; const float* fw = AIN(I_FNW);
    for (int r = GW(); r < RL; r += NGW()) {
        float* row = a.out + ((size_t)g * RL + r) * D;
        f32x4 v[4]; float ss = 0.f;
#pragma unroll
        for (int j = 0; j < 4; ++j) { v[j] = ((const f32x4*)row)[lane + 64 * j]; ss += (v[j].x * v[j].x + v[j].y * v[j].y) + (v[j].z * v[j].z + v[j].w * v[j].w); }
        const float rstd = 1.0f / sqrtf(wave_sum(ss) * (1.0f / D) + EPS);
#pragma unroll
        for (int j = 0; j < 4; ++j) { const int c4 = lane + 64 * j; ((f32x4*)row)[c4] = v[j] * rstd * ((const f32x4*)fw)[c4]; }
    }
}

__device__ __forceinline__ float logsig_fast(float x) { return fminf(x, 0.f) - __logf(1.0f + __expf(-fabsf(x))); }
__device__ __forceinline__ void phase_prep(const Ctx cx, const Args& a, int g, LAS unsigned char* lds) {
    const bf16_t* PROJ = (const bf16_t*)(a.ws + WS_BIG);
    const int tid = cx.tid;
    {
        LAS bf16_t* qs = (LAS bf16_t*)lds; LAS bf16_t* ks = (LAS bf16_t*)(lds + 16384); LAS float* fdl = (LAS float*)(lds + 32768); LAS float* part = (LAS float*)(lds + 36864);
        LAS bf16_t* qo = (LAS bf16_t*)(lds + 40960); LAS bf16_t* ko = (LAS bf16_t*)(lds + 57344);
        const int d = tid & 127, qt = tid >> 7;
        for (int item = cx.bid; item < BG * NCH * 8; item += cx.G) {
            const int h = item & 3, dir = (item >> 2) & 1, bc = item >> 3, b = bc / NCH, c = bc % NCH;
            const int row0 = c < 4 ? RL + b * CL + c * 64 : b * T + (c - 4) * 64;
            const bool lat = c >= 4;
#pragma unroll
            for (int k = 0; k < 2; ++k) { const int p = tid + 512 * k, r = p >> 4, c8 = (p & 15) * 8;
                *(LAS u32x4*)(ks + r * 128 + c8) = *(const u32x4*)(PROJ + (size_t)(row0 + r) * PN + PK + h * 128 + c8);
                if (lat) *(LAS u32x4*)(qs + r * 128 + c8) = *(const u32x4*)(PROJ + (size_t)(row0 + r) * PN + PQ + h * 128 + c8); }
#pragma unroll
            for (int k = 0; k < 2; ++k) { const int idx = tid + 512 * k; fdl[idx] = bf2f(PROJ[(size_t)(row0 + (idx >> 4)) * PN + PFD + dir * 16 + (idx & 15)]); }
            const int col = h * 128 + d;
            float fw[16];
#pragma unroll
            for (int r = 0; r < 16; ++r) fw[r] = AIN(I_FUP)[(size_t)(dir * 16 + r) * 512 + col];
            const float fbv = AIN(I_FB)[dir * 512 + col];
            __syncthreads();
            float la[16]; float psum = 0.f;
#pragma unroll
            for (int t = 0; t < 16; ++t) { const int i = 16 * qt + t; float dot = fbv;
#pragma unroll
                for (int r = 0; r < 16; ++r) dot += fdl[i * 16 + r] * fw[r];
                la[t] = logsig_fast(dot) * (1.0f / 16.0f); psum += la[t]; }
            part[qt * 128 + d] = psum;
            __syncthreads();
            const float p0 = part[d], p1 = part[128 + d], p2 = part[256 + d], p3 = part[384 + d];
            const float tot = (p0 + p1) + (p2 + p3);
            float run = dir == 0 ? (qt > 0 ? p0 : 0.f) + (qt > 1 ? p1 : 0.f) + (qt > 2 ? p2 : 0.f)
                                 : (qt < 3 ? p3 : 0.f) + (qt < 2 ? p2 : 0.f) + (qt < 1 ? p1 : 0.f);
            float ke[16];
            if (dir == 0) {
#pragma unroll
                for (int t = 0; t < 16; ++t) { const int i = 16 * qt + t; run += la[t];
                    const float kv = bf2f(ks[i * 128 + d]); ke[t] = kv * __expf(tot - run);
                    if (lat) { qo[i * 128 + d] = f2bf(bf2f(qs[i * 128 + d]) * 0.08838834764831845f * __expf(run)); ko[i * 128 + d] = f2bf(kv * __expf(-run)); } }
            } else {
#pragma unroll
                for (int t = 15; t >= 0; --t) { const int i = 16 * qt + t; run += la[t];
                    const float kv = bf2f(ks[i * 128 + d]); ke[t] = kv * __expf(tot - run);
                    if (lat) { qo[i * 128 + d] = f2bf(bf2f(qs[i * 128 + d]) * 0.08838834764831845f * __expf(run)); ko[i * 128 + d] = f2bf(kv * __expf(-run)); } }
            }
            const size_t tb = (((size_t)dir * BG + b) * NCH + c) * 4 + h;
            bf16_t* KET = (bf16_t*)(a.ws + WS_KET) + tb * 8192 + d * 64 + 16 * qt;
            { float k0[8], k1[8];
#pragma unroll
              for (int t = 0; t < 8; ++t) { k0[t] = ke[t]; k1[t] = ke[8 + t]; }
              *(u32x4*)KET = pack8(k0); *(u32x4*)(KET + 8) = pack8(k1); }
            if (qt == 0) ((float*)(a.ws + WS_BL))[tb * 128 + d] = tot;
            __syncthreads();
            if (lat) { bf16_t* QD = (bf16_t*)(a.ws + WS_QD) + tb * 8192; bf16_t* KI = (bf16_t*)(a.ws + WS_KI) + tb * 8192;
#pragma unroll
                for (int k = 0; k < 2; ++k) { const int p = tid + 512 * k; *(u32x4*)(QD + p * 8) = *(const LAS u32x4*)(qo + p * 8); *(u32x4*)(KI + p * 8) = *(const LAS u32x4*)(ko + p * 8); } }
            __syncthreads();
        }
    }
    {
        LAS bf16_t* vs = (LAS bf16_t*)lds;
        const int e = tid & 255, jh = tid >> 8;
        for (int item = cx.bid; item < BG * NCH * 4; item += cx.G) {
            const int h = item & 3, bc = item >> 2, b = bc / NCH, c = bc % NCH;
            const int row0 = c < 4 ? RL + b * CL + c * 64 : b * T + (c - 4) * 64;
#pragma unroll
            for (int k = 0; k < 4; ++k) { const int p = tid + 512 * k, r = p >> 5, c8 = (p & 31) * 8;
                *(LAS u32x4*)(vs + r * 256 + c8) = *(const u32x4*)(PROJ + (size_t)(row0 + r) * PN + PV + h * 256 + c8); }
            __syncthreads();
            bf16_t* VT = (bf16_t*)(a.ws + WS_VT) + ((((size_t)b * NCH + c) * 4 + h) * 256 + e) * 64 + 32 * jh;
#pragma unroll
            for (int jg = 0; jg < 4; ++jg) { float v[8];
#pragma unroll
                for (int jj = 0; jj < 8; ++jj) v[jj] = bf2f(vs[(32 * jh + 8 * jg + jj) * 256 + e]);
                *(u32x4*)(VT + 8 * jg) = pack8(v); }
            __syncthreads();
        }
    }
    bf16_t* XC = (bf16_t*)(a.ws + WS_XC);
    for (int idx = cx.bid * NTHR + cx.tid; idx < RG * 128; idx += cx.G * NTHR) {
        const int row = idx >> 7, c8 = (idx & 127) * 8;
        const int pos = row < RL ? (row & 63) : ((row - RL) & 255), len = row < RL ? 64 : 256;
        float acc[8];
#pragma unroll
        for (int i = 0; i < 8; ++i) acc[i] = AIN(I_CONVB)[c8 + i];
#pragma unroll
        for (int j = 0; j < 4; ++j) { const int p = pos + j - 2;
            if (p >= 0 && p < len) { float xv[8]; unpack8(*(const u32x4*)(PROJ + (size_t)(row + j - 2) * PN + PXL + c8), xv);
#pragma unroll
                for (int i = 0; i < 8; ++i) acc[i] += AIN(I_CONVW)[j * D + c8 + i] * xv[i]; } }
        *(u32x4*)(XC + (size_t)row * D + c8) = pack8(acc);
    }
}

__device__ __forceinline__ void phase_gatefix(const Ctx cx, const Args& a, LAS unsigned char* lds) {
    bf16_t* LA = (bf16_t*)(a.ws + WS_LA); bf16_t* UU = (bf16_t*)(a.ws + WS_UU); const bf16_t* XC = (const bf16_t*)(a.ws + WS_XC); const float* GC = (const float*)(a.ws + WS_GC);
    for (int idx = cx.bid * NTHR + cx.tid; idx < 2 * RG * 128; idx += cx.G * NTHR) {
        const int dir = idx >= RG * 128, rem = idx - dir * RG * 128, row = rem >> 7, c8 = (rem & 127) * 8;
        const size_t off = (size_t)dir * RG * D + (size_t)row * D + c8;
        float r[8], ig[8], xc[8]; unpack8(*(const u32x4*)(LA + off), r); unpack8(*(const u32x4*)(UU + off), ig); unpack8(*(const u32x4*)(XC + (size_t)row * D + c8), xc);
#pragma unroll
        for (int i = 0; i < 8; ++i) { const float l = -GC[(4 + dir) * D + c8 + i] * sigmoidf_(r[i] + GC[dir * D + c8 + i]);
            const float gi = sigmoidf_(ig[i] + GC[(2 + dir) * D + c8 + i]);
            r[i] = l; ig[i] = __builtin_amdgcn_sqrtf(fmaxf(one_minus_exp(2.0f * l), 0.f)) * gi * xc[i]; }
        *(u32x4*)(LA + off) = pack8(r); *(u32x4*)(UU + off) = pack8(ig);
    }
}

__device__ __forceinline__ int img_off(int nkg, int row, int kcol) { const int ob = (row & 15) * 64 + (kcol & 31) * 2; return ((row >> 4) * nkg + (kcol >> 5)) * 1024 + (ob ^ (((ob >> 9) & 1) << 5)); }
__device__ __forceinline__ bf16x8 ldfrag(const LAS unsigned char* img, int nkg, int row, int kcol) { return *(const LAS bf16x8*)(img + img_off(nkg, row, kcol)); }
#define MFMA16(a, b, c) __builtin_amdgcn_mfma_f32_16x16x32_bf16((a), (b), (c), 0, 0, 0)

__device__ __forceinline__ void phase_gla_scan(const Ctx cx, const Args& a, int g, LAS unsigned char* lds) {
    constexpr int XB = 57344, OFF_KI = 16384, OFF_KET = 32768, OFF_VT = 49152, OFF_P = 2 * XB, OFF_ST = OFF_P + 8192, OFF_BL = OFF_ST + 2 * 16384;
    static_assert(OFF_BL + 1024 <= LDS_BYTES, "gla scan LDS");
    const int tid = cx.tid, lane = tid & 63, w = tid >> 6, fr = lane & 15, fq = lane >> 4;
    const bf16_t* QDg = (const bf16_t*)(a.ws + WS_QD); const bf16_t* KIg = (const bf16_t*)(a.ws + WS_KI); const bf16_t* KETg = (const bf16_t*)(a.ws + WS_KET);
    const bf16_t* VTg = (const bf16_t*)(a.ws + WS_VT); const float* BLg = (const float*)(a.ws + WS_BL);
    bf16_t* Og = (bf16_t*)(a.ws + WS_OFB);
    for (int item = cx.bid; item < BG * 32; item += cx.G) {
        const int dvq = item & 3, dir = (item >> 2) & 1, h = (item >> 3) & 3, b = item >> 5;
        { u32x4 z = {0u, 0u, 0u, 0u}; *(LAS u32x4*)(lds + OFF_ST + tid * 32) = z; *(LAS u32x4*)(lds + OFF_ST + tid * 32 + 16) = z; }
        f32x4 accS[4];
#pragma unroll
        for (int t = 0; t < 4; ++t) accS[t] = (f32x4){0.f, 0.f, 0.f, 0.f};
        u32x4 pq[2], pk[2], pe[2], pv; float pbl = 0.f;
#define GLA_LOAD(s_) do { const int c_ = dir == 0 ? (s_) : ((s_) < 4 ? 3 - (s_) : 39 - (s_)); \
            const size_t tb_ = (((size_t)dir * BG + b) * NCH + c_) * 4 + h; \
            if (c_ >= 4) { pq[0] = ((const u32x4*)(QDg + tb_ * 8192))[tid]; pq[1] = ((const u32x4*)(QDg + tb_ * 8192))[tid + 512]; \
                           pk[0] = ((const u32x4*)(KIg + tb_ * 8192))[tid]; pk[1] = ((const u32x4*)(KIg + tb_ * 8192))[tid + 512]; } \
            pe[0] = ((const u32x4*)(KETg + tb_ * 8192))[tid]; pe[1] = ((const u32x4*)(KETg + tb_ * 8192))[tid + 512]; \
            pv = ((const u32x4*)(VTg + ((((size_t)b * NCH + c_) * 4 + h) * 256 + dvq * 64) * 64))[tid]; \
            if (tid < 128) pbl = BLg[tb_ * 128 + tid]; } while (0)
#define GLA_STORE(buf_) do { LAS unsigned char* X_ = lds + (buf_) * XB; \
            _Pragma("unroll") for (int i_ = 0; i_ < 2; ++i_) { const int p_ = tid + 512 * i_; \
                *(LAS u32x4*)(X_ + img_off(4, p_ >> 4, (p_ & 15) * 8)) = pq[i_]; *(LAS u32x4*)(X_ + OFF_KI + img_off(4, p_ >> 4, (p_ & 15) * 8)) = pk[i_]; \
                *(LAS u32x4*)(X_ + OFF_KET + img_off(2, p_ >> 3, (p_ & 7) * 8)) = pe[i_]; } \
            *(LAS u32x4*)(X_ + OFF_VT + img_off(2, tid >> 3, (tid & 7) * 8)) = pv; \
            if (tid < 128) ((LAS float*)(lds + OFF_BL + (buf_) * 512))[tid] = pbl; } while (0)
        pq[0] = pq[1] = pk[0] = pk[1] = (u32x4){0u, 0u, 0u, 0u};
        GLA_LOAD(0); GLA_STORE(0);
        __syncthreads();
        for (int s = 0; s < NCH; ++s) {
            const int cur = s & 1; const bool lat = s >= 4;
            const LAS unsigned char* X = lds + cur * XB;
#ifndef GLA_SAFE
            if (s + 1 < NCH) GLA_LOAD(s + 1);
#endif
            if (lat) {
                const int ti = w >> 1, tj0 = (w & 1) * 2;
                f32x4 sc[2] = {(f32x4){0.f, 0.f, 0.f, 0.f}, (f32x4){0.f, 0.f, 0.f, 0.f}};
#pragma unroll
                for (int kk = 0; kk < 4; ++kk) { const bf16x8 qa = ldfrag(X, 4, 16 * ti + fr, kk * 32 + fq * 8);
#pragma unroll
                    for (int t = 0; t < 2; ++t) { const bf16x8 kb = ldfrag(X + OFF_KI, 4, 16 * (tj0 + t) + fr, kk * 32 + fq * 8); sc[t] = MFMA16(qa, kb, sc[t]); } }
#pragma unroll
                for (int t = 0; t < 2; ++t)
#pragma unroll
                    for (int jj = 0; jj < 4; ++jj) { const int i = 16 * ti + 4 * fq + jj, j = 16 * (tj0 + t) + fr;
                        const bool keep = dir == 0 ? (j <= i) : (j > i);
                        *(LAS bf16_t*)(lds + OFF_P + img_off(2, i, j)) = f2bf(keep ? sc[t][jj] : 0.f); }
            }
            __syncthreads();
            const int te = w >> 1;
            if (lat) {
                const int c = dir == 0 ? s : 39 - s;
                const LAS unsigned char* STc = lds + OFF_ST + cur * 16384;
                f32x4 oc[2] = {(f32x4){0.f, 0.f, 0.f, 0.f}, (f32x4){0.f, 0.f, 0.f, 0.f}};
#pragma unroll
                for (int kk = 0; kk < 2; ++kk) { const bf16x8 va = ldfrag(X + OFF_VT, 2, 16 * te + fr, kk * 32 + fq * 8);
#pragma unroll
                    for (int t = 0; t < 2; ++t) { const bf16x8 pb = ldfrag(lds + OFF_P, 2, 16 * ((w & 1) * 2 + t) + fr, kk * 32 + fq * 8); oc[t] = MFMA16(va, pb, oc[t]); } }
#pragma unroll
                for (int kk = 0; kk < 4; ++kk) { const bf16x8 sa = ldfrag(STc, 4, 16 * te + fr, kk * 32 + fq * 8);
#pragma unroll
                    for (int t = 0; t < 2; ++t) { const bf16x8 qb = ldfrag(X, 4, 16 * ((w & 1) * 2 + t) + fr, kk * 32 + fq * 8); oc[t] = MFMA16(sa, qb, oc[t]); } }
#pragma unroll
                for (int t = 0; t < 2; ++t) { const int i = 16 * ((w & 1) * 2 + t) + fr; const size_t row = (size_t)b * T + (size_t)(c - 4) * 64 + i;
                    u32x2 o2; o2.x = cvt_pk_bf16(oc[t][0], oc[t][1]); o2.y = cvt_pk_bf16(oc[t][2], oc[t][3]);
                    *(u32x2*)(Og + ((size_t)dir * RL + row) * D + h * 256 + dvq * 64 + 16 * te + 4 * fq) = o2; }
            }
#ifdef GLA_SAFE
            __syncthreads();
#endif
            {
                const LAS float* blp = (const LAS float*)(lds + OFF_BL + cur * 512);
                LAS unsigned char* STn = lds + OFF_ST + (cur ^ 1) * 16384;
                bf16x8 vb[2];
#pragma unroll
                for (int kk = 0; kk < 2; ++kk) vb[kk] = ldfrag(X + OFF_VT, 2, 16 * te + fr, kk * 32 + fq * 8);
#pragma unroll
                for (int t = 0; t < 4; ++t) { const int td = (w & 1) * 4 + t;
#pragma unroll
                    for (int jj = 0; jj < 4; ++jj) accS[t][jj] *= __expf(blp[16 * td + 4 * fq + jj]);
#pragma unroll
                    for (int kk = 0; kk < 2; ++kk) { const bf16x8 ka = ldfrag(X + OFF_KET, 2, 16 * td + fr, kk * 32 + fq * 8); accS[t] = MFMA16(ka, vb[kk], accS[t]); }
                    u32x2 s2; s2.x = cvt_pk_bf16(accS[t][0], accS[t][1]); s2.y = cvt_pk_bf16(accS[t][2], accS[t][3]);
                    *(LAS u32x2*)(STn + img_off(4, 16 * te + fr, 16 * td + 4 * fq)) = s2; }
            }
#ifdef GLA_SAFE
            __syncthreads();
            if (s + 1 < NCH) { GLA_LOAD(s + 1); GLA_STORE(cur ^ 1); }
#else
            if (s + 1 < NCH) GLA_STORE(cur ^ 1);
#endif
            __syncthreads();
        }
#undef GLA_LOAD
#undef GLA_STORE
    }
}

__device__ __forceinline__ void phase_lru_scan(const Ctx cx, const Args& a, int g, LAS unsigned char* lds) {
    const int lane = cx.tid & 63, w = cx.tid >> 6;
    LAS f32x2* agg = (LAS f32x2*)lds;
    for (int item = cx.bid; item < BG * 32; item += cx.G) {
        const int cgp = item & 15, dir = (item >> 4) & 1, b = item >> 5, ch = cgp * 64 + lane;
        const bf16_t* LA = (const bf16_t*)(a.ws + WS_LA) + (size_t)dir * RG * D + ch; const bf16_t* UU = (const bf16_t*)(a.ws + WS_UU) + (size_t)dir * RG * D + ch;
        bf16_t* Hd = (bf16_t*)(a.ws + WS_HFB) + (size_t)dir * RL * D + ch;
#define LRU_ROW(s_) ((s_) < CL ? RL + b * CL + (dir ? CL - 1 - (s_) : (s_)) : b * T + (dir ? T - 1 - ((s_) - CL) : (s_) - CL))
        float A = 1.f, Z = 0.f;
        for (int blk = 0; blk < 9; ++blk) { const int s0 = 288 * w + 32 * blk; bf16_t la[32], uu[32];
#pragma unroll
            for (int k = 0; k < 32; ++k) { const size_t r = (size_t)LRU_ROW(s0 + k); la[k] = LA[r * D]; uu[k] = UU[r * D]; }
#pragma unroll
            for (int k = 0; k < 32; ++k) { const float av = __expf(bf2f(la[k])); Z = av * Z + bf2f(uu[k]); A *= av; } }
        agg[w * 64 + lane] = (f32x2){A, Z};
        __syncthreads();
        float hst = 0.f;
#pragma unroll
        for (int w2 = 0; w2 < 7; ++w2) { const f32x2 p = agg[w2 * 64 + lane]; if (w2 < w) hst = p.x * hst + p.y; }
        for (int blk = 0; blk < 9; ++blk) { const int s0 = 288 * w + 32 * blk; bf16_t la[32], uu[32];
#pragma unroll
            for (int k = 0; k < 32; ++k) { const size_t r = (size_t)LRU_ROW(s0 + k); la[k] = LA[r * D]; uu[k] = UU[r * D]; }
#pragma unroll
            for (int k = 0; k < 32; ++k) { const float av = __expf(bf2f(la[k])); hst = av * hst + bf2f(uu[k]);
                if (s0 + k >= CL) Hd[(size_t)LRU_ROW(s0 + k) * D] = f2bf(hst); } }
        __syncthreads();
#undef LRU_ROW
    }
}

__device__ __forceinline__ void phase_post(const Ctx cx, const Args& a, LAS unsigned char* lds, int g) {
    const int lane = cx.tid & 63;
    const bf16_t* PROJ = (const bf16_t*)(a.ws + WS_BIG);
    bf16_t* O0 = (bf16_t*)(a.ws + WS_OFB); const bf16_t* O1 = O0 + (size_t)RL * D;
    bf16_t* H0 = (bf16_t*)(a.ws + WS_HFB); const bf16_t* H1b = H0 + (size_t)RL * D;
    const float* gnw = AIN(I_GNW);
    for (int r = GW(); r < RL; r += NGW()) {
        const size_t off = (size_t)r * D + lane * 16;
        float o[16], t[8]; float ss = 0.f;
#pragma unroll
        for (int hf = 0; hf < 2; ++hf) { float x0[8], x1[8]; unpack8(*(const u32x4*)(O0 + off + 8 * hf), x0); unpack8(*(const u32x4*)(O1 + off + 8 * hf), x1);
#pragma unroll
            for (int i = 0; i < 8; ++i) { o[8 * hf + i] = x0[i] + x1[i]; ss += o[8 * hf + i] * o[8 * hf + i]; } }
        ss += __shfl_xor(ss, 1); ss += __shfl_xor(ss, 2); ss += __shfl_xor(ss, 4); ss += __shfl_xor(ss, 8);
        const float rstd = 1.0f / sqrtf(ss * (1.0f / 256.0f) + EPS);
#pragma unroll
        for (int hf = 0; hf < 2; ++hf) { float gg[8]; unpack8(*(const u32x4*)(PROJ + (size_t)r * PN + PGG + lane * 16 + 8 * hf), gg);
#pragma unroll
            for (int i = 0; i < 8; ++i) t[i] = o[8 * hf + i] * rstd * gnw[(lane & 15) * 16 + 8 * hf + i] * siluf_(gg[i]);
            *(u32x4*)(O0 + off + 8 * hf) = pack8(t); }
#pragma unroll
        for (int hf = 0; hf < 2; ++hf) { float x0[8], x1[8], yl[8]; unpack8(*(const u32x4*)(H0 + off + 8 * hf), x0); unpack8(*(const u32x4*)(H1b + off + 8 * hf), x1);
            unpack8(*(const u32x4*)(PROJ + (size_t)r * PN + PYL + lane * 16 + 8 * hf), yl);
#pragma unroll
            for (int i = 0; i < 8; ++i) t[i] = (x0[i] + x1[i]) * geluf_(yl[i]);
            *(u32x4*)(H0 + off + 8 * hf) = pack8(t); }
    }
}


#define XB_TMO      128
#define XB_XCNT(j)  (256  + 64 * (j))
#define XB_XSUB(j)  (1280 + 64 * (j))
#define XB_XGEN(j)  (2304 + 64 * (j))
#define XB_TOP      3328
#define XB_TOPGEN   3392
#define XCD_BAR_WORDS 3456
#define XB_SPIN_CAP (1u << 22)
__device__ __forceinline__ unsigned xb_ld(unsigned* p)              { return __hip_atomic_load(p, __ATOMIC_RELAXED, __HIP_MEMORY_SCOPE_AGENT); }
__device__ __forceinline__ unsigned xb_add(unsigned* p, unsigned v) { return __hip_atomic_fetch_add(p, v, __ATOMIC_RELAXED, __HIP_MEMORY_SCOPE_AGENT); }
__device__ __forceinline__ unsigned xb_xcc_id() { return (unsigned)__builtin_amdgcn_s_getreg((3 << 11) | 20) & 0xFu; }
#define XB_SPIN(cond, bar) do { unsigned _sp = 0; while (cond) { __builtin_amdgcn_s_sleep(1); \
    if ((++_sp & 255u) == 0u) { if (xb_ld(&(bar)[XB_TMO])) break; if (_sp > XB_SPIN_CAP) { atomicAdd(&(bar)[XB_TMO], 1u); break; } } } } while (0)
__device__ __forceinline__ void xcd_barrier_complete(unsigned* bar, unsigned x, unsigned G, unsigned& nloc, unsigned& nx) {
    unsigned sum, cnt, mine, sp = 0u;
    for (;;) {
        sum = 0u; cnt = 0u; mine = 0u;
#pragma unroll
        for (unsigned j = 0; j < 16; ++j) { const unsigned c = xb_ld(&bar[XB_XCNT(j)]); sum += c; cnt += (c > 0u) ? 1u : 0u; mine = (j == x) ? c : mine; }
        if (sum == G) break;
        __builtin_amdgcn_s_sleep(1);
        if ((++sp & 255u) == 0u) { if (xb_ld(&bar[XB_TMO])) break; if (sp > XB_SPIN_CAP) { atomicAdd(&bar[XB_TMO], 1u); break; } }
    }
    nloc = mine > 0u ? mine : 1u; nx = cnt > 0u ? cnt : 1u;
}
__device__ __forceinline__ void xcd_barrier(unsigned* bar, volatile LAS unsigned* st, int tid, unsigned G) {
    asm volatile("s_waitcnt vmcnt(0)" ::: "memory");
    __syncthreads();
    if (tid == 0) {
        __builtin_amdgcn_s_waitcnt(0);
        const unsigned x = xb_xcc_id();
        unsigned nloc = st[0], nx = st[1];
        if (nloc == 0u) { xcd_barrier_complete(bar, x, G, nloc, nx); st[0] = nloc; st[1] = nx; }
        const unsigned old = xb_add(&bar[XB_XSUB(x)], 1u);
        const unsigned gen = old / nloc;
        if (old + 1u == (gen + 1u) * nloc) {
            __builtin_amdgcn_fence(__ATOMIC_RELEASE, "agent");
            asm volatile("s_waitcnt vmcnt(0)" ::: "memory");
            const unsigned og = xb_add(&bar[XB_TOP], 1u);
            const unsigned tg = og / nx;
            if (og + 1u == (tg + 1u) * nx) xb_add(&bar[XB_TOPGEN], 1u);
            else XB_SPIN(xb_ld(&bar[XB_TOPGEN]) == tg, bar);
            __builtin_amdgcn_fence(__ATOMIC_ACQUIRE, "agent");
            xb_add(&bar[XB_XGEN(x)], 1u);
            asm volatile("s_waitcnt vmcnt(0)" ::: "memory");
        } else {
            XB_SPIN(xb_ld(&bar[XB_XGEN(x)]) == gen, bar);
            __builtin_amdgcn_fence(__ATOMIC_ACQUIRE, "agent");
            asm volatile("s_waitcnt vmcnt(0)" ::: "memory");
        }
    }
    __syncthreads();
}

constexpr int NPH = 17;
#ifndef USE_CG_ALL
#define USE_CG_ALL 0
#endif
#if ONE_LAUNCH
#define GRID_SYNC(k) do { if ((k) == 1 || USE_CG_ALL) cg::this_grid().sync(); else xcd_barrier((unsigned*)ws + 4096, (volatile LAS unsigned*)(lds + PTAB + 256), cx.tid, (unsigned)cx.G); } while (0)
#else
#define GRID_SYNC(k) do {} while (0)
#endif
#define STEP_BEGIN(k) if (a.lo <= (k) && (k) < a.hi) { \
        Ctx cx; { int t_ = wave_s * 64 + (int)__builtin_amdgcn_mbcnt_hi(~0u, __builtin_amdgcn_mbcnt_lo(~0u, 0u)), b_ = blockIdx.x, g_ = gridDim.x; asm volatile("" : "+v"(t_)); asm volatile("" : "+s"(b_), "+s"(g_)); cx.tid = t_; cx.bid = b_; cx.G = g_; } \
        const int G = cx.G, cidx = cx.bid; (void)G; (void)cidx; \
        unsigned char* ws = a.ws; asm volatile("" : "+s"(ws)); \
        if ((k) > a.lo) GRID_SYNC(k); \
        const float* MOD = (const float*)(ws + WS_MOD); float* H1 = (float*)(ws + WS_H1); bf16_t* U = (bf16_t*)(ws + WS_U); bf16_t* BIG = (bf16_t*)(ws + WS_BIG); bf16_t* XC = (bf16_t*)(ws + WS_XC); \
        (void)MOD; (void)H1; (void)U; (void)BIG; (void)XC; pg8::StaticOrder S; (void)S;
#define STEP_END }

template <int g>
__device__ __forceinline__ void run_group(const Args& a, LAS unsigned char* lds, const int wave_s) {
    constexpr int s0 = 2 + g * NPH;
    STEP_BEGIN(s0 + 0) if (PHON(0)) phase_normmod(cx, a, lds, g, 0, RG, 0); STEP_END
    STEP_BEGIN(s0 + 1) if (PHON(1)) { pg8::Gemm gm{U, (const bf16_t*)(ws + WS_WI1), RG, 2 * FH, D, D, D, 0, 0}; S.init(RG, 2 * FH, G, cidx);
                  pg8::EpiSwiglu E{BIG, FH}; pg8::gemm_phase<pg8::EpiSwiglu, true>(cx.tid, lds, gm, S, E); } STEP_END
    STEP_BEGIN(s0 + 2) if (PHON(2)) { pg8::Gemm gm{BIG, (const bf16_t*)(ws + WS_WO1), RG, D, FH, FH, FH, 0, 0}; S.init(RG, D, G, cidx);
                  pg8::EpiResid E{AIN(I_X) + (size_t)g * RL * D, AIN(I_CTX) + (size_t)g * RC * D, H1, H1 + (size_t)RL * D,
                                  MOD + (size_t)(g * BG) * NMOD + 2 * D, MOD + (size_t)32 * NMOD + 2 * D, 0.5f, RL / 256};
                  pg8::gemm_phase<pg8::EpiResid, true>(cx.tid, lds, gm, S, E); } STEP_END
    STEP_BEGIN(s0 + 3) if (PHON(3)) phase_normmod(cx, a, lds, g, 1, RG, 1); STEP_END
    STEP_BEGIN(s0 + 4) if (PHON(4)) { pg8::Gemm gm{U, (const bf16_t*)(ws + WS_WIN), RG, PN, D, D, D, 0, 0}; S.init(RG, PN, G, cidx);
                  pg8::EpiBf16 E{BIG, PN}; pg8::gemm_phase<pg8::EpiBf16, true>(cx.tid, lds, gm, S, E); } STEP_END
    STEP_BEGIN(s0 + 5) if (PHON(5)) phase_prep(cx, a, g, lds); STEP_END
    STEP_BEGIN(s0 + 6) if (PHON(6)) { pg8::Gemm gm{XC, (const bf16_t*)(ws + WS_WLG), RG, 4096, 128, D, 128, 1, 256}; S.init(RG, 4096, G, cidx);
                  pg8::EpiGate E{(bf16_t*)(ws + WS_LA), (bf16_t*)(ws + WS_UU)};
                  pg8::gemm_phase<pg8::EpiGate, true>(cx.tid, lds, gm, S, E); } STEP_END
    STEP_BEGIN(s0 + 7) if (PHON(7)) { phase_gatefix(cx, a, lds); phase_gla_scan(cx, a, g, lds); } STEP_END
    STEP_BEGIN(s0 + 8) if (PHON(8)) phase_lru_scan(cx, a, g, lds); STEP_END
    STEP_BEGIN(s0 + 9) if (PHON(9)) phase_post(cx, a, lds, g); STEP_END
    STEP_BEGIN(s0 + 10) if (PHON(10)) { pg8::Gemm gm{(const bf16_t*)(ws + WS_OFB), (const bf16_t*)(ws + WS_WOG), RL, D, D, D, D, 0, 0}; S.init(RL, D, G, cidx);
                   pg8::EpiMix<false> E{BIG, PGA, XC}; pg8::gemm_phase<pg8::EpiMix<false>, true>(cx.tid, lds, gm, S, E); } STEP_END
    STEP_BEGIN(s0 + 11) if (PHON(11)) { pg8::Gemm gm{(const bf16_t*)(ws + WS_HFB), (const bf16_t*)(ws + WS_WOL), RL, D, D, D, D, 0, 0}; S.init(RL, D, G, cidx);
                   pg8::EpiMix<true> E{BIG, PGB, XC}; pg8::gemm_phase<pg8::EpiMix<true>, true>(cx.tid, lds, gm, S, E); } STEP_END
    STEP_BEGIN(s0 + 12) if (PHON(12)) { pg8::Gemm gm{XC, (const bf16_t*)(ws + WS_WOO), RL, D, D, D, D, 0, 0}; S.init(RL, D, G, cidx);
                   pg8::EpiResid E{H1, H1, H1, H1, MOD + (size_t)(g * BG) * NMOD + 5 * D, MOD, 1.0f, RL / 256};
                   pg8::gemm_phase<pg8::EpiResid, true>(cx.tid, lds, gm, S, E); } STEP_END
    STEP_BEGIN(s0 + 13) if (PHON(13)) phase_normmod(cx, a, lds, g, 1, RL, 2); STEP_END
    STEP_BEGIN(s0 + 14) if (PHON(14)) { pg8::Gemm gm{U, (const bf16_t*)(ws + WS_WI2), RL, 2 * FH, D, D, D, 0, 0}; S.init(RL, 2 * FH, G, cidx);
                   pg8::EpiSwiglu E{BIG, FH}; pg8::gemm_phase<pg8::EpiSwiglu, true>(cx.tid, lds, gm, S, E); } STEP_END
    STEP_BEGIN(s0 + 15) if (PHON(15)) { pg8::Gemm gm{BIG, (const bf16_t*)(ws + WS_WO2), RL, D, FH, FH, FH, 0, 0}; S.init(RL, D, G, cidx);
                   float* og = a.out + (size_t)g * RL * D;
                   pg8::EpiResid E{H1, H1, og, og, MOD + (size_t)(g * BG) * NMOD + 8 * D, MOD, 0.5f, RL / 256};
                   pg8::gemm_phase<pg8::EpiResid, true>(cx.tid, lds, gm, S, E); } STEP_END
    STEP_BEGIN(s0 + 16) if (PHON(16)) phase_final(cx, a, lds, g); STEP_END
}

__global__ void __launch_bounds__(NTHR, 2) fwd_kernel(Args a) {
    extern __shared__ __attribute__((aligned(16))) unsigned char lds_raw[];
    LAS unsigned char* lds = (LAS unsigned char*)lds_raw;
    if (threadIdx.x < 26) ((LAS unsigned long long*)(lds + PTAB))[threadIdx.x] = (unsigned long long)a.in[threadIdx.x];
    if (threadIdx.x == 32) { ((LAS unsigned*)(lds + PTAB + 256))[0] = 0u; ((LAS unsigned*)(lds + PTAB + 256))[1] = 0u; }
#if ONE_LAUNCH
    if (threadIdx.x == 0) (void)xb_add((unsigned*)a.ws + 4096 + XB_XCNT(xb_xcc_id()), 1u);
#endif
    const int wave_s = __builtin_amdgcn_readfirstlane(threadIdx.x >> 6);
    __syncthreads();
    STEP_BEGIN(0) if (PHON(17)) phase_weights(cx, a, lds); STEP_END
    STEP_BEGIN(1) if (PHON(18)) phase_modreduce(cx, a, lds); STEP_END
    run_group<0>(a, lds, wave_s);
    run_group<1>(a, lds, wave_s);
    run_group<2>(a, lds, wave_s);
    run_group<3>(a, lds, wave_s);
}


#ifdef PROBE_STEP
__global__ void probe_kernel(const unsigned char* ws, float* out) {
    const size_t n = (size_t)65536 * 1024, q = n / 4;
    const bf16_t* r0 = (const bf16_t*)(ws + PROBE_R0); const bf16_t* r1 = (const bf16_t*)(ws + PROBE_R1); const bf16_t* r2 = (const bf16_t*)(ws + PROBE_R2); const bf16_t* r3 = (const bf16_t*)(ws + PROBE_R3);
    for (size_t i = (size_t)blockIdx.x * blockDim.x + threadIdx.x; i < q; i += (size_t)gridDim.x * blockDim.x) {
        out[i] = bf2f(r0[i]); out[q + i] = bf2f(r1[i]); out[2 * q + i] = bf2f(r2[i]); out[3 * q + i] = bf2f(r3[i]); }
}
#endif
extern "C" void kernel_launch(void* const* d_in, const int* in_sizes, int n_in, void* d_out, int out_size, void* d_ws, size_t ws_size, hipStream_t stream) {
    static int grid = 0;
    if (grid == 0) {
        if (n_in != 26 || ws_size < WS_END) { fprintf(stderr, "kernel_launch: unexpected inputs (n_in %d, ws %zu, need %zu)\n", n_in, ws_size, (size_t)WS_END); grid = -1; return; }
        int dev = 0, cus = 0, per_cu = 0;
        hipGetDevice(&dev); hipDeviceGetAttribute(&cus, hipDeviceAttributeMultiprocessorCount, dev);
        if (hipFuncSetAttribute((const void*)fwd_kernel, hipFuncAttributeMaxDynamicSharedMemorySize, LDS_BYTES) != hipSuccess) { fprintf(stderr, "kernel_launch: hipFuncSetAttribute failed\n"); grid = -1; return; }
        hipOccupancyMaxActiveBlocksPerMultiprocessor(&per_cu, (const void*)fwd_kernel, NTHR, LDS_BYTES);
        (void)hipGetLastError();
        if (per_cu < 1) per_cu = 1;
        grid = cus * 1;
    }
    if (grid < 0) return;
    Args a{};
    for (int i = 0; i < 26; ++i) a.in[i] = (const float*)d_in[i];
    a.out = (float*)d_out; a.ws = (unsigned char*)d_ws;
    const int nsteps = 2 + NG * NPH;
#if ONE_LAUNCH
    (void)hipMemsetAsync(d_ws, 0, 65536, stream);
    a.lo = 0; a.hi = nsteps;
    void* args[] = {&a};
    hipError_t e = hipLaunchCooperativeKernel((const void*)fwd_kernel, dim3(grid), dim3(NTHR), args, LDS_BYTES, stream);
    if (e != hipSuccess) fprintf(stderr, "cooperative launch failed: %s (grid %d)\n", hipGetErrorString(e), grid);
#else
#ifdef PROBE_STEP
    for (int s = 0; s <= PROBE_STEP; ++s) { a.lo = s; a.hi = s + 1; hipLaunchKernelGGL(fwd_kernel, dim3(grid), dim3(NTHR), LDS_BYTES, stream, a); }
    hipLaunchKernelGGL(probe_kernel, dim3(2048), dim3(256), 0, stream, (const unsigned char*)d_ws, (float*)d_out);
#else
    for (int s = 0; s < nsteps; ++s) { a.lo = s; a.hi = s + 1; hipLaunchKernelGGL(fwd_kernel, dim3(grid), dim3(NTHR), LDS_BYTES, stream, a); }
#endif
#endif
}
```

```cpp
#include <hip/hip_runtime.h>
#include <hip/hip_cooperative_groups.h>
#include <cstdio>
#include <cstdint>
namespace cg = cooperative_groups;

#ifndef ONE_LAUNCH
#define ONE_LAUNCH 1
#endif

#ifndef PHMASK
#define PHMASK 0x1fffff
#endif
#define PHON(n) (((PHMASK) >> (n)) & 1)
#define LAS __attribute__((address_space(3)))
typedef unsigned short bf16_t;
typedef short bf16x8 __attribute__((ext_vector_type(8)));
typedef float f32x4 __attribute__((ext_vector_type(4)));
typedef float f32x2 __attribute__((ext_vector_type(2)));
typedef unsigned u32x4 __attribute__((ext_vector_type(4)));
typedef unsigned u32x2 __attribute__((ext_vector_type(2)));

constexpr int D = 1024, NB = 32, T = 2048, CL = 256, FH = 2816, INW = 7200, PN = 7424, NMOD = 9216;
constexpr int NG = 4, BG = NB / NG;
constexpr int RL = BG * T, RC = BG * CL, RG = RL + RC;
constexpr int NCH = 36;
constexpr float EPS = 1e-6f;
constexpr int PQ = 0, PK = 512, PV = 1024, PGG = 2048, PXL = 3072, PYL = 4096, PGA = 5120, PGB = 6144, PFD = 7168;

constexpr size_t al(size_t x) { return (x + 4095) & ~(size_t)4095; }
constexpr size_t WS_WI1 = 1 << 20;
constexpr size_t WS_WO1 = WS_WI1 + al((size_t)2 * FH * D * 2);
constexpr size_t WS_WI2 = WS_WO1 + al((size_t)D * FH * 2);
constexpr size_t WS_WO2 = WS_WI2 + al((size_t)2 * FH * D * 2);
constexpr size_t WS_WIN = WS_WO2 + al((size_t)D * FH * 2);
constexpr size_t WS_WOG = WS_WIN + al((size_t)PN * D * 2);
constexpr size_t WS_WOL = WS_WOG + al((size_t)D * D * 2);
constexpr size_t WS_WOO = WS_WOL + al((size_t)D * D * 2);
constexpr size_t WS_WLG = WS_WOO + al((size_t)D * D * 2);
constexpr size_t WS_MODP = WS_WLG + al((size_t)4096 * 128 * 2);
constexpr size_t WS_MOD = WS_MODP + al((size_t)16 * 33 * NMOD * 4);
constexpr size_t WS_GC = WS_MOD + al((size_t)33 * NMOD * 4);
constexpr size_t WS_H1 = WS_GC + al((size_t)6 * D * 4);
constexpr size_t WS_U = WS_H1 + al((size_t)RG * D * 4);
constexpr size_t WS_BIG = WS_U + al((size_t)RG * D * 2);
constexpr size_t WS_XC = WS_BIG + al((size_t)RG * PN * 2);
constexpr size_t WS_LA = WS_XC + al((size_t)RG * D * 2);
constexpr size_t WS_UU = WS_LA + al((size_t)2 * RG * D * 2);
constexpr size_t WS_HFB = WS_UU + al((size_t)2 * RG * D * 2);
constexpr size_t WS_OFB = WS_HFB + al((size_t)2 * RL * D * 2);
constexpr size_t GT = (size_t)2 * BG * NCH * 4;
constexpr size_t WS_QD = WS_OFB + al((size_t)2 * RL * D * 2);
constexpr size_t WS_KI = WS_QD + al(GT * 8192 * 2);
constexpr size_t WS_KET = WS_KI + al(GT * 8192 * 2);
constexpr size_t WS_VT = WS_KET + al(GT * 8192 * 2);
constexpr size_t WS_BL = WS_VT + al((size_t)BG * NCH * 4 * 16384 * 2);
constexpr size_t WS_END = WS_BL + al(GT * 128 * 4);
static_assert(WS_END <= (size_t)1073741824, "workspace map exceeds 1 GiB");

constexpr int LDS_BYTES = 163840, PTAB = LDS_BYTES - 512;

typedef __bf16 bf16x2_t __attribute__((ext_vector_type(2)));
__device__ __forceinline__ unsigned cvt_pk_bf16(float lo, float hi) { const f32x2 v = {lo, hi}; return __builtin_bit_cast(unsigned, __builtin_convertvector(v, bf16x2_t)); }
__device__ __forceinline__ bf16_t f2bf(float f) { return (bf16_t)(cvt_pk_bf16(f, 0.f) & 0xffffu); }
__device__ __forceinline__ float bf2f(bf16_t h) { return __uint_as_float(((unsigned)h) << 16); }
__device__ __forceinline__ float bflo(unsigned w) { return __uint_as_float(w << 16); }
__device__ __forceinline__ float bfhi(unsigned w) { return __uint_as_float(w & 0xffff0000u); }
__device__ __forceinline__ float sigmoidf_(float x) { return __builtin_amdgcn_rcpf(1.0f + __expf(-x)); }
__device__ __forceinline__ float siluf_(float x) { return x * __builtin_amdgcn_rcpf(1.0f + __expf(-x)); }
__device__ __forceinline__ float geluf_(float x) { const float z = 0.7978845608028654f * (x + 0.044715f * x * x * x); return x * (1.0f - __builtin_amdgcn_rcpf(1.0f + __expf(2.0f * z))); }
__device__ __forceinline__ float logsigf_(float x) { return fminf(x, 0.f) - log1pf(__expf(-fabsf(x))); }
__device__ __forceinline__ float one_minus_exp(float x) {
    const float ser = -x * (1.0f + x * (0.5f + x * (0.16666667f + x * (0.041666668f + x * (0.0083333338f + x * (0.0013888889f + x * 0.0001984127f))))));
    return x > -0.3f ? ser : 1.0f - __expf(x);
}
__device__ __forceinline__ float wave_sum(float v) {
#pragma unroll
    for (int o = 1; o < 64; o <<= 1) v += __shfl_xor(v, o);
    return v;
}
__device__ __forceinline__ void unpack8(const u32x4 w, float (&f)[8]) {
    f[0] = bflo(w.x); f[1] = bfhi(w.x); f[2] = bflo(w.y); f[3] = bfhi(w.y); f[4] = bflo(w.z); f[5] = bfhi(w.z); f[6] = bflo(w.w); f[7] = bfhi(w.w);
}
__device__ __forceinline__ u32x4 pack8(const float (&f)[8]) {
    u32x4 w; w.x = cvt_pk_bf16(f[0], f[1]); w.y = cvt_pk_bf16(f[2], f[3]); w.z = cvt_pk_bf16(f[4], f[5]); w.w = cvt_pk_bf16(f[6], f[7]); return w;
}

namespace pg8 {
constexpr int BM = 256, BK = 64, HALF = 128, HTB = HALF * BK * 2, STAGE_BYTES = 8 * HTB, NXCD = 8, WGM = 8;
__host__ __device__ __forceinline__ int lds_byte(int r, int c) { const int st = (r >> 4) * 2 + (c >> 5), rr = r & 15, cc = c & 31, ob = rr * 64 + cc * 2; return st * 1024 + (ob ^ (((ob >> 9) & 1) << 5)); }
__host__ __device__ __forceinline__ void stage_rc(int b, int& R, int& C) { const int st = b / 1024, sb = b % 1024, swz = sb ^ (((sb >> 9) & 1) << 5); R = (st >> 1) * 16 + swz / 64; C = (st & 1) * 32 + (swz % 64) / 2; }
__host__ __device__ __forceinline__ int perm32(int rho) { const int n = rho >> 4, i = rho & 15; return 8 * (i >> 2) + 4 * n + (i & 3); }
struct Unit { int pm, pn; };
struct Gemm { const bf16_t* A; const bf16_t* Bt; int M, N, K, lda, ldb, a_pn_shift, a_pn_bytes; };
struct StaticOrder {
    int nM, nN, nwg, G, c;
    __device__ void init(int M, int N, int G_, int c_) { nM = M / BM; nN = N / BM; nwg = nM * nN; G = G_; c = c_; }
    __device__ bool next(int i, Unit& u) const {
        const long L = (long)i * G + c; if (L >= nwg) return false;
        int wgid = (int)L; { const int q = nwg / NXCD, r = nwg % NXCD, xcd = wgid % NXCD, off = wgid / NXCD; wgid = (xcd < r ? xcd * (q + 1) : r * (q + 1) + (xcd - r) * q) + off; }
        const int nig = WGM * nN, gid = wgid / nig, fm = gid * WGM, gsz = (nM - fm) < WGM ? (nM - fm) : WGM;
        u.pm = fm + ((wgid % nig) % gsz); u.pn = (wgid % nig) / gsz; return true;
    }
};
template <class Epi, bool ALIGN_EPI>
__device__ __forceinline__ void gemm_phase(const int tid, LAS unsigned char* lds, const Gemm g, const StaticOrder& S, const Epi& E) {
    const int wid = __builtin_amdgcn_readfirstlane(tid >> 6), lane = tid & 63, wr = wid >> 2, wc = wid & 3, fr = lane & 15, fq = lane >> 4;
    const int K = g.K, nt = K / BK;
    unsigned voffA[2], voffB[2];
#pragma unroll
    for (int i = 0; i < 2; ++i) { int R, C; stage_rc(tid * 16 + i * 8192, R, C); const int Rb = Epi::PERM ? ((R & ~31) + perm32(R & 31)) : R;
        voffA[i] = (unsigned)(R * g.lda + C) * 2u; voffB[i] = (unsigned)(Rb * g.ldb + C) * 2u; }
    const size_t kstep = (size_t)(BK * 2);
    const size_t hstepA = (size_t)HALF * g.lda * 2, hstepB = (size_t)HALF * g.ldb * 2;
    const size_t tstepA = 2 * hstepA, tstepB = 2 * hstepB;
    const unsigned ldsw = (unsigned)wid * 1024u;
    const int aoff = lds_byte(wr * 64 + fr, fq * 8), boff = lds_byte(wc * 32 + fr, fq * 8);
#define PG8_SA(b, h) (((b) * 2 + (h)) * HTB)
#define PG8_SB(b, h) ((4 + (b) * 2 + (h)) * HTB)
#define PG8_STAGE(bufoff, gbase, voff) do { _Pragma("unroll") for (int _i = 0; _i < 2; ++_i) \
        __builtin_amdgcn_global_load_lds((const unsigned*)((const char*)(gbase) + (voff)[_i]), (LAS unsigned*)(lds + (bufoff) + ldsw + _i * 8192), 16, 0, 0); } while (0)
#define PG8_LDA(dst, b, h) do { _Pragma("unroll") for (int m = 0; m < 4; ++m) _Pragma("unroll") for (int k = 0; k < 2; ++k) dst[m][k] = *(const LAS bf16x8*)(lds + PG8_SA(b, h) + aoff + m * 2048 + k * 1024); } while (0)
#define PG8_LDB(dst, b, h) do { _Pragma("unroll") for (int n = 0; n < 2; ++n) _Pragma("unroll") for (int k = 0; k < 2; ++k) dst[n][k] = *(const LAS bf16x8*)(lds + PG8_SB(b, h) + boff + n * 2048 + k * 1024); } while (0)
#define PG8_MMA(ai, bj, At, Bt) do { __builtin_amdgcn_s_setprio(1); _Pragma("unroll") for (int m = 0; m < 4; ++m) _Pragma("unroll") for (int n = 0; n < 2; ++n) _Pragma("unroll") for (int k = 0; k < 2; ++k) \
        acc[ai][bj][m][n] = __builtin_amdgcn_mfma_f32_16x16x32_bf16(Bt[n][k], At[m][k], acc[ai][bj][m][n], 0, 0, 0); __builtin_amdgcn_s_setprio(0); } while (0)
#define PG8_WAIT_V(n) asm volatile("s_waitcnt vmcnt(" #n ")" ::: "memory")
#define PG8_WAIT_L(n) asm volatile("s_waitcnt lgkmcnt(" #n ")" ::: "memory")
#define PG8_BAR __builtin_amdgcn_s_barrier()
#define PG8_SCHED __builtin_amdgcn_sched_barrier(0)
    Unit cur, nxt; int ui = 0;
    if (!S.next(0, cur)) return;
    f32x4 acc[2][2][4][2];
#pragma unroll
    for (int a = 0; a < 2; ++a)
#pragma unroll
        for (int b = 0; b < 2; ++b)
#pragma unroll
            for (int m = 0; m < 4; ++m)
#pragma unroll
                for (int n = 0; n < 2; ++n) acc[a][b][m][n] = (f32x4){0.f, 0.f, 0.f, 0.f};
    bf16x8 At[4][2], B0[2][2], B1[2][2];
    const char* cA = (const char*)g.A + (size_t)cur.pm * tstepA + (size_t)((cur.pn >> g.a_pn_shift) * g.a_pn_bytes);
    const char* cB = (const char*)g.Bt + (size_t)cur.pn * tstepB;
    PG8_STAGE(PG8_SB(0, 0), cB, voffB); PG8_STAGE(PG8_SB(0, 1), cB + hstepB, voffB); PG8_STAGE(PG8_SA(0, 0), cA, voffA); PG8_STAGE(PG8_SA(0, 1), cA + hstepA, voffA);
    if (wr == 1) PG8_BAR;
    PG8_WAIT_V(2); PG8_BAR;
    PG8_STAGE(PG8_SB(1, 0), cB + kstep, voffB); PG8_STAGE(PG8_SA(1, 0), cA + kstep, voffA); PG8_STAGE(PG8_SB(1, 1), cB + hstepB + kstep, voffB);
    PG8_WAIT_V(6); PG8_BAR;
    for (;;) {
        const bool has_next = S.next(ui + 1, nxt);
        const char* nA = has_next ? (const char*)g.A + (size_t)nxt.pm * tstepA + (size_t)((nxt.pn >> g.a_pn_shift) * g.a_pn_bytes) : cA;
        const char* nB = has_next ? (const char*)g.Bt + (size_t)nxt.pn * tstepB : cB;
        for (int t = 0; t < nt; t += 2) {
            const bool last = (t == nt - 2);
            const char* a1 = cA + (size_t)(t + 1) * kstep;
            const char* a2 = last ? nA : cA + (size_t)(t + 2) * kstep; const char* b2 = last ? nB : cB + (size_t)(t + 2) * kstep;
            const char* a3 = a2 + kstep; const char* b3 = b2 + kstep;
            PG8_LDB(B0, 0, 0); PG8_LDB(B1, 0, 1); PG8_SCHED; PG8_LDA(At, 0, 0); PG8_STAGE(PG8_SA(1, 1), a1 + hstepA, voffA);
            PG8_WAIT_V(8); PG8_WAIT_L(0); PG8_BAR; PG8_MMA(0, 0, At, B0); PG8_MMA(0, 1, At, B1); PG8_BAR; PG8_SCHED;
            PG8_LDA(At, 0, 1); PG8_STAGE(PG8_SB(0, 0), b2, voffB); PG8_STAGE(PG8_SB(0, 1), b2 + hstepB, voffB); PG8_STAGE(PG8_SA(0, 0), a2, voffA);
            PG8_WAIT_V(8); PG8_WAIT_L(0); PG8_BAR; PG8_MMA(1, 0, At, B0); PG8_MMA(1, 1, At, B1); PG8_BAR; PG8_SCHED;
            PG8_LDB(B0, 1, 0); PG8_LDB(B1, 1, 1); PG8_SCHED; PG8_LDA(At, 1, 0); PG8_STAGE(PG8_SA(0, 1), a2 + hstepA, voffA);
            PG8_WAIT_V(8); PG8_WAIT_L(0); PG8_BAR; PG8_MMA(0, 0, At, B0); PG8_MMA(0, 1, At, B1); PG8_BAR; PG8_SCHED;
            PG8_LDA(At, 1, 1); PG8_STAGE(PG8_SB(1, 0), b3, voffB); PG8_STAGE(PG8_SB(1, 1), b3 + hstepB, voffB); PG8_STAGE(PG8_SA(1, 0), a3, voffA);
            PG8_WAIT_V(8); PG8_WAIT_L(0); PG8_BAR; PG8_MMA(1, 0, At, B0); PG8_MMA(1, 1, At, B1); PG8_BAR; PG8_SCHED;
        }
        if constexpr (ALIGN_EPI) { if (wr == 0) PG8_BAR; }
        { int fr_ = fr, fq_ = fq; asm volatile("" : "+v"(fr_), "+v"(fq_)); E(acc, cur, wr, wc, fr_, fq_); }
        if (!has_next) break;
#pragma unroll
        for (int a = 0; a < 2; ++a)
#pragma unroll
            for (int b = 0; b < 2; ++b)
#pragma unroll
                for (int m = 0; m < 4; ++m)
#pragma unroll
                    for (int n = 0; n < 2; ++n) acc[a][b][m][n] = (f32x4){0.f, 0.f, 0.f, 0.f};
        cur = nxt; cA = nA; cB = nB; ++ui;
        if constexpr (ALIGN_EPI) { if (wr == 1) PG8_BAR; }
    }
    PG8_WAIT_V(0);
    if constexpr (!ALIGN_EPI) { if (wr == 0) PG8_BAR; }
    PG8_BAR;
#undef PG8_SA
#undef PG8_SB
#undef PG8_STAGE
#undef PG8_LDA
#undef PG8_LDB
#undef PG8_MMA
#undef PG8_WAIT_V
#undef PG8_WAIT_L
#undef PG8_BAR
#undef PG8_SCHED
}

struct EpiBf16 {
    static constexpr bool PERM = true;
    bf16_t* O; int ldc;
    __device__ __forceinline__ void operator()(const f32x4 (&acc)[2][2][4][2], const Unit& u, int wr, int wc, int fr, int fq) const {
        const int row0 = u.pm * BM + wr * 64 + fr, col0 = u.pn * BM + wc * 32 + 8 * fq;
#pragma unroll
        for (int ai = 0; ai < 2; ++ai)
#pragma unroll
            for (int m = 0; m < 4; ++m) { bf16_t* rowp = O + (size_t)(row0 + ai * HALF + m * 16) * ldc + col0;
#pragma unroll
                for (int bj = 0; bj < 2; ++bj) { const f32x4 v0 = acc[ai][bj][m][0], v1 = acc[ai][bj][m][1];
                    u32x4 w; w.x = cvt_pk_bf16(v0[0], v0[1]); w.y = cvt_pk_bf16(v0[2], v0[3]); w.z = cvt_pk_bf16(v1[0], v1[1]); w.w = cvt_pk_bf16(v1[2], v1[3]);
                    *(u32x4*)(rowp + bj * HALF) = w; } }
    }
};
struct EpiSwiglu {
    static constexpr bool PERM = true;
    bf16_t* O; int ldc;
    __device__ __forceinline__ void operator()(const f32x4 (&acc)[2][2][4][2], const Unit& u, int wr, int wc, int fr, int fq) const {
        const int row0 = u.pm * BM + wr * 64 + fr, col0 = u.pn * HALF + wc * 32 + 8 * fq;
#pragma unroll
        for (int ai = 0; ai < 2; ++ai)
#pragma unroll
            for (int m = 0; m < 4; ++m) { bf16_t* rowp = O + (size_t)(row0 + ai * HALF + m * 16) * ldc + col0;
                float o[8];
#pragma unroll
                for (int n = 0; n < 2; ++n)
#pragma unroll
                    for (int j = 0; j < 4; ++j) o[4 * n + j] = siluf_(acc[ai][0][m][n][j]) * acc[ai][1][m][n][j];
                *(u32x4*)rowp = pack8(o); }
    }
};
struct EpiResid {
    static constexpr bool PERM = false;
    const float* baseL; const float* baseC; float* outL; float* outC; const float* modL; const float* modC; float scale; int nlat;
    __device__ __forceinline__ void operator()(const f32x4 (&acc)[2][2][4][2], const Unit& u, int wr, int wc, int fr, int fq) const {
        const bool lat = u.pm < nlat;
        const size_t toff = (size_t)(lat ? u.pm : u.pm - nlat) * BM * D + (size_t)(wr * 64 + fr) * D + u.pn * BM + wc * 32 + 4 * fq;
        const float* base = (lat ? baseL : baseC) + toff;
        float* out = (lat ? outL : outC) + toff;
        const float* mg = (lat ? modL + (size_t)(u.pm >> 3) * NMOD : modC) + u.pn * BM + wc * 32 + 4 * fq;
#pragma unroll
        for (int bj = 0; bj < 2; ++bj)
#pragma unroll
            for (int n = 0; n < 2; ++n) { const f32x4 gv = *(const f32x4*)(mg + bj * HALF + n * 16) * scale;
#pragma unroll
                for (int ai = 0; ai < 2; ++ai)
#pragma unroll
                    for (int m = 0; m < 4; ++m) { const size_t off = (size_t)(ai * HALF + m * 16) * D + bj * HALF + n * 16;
                        const f32x4 bs = *(const f32x4*)(base + off); *(f32x4*)(out + off) = bs + gv * acc[ai][bj][m][n]; } }
    }
};
__device__ __forceinline__ float one_minus_exp(float x) {
    const float ser = -x * (1.0f + x * (0.5f + x * (0.16666667f + x * (0.041666668f + x * (0.0083333338f + x * (0.0013888889f + x * 0.0001984127f))))));
    return x > -0.3f ? ser : 1.0f - __expf(x);
}
struct EpiGate {
    static constexpr bool PERM = true;
    bf16_t* LA; bf16_t* UU;
    __device__ __forceinline__ void operator()(const f32x4 (&acc)[2][2][4][2], const Unit& u, int wr, int wc, int fr, int fq) const {
        const int blk = u.pn >> 1, dir = u.pn & 1, ch0 = blk * HALF + wc * 32 + 8 * fq, row0 = u.pm * BM + wr * 64 + fr;
#pragma unroll
        for (int ai = 0; ai < 2; ++ai)
#pragma unroll
            for (int m = 0; m < 4; ++m) { const size_t off = (size_t)dir * RG * D + (size_t)(row0 + ai * HALF + m * 16) * D + ch0;
#pragma unroll
                for (int bj = 0; bj < 2; ++bj) { const f32x4 v0 = acc[ai][bj][m][0], v1 = acc[ai][bj][m][1];
                    u32x4 w; w.x = cvt_pk_bf16(v0[0], v0[1]); w.y = cvt_pk_bf16(v0[2], v0[3]); w.z = cvt_pk_bf16(v1[0], v1[1]); w.w = cvt_pk_bf16(v1[2], v1[3]);
                    *(u32x4*)((bj ? UU : LA) + off) = w; } }
    }
};
template <bool ACCUM> struct EpiMix {
    static constexpr bool PERM = true;
    const bf16_t* PROJ; int gcol; bf16_t* MG;
    __device__ __forceinline__ void operator()(const f32x4 (&acc)[2][2][4][2], const Unit& u, int wr, int wc, int fr, int fq) const {
        const int row0 = u.pm * BM + wr * 64 + fr, col0 = u.pn * BM + wc * 32 + 8 * fq;
#pragma unroll
        for (int ai = 0; ai < 2; ++ai)
#pragma unroll
            for (int m = 0; m < 4; ++m) { const size_t row = (size_t)(row0 + ai * HALF + m * 16);
#pragma unroll
                for (int bj = 0; bj < 2; ++bj) { float gt[8], o[8]; unpack8(*(const u32x4*)(PROJ + row * PN + gcol + col0 + bj * HALF), gt);
                    bf16_t* dst = MG + row * D + col0 + bj * HALF;
                    if (ACCUM) unpack8(*(const u32x4*)dst, o); else {
#pragma unroll
                        for (int i = 0; i < 8; ++i) o[i] = 0.f; }
#pragma unroll
                    for (int n = 0; n < 2; ++n)
#pragma unroll
                        for (int j = 0; j < 4; ++j) o[4 * n + j] += sigmoidf_(gt[4 * n + j]) * acc[ai][bj][m][n][j];
                    *(u32x4*)dst = pack8(o); } }
    }
};
}

struct Args {
    const float* in[26]; float* out; unsigned char* ws; int lo, hi;
};
enum { I_X = 0, I_C, I_CTX, I_CCTX, I_WADA, I_BADA, I_NORMW, I_F1WI, I_F1WO, I_F2WI, I_F2WO, I_WIN, I_FUP, I_FB, I_GNW, I_CONVW, I_CONVB, I_WR, I_BR, I_WI, I_BI, I_LAM, I_WOG, I_WOL, I_WOO, I_FNW };

#define NTHR 512
__device__ __forceinline__ const float* inp(const LAS unsigned char* lds, int i) { const LAS unsigned* t = (const LAS unsigned*)(lds + PTAB) + 2 * i;
    const unsigned lo = __builtin_amdgcn_readfirstlane(t[0]), hi = __builtin_amdgcn_readfirstlane(t[1]); return (const float*)(((unsigned long long)hi << 32) | lo); }
#define AIN(i) inp(lds, (i))
struct Ctx { int tid, bid, G; };
#define GW() (cx.bid * 8 + (cx.tid >> 6))
#define NGW() (cx.G * 8)

__device__ __forceinline__ void transpose_item(const float* W, int ldw, int K, int k0, int n0, bf16_t* WT, int drow, LAS float* scr, int lane) {
#pragma unroll 8
    for (int i = 0; i < 32; ++i) { const int kk = 2 * i + (lane >> 5); scr[kk * 33 + (lane & 31)] = W[(size_t)(k0 + kk) * ldw + n0 + (lane & 31)]; }
    asm volatile("s_waitcnt lgkmcnt(0)" ::: "memory");
    const int c = lane & 7;
#pragma unroll
    for (int j = 0; j < 4; ++j) { const int n = (lane >> 3) + 8 * j; const LAS float* s = scr + (8 * c) * 33 + n;
        u32x4 o; o.x = cvt_pk_bf16(s[0 * 33], s[1 * 33]); o.y = cvt_pk_bf16(s[2 * 33], s[3 * 33]); o.z = cvt_pk_bf16(s[4 * 33], s[5 * 33]); o.w = cvt_pk_bf16(s[6 * 33], s[7 * 33]);
        *(u32x4*)(WT + (size_t)(drow + n) * K + k0 + 8 * c) = o; }
    asm volatile("s_waitcnt lgkmcnt(0)" ::: "memory");
}
__device__ __forceinline__ int wi_drow(int n0) { return n0 < FH ? (n0 >> 7) * 256 + (n0 & 127) : ((n0 - FH) >> 7) * 256 + 128 + ((n0 - FH) & 127); }
__device__ __forceinline__ int win_drow(int n0) { return n0 < 3072 ? n0 : (n0 == 3072 ? PFD : n0 - 32); }

__device__ __forceinline__ void phase_weights(const Ctx cx, const Args& a, LAS unsigned char* lds) {
    const int lane = cx.tid & 63, wave = cx.tid >> 6;
    LAS float* scr = (LAS float*)(lds + wave * 16384);
    unsigned char* ws = a.ws;
    constexpr int I_WI_ = (D / 64) * (2 * FH / 32), I_WO_ = (FH / 64) * (D / 32), I_IN_ = (D / 64) * (INW / 32), I_SQ_ = (D / 64) * (D / 32), I_LG_ = 32 * 8;
    constexpr int NIT = 2 * I_WI_ + 2 * I_WO_ + I_IN_ + 3 * I_SQ_ + I_LG_;
    if (PHON(19)) for (int it = GW(); it < NIT; it += NGW()) {
        int r = it;
        if (r < 2 * I_WI_) { const int w = r / I_WI_; r %= I_WI_; const int nb = 2 * FH / 32, kb = r / nb, n0 = (r % nb) * 32;
            transpose_item(AIN(w ? I_F2WI : I_F1WI), 2 * FH, D, kb * 64, n0, (bf16_t*)(ws + (w ? WS_WI2 : WS_WI1)), wi_drow(n0), scr, lane); continue; }
        r -= 2 * I_WI_;
        if (r < 2 * I_WO_) { const int w = r / I_WO_; r %= I_WO_; const int nb = D / 32, kb = r / nb, n0 = (r % nb) * 32;
            transpose_item(AIN(w ? I_F2WO : I_F1WO), D, FH, kb * 64, n0, (bf16_t*)(ws + (w ? WS_WO2 : WS_WO1)), n0, scr, lane); continue; }
        r -= 2 * I_WO_;
        if (r < I_IN_) { const int nb = INW / 32, kb = r / nb, n0 = (r % nb) * 32;
            transpose_item(AIN(I_WIN), INW, D, kb * 64, n0, (bf16_t*)(ws + WS_WIN), win_drow(n0), scr, lane); continue; }
        r -= I_IN_;
        if (r < 3 * I_SQ_) { const int w = r / I_SQ_; r %= I_SQ_; const int nb = D / 32, kb = r / nb, n0 = (r % nb) * 32;
            transpose_item(AIN(w == 0 ? I_WOG : (w == 1 ? I_WOL : I_WOO)), D, D, kb * 64, n0, (bf16_t*)(ws + (w == 0 ? WS_WOG : (w == 1 ? WS_WOL : WS_WOO))), n0, scr, lane); continue; }
        r -= 3 * I_SQ_;
        { const int mat = r >> 3, sub = r & 7, gate = mat >> 4, dir = (mat >> 3) & 1, blk = mat & 7;
          const float* src = AIN(gate ? I_WI : I_WR) + (size_t)(dir * 8 + blk) * 128 * 128;
          const int kb = sub >> 2, n0 = (sub & 3) * 32;
          transpose_item(src, 128, 128, kb * 64, n0, (bf16_t*)(ws + WS_WLG), ((blk * 2 + dir) * 2 + gate) * 128 + n0, scr, lane); }
    }
    { u32x4* z = (u32x4*)(ws + WS_WIN + (size_t)INW * D * 2); const int n16 = (PN - INW) * D * 2 / 16;
      for (int i = cx.bid * NTHR + cx.tid; i < n16; i += cx.G * NTHR) z[i] = (u32x4){0u, 0u, 0u, 0u}; }
    __syncthreads();
    LAS float* sl = (LAS float*)lds;
    float* MODP = (float*)(ws + WS_MODP);
    if (PHON(20)) for (int item = cx.bid; item < 18 * 16; item += cx.G) {
        const int cb = item % 18, ks = item / 18, col = cb * 512 + cx.tid;
        for (int idx = cx.tid; idx < 33 * 64; idx += NTHR) { const int b = idx >> 6, k = idx & 63; const float cv = b < 32 ? AIN(I_C)[b * D + ks * 64 + k] : AIN(I_CCTX)[ks * 64 + k]; sl[idx] = siluf_(cv); }
        __syncthreads();
        float acc[33];
#pragma unroll
        for (int b = 0; b < 33; ++b) acc[b] = 0.f;
        const float* wp = AIN(I_WADA) + (size_t)(ks * 64) * NMOD + col;
#pragma unroll 4
        for (int k = 0; k < 64; ++k) { const float w = wp[(size_t)k * NMOD];
#pragma unroll
            for (int b = 0; b < 33; ++b) acc[b] += sl[b * 64 + k] * w; }
#pragma unroll
        for (int b = 0; b < 33; ++b) MODP[(size_t)(ks * 33 + b) * NMOD + col] = acc[b];
        __syncthreads();
    }
}
__device__ __forceinline__ void phase_modreduce(const Ctx cx, const Args& a, LAS unsigned char* lds) {
    const float* MODP = (const float*)(a.ws + WS_MODP); float* MOD = (float*)(a.ws + WS_MOD);
    for (int idx = cx.bid * NTHR + cx.tid; idx < 33 * NMOD; idx += cx.G * NTHR) {
        float s = AIN(I_BADA)[idx % NMOD];
#pragma unroll
        for (int ks = 0; ks < 16; ++ks) s += MODP[(size_t)ks * 33 * NMOD + idx];
        MOD[idx] = s;
    }
    float* GC = (float*)(a.ws + WS_GC);
    for (int idx = cx.bid * NTHR + cx.tid; idx < 2 * D; idx += cx.G * NTHR) { GC[idx] = AIN(I_BR)[idx]; GC[2 * D + idx] = AIN(I_BI)[idx]; GC[4 * D + idx] = 8.0f * log1pf(__expf(-AIN(I_LAM)[idx])); }
}

__device__ __forceinline__ void phase_normmod(const Ctx cx, const Args& a, LAS unsigned char* lds, int g, int mode, int nrows, int sub) {
    const int lane = cx.tid & 63;
    const float* MOD = (const float*)(a.ws + WS_MOD); const float* nw = AIN(I_NORMW) + sub * D;
    const float* H1 = (const float*)(a.ws + WS_H1); bf16_t* U = (bf16_t*)(a.ws + WS_U);
    for (int r = GW(); r < nrows; r += NGW()) {
        const float* src = mode ? H1 + (size_t)r * D : (r < RL ? AIN(I_X) + ((size_t)g * RL + r) * D : AIN(I_CTX) + ((size_t)g * RC + (r - RL)) * D);
        const int mrow = r < RL ? g * BG + r / T : 32;
        const float* sh = MOD + (size_t)mrow * NMOD + (3 * sub) * D; const float* sc = sh + D;
        f32x4 v[4]; float ss = 0.f;
#pragma unroll
        for (int j = 0; j < 4; ++j) { v[j] = ((const f32x4*)src)[lane + 64 * j]; ss += (v[j].x * v[j].x + v[j].y * v[j].y) + (v[j].z * v[j].z + v[j].w * v[j].w); }
        const float rstd = 1.0f / sqrtf(wave_sum(ss) * (1.0f / D) + EPS);
#pragma unroll
        for (int j = 0; j < 4; ++j) { const int c4 = lane + 64 * j; const f32x4 w = ((const f32x4*)nw)[c4], s4 = ((const f32x4*)sh)[c4], c1 = ((const f32x4*)sc)[c4];
            const f32x4 o = v[j] * rstd * w * (c1 + 1.0f) + s4;
            u32x2 p; p.x = cvt_pk_bf16(o.x, o.y); p.y = cvt_pk_bf16(o.z, o.w); ((u32x2*)(U + (size_t)r * D))[c4] = p; }
    }
}
__device__ __forceinline__ void phase_final(const Ctx cx, const Args& a, LAS unsigned char* lds, int g) {
    const int lane = cx.tid & 63; const float* fw = AIN(I_FNW);
    for (int r = GW(); r < RL; r += NGW()) {
        float* row = a.out + ((size_t)g * RL + r) * D;
        f32x4 v[4]; float ss = 0.f;
#pragma unroll
        for (int j = 0; j < 4; ++j) { v[j] = ((const f32x4*)row)[lane + 64 * j]; ss += (v[j].x * v[j].x + v[j].y * v[j].y) + (v[j].z * v[j].z + v[j].w * v[j].w); }
        const float rstd = 1.0f / sqrtf(wave_sum(ss) * (1.0f / D) + EPS);
#pragma unroll
        for (int j = 0; j < 4; ++j) { const int c4 = lane + 64 * j; ((f32x4*)row)[c4] = v[j] * rstd * ((const f32x4*)fw)[c4]; }
    }
}

__device__ __forceinline__ float logsig_fast(float x) { return fminf(x, 0.f) - __logf(1.0f + __expf(-fabsf(x))); }
__device__ __forceinline__ void phase_prep(const Ctx cx, const Args& a, int g, LAS unsigned char* lds) {
    const bf16_t* PROJ = (const bf16_t*)(a.ws + WS_BIG);
    const int tid = cx.tid;
    {
        LAS bf16_t* qs = (LAS bf16_t*)lds; LAS bf16_t* ks = (LAS bf16_t*)(lds + 16384); LAS float* fdl = (LAS float*)(lds + 32768); LAS float* part = (LAS float*)(lds + 36864);
        LAS bf16_t* qo = (LAS bf16_t*)(lds + 40960); LAS bf16_t* ko = (LAS bf16_t*)(lds + 57344);
        const int d = tid & 127, qt = tid >> 7;
        for (int item = cx.bid; item < BG * NCH * 8; item += cx.G) {
            const int h = item & 3, dir = (item >> 2) & 1, bc = item >> 3, b = bc / NCH, c = bc % NCH;
            const int row0 = c < 4 ? RL + b * CL + c * 64 : b * T + (c - 4) * 64;
            const bool lat = c >= 4;
#pragma unroll
            for (int k = 0; k < 2; ++k) { const int p = tid + 512 * k, r = p >> 4, c8 = (p & 15) * 8;
                *(LAS u32x4*)(ks + r * 128 + c8) = *(const u32x4*)(PROJ + (size_t)(row0 + r) * PN + PK + h * 128 + c8);
                if (lat) *(LAS u32x4*)(qs + r * 128 + c8) = *(const u32x4*)(PROJ + (size_t)(row0 + r) * PN + PQ + h * 128 + c8); }
#pragma unroll
            for (int k = 0; k < 2; ++k) { const int idx = tid + 512 * k; fdl[idx] = bf2f(PROJ[(size_t)(row0 + (idx >> 4)) * PN + PFD + dir * 16 + (idx & 15)]); }
            const int col = h * 128 + d;
            float fw[16];
#pragma unroll
            for (int r = 0; r < 16; ++r) fw[r] = AIN(I_FUP)[(size_t)(dir * 16 + r) * 512 + col];
            const float fbv = AIN(I_FB)[dir * 512 + col];
            __syncthreads();
            float la[16]; float psum = 0.f;
#pragma unroll
            for (int t = 0; t < 16; ++t) { const int i = 16 * qt + t; float dot = fbv;
#pragma unroll
                for (int r = 0; r < 16; ++r) dot += fdl[i * 16 + r] * fw[r];
                la[t] = logsig_fast(dot) * (1.0f / 16.0f); psum += la[t]; }
            part[qt * 128 + d] = psum;
            __syncthreads();
            const float p0 = part[d], p1 = part[128 + d], p2 = part[256 + d], p3 = part[384 + d];
            const float tot = (p0 + p1) + (p2 + p3);
            float run = dir == 0 ? (qt > 0 ? p0 : 0.f) + (qt > 1 ? p1 : 0.f) + (qt > 2 ? p2 : 0.f)
                                 : (qt < 3 ? p3 : 0.f) + (qt < 2 ? p2 : 0.f) + (qt < 1 ? p1 : 0.f);
            float ke[16];
            if (dir == 0) {
#pragma unroll
                for (int t = 0; t < 16; ++t) { const int i = 16 * qt + t; run += la[t];
                    const float kv = bf2f(ks[i * 128 + d]); ke[t] = kv * __expf(tot - run);
                    if (lat) { qo[i * 128 + d] = f2bf(bf2f(qs[i * 128 + d]) * 0.08838834764831845f * __expf(run)); ko[i * 128 + d] = f2bf(kv * __expf(-run)); } }
            } else {
#pragma unroll
                for (int t = 15; t >= 0; --t) { const int i = 16 * qt + t; run += la[t];
                    const float kv = bf2f(ks[i * 128 + d]); ke[t] = kv * __expf(tot - run);
                    if (lat) { qo[i * 128 + d] = f2bf(bf2f(qs[i * 128 + d]) * 0.08838834764831845f * __expf(run)); ko[i * 128 + d] = f2bf(kv * __expf(-run)); } }
            }
            const size_t tb = (((size_t)dir * BG + b) * NCH + c) * 4 + h;
            bf16_t* KET = (bf16_t*)(a.ws + WS_KET) + tb * 8192 + d * 64 + 16 * qt;
            { float k0[8], k1[8];
#pragma unroll
              for (int t = 0; t < 8; ++t) { k0[t] = ke[t]; k1[t] = ke[8 + t]; }
              *(u32x4*)KET = pack8(k0); *(u32x4*)(KET + 8) = pack8(k1); }
            if (qt == 0) ((float*)(a.ws + WS_BL))[tb * 128 + d] = tot;
            __syncthreads();
            if (lat) { bf16_t* QD = (bf16_t*)(a.ws + WS_QD) + tb * 8192; bf16_t* KI = (bf16_t*)(a.ws + WS_KI) + tb * 8192;
#pragma unroll
                for (int k = 0; k < 2; ++k) { const int p = tid + 512 * k; *(u32x4*)(QD + p * 8) = *(const LAS u32x4*)(qo + p * 8); *(u32x4*)(KI + p * 8) = *(const LAS u32x4*)(ko + p * 8); } }
            __syncthreads();
        }
    }
    {
        LAS bf16_t* vs = (LAS bf16_t*)lds;
        const int e = tid & 255, jh = tid >> 8;
        for (int item = cx.bid; item < BG * NCH * 4; item += cx.G) {
            const int h = item & 3, bc = item >> 2, b = bc / NCH, c = bc % NCH;
            const int row0 = c < 4 ? RL + b * CL + c * 64 : b * T + (c - 4) * 64;
#pragma unroll
            for (int k = 0; k < 4; ++k) { const int p = tid + 512 * k, r = p >> 5, c8 = (p & 31) * 8;
                *(LAS u32x4*)(vs + r * 256 + c8) = *(const u32x4*)(PROJ + (size_t)(row0 + r) * PN + PV + h * 256 + c8); }
            __syncthreads();
            bf16_t* VT = (bf16_t*)(a.ws + WS_VT) + ((((size_t)b * NCH + c) * 4 + h) * 256 + e) * 64 + 32 * jh;
#pragma unroll
            for (int jg = 0; jg < 4; ++jg) { float v[8];
#pragma unroll
                for (int jj = 0; jj < 8; ++jj) v[jj] = bf2f(vs[(32 * jh + 8 * jg + jj) * 256 + e]);
                *(u32x4*)(VT + 8 * jg) = pack8(v); }
            __syncthreads();
        }
    }
    bf16_t* XC = (bf16_t*)(a.ws + WS_XC);
    for (int idx = cx.bid * NTHR + cx.tid; idx < RG * 128; idx += cx.G * NTHR) {
        const int row = idx >> 7, c8 = (idx & 127) * 8;
        const int pos = row < RL ? (row & 63) : ((row - RL) & 255), len = row < RL ? 64 : 256;
        float acc[8];
#pragma unroll
        for (int i = 0; i < 8; ++i) acc[i] = AIN(I_CONVB)[c8 + i];
#pragma unroll
        for (int j = 0; j < 4; ++j) { const int p = pos + j - 2;
            if (p >= 0 && p < len) { float xv[8]; unpack8(*(const u32x4*)(PROJ + (size_t)(row + j - 2) * PN + PXL + c8), xv);
#pragma unroll
                for (int i = 0; i < 8; ++i) acc[i] += AIN(I_CONVW)[j * D + c8 + i] * xv[i]; } }
        *(u32x4*)(XC + (size_t)row * D + c8) = pack8(acc);
    }
}

__device__ __forceinline__ void phase_gatefix(const Ctx cx, const Args& a, LAS unsigned char* lds) {
    bf16_t* LA = (bf16_t*)(a.ws + WS_LA); bf16_t* UU = (bf16_t*)(a.ws + WS_UU); const bf16_t* XC = (const bf16_t*)(a.ws + WS_XC); const float* GC = (const float*)(a.ws + WS_GC);
    for (int idx = cx.bid * NTHR + cx.tid; idx < 2 * RG * 128; idx += cx.G * NTHR) {
        const int dir = idx >= RG * 128, rem = idx - dir * RG * 128, row = rem >> 7, c8 = (rem & 127) * 8;
        const size_t off = (size_t)dir * RG * D + (size_t)row * D + c8;
        float r[8], ig[8], xc[8]; unpack8(*(const u32x4*)(LA + off), r); unpack8(*(const u32x4*)(UU + off), ig); unpack8(*(const u32x4*)(XC + (size_t)row * D + c8), xc);
#pragma unroll
        for (int i = 0; i < 8; ++i) { const float l = -GC[(4 + dir) * D + c8 + i] * sigmoidf_(r[i] + GC[dir * D + c8 + i]);
            const float gi = sigmoidf_(ig[i] + GC[(2 + dir) * D + c8 + i]);
            r[i] = l; ig[i] = __builtin_amdgcn_sqrtf(fmaxf(one_minus_exp(2.0f * l), 0.f)) * gi * xc[i]; }
        *(u32x4*)(LA + off) = pack8(r); *(u32x4*)(UU + off) = pack8(ig);
    }
}

__device__ __forceinline__ int img_off(int nkg, int row, int kcol) { const int ob = (row & 15) * 64 + (kcol & 31) * 2; return ((row >> 4) * nkg + (kcol >> 5)) * 1024 + (ob ^ (((ob >> 9) & 1) << 5)); }
__device__ __forceinline__ bf16x8 ldfrag(const LAS unsigned char* img, int nkg, int row, int kcol) { return *(const LAS bf16x8*)(img + img_off(nkg, row, kcol)); }
#define MFMA16(a, b, c) __builtin_amdgcn_mfma_f32_16x16x32_bf16((a), (b), (c), 0, 0, 0)

__device__ __forceinline__ void phase_gla_scan(const Ctx cx, const Args& a, int g, LAS unsigned char* lds) {
    constexpr int XB = 57344, OFF_KI = 16384, OFF_KET = 32768, OFF_VT = 49152, OFF_P = 2 * XB, OFF_ST = OFF_P + 8192, OFF_BL = OFF_ST + 2 * 16384;
    static_assert(OFF_BL + 1024 <= LDS_BYTES, "gla scan LDS");
    const int tid = cx.tid, lane = tid & 63, w = tid >> 6, fr = lane & 15, fq = lane >> 4;
    const bf16_t* QDg = (const bf16_t*)(a.ws + WS_QD); const bf16_t* KIg = (const bf16_t*)(a.ws + WS_KI); const bf16_t* KETg = (const bf16_t*)(a.ws + WS_KET);
    const bf16_t* VTg = (const bf16_t*)(a.ws + WS_VT); const float* BLg = (const float*)(a.ws + WS_BL);
    bf16_t* Og = (bf16_t*)(a.ws + WS_OFB);
    for (int item = cx.bid; item < BG * 32; item += cx.G) {
        const int dvq = item & 3, dir = (item >> 2) & 1, h = (item >> 3) & 3, b = item >> 5;
        { u32x4 z = {0u, 0u, 0u, 0u}; *(LAS u32x4*)(lds + OFF_ST + tid * 32) = z; *(LAS u32x4*)(lds + OFF_ST + tid * 32 + 16) = z; }
        f32x4 accS[4];
#pragma unroll
        for (int t = 0; t < 4; ++t) accS[t] = (f32x4){0.f, 0.f, 0.f, 0.f};
        u32x4 pq[2], pk[2], pe[2], pv; float pbl = 0.f;
#define GLA_LOAD(s_) do { const int c_ = dir == 0 ? (s_) : ((s_) < 4 ? 3 - (s_) : 39 - (s_)); \
            const size_t tb_ = (((size_t)dir * BG + b) * NCH + c_) * 4 + h; \
            if (c_ >= 4) { pq[0] = ((const u32x4*)(QDg + tb_ * 8192))[tid]; pq[1] = ((const u32x4*)(QDg + tb_ * 8192))[tid + 512]; \
                           pk[0] = ((const u32x4*)(KIg + tb_ * 8192))[tid]; pk[1] = ((const u32x4*)(KIg + tb_ * 8192))[tid + 512]; } \
            pe[0] = ((const u32x4*)(KETg + tb_ * 8192))[tid]; pe[1] = ((const u32x4*)(KETg + tb_ * 8192))[tid + 512]; \
            pv = ((const u32x4*)(VTg + ((((size_t)b * NCH + c_) * 4 + h) * 256 + dvq * 64) * 64))[tid]; \
            if (tid < 128) pbl = BLg[tb_ * 128 + tid]; } while (0)
#define GLA_STORE(buf_) do { LAS unsigned char* X_ = lds + (buf_) * XB; \
            _Pragma("unroll") for (int i_ = 0; i_ < 2; ++i_) { const int p_ = tid + 512 * i_; \
                *(LAS u32x4*)(X_ + img_off(4, p_ >> 4, (p_ & 15) * 8)) = pq[i_]; *(LAS u32x4*)(X_ + OFF_KI + img_off(4, p_ >> 4, (p_ & 15) * 8)) = pk[i_]; \
                *(LAS u32x4*)(X_ + OFF_KET + img_off(2, p_ >> 3, (p_ & 7) * 8)) = pe[i_]; } \
            *(LAS u32x4*)(X_ + OFF_VT + img_off(2, tid >> 3, (tid & 7) * 8)) = pv; \
            if (tid < 128) ((LAS float*)(lds + OFF_BL + (buf_) * 512))[tid] = pbl; } while (0)
        pq[0] = pq[1] = pk[0] = pk[1] = (u32x4){0u, 0u, 0u, 0u};
        GLA_LOAD(0); GLA_STORE(0);
        __syncthreads();
        for (int s = 0; s < NCH; ++s) {
            const int cur = s & 1; const bool lat = s >= 4;
            const LAS unsigned char* X = lds + cur * XB;
#ifndef GLA_SAFE
            if (s + 1 < NCH) GLA_LOAD(s + 1);
#endif
            if (lat) {
                const int ti = w >> 1, tj0 = (w & 1) * 2;
                f32x4 sc[2] = {(f32x4){0.f, 0.f, 0.f, 0.f}, (f32x4){0.f, 0.f, 0.f, 0.f}};
#pragma unroll
                for (int kk = 0; kk < 4; ++kk) { const bf16x8 qa = ldfrag(X, 4, 16 * ti + fr, kk * 32 + fq * 8);
#pragma unroll
                    for (int t = 0; t < 2; ++t) { const bf16x8 kb = ldfrag(X + OFF_KI, 4, 16 * (tj0 + t) + fr, kk * 32 + fq * 8); sc[t] = MFMA16(qa, kb, sc[t]); } }
#pragma unroll
                for (int t = 0; t < 2; ++t)
#pragma unroll
                    for (int jj = 0; jj < 4; ++jj) { const int i = 16 * ti + 4 * fq + jj, j = 16 * (tj0 + t) + fr;
                        const bool keep = dir == 0 ? (j <= i) : (j > i);
                        *(LAS bf16_t*)(lds + OFF_P + img_off(2, i, j)) = f2bf(keep ? sc[t][jj] : 0.f); }
            }
            __syncthreads();
            const int te = w >> 1;
            if (lat) {
                const int c = dir == 0 ? s : 39 - s;
                const LAS unsigned char* STc = lds + OFF_ST + cur * 16384;
                f32x4 oc[2] = {(f32x4){0.f, 0.f, 0.f, 0.f}, (f32x4){0.f, 0.f, 0.f, 0.f}};
#pragma unroll
                for (int kk = 0; kk < 2; ++kk) { const bf16x8 va = ldfrag(X + OFF_VT, 2, 16 * te + fr, kk * 32 + fq * 8);
#pragma unroll
                    for (int t = 0; t < 2; ++t) { const bf16x8 pb = ldfrag(lds + OFF_P, 2, 16 * ((w & 1) * 2 + t) + fr, kk * 32 + fq * 8); oc[t] = MFMA16(va, pb, oc[t]); } }
#pragma unroll
                for (int kk = 0; kk < 4; ++kk) { const bf16x8 sa = ldfrag(STc, 4, 16 * te + fr, kk * 32 + fq * 8);
#pragma unroll
                    for (int t = 0; t < 2; ++t) { const bf16x8 qb = ldfrag(X, 4, 16 * ((w & 1) * 2 + t) + fr, kk * 32 + fq * 8); oc[t] = MFMA16(sa, qb, oc[t]); } }
#pragma unroll
                for (int t = 0; t < 2; ++t) { const int i = 16 * ((w & 1) * 2 + t) + fr; const size_t row = (size_t)b * T + (size_t)(c - 4) * 64 + i;
                    u32x2 o2; o2.x = cvt_pk_bf16(oc[t][0], oc[t][1]); o2.y = cvt_pk_bf16(oc[t][2], oc[t][3]);
                    *(u32x2*)(Og + ((size_t)dir * RL + row) * D + h * 256 + dvq * 64 + 16 * te + 4 * fq) = o2; }
            }
#ifdef GLA_SAFE
            __syncthreads();
#endif
            {
                const LAS float* blp = (const LAS float*)(lds + OFF_BL + cur * 512);
                LAS unsigned char* STn = lds + OFF_ST + (cur ^ 1) * 16384;
                bf16x8 vb[2];
#pragma unroll
                for (int kk = 0; kk < 2; ++kk) vb[kk] = ldfrag(X + OFF_VT, 2, 16 * te + fr, kk * 32 + fq * 8);
#pragma unroll
                for (int t = 0; t < 4; ++t) { const int td = (w & 1) * 4 + t;
#pragma unroll
                    for (int jj = 0; jj < 4; ++jj) accS[t][jj] *= __expf(blp[16 * td + 4 * fq + jj]);
#pragma unroll
                    for (int kk = 0; kk < 2; ++kk) { const bf16x8 ka = ldfrag(X + OFF_KET, 2, 16 * td + fr, kk * 32 + fq * 8); accS[t] = MFMA16(ka, vb[kk], accS[t]); }
                    u32x2 s2; s2.x = cvt_pk_bf16(accS[t][0], accS[t][1]); s2.y = cvt_pk_bf16(accS[t][2], accS[t][3]);
                    *(LAS u32x2*)(STn + img_off(4, 16 * te + fr, 16 * td + 4 * fq)) = s2; }
            }
#ifdef GLA_SAFE
            __syncthreads();
            if (s + 1 < NCH) { GLA_LOAD(s + 1); GLA_STORE(cur ^ 1); }
#else
            if (s + 1 < NCH) GLA_STORE(cur ^ 1);
#endif
            __syncthreads();
        }
#undef GLA_LOAD
#undef GLA_STORE
    }
}

__device__ __forceinline__ void phase_lru_scan(const Ctx cx, const Args& a, int g, LAS unsigned char* lds) {
    const int lane = cx.tid & 63, w = cx.tid >> 6;
    LAS f32x2* agg = (LAS f32x2*)lds;
    const float* GC = (const float*)(a.ws + WS_GC);
    for (int item = cx.bid; item < BG * 32; item += cx.G) {
        const int cgp = item & 15, dir = (item >> 4) & 1, b = item >> 5, ch = cgp * 64 + lane;
        const bf16_t* RR = (const bf16_t*)(a.ws + WS_LA) + (size_t)dir * RG * D + ch; const bf16_t* II = (const bf16_t*)(a.ws + WS_UU) + (size_t)dir * RG * D + ch;
        const bf16_t* XCp = (const bf16_t*)(a.ws + WS_XC) + ch;
        bf16_t* Hd = (bf16_t*)(a.ws + WS_HFB) + (size_t)dir * RL * D + ch;
        const float cbr = GC[dir * D + ch], cbi = GC[(2 + dir) * D + ch], csp = GC[(4 + dir) * D + ch];
#define LRU_ROW(s_) ((s_) < CL ? RL + b * CL + (dir ? CL - 1 - (s_) : (s_)) : b * T + (dir ? T - 1 - ((s_) - CL) : (s_) - CL))
#define LRU_GATES(k_) const float l_ = -csp * sigmoidf_(bf2f(rr[k_]) + cbr); const float av = __expf(l_); \
            const float uv = __builtin_amdgcn_sqrtf(fmaxf(one_minus_exp(2.0f * l_), 0.f)) * sigmoidf_(bf2f(ii[k_]) + cbi) * bf2f(xx[k_]);
        float A = 1.f, Z = 0.f;
        for (int blk = 0; blk < 18; ++blk) { const int s0 = 288 * w + 16 * blk; bf16_t rr[16], ii[16], xx[16];
#pragma unroll
            for (int k = 0; k < 16; ++k) { const size_t r = (size_t)LRU_ROW(s0 + k); rr[k] = RR[r * D]; ii[k] = II[r * D]; xx[k] = XCp[r * D]; }
#pragma unroll
            for (int k = 0; k < 16; ++k) { LRU_GATES(k) Z = av * Z + uv; A *= av; } }
        agg[w * 64 + lane] = (f32x2){A, Z};
        __syncthreads();
        float hst = 0.f;
#pragma unroll
        for (int w2 = 0; w2 < 7; ++w2) { const f32x2 p = agg[w2 * 64 + lane]; if (w2 < w) hst = p.x * hst + p.y; }
        for (int blk = 0; blk < 18; ++blk) { const int s0 = 288 * w + 16 * blk; bf16_t rr[16], ii[16], xx[16];
#pragma unroll
            for (int k = 0; k < 16; ++k) { const size_t r = (size_t)LRU_ROW(s0 + k); rr[k] = RR[r * D]; ii[k] = II[r * D]; xx[k] = XCp[r * D]; }
#pragma unroll
            for (int k = 0; k < 16; ++k) { LRU_GATES(k) hst = av * hst + uv;
                if (s0 + k >= CL) Hd[(size_t)LRU_ROW(s0 + k) * D] = f2bf(hst); } }
        __syncthreads();
#undef LRU_ROW
#undef LRU_GATES
    }
}

__device__ __forceinline__ void phase_post(const Ctx cx, const Args& a, LAS unsigned char* lds, int g) {
    const int lane = cx.tid & 63;
    const bf16_t* PROJ = (const bf16_t*)(a.ws + WS_BIG);
    bf16_t* O0 = (bf16_t*)(a.ws + WS_OFB); const bf16_t* O1 = O0 + (size_t)RL * D;
    bf16_t* H0 = (bf16_t*)(a.ws + WS_HFB); const bf16_t* H1b = H0 + (size_t)RL * D;
    const float* gnw = AIN(I_GNW);
    for (int r = GW(); r < RL; r += NGW()) {
        const size_t off = (size_t)r * D + lane * 16;
        float o[16], t[8]; float ss = 0.f;
#pragma unroll
        for (int hf = 0; hf < 2; ++hf) { float x0[8], x1[8]; unpack8(*(const u32x4*)(O0 + off + 8 * hf), x0); unpack8(*(const u32x4*)(O1 + off + 8 * hf), x1);
#pragma unroll
            for (int i = 0; i < 8; ++i) { o[8 * hf + i] = x0[i] + x1[i]; ss += o[8 * hf + i] * o[8 * hf + i]; } }
        ss += __shfl_xor(ss, 1); ss += __shfl_xor(ss, 2); ss += __shfl_xor(ss, 4); ss += __shfl_xor(ss, 8);
        const float rstd = 1.0f / sqrtf(ss * (1.0f / 256.0f) + EPS);
#pragma unroll
        for (int hf = 0; hf < 2; ++hf) { float gg[8]; unpack8(*(const u32x4*)(PROJ + (size_t)r * PN + PGG + lane * 16 + 8 * hf), gg);
#pragma unroll
            for (int i = 0; i < 8; ++i) t[i] = o[8 * hf + i] * rstd * gnw[(lane & 15) * 16 + 8 * hf + i] * siluf_(gg[i]);
            *(u32x4*)(O0 + off + 8 * hf) = pack8(t); }
#pragma unroll
        for (int hf = 0; hf < 2; ++hf) { float x0[8], x1[8], yl[8]; unpack8(*(const u32x4*)(H0 + off + 8 * hf), x0); unpack8(*(const u32x4*)(H1b + off + 8 * hf), x1);
            unpack8(*(const u32x4*)(PROJ + (size_t)r * PN + PYL + lane * 16 + 8 * hf), yl);
#pragma unroll
            for (int i = 0; i < 8; ++i) t[i] = (x0[i] + x1[i]) * geluf_(yl[i]);
            *(u32x4*)(H0 + off + 8 * hf) = pack8(t); }
    }
}


#define XB_TMO      128
#define XB_XCNT(j)  (256  + 64 * (j))
#define XB_XSUB(j)  (1280 + 64 * (j))
#define XB_XGEN(j)  (2304 + 64 * (j))
#define XB_TOP      3328
#define XB_TOPGEN   3392
#define XCD_BAR_WORDS 3456
#define XB_SPIN_CAP (1u << 22)
__device__ __forceinline__ unsigned xb_ld(unsigned* p)              { return __hip_atomic_load(p, __ATOMIC_RELAXED, __HIP_MEMORY_SCOPE_AGENT); }
__device__ __forceinline__ unsigned xb_add(unsigned* p, unsigned v) { return __hip_atomic_fetch_add(p, v, __ATOMIC_RELAXED, __HIP_MEMORY_SCOPE_AGENT); }
__device__ __forceinline__ unsigned xb_xcc_id() { return (unsigned)__builtin_amdgcn_s_getreg((3 << 11) | 20) & 0xFu; }
#define XB_SPIN(cond, bar) do { unsigned _sp = 0; while (cond) { __builtin_amdgcn_s_sleep(1); \
    if ((++_sp & 255u) == 0u) { if (xb_ld(&(bar)[XB_TMO])) break; if (_sp > XB_SPIN_CAP) { atomicAdd(&(bar)[XB_TMO], 1u); break; } } } } while (0)
__device__ __forceinline__ void xcd_barrier_complete(unsigned* bar, unsigned x, unsigned G, unsigned& nloc, unsigned& nx) {
    unsigned sum, cnt, mine, sp = 0u;
    for (;;) {
        sum = 0u; cnt = 0u; mine = 0u;
#pragma unroll
        for (unsigned j = 0; j < 16; ++j) { const unsigned c = xb_ld(&bar[XB_XCNT(j)]); sum += c; cnt += (c > 0u) ? 1u : 0u; mine = (j == x) ? c : mine; }
        if (sum == G) break;
        __builtin_amdgcn_s_sleep(1);
        if ((++sp & 255u) == 0u) { if (xb_ld(&bar[XB_TMO])) break; if (sp > XB_SPIN_CAP) { atomicAdd(&bar[XB_TMO], 1u); break; } }
    }
    nloc = mine > 0u ? mine : 1u; nx = cnt > 0u ? cnt : 1u;
}
__device__ __forceinline__ void xcd_barrier(unsigned* bar, volatile LAS unsigned* st, int tid, unsigned G) {
    asm volatile("s_waitcnt vmcnt(0)" ::: "memory");
    __syncthreads();
    if (tid == 0) {
        __builtin_amdgcn_s_waitcnt(0);
        const unsigned x = xb_xcc_id();
        unsigned nloc = st[0], nx = st[1];
        if (nloc == 0u) { xcd_barrier_complete(bar, x, G, nloc, nx); st[0] = nloc; st[1] = nx; }
        const unsigned old = xb_add(&bar[XB_XSUB(x)], 1u);
        const unsigned gen = old / nloc;
        if (old + 1u == (gen + 1u) * nloc) {
            __builtin_amdgcn_fence(__ATOMIC_RELEASE, "agent");
            asm volatile("s_waitcnt vmcnt(0)" ::: "memory");
            const unsigned og = xb_add(&bar[XB_TOP], 1u);
            const unsigned tg = og / nx;
            if (og + 1u == (tg + 1u) * nx) xb_add(&bar[XB_TOPGEN], 1u);
            else XB_SPIN(xb_ld(&bar[XB_TOPGEN]) == tg, bar);
            __builtin_amdgcn_fence(__ATOMIC_ACQUIRE, "agent");
            xb_add(&bar[XB_XGEN(x)], 1u);
            asm volatile("s_waitcnt vmcnt(0)" ::: "memory");
        } else {
            XB_SPIN(xb_ld(&bar[XB_XGEN(x)]) == gen, bar);
            __builtin_amdgcn_fence(__ATOMIC_ACQUIRE, "agent");
            asm volatile("s_waitcnt vmcnt(0)" ::: "memory");
        }
    }
    __syncthreads();
}

constexpr int NPH = 17;
#ifndef USE_CG_ALL
#define USE_CG_ALL 0
#endif
#if ONE_LAUNCH
#define GRID_SYNC(k) do { if ((k) == 1 || USE_CG_ALL) cg::this_grid().sync(); else xcd_barrier((unsigned*)ws + 4096, (volatile LAS unsigned*)(lds + PTAB + 256), cx.tid, (unsigned)cx.G); } while (0)
#else
#define GRID_SYNC(k) do {} while (0)
#endif
#define STEP_BEGIN(k) if (a.lo <= (k) && (k) < a.hi) { \
        Ctx cx; { int t_ = wave_s * 64 + (int)__builtin_amdgcn_mbcnt_hi(~0u, __builtin_amdgcn_mbcnt_lo(~0u, 0u)), b_ = blockIdx.x, g_ = gridDim.x; asm volatile("" : "+v"(t_)); asm volatile("" : "+s"(b_), "+s"(g_)); cx.tid = t_; cx.bid = b_; cx.G = g_; } \
        const int G = cx.G, cidx = cx.bid; (void)G; (void)cidx; \
        unsigned char* ws = a.ws; asm volatile("" : "+s"(ws)); \
        if ((k) > a.lo) GRID_SYNC(k); \
        const float* MOD = (const float*)(ws + WS_MOD); float* H1 = (float*)(ws + WS_H1); bf16_t* U = (bf16_t*)(ws + WS_U); bf16_t* BIG = (bf16_t*)(ws + WS_BIG); bf16_t* XC = (bf16_t*)(ws + WS_XC); \
        (void)MOD; (void)H1; (void)U; (void)BIG; (void)XC; pg8::StaticOrder S; (void)S;
#define STEP_END }

template <int g>
__device__ __forceinline__ void run_group(const Args& a, LAS unsigned char* lds, const int wave_s) {
    constexpr int s0 = 2 + g * NPH;
    STEP_BEGIN(s0 + 0) if (PHON(0)) phase_normmod(cx, a, lds, g, 0, RG, 0); STEP_END
    STEP_BEGIN(s0 + 1) if (PHON(1)) { pg8::Gemm gm{U, (const bf16_t*)(ws + WS_WI1), RG, 2 * FH, D, D, D, 0, 0}; S.init(RG, 2 * FH, G, cidx);
                  pg8::EpiSwiglu E{BIG, FH}; pg8::gemm_phase<pg8::EpiSwiglu, true>(cx.tid, lds, gm, S, E); } STEP_END
    STEP_BEGIN(s0 + 2) if (PHON(2)) { pg8::Gemm gm{BIG, (const bf16_t*)(ws + WS_WO1), RG, D, FH, FH, FH, 0, 0}; S.init(RG, D, G, cidx);
                  pg8::EpiResid E{AIN(I_X) + (size_t)g * RL * D, AIN(I_CTX) + (size_t)g * RC * D, H1, H1 + (size_t)RL * D,
                                  MOD + (size_t)(g * BG) * NMOD + 2 * D, MOD + (size_t)32 * NMOD + 2 * D, 0.5f, RL / 256};
                  pg8::gemm_phase<pg8::EpiResid, true>(cx.tid, lds, gm, S, E); } STEP_END
    STEP_BEGIN(s0 + 3) if (PHON(3)) phase_normmod(cx, a, lds, g, 1, RG, 1); STEP_END
    STEP_BEGIN(s0 + 4) if (PHON(4)) { pg8::Gemm gm{U, (const bf16_t*)(ws + WS_WIN), RG, PN, D, D, D, 0, 0}; S.init(RG, PN, G, cidx);
                  pg8::EpiBf16 E{BIG, PN}; pg8::gemm_phase<pg8::EpiBf16, true>(cx.tid, lds, gm, S, E); } STEP_END
    STEP_BEGIN(s0 + 5) if (PHON(5)) phase_prep(cx, a, g, lds); STEP_END
    STEP_BEGIN(s0 + 6) if (PHON(6)) { pg8::Gemm gm{XC, (const bf16_t*)(ws + WS_WLG), RG, 4096, 128, D, 128, 1, 256}; S.init(RG, 4096, G, cidx);
                  pg8::EpiGate E{(bf16_t*)(ws + WS_LA), (bf16_t*)(ws + WS_UU)};
                  pg8::gemm_phase<pg8::EpiGate, true>(cx.tid, lds, gm, S, E); } STEP_END
    STEP_BEGIN(s0 + 7) if (PHON(7)) { phase_gla_scan(cx, a, g, lds); } STEP_END
    STEP_BEGIN(s0 + 8) if (PHON(8)) phase_lru_scan(cx, a, g, lds); STEP_END
    STEP_BEGIN(s0 + 9) if (PHON(9)) phase_post(cx, a, lds, g); STEP_END
    STEP_BEGIN(s0 + 10) if (PHON(10)) { pg8::Gemm gm{(const bf16_t*)(ws + WS_OFB), (const bf16_t*)(ws + WS_WOG), RL, D, D, D, D, 0, 0}; S.init(RL, D, G, cidx);
                   pg8::EpiMix<false> E{BIG, PGA, XC}; pg8::gemm_phase<pg8::EpiMix<false>, true>(cx.tid, lds, gm, S, E); } STEP_END
    STEP_BEGIN(s0 + 11) if (PHON(11)) { pg8::Gemm gm{(const bf16_t*)(ws + WS_HFB), (const bf16_t*)(ws + WS_WOL), RL, D, D, D, D, 0, 0}; S.init(RL, D, G, cidx);
                   pg8::EpiMix<true> E{BIG, PGB, XC}; pg8::gemm_phase<pg8::EpiMix<true>, true>(cx.tid, lds, gm, S, E); } STEP_END
    STEP_BEGIN(s0 + 12) if (PHON(12)) { pg8::Gemm gm{XC, (const bf16_t*)(ws + WS_WOO), RL, D, D, D, D, 0, 0}; S.init(RL, D, G, cidx);
                   pg8::EpiResid E{H1, H1, H1, H1, MOD + (size_t)(g * BG) * NMOD + 5 * D, MOD, 1.0f, RL / 256};
                   pg8::gemm_phase<pg8::EpiResid, true>(cx.tid, lds, gm, S, E); } STEP_END
    STEP_BEGIN(s0 + 13) if (PHON(13)) phase_normmod(cx, a, lds, g, 1, RL, 2); STEP_END
    STEP_BEGIN(s0 + 14) if (PHON(14)) { pg8::Gemm gm{U, (const bf16_t*)(ws + WS_WI2), RL, 2 * FH, D, D, D, 0, 0}; S.init(RL, 2 * FH, G, cidx);
                   pg8::EpiSwiglu E{BIG, FH}; pg8::gemm_phase<pg8::EpiSwiglu, true>(cx.tid, lds, gm, S, E); } STEP_END
    STEP_BEGIN(s0 + 15) if (PHON(15)) { pg8::Gemm gm{BIG, (const bf16_t*)(ws + WS_WO2), RL, D, FH, FH, FH, 0, 0}; S.init(RL, D, G, cidx);
                   float* og = a.out + (size_t)g * RL * D;
                   pg8::EpiResid E{H1, H1, og, og, MOD + (size_t)(g * BG) * NMOD + 8 * D, MOD, 0.5f, RL / 256};
                   pg8::gemm_phase<pg8::EpiResid, true>(cx.tid, lds, gm, S, E); } STEP_END
    STEP_BEGIN(s0 + 16) if (PHON(16)) phase_final(cx, a, lds, g); STEP_END
}

__global__ void __launch_bounds__(NTHR, 2) fwd_kernel(Args a) {
    extern __shared__ __attribute__((aligned(16))) unsigned char lds_raw[];
    LAS unsigned char* lds = (LAS unsigned char*)lds_raw;
    if (threadIdx.x < 26) ((LAS unsigned long long*)(lds + PTAB))[threadIdx.x] = (unsigned long long)a.in[threadIdx.x];
    if (threadIdx.x == 32) { ((LAS unsigned*)(lds + PTAB + 256))[0] = 0u; ((LAS unsigned*)(lds + PTAB + 256))[1] = 0u; }
#if ONE_LAUNCH
    if (threadIdx.x == 0) (void)xb_add((unsigned*)a.ws + 4096 + XB_XCNT(xb_xcc_id()), 1u);
#endif
    const int wave_s = __builtin_amdgcn_readfirstlane(threadIdx.x >> 6);
    __syncthreads();
    STEP_BEGIN(0) if (PHON(17)) phase_weights(cx, a, lds); STEP_END
    STEP_BEGIN(1) if (PHON(18)) phase_modreduce(cx, a, lds); STEP_END
    run_group<0>(a, lds, wave_s);
    run_group<1>(a, lds, wave_s);
    run_group<2>(a, lds, wave_s);
    run_group<3>(a, lds, wave_s);
}


#ifdef PROBE_STEP
__global__ void probe_kernel(const unsigned char* ws, float* out) {
    const size_t n = (size_t)65536 * 1024, q = n / 4;
    const bf16_t* r0 = (const bf16_t*)(ws + PROBE_R0); const bf16_t* r1 = (const bf16_t*)(ws + PROBE_R1); const bf16_t* r2 = (const bf16_t*)(ws + PROBE_R2); const bf16_t* r3 = (const bf16_t*)(ws + PROBE_R3);
    for (size_t i = (size_t)blockIdx.x * blockDim.x + threadIdx.x; i < q; i += (size_t)gridDim.x * blockDim.x) {
        out[i] = bf2f(r0[i]); out[q + i] = bf2f(r1[i]); out[2 * q + i] = bf2f(r2[i]); out[3 * q + i] = bf2f(r3[i]); }
}
#endif
extern "C" void kernel_launch(void* const* d_in, const int* in_sizes, int n_in, void* d_out, int out_size, void* d_ws, size_t ws_size, hipStream_t stream) {
    static int grid = 0;
    if (grid == 0) {
        if (n_in != 26 || ws_size < WS_END) { fprintf(stderr, "kernel_launch: unexpected inputs (n_in %d, ws %zu, need %zu)\n", n_in, ws_size, (size_t)WS_END); grid = -1; return; }
        int dev = 0, cus = 0, per_cu = 0;
        hipGetDevice(&dev); hipDeviceGetAttribute(&cus, hipDeviceAttributeMultiprocessorCount, dev);
        if (hipFuncSetAttribute((const void*)fwd_kernel, hipFuncAttributeMaxDynamicSharedMemorySize, LDS_BYTES) != hipSuccess) { fprintf(stderr, "kernel_launch: hipFuncSetAttribute failed\n"); grid = -1; return; }
        hipOccupancyMaxActiveBlocksPerMultiprocessor(&per_cu, (const void*)fwd_kernel, NTHR, LDS_BYTES);
        (void)hipGetLastError();
        if (per_cu < 1) per_cu = 1;
        grid = cus * 1;
    }
    if (grid < 0) return;
    Args a{};
    for (int i = 0; i < 26; ++i) a.in[i] = (const float*)d_in[i];
    a.out = (float*)d_out; a.ws = (unsigned char*)d_ws;
    const int nsteps = 2 + NG * NPH;
#if ONE_LAUNCH
    (void)hipMemsetAsync(d_ws, 0, 65536, stream);
    a.lo = 0; a.hi = nsteps;
    void* args[] = {&a};
    hipError_t e = hipLaunchCooperativeKernel((const void*)fwd_kernel, dim3(grid), dim3(NTHR), args, LDS_BYTES, stream);
    if (e != hipSuccess) fprintf(stderr, "cooperative launch failed: %s (grid %d)\n", hipGetErrorString(e), grid);
#else
#ifdef PROBE_STEP
    for (int s = 0; s <= PROBE_STEP; ++s) { a.lo = s; a.hi = s + 1; hipLaunchKernelGGL(fwd_kernel, dim3(grid), dim3(NTHR), LDS_BYTES, stream, a); }
    hipLaunchKernelGGL(probe_kernel, dim3(2048), dim3(256), 0, stream, (const unsigned char*)d_ws, (float*)d_out);
#else
    for (int s = 0; s < nsteps; ++s) { a.lo = s; a.hi = s + 1; hipLaunchKernelGGL(fwd_kernel, dim3(grid), dim3(NTHR), LDS_BYTES, stream, a); }
#endif
#endif
}
```

```cpp
#include <hip/hip_runtime.h>
#include <hip/hip_cooperative_groups.h>
#include <cstdio>
#include <cstdint>
namespace cg = cooperative_groups;

#ifndef ONE_LAUNCH
#define ONE_LAUNCH 1
#endif

#ifndef PHMASK
#define PHMASK 0x1fffff
#endif
#define PHON(n) (((PHMASK) >> (n)) & 1)
#define LAS __attribute__((address_space(3)))
typedef unsigned short bf16_t;
typedef short bf16x8 __attribute__((ext_vector_type(8)));
typedef float f32x4 __attribute__((ext_vector_type(4)));
typedef float f32x2 __attribute__((ext_vector_type(2)));
typedef unsigned u32x4 __attribute__((ext_vector_type(4)));
typedef unsigned u32x2 __attribute__((ext_vector_type(2)));

constexpr int D = 1024, NB = 32, T = 2048, CL = 256, FH = 2816, INW = 7200, PN = 7424, NMOD = 9216;
constexpr int NG = 4, BG = NB / NG;
constexpr int RL = BG * T, RC = BG * CL, RG = RL + RC;
constexpr int NCH = 36;
constexpr float EPS = 1e-6f;
constexpr int PQ = 0, PK = 512, PV = 1024, PGG = 2048, PXL = 3072, PYL = 4096, PGA = 5120, PGB = 6144, PFD = 7168;

constexpr size_t al(size_t x) { return (x + 4095) & ~(size_t)4095; }
constexpr size_t WS_WI1 = 1 << 20;
constexpr size_t WS_WO1 = WS_WI1 + al((size_t)2 * FH * D * 2);
constexpr size_t WS_WI2 = WS_WO1 + al((size_t)D * FH * 2);
constexpr size_t WS_WO2 = WS_WI2 + al((size_t)2 * FH * D * 2);
constexpr size_t WS_WIN = WS_WO2 + al((size_t)D * FH * 2);
constexpr size_t WS_WOG = WS_WIN + al((size_t)PN * D * 2);
constexpr size_t WS_WOL = WS_WOG + al((size_t)D * D * 2);
constexpr size_t WS_WOO = WS_WOL + al((size_t)D * D * 2);
constexpr size_t WS_WLG = WS_WOO + al((size_t)D * D * 2);
constexpr size_t WS_MODP = WS_WLG + al((size_t)4096 * 128 * 2);
constexpr size_t WS_MOD = WS_MODP + al((size_t)16 * 33 * NMOD * 4);
constexpr size_t WS_GC = WS_MOD + al((size_t)33 * NMOD * 4);
constexpr size_t WS_H1 = WS_GC + al((size_t)6 * D * 4);
constexpr size_t WS_U = WS_H1 + al((size_t)RG * D * 4);
constexpr size_t WS_BIG = WS_U + al((size_t)RG * D * 2);
constexpr size_t WS_XC = WS_BIG + al((size_t)RG * PN * 2);
constexpr size_t WS_LA = WS_XC + al((size_t)RG * D * 2);
constexpr size_t WS_UU = WS_LA + al((size_t)2 * RG * D * 2);
constexpr size_t WS_HFB = WS_UU + al((size_t)2 * RG * D * 2);
constexpr size_t WS_OFB = WS_HFB + al((size_t)2 * RL * D * 2);
constexpr size_t GT = (size_t)2 * BG * NCH * 4;
constexpr size_t WS_QD = WS_OFB + al((size_t)2 * RL * D * 2);
constexpr size_t WS_KI = WS_QD + al(GT * 8192 * 2);
constexpr size_t WS_KET = WS_KI + al(GT * 8192 * 2);
constexpr size_t WS_VT = WS_KET + al(GT * 8192 * 2);
constexpr size_t WS_BL = WS_VT + al((size_t)BG * NCH * 4 * 16384 * 2);
constexpr size_t WS_END = WS_BL + al(GT * 128 * 4);
static_assert(WS_END <= (size_t)1073741824, "workspace map exceeds 1 GiB");

constexpr int LDS_BYTES = 163840, PTAB = LDS_BYTES - 512;

typedef __bf16 bf16x2_t __attribute__((ext_vector_type(2)));
__device__ __forceinline__ unsigned cvt_pk_bf16(float lo, float hi) { const f32x2 v = {lo, hi}; return __builtin_bit_cast(unsigned, __builtin_convertvector(v, bf16x2_t)); }
__device__ __forceinline__ bf16_t f2bf(float f) { return (bf16_t)(cvt_pk_bf16(f, 0.f) & 0xffffu); }
__device__ __forceinline__ float bf2f(bf16_t h) { return __uint_as_float(((unsigned)h) << 16); }
__device__ __forceinline__ float bflo(unsigned w) { return __uint_as_float(w << 16); }
__device__ __forceinline__ float bfhi(unsigned w) { return __uint_as_float(w & 0xffff0000u); }
__device__ __forceinline__ float sigmoidf_(float x) { return __builtin_amdgcn_rcpf(1.0f + __expf(-x)); }
__device__ __forceinline__ float siluf_(float x) { return x * __builtin_amdgcn_rcpf(1.0f + __expf(-x)); }
__device__ __forceinline__ float geluf_(float x) { const float z = 0.7978845608028654f * (x + 0.044715f * x * x * x); return x * (1.0f - __builtin_amdgcn_rcpf(1.0f + __expf(2.0f * z))); }
__device__ __forceinline__ float logsigf_(float x) { return fminf(x, 0.f) - log1pf(__expf(-fabsf(x))); }
__device__ __forceinline__ float one_minus_exp(float x) {
    const float ser = -x * (1.0f + x * (0.5f + x * (0.16666667f + x * (0.041666668f + x * (0.0083333338f + x * (0.0013888889f + x * 0.0001984127f))))));
    return x > -0.3f ? ser : 1.0f - __expf(x);
}
__device__ __forceinline__ float wave_sum(float v) {
#pragma unroll
    for (int o = 1; o < 64; o <<= 1) v += __shfl_xor(v, o);
    return v;
}
__device__ __forceinline__ void unpack8(const u32x4 w, float (&f)[8]) {
    f[0] = bflo(w.x); f[1] = bfhi(w.x); f[2] = bflo(w.y); f[3] = bfhi(w.y); f[4] = bflo(w.z); f[5] = bfhi(w.z); f[6] = bflo(w.w); f[7] = bfhi(w.w);
}
__device__ __forceinline__ u32x4 pack8(const float (&f)[8]) {
    u32x4 w; w.x = cvt_pk_bf16(f[0], f[1]); w.y = cvt_pk_bf16(f[2], f[3]); w.z = cvt_pk_bf16(f[4], f[5]); w.w = cvt_pk_bf16(f[6], f[7]); return w;
}

namespace pg8 {
constexpr int BM = 256, BK = 64, HALF = 128, HTB = HALF * BK * 2, STAGE_BYTES = 8 * HTB, NXCD = 8, WGM = 8;
__host__ __device__ __forceinline__ int lds_byte(int r, int c) { const int st = (r >> 4) * 2 + (c >> 5), rr = r & 15, cc = c & 31, ob = rr * 64 + cc * 2; return st * 1024 + (ob ^ (((ob >> 9) & 1) << 5)); }
__host__ __device__ __forceinline__ void stage_rc(int b, int& R, int& C) { const int st = b / 1024, sb = b % 1024, swz = sb ^ (((sb >> 9) & 1) << 5); R = (st >> 1) * 16 + swz / 64; C = (st & 1) * 32 + (swz % 64) / 2; }
__host__ __device__ __forceinline__ int perm32(int rho) { const int n = rho >> 4, i = rho & 15; return 8 * (i >> 2) + 4 * n + (i & 3); }
struct Unit { int pm, pn; };
struct Gemm { const bf16_t* A; const bf16_t* Bt; int M, N, K, lda, ldb, a_pn_shift, a_pn_bytes; };
struct StaticOrder {
    int nM, nN, nwg, G, c, ext, ext_pm0;
    __device__ void init(int M, int N, int G_, int c_) { nM = M / BM; nN = N / BM; nwg = nM * nN; G = G_; c = c_; ext = 0; ext_pm0 = 0; }
    __device__ bool next(int i, Unit& u) const {
        const long L = (long)i * G + c;
        if (L >= nwg) { if (L >= nwg + ext) return false; const int idx = (int)(L - nwg), t = idx % 11; u.pm = ext_pm0 + idx / 11; u.pn = t < 6 ? t + 2 : (t < 10 ? t + 6 : 28); return true; }
        int wgid = (int)L; { const int q = nwg / NXCD, r = nwg % NXCD, xcd = wgid % NXCD, off = wgid / NXCD; wgid = (xcd < r ? xcd * (q + 1) : r * (q + 1) + (xcd - r) * q) + off; }
        const int nig = WGM * nN, gid = wgid / nig, fm = gid * WGM, gsz = (nM - fm) < WGM ? (nM - fm) : WGM;
        u.pm = fm + ((wgid % nig) % gsz); u.pn = (wgid % nig) / gsz; return true;
    }
};
template <class Epi, bool ALIGN_EPI>
__device__ __forceinline__ void gemm_phase(const int tid, LAS unsigned char* lds, const Gemm g, const StaticOrder& S, const Epi& E) {
    const int wid = __builtin_amdgcn_readfirstlane(tid >> 6), lane = tid & 63, wr = wid >> 2, wc = wid & 3, fr = lane & 15, fq = lane >> 4;
    const int K = g.K, nt = K / BK;
    unsigned voffA[2], voffB[2];
#pragma unroll
    for (int i = 0; i < 2; ++i) { int R, C; stage_rc(tid * 16 + i * 8192, R, C); const int Rb = Epi::PERM ? ((R & ~31) + perm32(R & 31)) : R;
        voffA[i] = (unsigned)(R * g.lda + C) * 2u; voffB[i] = (unsigned)(Rb * g.ldb + C) * 2u; }
    const size_t kstep = (size_t)(BK * 2);
    const size_t hstepA = (size_t)HALF * g.lda * 2, hstepB = (size_t)HALF * g.ldb * 2;
    const size_t tstepA = 2 * hstepA, tstepB = 2 * hstepB;
    const unsigned ldsw = (unsigned)wid * 1024u;
    const int aoff = lds_byte(wr * 64 + fr, fq * 8), boff = lds_byte(wc * 32 + fr, fq * 8);
#define PG8_SA(b, h) (((b) * 2 + (h)) * HTB)
#define PG8_SB(b, h) ((4 + (b) * 2 + (h)) * HTB)
#define PG8_STAGE(bufoff, gbase, voff) do { _Pragma("unroll") for (int _i = 0; _i < 2; ++_i) \
        __builtin_amdgcn_global_load_lds((const unsigned*)((const char*)(gbase) + (voff)[_i]), (LAS unsigned*)(lds + (bufoff) + ldsw + _i * 8192), 16, 0, 0); } while (0)
#define PG8_LDA(dst, b, h) do { _Pragma("unroll") for (int m = 0; m < 4; ++m) _Pragma("unroll") for (int k = 0; k < 2; ++k) dst[m][k] = *(const LAS bf16x8*)(lds + PG8_SA(b, h) + aoff + m * 2048 + k * 1024); } while (0)
#define PG8_LDB(dst, b, h) do { _Pragma("unroll") for (int n = 0; n < 2; ++n) _Pragma("unroll") for (int k = 0; k < 2; ++k) dst[n][k] = *(const LAS bf16x8*)(lds + PG8_SB(b, h) + boff + n * 2048 + k * 1024); } while (0)
#define PG8_MMA(ai, bj, At, Bt) do { __builtin_amdgcn_s_setprio(1); _Pragma("unroll") for (int m = 0; m < 4; ++m) _Pragma("unroll") for (int n = 0; n < 2; ++n) _Pragma("unroll") for (int k = 0; k < 2; ++k) \
        acc[ai][bj][m][n] = __builtin_amdgcn_mfma_f32_16x16x32_bf16(Bt[n][k], At[m][k], acc[ai][bj][m][n], 0, 0, 0); __builtin_amdgcn_s_setprio(0); } while (0)
#define PG8_WAIT_V(n) asm volatile("s_waitcnt vmcnt(" #n ")" ::: "memory")
#define PG8_WAIT_L(n) asm volatile("s_waitcnt lgkmcnt(" #n ")" ::: "memory")
#define PG8_BAR __builtin_amdgcn_s_barrier()
#define PG8_SCHED __builtin_amdgcn_sched_barrier(0)
    Unit cur, nxt; int ui = 0;
    if (!S.next(0, cur)) return;
    f32x4 acc[2][2][4][2];
#pragma unroll
    for (int a = 0; a < 2; ++a)
#pragma unroll
        for (int b = 0; b < 2; ++b)
#pragma unroll
            for (int m = 0; m < 4; ++m)
#pragma unroll
                for (int n = 0; n < 2; ++n) acc[a][b][m][n] = (f32x4){0.f, 0.f, 0.f, 0.f};
    bf16x8 At[4][2], B0[2][2], B1[2][2];
    const char* cA = (const char*)g.A + (size_t)cur.pm * tstepA + (size_t)((cur.pn >> g.a_pn_shift) * g.a_pn_bytes);
    const char* cB = (const char*)g.Bt + (size_t)cur.pn * tstepB;
    PG8_STAGE(PG8_SB(0, 0), cB, voffB); PG8_STAGE(PG8_SB(0, 1), cB + hstepB, voffB); PG8_STAGE(PG8_SA(0, 0), cA, voffA); PG8_STAGE(PG8_SA(0, 1), cA + hstepA, voffA);
    if (wr == 1) PG8_BAR;
    PG8_WAIT_V(2); PG8_BAR;
    PG8_STAGE(PG8_SB(1, 0), cB + kstep, voffB); PG8_STAGE(PG8_SA(1, 0), cA + kstep, voffA); PG8_STAGE(PG8_SB(1, 1), cB + hstepB + kstep, voffB);
    PG8_WAIT_V(6); PG8_BAR;
    for (;;) {
        const bool has_next = S.next(ui + 1, nxt);
        const char* nA = has_next ? (const char*)g.A + (size_t)nxt.pm * tstepA + (size_t)((nxt.pn >> g.a_pn_shift) * g.a_pn_bytes) : cA;
        const char* nB = has_next ? (const char*)g.Bt + (size_t)nxt.pn * tstepB : cB;
        for (int t = 0; t < nt; t += 2) {
            const bool last = (t == nt - 2);
            const char* a1 = cA + (size_t)(t + 1) * kstep;
            const char* a2 = last ? nA : cA + (size_t)(t + 2) * kstep; const char* b2 = last ? nB : cB + (size_t)(t + 2) * kstep;
            const char* a3 = a2 + kstep; const char* b3 = b2 + kstep;
            PG8_LDB(B0, 0, 0); PG8_LDB(B1, 0, 1); PG8_SCHED; PG8_LDA(At, 0, 0); PG8_STAGE(PG8_SA(1, 1), a1 + hstepA, voffA);
            PG8_WAIT_V(8); PG8_WAIT_L(0); PG8_BAR; PG8_MMA(0, 0, At, B0); PG8_MMA(0, 1, At, B1); PG8_BAR; PG8_SCHED;
            PG8_LDA(At, 0, 1); PG8_STAGE(PG8_SB(0, 0), b2, voffB); PG8_STAGE(PG8_SB(0, 1), b2 + hstepB, voffB); PG8_STAGE(PG8_SA(0, 0), a2, voffA);
            PG8_WAIT_V(8); PG8_WAIT_L(0); PG8_BAR; PG8_MMA(1, 0, At, B0); PG8_MMA(1, 1, At, B1); PG8_BAR; PG8_SCHED;
            PG8_LDB(B0, 1, 0); PG8_LDB(B1, 1, 1); PG8_SCHED; PG8_LDA(At, 1, 0); PG8_STAGE(PG8_SA(0, 1), a2 + hstepA, voffA);
            PG8_WAIT_V(8); PG8_WAIT_L(0); PG8_BAR; PG8_MMA(0, 0, At, B0); PG8_MMA(0, 1, At, B1); PG8_BAR; PG8_SCHED;
            PG8_LDA(At, 1, 1); PG8_STAGE(PG8_SB(1, 0), b3, voffB); PG8_STAGE(PG8_SB(1, 1), b3 + hstepB, voffB); PG8_STAGE(PG8_SA(1, 0), a3, voffA);
            PG8_WAIT_V(8); PG8_WAIT_L(0); PG8_BAR; PG8_MMA(1, 0, At, B0); PG8_MMA(1, 1, At, B1); PG8_BAR; PG8_SCHED;
        }
        if constexpr (ALIGN_EPI) { if (wr == 0) PG8_BAR; }
        { int fr_ = fr, fq_ = fq; asm volatile("" : "+v"(fr_), "+v"(fq_)); E(acc, cur, wr, wc, fr_, fq_); }
        if (!has_next) break;
#pragma unroll
        for (int a = 0; a < 2; ++a)
#pragma unroll
            for (int b = 0; b < 2; ++b)
#pragma unroll
                for (int m = 0; m < 4; ++m)
#pragma unroll
                    for (int n = 0; n < 2; ++n) acc[a][b][m][n] = (f32x4){0.f, 0.f, 0.f, 0.f};
        cur = nxt; cA = nA; cB = nB; ++ui;
        if constexpr (ALIGN_EPI) { if (wr == 1) PG8_BAR; }
    }
    PG8_WAIT_V(0);
    if constexpr (!ALIGN_EPI) { if (wr == 0) PG8_BAR; }
    PG8_BAR;
#undef PG8_SA
#undef PG8_SB
#undef PG8_STAGE
#undef PG8_LDA
#undef PG8_LDB
#undef PG8_MMA
#undef PG8_WAIT_V
#undef PG8_WAIT_L
#undef PG8_BAR
#undef PG8_SCHED
}

struct EpiBf16 {
    static constexpr bool PERM = true;
    bf16_t* O; int ldc;
    __device__ __forceinline__ void operator()(const f32x4 (&acc)[2][2][4][2], const Unit& u, int wr, int wc, int fr, int fq) const {
        const int row0 = u.pm * BM + wr * 64 + fr, col0 = u.pn * BM + wc * 32 + 8 * fq;
#pragma unroll
        for (int ai = 0; ai < 2; ++ai)
#pragma unroll
            for (int m = 0; m < 4; ++m) { bf16_t* rowp = O + (size_t)(row0 + ai * HALF + m * 16) * ldc + col0;
#pragma unroll
                for (int bj = 0; bj < 2; ++bj) { const f32x4 v0 = acc[ai][bj][m][0], v1 = acc[ai][bj][m][1];
                    u32x4 w; w.x = cvt_pk_bf16(v0[0], v0[1]); w.y = cvt_pk_bf16(v0[2], v0[3]); w.z = cvt_pk_bf16(v1[0], v1[1]); w.w = cvt_pk_bf16(v1[2], v1[3]);
                    *(u32x4*)(rowp + bj * HALF) = w; } }
    }
};
struct EpiSwiglu {
    static constexpr bool PERM = true;
    bf16_t* O; int ldc;
    __device__ __forceinline__ void operator()(const f32x4 (&acc)[2][2][4][2], const Unit& u, int wr, int wc, int fr, int fq) const {
        const int row0 = u.pm * BM + wr * 64 + fr, col0 = u.pn * HALF + wc * 32 + 8 * fq;
#pragma unroll
        for (int ai = 0; ai < 2; ++ai)
#pragma unroll
            for (int m = 0; m < 4; ++m) { bf16_t* rowp = O + (size_t)(row0 + ai * HALF + m * 16) * ldc + col0;
                float o[8];
#pragma unroll
                for (int n = 0; n < 2; ++n)
#pragma unroll
                    for (int j = 0; j < 4; ++j) o[4 * n + j] = siluf_(acc[ai][0][m][n][j]) * acc[ai][1][m][n][j];
                *(u32x4*)rowp = pack8(o); }
    }
};
struct EpiResid {
    static constexpr bool PERM = false;
    const float* baseL; const float* baseC; float* outL; float* outC; const float* modL; const float* modC; float scale; int nlat;
    __device__ __forceinline__ void operator()(const f32x4 (&acc)[2][2][4][2], const Unit& u, int wr, int wc, int fr, int fq) const {
        const bool lat = u.pm < nlat;
        const size_t toff = (size_t)(lat ? u.pm : u.pm - nlat) * BM * D + (size_t)(wr * 64 + fr) * D + u.pn * BM + wc * 32 + 4 * fq;
        const float* base = (lat ? baseL : baseC) + toff;
        float* out = (lat ? outL : outC) + toff;
        const float* mg = (lat ? modL + (size_t)(u.pm >> 3) * NMOD : modC) + u.pn * BM + wc * 32 + 4 * fq;
#pragma unroll
        for (int bj = 0; bj < 2; ++bj)
#pragma unroll
            for (int n = 0; n < 2; ++n) { const f32x4 gv = *(const f32x4*)(mg + bj * HALF + n * 16) * scale;
#pragma unroll
                for (int ai = 0; ai < 2; ++ai)
#pragma unroll
                    for (int m = 0; m < 4; ++m) { const size_t off = (size_t)(ai * HALF + m * 16) * D + bj * HALF + n * 16;
                        const f32x4 bs = *(const f32x4*)(base + off); *(f32x4*)(out + off) = bs + gv * acc[ai][bj][m][n]; } }
    }
};
__device__ __forceinline__ float one_minus_exp(float x) {
    const float ser = -x * (1.0f + x * (0.5f + x * (0.16666667f + x * (0.041666668f + x * (0.0083333338f + x * (0.0013888889f + x * 0.0001984127f))))));
    return x > -0.3f ? ser : 1.0f - __expf(x);
}
struct EpiGate {
    static constexpr bool PERM = true;
    bf16_t* LA; bf16_t* UU;
    __device__ __forceinline__ void operator()(const f32x4 (&acc)[2][2][4][2], const Unit& u, int wr, int wc, int fr, int fq) const {
        const int blk = u.pn >> 1, dir = u.pn & 1, ch0 = blk * HALF + wc * 32 + 8 * fq, row0 = u.pm * BM + wr * 64 + fr;
#pragma unroll
        for (int ai = 0; ai < 2; ++ai)
#pragma unroll
            for (int m = 0; m < 4; ++m) { const size_t off = (size_t)dir * RG * D + (size_t)(row0 + ai * HALF + m * 16) * D + ch0;
#pragma unroll
                for (int bj = 0; bj < 2; ++bj) { const f32x4 v0 = acc[ai][bj][m][0], v1 = acc[ai][bj][m][1];
                    u32x4 w; w.x = cvt_pk_bf16(v0[0], v0[1]); w.y = cvt_pk_bf16(v0[2], v0[3]); w.z = cvt_pk_bf16(v1[0], v1[1]); w.w = cvt_pk_bf16(v1[2], v1[3]);
                    *(u32x4*)((bj ? UU : LA) + off) = w; } }
    }
};
template <bool ACCUM> struct EpiMix {
    static constexpr bool PERM = true;
    const bf16_t* PROJ; int gcol; bf16_t* MG;
    __device__ __forceinline__ void operator()(const f32x4 (&acc)[2][2][4][2], const Unit& u, int wr, int wc, int fr, int fq) const {
        const int row0 = u.pm * BM + wr * 64 + fr, col0 = u.pn * BM + wc * 32 + 8 * fq;
#pragma unroll
        for (int ai = 0; ai < 2; ++ai)
#pragma unroll
            for (int m = 0; m < 4; ++m) { const size_t row = (size_t)(row0 + ai * HALF + m * 16);
#pragma unroll
                for (int bj = 0; bj < 2; ++bj) { float gt[8], o[8]; unpack8(*(const u32x4*)(PROJ + row * PN + gcol + col0 + bj * HALF), gt);
                    bf16_t* dst = MG + row * D + col0 + bj * HALF;
                    if (ACCUM) unpack8(*(const u32x4*)dst, o); else {
#pragma unroll
                        for (int i = 0; i < 8; ++i) o[i] = 0.f; }
#pragma unroll
                    for (int n = 0; n < 2; ++n)
#pragma unroll
                        for (int j = 0; j < 4; ++j) o[4 * n + j] += sigmoidf_(gt[4 * n + j]) * acc[ai][bj][m][n][j];
                    *(u32x4*)dst = pack8(o); } }
    }
};
}

struct Args {
    const float* in[26]; float* out; unsigned char* ws; int lo, hi;
};
enum { I_X = 0, I_C, I_CTX, I_CCTX, I_WADA, I_BADA, I_NORMW, I_F1WI, I_F1WO, I_F2WI, I_F2WO, I_WIN, I_FUP, I_FB, I_GNW, I_CONVW, I_CONVB, I_WR, I_BR, I_WI, I_BI, I_LAM, I_WOG, I_WOL, I_WOO, I_FNW };

#define NTHR 512
__device__ __forceinline__ const float* inp(const LAS unsigned char* lds, int i) { const LAS unsigned* t = (const LAS unsigned*)(lds + PTAB) + 2 * i;
    const unsigned lo = __builtin_amdgcn_readfirstlane(t[0]), hi = __builtin_amdgcn_readfirstlane(t[1]); return (const float*)(((unsigned long long)hi << 32) | lo); }
#define AIN(i) inp(lds, (i))
struct Ctx { int tid, bid, G; };
#define GW() (cx.bid * 8 + (cx.tid >> 6))
#define NGW() (cx.G * 8)

__device__ __forceinline__ void transpose_item(const float* W, int ldw, int K, int k0, int n0, bf16_t* WT, int drow, LAS float* scr, int lane) {
#pragma unroll 8
    for (int i = 0; i < 32; ++i) { const int kk = 2 * i + (lane >> 5); scr[kk * 33 + (lane & 31)] = W[(size_t)(k0 + kk) * ldw + n0 + (lane & 31)]; }
    asm volatile("s_waitcnt lgkmcnt(0)" ::: "memory");
    const int c = lane & 7;
#pragma unroll
    for (int j = 0; j < 4; ++j) { const int n = (lane >> 3) + 8 * j; const LAS float* s = scr + (8 * c) * 33 + n;
        u32x4 o; o.x = cvt_pk_bf16(s[0 * 33], s[1 * 33]); o.y = cvt_pk_bf16(s[2 * 33], s[3 * 33]); o.z = cvt_pk_bf16(s[4 * 33], s[5 * 33]); o.w = cvt_pk_bf16(s[6 * 33], s[7 * 33]);
        *(u32x4*)(WT + (size_t)(drow + n) * K + k0 + 8 * c) = o; }
    asm volatile("s_waitcnt lgkmcnt(0)" ::: "memory");
}
__device__ __forceinline__ int wi_drow(int n0) { return n0 < FH ? (n0 >> 7) * 256 + (n0 & 127) : ((n0 - FH) >> 7) * 256 + 128 + ((n0 - FH) & 127); }
__device__ __forceinline__ int win_drow(int n0) { return n0 < 3072 ? n0 : (n0 == 3072 ? PFD : n0 - 32); }

__device__ __forceinline__ void phase_weights(const Ctx cx, const Args& a, LAS unsigned char* lds) {
    const int lane = cx.tid & 63, wave = cx.tid >> 6;
    LAS float* scr = (LAS float*)(lds + wave * 16384);
    unsigned char* ws = a.ws;
    constexpr int I_WI_ = (D / 64) * (2 * FH / 32), I_WO_ = (FH / 64) * (D / 32), I_IN_ = (D / 64) * (INW / 32), I_SQ_ = (D / 64) * (D / 32), I_LG_ = 32 * 8;
    constexpr int NIT = 2 * I_WI_ + 2 * I_WO_ + I_IN_ + 3 * I_SQ_ + I_LG_;
    if (PHON(19)) for (int it = GW(); it < NIT; it += NGW()) {
        int r = it;
        if (r < 2 * I_WI_) { const int w = r / I_WI_; r %= I_WI_; const int nb = 2 * FH / 32, kb = r / nb, n0 = (r % nb) * 32;
            transpose_item(AIN(w ? I_F2WI : I_F1WI), 2 * FH, D, kb * 64, n0, (bf16_t*)(ws + (w ? WS_WI2 : WS_WI1)), wi_drow(n0), scr, lane); continue; }
        r -= 2 * I_WI_;
        if (r < 2 * I_WO_) { const int w = r / I_WO_; r %= I_WO_; const int nb = D / 32, kb = r / nb, n0 = (r % nb) * 32;
            transpose_item(AIN(w ? I_F2WO : I_F1WO), D, FH, kb * 64, n0, (bf16_t*)(ws + (w ? WS_WO2 : WS_WO1)), n0, scr, lane); continue; }
        r -= 2 * I_WO_;
        if (r < I_IN_) { const int nb = INW / 32, kb = r / nb, n0 = (r % nb) * 32;
            transpose_item(AIN(I_WIN), INW, D, kb * 64, n0, (bf16_t*)(ws + WS_WIN), win_drow(n0), scr, lane); continue; }
        r -= I_IN_;
        if (r < 3 * I_SQ_) { const int w = r / I_SQ_; r %= I_SQ_; const int nb = D / 32, kb = r / nb, n0 = (r % nb) * 32;
            transpose_item(AIN(w == 0 ? I_WOG : (w == 1 ? I_WOL : I_WOO)), D, D, kb * 64, n0, (bf16_t*)(ws + (w == 0 ? WS_WOG : (w == 1 ? WS_WOL : WS_WOO))), n0, scr, lane); continue; }
        r -= 3 * I_SQ_;
        { const int mat = r >> 3, sub = r & 7, gate = mat >> 4, dir = (mat >> 3) & 1, blk = mat & 7;
          const float* src = AIN(gate ? I_WI : I_WR) + (size_t)(dir * 8 + blk) * 128 * 128;
          const int kb = sub >> 2, n0 = (sub & 3) * 32;
          transpose_item(src, 128, 128, kb * 64, n0, (bf16_t*)(ws + WS_WLG), ((blk * 2 + dir) * 2 + gate) * 128 + n0, scr, lane); }
    }
    { u32x4* z = (u32x4*)(ws + WS_WIN + (size_t)INW * D * 2); const int n16 = (PN - INW) * D * 2 / 16;
      for (int i = cx.bid * NTHR + cx.tid; i < n16; i += cx.G * NTHR) z[i] = (u32x4){0u, 0u, 0u, 0u}; }
    __syncthreads();
    LAS float* sl = (LAS float*)lds;
    float* MODP = (float*)(ws + WS_MODP);
    if (PHON(20)) for (int item = cx.bid; item < 18 * 16; item += cx.G) {
        const int cb = item % 18, ks = item / 18, col = cb * 512 + cx.tid;
        for (int idx = cx.tid; idx < 33 * 64; idx += NTHR) { const int b = idx >> 6, k = idx & 63; const float cv = b < 32 ? AIN(I_C)[b * D + ks * 64 + k] : AIN(I_CCTX)[ks * 64 + k]; sl[idx] = siluf_(cv); }
        __syncthreads();
        float acc[33];
#pragma unroll
        for (int b = 0; b < 33; ++b) acc[b] = 0.f;
        const float* wp = AIN(I_WADA) + (size_t)(ks * 64) * NMOD + col;
#pragma unroll 4
        for (int k = 0; k < 64; ++k) { const float w = wp[(size_t)k * NMOD];
#pragma unroll
            for (int b = 0; b < 33; ++b) acc[b] += sl[b * 64 + k] * w; }
#pragma unroll
        for (int b = 0; b < 33; ++b) MODP[(size_t)(ks * 33 + b) * NMOD + col] = acc[b];
        __syncthreads();
    }
}
__device__ __forceinline__ void phase_modreduce(const Ctx cx, const Args& a, LAS unsigned char* lds) {
    const float* MODP = (const float*)(a.ws + WS_MODP); float* MOD = (float*)(a.ws + WS_MOD);
    for (int idx = cx.bid * NTHR + cx.tid; idx < 33 * NMOD; idx += cx.G * NTHR) {
        float s = AIN(I_BADA)[idx % NMOD];
#pragma unroll
        for (int ks = 0; ks < 16; ++ks) s += MODP[(size_t)ks * 33 * NMOD + idx];
        MOD[idx] = s;
    }
    float* GC = (float*)(a.ws + WS_GC);
    for (int idx = cx.bid * NTHR + cx.tid; idx < 2 * D; idx += cx.G * NTHR) { GC[idx] = AIN(I_BR)[idx]; GC[2 * D + idx] = AIN(I_BI)[idx]; GC[4 * D + idx] = 8.0f * log1pf(__expf(-AIN(I_LAM)[idx])); }
}

__device__ __forceinline__ void phase_normmod(const Ctx cx, const Args& a, LAS unsigned char* lds, int g, int mode, int nrows, int sub) {
    const int lane = cx.tid & 63;
    const float* MOD = (const float*)(a.ws + WS_MOD); const float* nw = AIN(I_NORMW) + sub * D;
    const float* H1 = (const float*)(a.ws + WS_H1); bf16_t* U = (bf16_t*)(a.ws + WS_U);
    const float* xin = AIN(I_X); const float* cin = AIN(I_CTX);
    for (int r0 = 2 * GW(); r0 < nrows; r0 += 2 * NGW()) {
        f32x4 v[2][4]; float ss[2];
#pragma unroll
        for (int q = 0; q < 2; ++q) { const int r = r0 + q;
            const float* src = mode ? H1 + (size_t)r * D : (r < RL ? xin + ((size_t)g * RL + r) * D : cin + ((size_t)g * RC + (r - RL)) * D);
            ss[q] = 0.f;
#pragma unroll
            for (int j = 0; j < 4; ++j) { v[q][j] = ((const f32x4*)src)[lane + 64 * j]; } }
#pragma unroll
        for (int q = 0; q < 2; ++q)
#pragma unroll
            for (int j = 0; j < 4; ++j) ss[q] += (v[q][j].x * v[q][j].x + v[q][j].y * v[q][j].y) + (v[q][j].z * v[q][j].z + v[q][j].w * v[q][j].w);
#pragma unroll
        for (int o = 1; o < 64; o <<= 1) { ss[0] += __shfl_xor(ss[0], o); ss[1] += __shfl_xor(ss[1], o); }
#pragma unroll
        for (int q = 0; q < 2; ++q) { const int r = r0 + q; const int mrow = r < RL ? g * BG + r / T : 32;
            const float* sh = MOD + (size_t)mrow * NMOD + (3 * sub) * D; const float* sc = sh + D;
            const float rstd = 1.0f / sqrtf(ss[q] * (1.0f / D) + EPS);
#pragma unroll
            for (int j = 0; j < 4; ++j) { const int c4 = lane + 64 * j; const f32x4 w = ((const f32x4*)nw)[c4], s4 = ((const f32x4*)sh)[c4], c1 = ((const f32x4*)sc)[c4];
                const f32x4 o = v[q][j] * rstd * w * (c1 + 1.0f) + s4;
                u32x2 p; p.x = cvt_pk_bf16(o.x, o.y); p.y = cvt_pk_bf16(o.z, o.w); ((u32x2*)(U + (size_t)r * D))[c4] = p; } }
    }
}
__device__ __forceinline__ void phase_final(const Ctx cx, const Args& a, LAS unsigned char* lds, int g) {
    const int lane = cx.tid & 63; const float* fw = AIN(I_FNW);
    for (int r0 = 2 * GW(); r0 < RL; r0 += 2 * NGW()) {
        float* row = a.out + ((size_t)g * RL + r0) * D;
        f32x4 v[2][4]; float ss[2] = {0.f, 0.f};
#pragma unroll
        for (int q = 0; q < 2; ++q)
#pragma unroll
            for (int j = 0; j < 4; ++j) v[q][j] = ((const f32x4*)(row + q * D))[lane + 64 * j];
#pragma unroll
        for (int q = 0; q < 2; ++q)
#pragma unroll
            for (int j = 0; j < 4; ++j) ss[q] += (v[q][j].x * v[q][j].x + v[q][j].y * v[q][j].y) + (v[q][j].z * v[q][j].z + v[q][j].w * v[q][j].w);
#pragma unroll
        for (int o = 1; o < 64; o <<= 1) { ss[0] += __shfl_xor(ss[0], o); ss[1] += __shfl_xor(ss[1], o); }
#pragma unroll
        for (int q = 0; q < 2; ++q) { const float rstd = 1.0f / sqrtf(ss[q] * (1.0f / D) + EPS);
#pragma unroll
            for (int j = 0; j < 4; ++j) { const int c4 = lane + 64 * j; ((f32x4*)(row + q * D))[c4] = v[q][j] * rstd * ((const f32x4*)fw)[c4]; } }
    }
}

__device__ __forceinline__ float logsig_fast(float x) { return fminf(x, 0.f) - __logf(1.0f + __expf(-fabsf(x))); }
__device__ __forceinline__ void phase_prep(const Ctx cx, const Args& a, int g, LAS unsigned char* lds) {
    const bf16_t* PROJ = (const bf16_t*)(a.ws + WS_BIG);
    const int tid = cx.tid;
    {
        LAS bf16_t* qs = (LAS bf16_t*)lds; LAS bf16_t* ks = (LAS bf16_t*)(lds + 16384); LAS float* fdl = (LAS float*)(lds + 32768); LAS float* part = (LAS float*)(lds + 36864);
        LAS bf16_t* qo = (LAS bf16_t*)(lds + 40960); LAS bf16_t* ko = (LAS bf16_t*)(lds + 57344);
        const int d = tid & 127, qt = tid >> 7;
        for (int item = cx.bid; item < BG * NCH * 8; item += cx.G) {
            const int h = item & 3, dir = (item >> 2) & 1, bc = item >> 3, b = bc / NCH, c = bc % NCH;
            const int row0 = c < 4 ? RL + b * CL + c * 64 : b * T + (c - 4) * 64;
            const bool lat = c >= 4;
#pragma unroll
            for (int k = 0; k < 2; ++k) { const int p = tid + 512 * k, r = p >> 4, c8 = (p & 15) * 8;
                *(LAS u32x4*)(ks + r * 128 + c8) = *(const u32x4*)(PROJ + (size_t)(row0 + r) * PN + PK + h * 128 + c8);
                if (lat) *(LAS u32x4*)(qs + r * 128 + c8) = *(const u32x4*)(PROJ + (size_t)(row0 + r) * PN + PQ + h * 128 + c8); }
#pragma unroll
            for (int k = 0; k < 2; ++k) { const int idx = tid + 512 * k; fdl[idx] = bf2f(PROJ[(size_t)(row0 + (idx >> 4)) * PN + PFD + dir * 16 + (idx & 15)]); }
            const int col = h * 128 + d;
            float fw[16];
#pragma unroll
            for (int r = 0; r < 16; ++r) fw[r] = AIN(I_FUP)[(size_t)(dir * 16 + r) * 512 + col];
            const float fbv = AIN(I_FB)[dir * 512 + col];
            __syncthreads();
            float la[16]; float psum = 0.f;
#pragma unroll
            for (int t = 0; t < 16; ++t) { const int i = 16 * qt + t; float dot = fbv;
#pragma unroll
                for (int r = 0; r < 16; ++r) dot += fdl[i * 16 + r] * fw[r];
                la[t] = logsig_fast(dot) * (1.0f / 16.0f); psum += la[t]; }
            part[qt * 128 + d] = psum;
            __syncthreads();
            const float p0 = part[d], p1 = part[128 + d], p2 = part[256 + d], p3 = part[384 + d];
            const float tot = (p0 + p1) + (p2 + p3);
            float run = dir == 0 ? (qt > 0 ? p0 : 0.f) + (qt > 1 ? p1 : 0.f) + (qt > 2 ? p2 : 0.f)
                                 : (qt < 3 ? p3 : 0.f) + (qt < 2 ? p2 : 0.f) + (qt < 1 ? p1 : 0.f);
            float ke[16];
            if (dir == 0) {
#pragma unroll
                for (int t = 0; t < 16; ++t) { const int i = 16 * qt + t; run += la[t];
                    const float kv = bf2f(ks[i * 128 + d]); ke[t] = kv * __expf(tot - run);
                    if (lat) { qo[i * 128 + d] = f2bf(bf2f(qs[i * 128 + d]) * 0.08838834764831845f * __expf(run)); ko[i * 128 + d] = f2bf(kv * __expf(-run)); } }
            } else {
#pragma unroll
                for (int t = 15; t >= 0; --t) { const int i = 16 * qt + t; run += la[t];
                    const float kv = bf2f(ks[i * 128 + d]); ke[t] = kv * __expf(tot - run);
                    if (lat) { qo[i * 128 + d] = f2bf(bf2f(qs[i * 128 + d]) * 0.08838834764831845f * __expf(run)); ko[i * 128 + d] = f2bf(kv * __expf(-run)); } }
            }
            const size_t tb = (((size_t)dir * BG + b) * NCH + c) * 4 + h;
            bf16_t* KET = (bf16_t*)(a.ws + WS_KET) + tb * 8192 + d * 64 + 16 * qt;
            { float k0[8], k1[8];
#pragma unroll
              for (int t = 0; t < 8; ++t) { k0[t] = ke[t]; k1[t] = ke[8 + t]; }
              *(u32x4*)KET = pack8(k0); *(u32x4*)(KET + 8) = pack8(k1); }
            if (qt == 0) ((float*)(a.ws + WS_BL))[tb * 128 + d] = tot;
            __syncthreads();
            if (lat) { bf16_t* QD = (bf16_t*)(a.ws + WS_QD) + tb * 8192; bf16_t* KI = (bf16_t*)(a.ws + WS_KI) + tb * 8192;
#pragma unroll
                for (int k = 0; k < 2; ++k) { const int p = tid + 512 * k; *(u32x4*)(QD + p * 8) = *(const LAS u32x4*)(qo + p * 8); *(u32x4*)(KI + p * 8) = *(const LAS u32x4*)(ko + p * 8); } }
            __syncthreads();
        }
    }
    {
        LAS bf16_t* vs = (LAS bf16_t*)lds;
        const int e = tid & 255, jh = tid >> 8;
        for (int item = cx.bid; item < BG * NCH * 4; item += cx.G) {
            const int h = item & 3, bc = item >> 2, b = bc / NCH, c = bc % NCH;
            const int row0 = c < 4 ? RL + b * CL + c * 64 : b * T + (c - 4) * 64;
#pragma unroll
            for (int k = 0; k < 4; ++k) { const int p = tid + 512 * k, r = p >> 5, c8 = (p & 31) * 8;
                *(LAS u32x4*)(vs + r * 256 + c8) = *(const u32x4*)(PROJ + (size_t)(row0 + r) * PN + PV + h * 256 + c8); }
            __syncthreads();
            bf16_t* VT = (bf16_t*)(a.ws + WS_VT) + ((((size_t)b * NCH + c) * 4 + h) * 256 + e) * 64 + 32 * jh;
#pragma unroll
            for (int jg = 0; jg < 4; ++jg) { float v[8];
#pragma unroll
                for (int jj = 0; jj < 8; ++jj) v[jj] = bf2f(vs[(32 * jh + 8 * jg + jj) * 256 + e]);
                *(u32x4*)(VT + 8 * jg) = pack8(v); }
            __syncthreads();
        }
    }
    bf16_t* XC = (bf16_t*)(a.ws + WS_XC);
    for (int idx = cx.bid * NTHR + cx.tid; idx < RG * 128; idx += cx.G * NTHR) {
        const int row = idx >> 7, c8 = (idx & 127) * 8;
        const int pos = row < RL ? (row & 63) : ((row - RL) & 255), len = row < RL ? 64 : 256;
        float acc[8];
#pragma unroll
        for (int i = 0; i < 8; ++i) acc[i] = AIN(I_CONVB)[c8 + i];
#pragma unroll
        for (int j = 0; j < 4; ++j) { const int p = pos + j - 2;
            if (p >= 0 && p < len) { float xv[8]; unpack8(*(const u32x4*)(PROJ + (size_t)(row + j - 2) * PN + PXL + c8), xv);
#pragma unroll
                for (int i = 0; i < 8; ++i) acc[i] += AIN(I_CONVW)[j * D + c8 + i] * xv[i]; } }
        *(u32x4*)(XC + (size_t)row * D + c8) = pack8(acc);
    }
}

__device__ __forceinline__ void phase_gatefix(const Ctx cx, const Args& a, LAS unsigned char* lds) {
    bf16_t* LA = (bf16_t*)(a.ws + WS_LA); bf16_t* UU = (bf16_t*)(a.ws + WS_UU); const bf16_t* XC = (const bf16_t*)(a.ws + WS_XC); const float* GC = (const float*)(a.ws + WS_GC);
    for (int idx = cx.bid * NTHR + cx.tid; idx < 2 * RG * 128; idx += cx.G * NTHR) {
        const int dir = idx >= RG * 128, rem = idx - dir * RG * 128, row = rem >> 7, c8 = (rem & 127) * 8;
        const size_t off = (size_t)dir * RG * D + (size_t)row * D + c8;
        float r[8], ig[8], xc[8]; unpack8(*(const u32x4*)(LA + off), r); unpack8(*(const u32x4*)(UU + off), ig); unpack8(*(const u32x4*)(XC + (size_t)row * D + c8), xc);
#pragma unroll
        for (int i = 0; i < 8; ++i) { const float l = -GC[(4 + dir) * D + c8 + i] * sigmoidf_(r[i] + GC[dir * D + c8 + i]);
            const float gi = sigmoidf_(ig[i] + GC[(2 + dir) * D + c8 + i]);
            r[i] = l; ig[i] = __builtin_amdgcn_sqrtf(fmaxf(one_minus_exp(2.0f * l), 0.f)) * gi * xc[i]; }
        *(u32x4*)(LA + off) = pack8(r); *(u32x4*)(UU + off) = pack8(ig);
    }
}

__device__ __forceinline__ int img_off(int nkg, int row, int kcol) { const int ob = (row & 15) * 64 + (kcol & 31) * 2; return ((row >> 4) * nkg + (kcol >> 5)) * 1024 + (ob ^ (((ob >> 9) & 1) << 5)); }
__device__ __forceinline__ bf16x8 ldfrag(const LAS unsigned char* img, int nkg, int row, int kcol) { return *(const LAS bf16x8*)(img + img_off(nkg, row, kcol)); }
#define MFMA16(a, b, c) __builtin_amdgcn_mfma_f32_16x16x32_bf16((a), (b), (c), 0, 0, 0)

__device__ __forceinline__ void phase_gla_scan(const Ctx cx, const Args& a, int g, LAS unsigned char* lds) {
    constexpr int XB = 57344, OFF_KI = 16384, OFF_KET = 32768, OFF_VT = 49152, OFF_P = 2 * XB, OFF_ST = OFF_P + 8192, OFF_BL = OFF_ST + 2 * 16384;
    static_assert(OFF_BL + 1024 <= LDS_BYTES, "gla scan LDS");
    const int tid = cx.tid, lane = tid & 63, w = tid >> 6, fr = lane & 15, fq = lane >> 4;
    const bf16_t* QDg = (const bf16_t*)(a.ws + WS_QD); const bf16_t* KIg = (const bf16_t*)(a.ws + WS_KI); const bf16_t* KETg = (const bf16_t*)(a.ws + WS_KET);
    const bf16_t* VTg = (const bf16_t*)(a.ws + WS_VT); const float* BLg = (const float*)(a.ws + WS_BL);
    bf16_t* Og = (bf16_t*)(a.ws + WS_OFB);
    for (int item = cx.bid; item < BG * 32; item += cx.G) {
        const int dvq = item & 3, dir = (item >> 2) & 1, h = (item >> 3) & 3, b = item >> 5;
        { u32x4 z = {0u, 0u, 0u, 0u}; *(LAS u32x4*)(lds + OFF_ST + tid * 32) = z; *(LAS u32x4*)(lds + OFF_ST + tid * 32 + 16) = z; }
        f32x4 accS[4];
#pragma unroll
        for (int t = 0; t < 4; ++t) accS[t] = (f32x4){0.f, 0.f, 0.f, 0.f};
        u32x4 pq[2], pk[2], pe[2], pv; float pbl = 0.f;
#define GLA_LOAD(s_) do { const int c_ = dir == 0 ? (s_) : ((s_) < 4 ? 3 - (s_) : 39 - (s_)); \
            const size_t tb_ = (((size_t)dir * BG + b) * NCH + c_) * 4 + h; \
            if (c_ >= 4) { pq[0] = ((const u32x4*)(QDg + tb_ * 8192))[tid]; pq[1] = ((const u32x4*)(QDg + tb_ * 8192))[tid + 512]; \
                           pk[0] = ((const u32x4*)(KIg + tb_ * 8192))[tid]; pk[1] = ((const u32x4*)(KIg + tb_ * 8192))[tid + 512]; } \
            pe[0] = ((const u32x4*)(KETg + tb_ * 8192))[tid]; pe[1] = ((const u32x4*)(KETg + tb_ * 8192))[tid + 512]; \
            pv = ((const u32x4*)(VTg + ((((size_t)b * NCH + c_) * 4 + h) * 256 + dvq * 64) * 64))[tid]; \
            if (tid < 128) pbl = BLg[tb_ * 128 + tid]; } while (0)
#define GLA_STORE(buf_) do { LAS unsigned char* X_ = lds + (buf_) * XB; \
            _Pragma("unroll") for (int i_ = 0; i_ < 2; ++i_) { const int p_ = tid + 512 * i_; \
                *(LAS u32x4*)(X_ + img_off(4, p_ >> 4, (p_ & 15) * 8)) = pq[i_]; *(LAS u32x4*)(X_ + OFF_KI + img_off(4, p_ >> 4, (p_ & 15) * 8)) = pk[i_]; \
                *(LAS u32x4*)(X_ + OFF_KET + img_off(2, p_ >> 3, (p_ & 7) * 8)) = pe[i_]; } \
            *(LAS u32x4*)(X_ + OFF_VT + img_off(2, tid >> 3, (tid & 7) * 8)) = pv; \
            if (tid < 128) ((LAS float*)(lds + OFF_BL + (buf_) * 512))[tid] = pbl; } while (0)
        pq[0] = pq[1] = pk[0] = pk[1] = (u32x4){0u, 0u, 0u, 0u};
        GLA_LOAD(0); GLA_STORE(0);
        __syncthreads();
        for (int s = 0; s < NCH; ++s) {
            const int cur = s & 1; const bool lat = s >= 4;
            const LAS unsigned char* X = lds + cur * XB;
#ifndef GLA_SAFE
            if (s + 1 < NCH) GLA_LOAD(s + 1);
#endif
            if (lat) {
                const int ti = w >> 1, tj0 = (w & 1) * 2;
                f32x4 sc[2] = {(f32x4){0.f, 0.f, 0.f, 0.f}, (f32x4){0.f, 0.f, 0.f, 0.f}};
#pragma unroll
                for (int kk = 0; kk < 4; ++kk) { const bf16x8 qa = ldfrag(X, 4, 16 * ti + fr, kk * 32 + fq * 8);
#pragma unroll
                    for (int t = 0; t < 2; ++t) { const bf16x8 kb = ldfrag(X + OFF_KI, 4, 16 * (tj0 + t) + fr, kk * 32 + fq * 8); sc[t] = MFMA16(qa, kb, sc[t]); } }
#pragma unroll
                for (int t = 0; t < 2; ++t)
#pragma unroll
                    for (int jj = 0; jj < 4; ++jj) { const int i = 16 * ti + 4 * fq + jj, j = 16 * (tj0 + t) + fr;
                        const bool keep = dir == 0 ? (j <= i) : (j > i);
                        *(LAS bf16_t*)(lds + OFF_P + img_off(2, i, j)) = f2bf(keep ? sc[t][jj] : 0.f); }
            }
            __syncthreads();
            const int te = w >> 1;
            if (lat) {
                const int c = dir == 0 ? s : 39 - s;
                const LAS unsigned char* STc = lds + OFF_ST + cur * 16384;
                f32x4 oc[2] = {(f32x4){0.f, 0.f, 0.f, 0.f}, (f32x4){0.f, 0.f, 0.f, 0.f}};
#pragma unroll
                for (int kk = 0; kk < 2; ++kk) { const bf16x8 va = ldfrag(X + OFF_VT, 2, 16 * te + fr, kk * 32 + fq * 8);
#pragma unroll
                    for (int t = 0; t < 2; ++t) { const bf16x8 pb = ldfrag(lds + OFF_P, 2, 16 * ((w & 1) * 2 + t) + fr, kk * 32 + fq * 8); oc[t] = MFMA16(va, pb, oc[t]); } }
#pragma unroll
                for (int kk = 0; kk < 4; ++kk) { const bf16x8 sa = ldfrag(STc, 4, 16 * te + fr, kk * 32 + fq * 8);
#pragma unroll
                    for (int t = 0; t < 2; ++t) { const bf16x8 qb = ldfrag(X, 4, 16 * ((w & 1) * 2 + t) + fr, kk * 32 + fq * 8); oc[t] = MFMA16(sa, qb, oc[t]); } }
#pragma unroll
                for (int t = 0; t < 2; ++t) { const int i = 16 * ((w & 1) * 2 + t) + fr; const size_t row = (size_t)b * T + (size_t)(c - 4) * 64 + i;
                    u32x2 o2; o2.x = cvt_pk_bf16(oc[t][0], oc[t][1]); o2.y = cvt_pk_bf16(oc[t][2], oc[t][3]);
                    *(u32x2*)(Og + ((size_t)dir * RL + row) * D + h * 256 + dvq * 64 + 16 * te + 4 * fq) = o2; }
            }
#ifdef GLA_SAFE
            __syncthreads();
#endif
            {
                const LAS float* blp = (const LAS float*)(lds + OFF_BL + cur * 512);
                LAS unsigned char* STn = lds + OFF_ST + (cur ^ 1) * 16384;
                bf16x8 vb[2];
#pragma unroll
                for (int kk = 0; kk < 2; ++kk) vb[kk] = ldfrag(X + OFF_VT, 2, 16 * te + fr, kk * 32 + fq * 8);
#pragma unroll
                for (int t = 0; t < 4; ++t) { const int td = (w & 1) * 4 + t;
#pragma unroll
                    for (int jj = 0; jj < 4; ++jj) accS[t][jj] *= __expf(blp[16 * td + 4 * fq + jj]);
#pragma unroll
                    for (int kk = 0; kk < 2; ++kk) { const bf16x8 ka = ldfrag(X + OFF_KET, 2, 16 * td + fr, kk * 32 + fq * 8); accS[t] = MFMA16(ka, vb[kk], accS[t]); }
                    u32x2 s2; s2.x = cvt_pk_bf16(accS[t][0], accS[t][1]); s2.y = cvt_pk_bf16(accS[t][2], accS[t][3]);
                    *(LAS u32x2*)(STn + img_off(4, 16 * te + fr, 16 * td + 4 * fq)) = s2; }
            }
#ifdef GLA_SAFE
            __syncthreads();
            if (s + 1 < NCH) { GLA_LOAD(s + 1); GLA_STORE(cur ^ 1); }
#else
            if (s + 1 < NCH) GLA_STORE(cur ^ 1);
#endif
            __syncthreads();
        }
#undef GLA_LOAD
#undef GLA_STORE
    }
}

__device__ __forceinline__ void phase_lru_scan(const Ctx cx, const Args& a, int g, LAS unsigned char* lds) {
    const int lane = cx.tid & 63, w = cx.tid >> 6;
    LAS f32x2* agg = (LAS f32x2*)lds;
    const float* GC = (const float*)(a.ws + WS_GC);
    for (int item = cx.bid; item < BG * 32; item += cx.G) {
        const int cgp = item & 15, dir = (item >> 4) & 1, b = item >> 5, ch = cgp * 64 + lane;
        const bf16_t* RR = (const bf16_t*)(a.ws + WS_LA) + (size_t)dir * RG * D + ch; const bf16_t* II = (const bf16_t*)(a.ws + WS_UU) + (size_t)dir * RG * D + ch;
        const bf16_t* XCp = (const bf16_t*)(a.ws + WS_XC) + ch;
        bf16_t* Hd = (bf16_t*)(a.ws + WS_HFB) + (size_t)dir * RL * D + ch;
        const float cbr = GC[dir * D + ch], cbi = GC[(2 + dir) * D + ch], csp = GC[(4 + dir) * D + ch];
#define LRU_ROW(s_) ((s_) < CL ? RL + b * CL + (dir ? CL - 1 - (s_) : (s_)) : b * T + (dir ? T - 1 - ((s_) - CL) : (s_) - CL))
#define LRU_GATES(k_) const float l_ = -csp * sigmoidf_(bf2f(rr[k_]) + cbr); const float av = __expf(l_); \
            const float uv = __builtin_amdgcn_sqrtf(fmaxf(one_minus_exp(2.0f * l_), 0.f)) * sigmoidf_(bf2f(ii[k_]) + cbi) * bf2f(xx[k_]);
        float A = 1.f, Z = 0.f;
        for (int blk = 0; blk < 18; ++blk) { const int s0 = 288 * w + 16 * blk; bf16_t rr[16], ii[16], xx[16];
#pragma unroll
            for (int k = 0; k < 16; ++k) { const size_t r = (size_t)LRU_ROW(s0 + k); rr[k] = RR[r * D]; ii[k] = II[r * D]; xx[k] = XCp[r * D]; }
#pragma unroll
            for (int k = 0; k < 16; ++k) { LRU_GATES(k) Z = av * Z + uv; A *= av; } }
        agg[w * 64 + lane] = (f32x2){A, Z};
        __syncthreads();
        float hst = 0.f;
#pragma unroll
        for (int w2 = 0; w2 < 7; ++w2) { const f32x2 p = agg[w2 * 64 + lane]; if (w2 < w) hst = p.x * hst + p.y; }
        for (int blk = 0; blk < 18; ++blk) { const int s0 = 288 * w + 16 * blk; bf16_t rr[16], ii[16], xx[16];
#pragma unroll
            for (int k = 0; k < 16; ++k) { const size_t r = (size_t)LRU_ROW(s0 + k); rr[k] = RR[r * D]; ii[k] = II[r * D]; xx[k] = XCp[r * D]; }
#pragma unroll
            for (int k = 0; k < 16; ++k) { LRU_GATES(k) hst = av * hst + uv;
                if (s0 + k >= CL) Hd[(size_t)LRU_ROW(s0 + k) * D] = f2bf(hst); } }
        __syncthreads();
#undef LRU_ROW
#undef LRU_GATES
    }
}

__device__ __forceinline__ void phase_post(const Ctx cx, const Args& a, LAS unsigned char* lds, int g) {
    const int lane = cx.tid & 63;
    const bf16_t* PROJ = (const bf16_t*)(a.ws + WS_BIG);
    bf16_t* O0 = (bf16_t*)(a.ws + WS_OFB); const bf16_t* O1 = O0 + (size_t)RL * D;
    bf16_t* H0 = (bf16_t*)(a.ws + WS_HFB); const bf16_t* H1b = H0 + (size_t)RL * D;
    const float* gnw = AIN(I_GNW);
    for (int r = GW(); r < RL; r += NGW()) {
        const size_t off = (size_t)r * D + lane * 16;
        float o[16], t[8]; float ss = 0.f;
#pragma unroll
        for (int hf = 0; hf < 2; ++hf) { float x0[8], x1[8]; unpack8(*(const u32x4*)(O0 + off + 8 * hf), x0); unpack8(*(const u32x4*)(O1 + off + 8 * hf), x1);
#pragma unroll
            for (int i = 0; i < 8; ++i) { o[8 * hf + i] = x0[i] + x1[i]; ss += o[8 * hf + i] * o[8 * hf + i]; } }
        ss += __shfl_xor(ss, 1); ss += __shfl_xor(ss, 2); ss += __shfl_xor(ss, 4); ss += __shfl_xor(ss, 8);
        const float rstd = 1.0f / sqrtf(ss * (1.0f / 256.0f) + EPS);
#pragma unroll
        for (int hf = 0; hf < 2; ++hf) { float gg[8]; unpack8(*(const u32x4*)(PROJ + (size_t)r * PN + PGG + lane * 16 + 8 * hf), gg);
#pragma unroll
            for (int i = 0; i < 8; ++i) t[i] = o[8 * hf + i] * rstd * gnw[(lane & 15) * 16 + 8 * hf + i] * siluf_(gg[i]);
            *(u32x4*)(O0 + off + 8 * hf) = pack8(t); }
#pragma unroll
        for (int hf = 0; hf < 2; ++hf) { float x0[8], x1[8], yl[8]; unpack8(*(const u32x4*)(H0 + off + 8 * hf), x0); unpack8(*(const u32x4*)(H1b + off + 8 * hf), x1);
            unpack8(*(const u32x4*)(PROJ + (size_t)r * PN + PYL + lane * 16 + 8 * hf), yl);
#pragma unroll
            for (int i = 0; i < 8; ++i) t[i] = (x0[i] + x1[i]) * geluf_(yl[i]);
            *(u32x4*)(H0 + off + 8 * hf) = pack8(t); }
    }
}


#define XB_TMO      128
#define XB_XCNT(j)  (256  + 64 * (j))
#define XB_XSUB(j)  (1280 + 64 * (j))
#define XB_XGEN(j)  (2304 + 64 * (j))
#define XB_TOP      3328
#define XB_TOPGEN   3392
#define XCD_BAR_WORDS 3456
#define XB_SPIN_CAP (1u << 22)
__device__ __forceinline__ unsigned xb_ld(unsigned* p)              { return __hip_atomic_load(p, __ATOMIC_RELAXED, __HIP_MEMORY_SCOPE_AGENT); }
__device__ __forceinline__ unsigned xb_add(unsigned* p, unsigned v) { return __hip_atomic_fetch_add(p, v, __ATOMIC_RELAXED, __HIP_MEMORY_SCOPE_AGENT); }
__device__ __forceinline__ unsigned xb_xcc_id() { return (unsigned)__builtin_amdgcn_s_getreg((3 << 11) | 20) & 0xFu; }
#define XB_SPIN(cond, bar) do { unsigned _sp = 0; while (cond) { __builtin_amdgcn_s_sleep(1); \
    if ((++_sp & 255u) == 0u) { if (xb_ld(&(bar)[XB_TMO])) break; if (_sp > XB_SPIN_CAP) { atomicAdd(&(bar)[XB_TMO], 1u); break; } } } } while (0)
__device__ __forceinline__ void xcd_barrier_complete(unsigned* bar, unsigned x, unsigned G, unsigned& nloc, unsigned& nx) {
    unsigned sum, cnt, mine, sp = 0u;
    for (;;) {
        sum = 0u; cnt = 0u; mine = 0u;
#pragma unroll
        for (unsigned j = 0; j < 16; ++j) { const unsigned c = xb_ld(&bar[XB_XCNT(j)]); sum += c; cnt += (c > 0u) ? 1u : 0u; mine = (j == x) ? c : mine; }
        if (sum == G) break;
        __builtin_amdgcn_s_sleep(1);
        if ((++sp & 255u) == 0u) { if (xb_ld(&bar[XB_TMO])) break; if (sp > XB_SPIN_CAP) { atomicAdd(&bar[XB_TMO], 1u); break; } }
    }
    nloc = mine > 0u ? mine : 1u; nx = cnt > 0u ? cnt : 1u;
}
__device__ __forceinline__ void xcd_barrier(unsigned* bar, volatile LAS unsigned* st, int tid, unsigned G) {
    asm volatile("s_waitcnt vmcnt(0)" ::: "memory");
    __syncthreads();
    if (tid == 0) {
        __builtin_amdgcn_s_waitcnt(0);
        const unsigned x = xb_xcc_id();
        unsigned nloc = st[0], nx = st[1];
        if (nloc == 0u) { xcd_barrier_complete(bar, x, G, nloc, nx); st[0] = nloc; st[1] = nx; }
        const unsigned old = xb_add(&bar[XB_XSUB(x)], 1u);
        const unsigned gen = old / nloc;
        if (old + 1u == (gen + 1u) * nloc) {
            __builtin_amdgcn_fence(__ATOMIC_RELEASE, "agent");
            asm volatile("s_waitcnt vmcnt(0)" ::: "memory");
            const unsigned og = xb_add(&bar[XB_TOP], 1u);
            const unsigned tg = og / nx;
            if (og + 1u == (tg + 1u) * nx) xb_add(&bar[XB_TOPGEN], 1u);
            else XB_SPIN(xb_ld(&bar[XB_TOPGEN]) == tg, bar);
            __builtin_amdgcn_fence(__ATOMIC_ACQUIRE, "agent");
            xb_add(&bar[XB_XGEN(x)], 1u);
            asm volatile("s_waitcnt vmcnt(0)" ::: "memory");
        } else {
            XB_SPIN(xb_ld(&bar[XB_XGEN(x)]) == gen, bar);
            __builtin_amdgcn_fence(__ATOMIC_ACQUIRE, "agent");
            asm volatile("s_waitcnt vmcnt(0)" ::: "memory");
        }
    }
    __syncthreads();
}

constexpr int NPH = 17;
#ifndef USE_CG_ALL
#define USE_CG_ALL 0
#endif
#if ONE_LAUNCH
#define GRID_SYNC(k) do { if ((k) == 1 || USE_CG_ALL) cg::this_grid().sync(); else xcd_barrier((unsigned*)ws + 4096, (volatile LAS unsigned*)(lds + PTAB + 256), cx.tid, (unsigned)cx.G); } while (0)
#else
#define GRID_SYNC(k) do {} while (0)
#endif
#define STEP_BEGIN(k) if (a.lo <= (k) && (k) < a.hi) { \
        Ctx cx; { int t_ = wave_s * 64 + (int)__builtin_amdgcn_mbcnt_hi(~0u, __builtin_amdgcn_mbcnt_lo(~0u, 0u)), b_ = blockIdx.x, g_ = gridDim.x; asm volatile("" : "+v"(t_)); asm volatile("" : "+s"(b_), "+s"(g_)); cx.tid = t_; cx.bid = b_; cx.G = g_; } \
        const int G = cx.G, cidx = cx.bid; (void)G; (void)cidx; \
        unsigned char* ws = a.ws; asm volatile("" : "+s"(ws)); \
        if ((k) > a.lo) GRID_SYNC(k); \
        const float* MOD = (const float*)(ws + WS_MOD); float* H1 = (float*)(ws + WS_H1); bf16_t* U = (bf16_t*)(ws + WS_U); bf16_t* BIG = (bf16_t*)(ws + WS_BIG); bf16_t* XC = (bf16_t*)(ws + WS_XC); \
        (void)MOD; (void)H1; (void)U; (void)BIG; (void)XC; pg8::StaticOrder S; (void)S;
#define STEP_END }

template <int g>
__device__ __forceinline__ void run_group(const Args& a, LAS unsigned char* lds, const int wave_s) {
    constexpr int s0 = 2 + g * NPH;
    if (g == 0) { STEP_BEGIN(s0 + 0) if (PHON(0)) phase_normmod(cx, a, lds, g, 0, RG, 0); STEP_END }
    STEP_BEGIN(s0 + 1) if (PHON(1)) { pg8::Gemm gm{U, (const bf16_t*)(ws + WS_WI1), RG, 2 * FH, D, D, D, 0, 0}; S.init(RG, 2 * FH, G, cidx);
                  pg8::EpiSwiglu E{BIG, FH}; pg8::gemm_phase<pg8::EpiSwiglu, true>(cx.tid, lds, gm, S, E); } STEP_END
    STEP_BEGIN(s0 + 2) if (PHON(2)) { pg8::Gemm gm{BIG, (const bf16_t*)(ws + WS_WO1), RG, D, FH, FH, FH, 0, 0}; S.init(RG, D, G, cidx);
                  pg8::EpiResid E{AIN(I_X) + (size_t)g * RL * D, AIN(I_CTX) + (size_t)g * RC * D, H1, H1 + (size_t)RL * D,
                                  MOD + (size_t)(g * BG) * NMOD + 2 * D, MOD + (size_t)32 * NMOD + 2 * D, 0.5f, RL / 256};
                  pg8::gemm_phase<pg8::EpiResid, true>(cx.tid, lds, gm, S, E); } STEP_END
    STEP_BEGIN(s0 + 3) if (PHON(3)) phase_normmod(cx, a, lds, g, 1, RG, 1); STEP_END
    STEP_BEGIN(s0 + 4) if (PHON(4)) { pg8::Gemm gm{U, (const bf16_t*)(ws + WS_WIN), RG, PN, D, D, D, 0, 0}; S.init(RL, PN, G, cidx); S.ext = (RC / 256) * 11; S.ext_pm0 = RL / 256;
                  pg8::EpiBf16 E{BIG, PN}; pg8::gemm_phase<pg8::EpiBf16, true>(cx.tid, lds, gm, S, E); } STEP_END
    STEP_BEGIN(s0 + 5) if (PHON(5)) phase_prep(cx, a, g, lds); STEP_END
    STEP_BEGIN(s0 + 6) if (PHON(6)) { pg8::Gemm gm{XC, (const bf16_t*)(ws + WS_WLG), RG, 4096, 128, D, 128, 1, 256}; S.init(RG, 4096, G, cidx);
                  pg8::EpiGate E{(bf16_t*)(ws + WS_LA), (bf16_t*)(ws + WS_UU)};
                  pg8::gemm_phase<pg8::EpiGate, true>(cx.tid, lds, gm, S, E); } STEP_END
    STEP_BEGIN(s0 + 7) if (PHON(7)) { phase_gla_scan(cx, a, g, lds); } STEP_END
    STEP_BEGIN(s0 + 8) if (PHON(8)) phase_lru_scan(cx, a, g, lds); STEP_END
    STEP_BEGIN(s0 + 9) if (PHON(9)) phase_post(cx, a, lds, g); STEP_END
    STEP_BEGIN(s0 + 10) if (PHON(10)) { pg8::Gemm gm{(const bf16_t*)(ws + WS_OFB), (const bf16_t*)(ws + WS_WOG), RL, D, D, D, D, 0, 0}; S.init(RL, D, G, cidx);
                   pg8::EpiMix<false> E{BIG, PGA, XC}; pg8::gemm_phase<pg8::EpiMix<false>, true>(cx.tid, lds, gm, S, E); } STEP_END
    STEP_BEGIN(s0 + 11) if (PHON(11)) { pg8::Gemm gm{(const bf16_t*)(ws + WS_HFB), (const bf16_t*)(ws + WS_WOL), RL, D, D, D, D, 0, 0}; S.init(RL, D, G, cidx);
                   pg8::EpiMix<true> E{BIG, PGB, XC}; pg8::gemm_phase<pg8::EpiMix<true>, true>(cx.tid, lds, gm, S, E); } STEP_END
    STEP_BEGIN(s0 + 12) if (PHON(12)) { pg8::Gemm gm{XC, (const bf16_t*)(ws + WS_WOO), RL, D, D, D, D, 0, 0}; S.init(RL, D, G, cidx);
                   pg8::EpiResid E{H1, H1, H1, H1, MOD + (size_t)(g * BG) * NMOD + 5 * D, MOD, 1.0f, RL / 256};
                   pg8::gemm_phase<pg8::EpiResid, true>(cx.tid, lds, gm, S, E); } STEP_END
    STEP_BEGIN(s0 + 13) if (PHON(13)) phase_normmod(cx, a, lds, g, 1, RL, 2); STEP_END
    STEP_BEGIN(s0 + 14) if (PHON(14)) { pg8::Gemm gm{U, (const bf16_t*)(ws + WS_WI2), RL, 2 * FH, D, D, D, 0, 0}; S.init(RL, 2 * FH, G, cidx);
                   pg8::EpiSwiglu E{BIG, FH}; pg8::gemm_phase<pg8::EpiSwiglu, true>(cx.tid, lds, gm, S, E); } STEP_END
    STEP_BEGIN(s0 + 15) if (PHON(15)) { pg8::Gemm gm{BIG, (const bf16_t*)(ws + WS_WO2), RL, D, FH, FH, FH, 0, 0}; S.init(RL, D, G, cidx);
                   float* og = a.out + (size_t)g * RL * D;
                   pg8::EpiResid E{H1, H1, og, og, MOD + (size_t)(g * BG) * NMOD + 8 * D, MOD, 0.5f, RL / 256};
                   pg8::gemm_phase<pg8::EpiResid, true>(cx.tid, lds, gm, S, E); } STEP_END
    STEP_BEGIN(s0 + 16) if (PHON(16)) { phase_final(cx, a, lds, g); if (g + 1 < NG) phase_normmod(cx, a, lds, g + 1, 0, RG, 0); } STEP_END
}

__global__ void __launch_bounds__(NTHR, 2) fwd_kernel(Args a) {
    extern __shared__ __attribute__((aligned(16))) unsigned char lds_raw[];
    LAS unsigned char* lds = (LAS unsigned char*)lds_raw;
    if (threadIdx.x < 26) ((LAS unsigned long long*)(lds + PTAB))[threadIdx.x] = (unsigned long long)a.in[threadIdx.x];
    if (threadIdx.x == 32) { ((LAS unsigned*)(lds + PTAB + 256))[0] = 0u; ((LAS unsigned*)(lds + PTAB + 256))[1] = 0u; }
#if ONE_LAUNCH
    if (threadIdx.x == 0) (void)xb_add((unsigned*)a.ws + 4096 + XB_XCNT(xb_xcc_id()), 1u);
#endif
    const int wave_s = __builtin_amdgcn_readfirstlane(threadIdx.x >> 6);
    __syncthreads();
    STEP_BEGIN(0) if (PHON(17)) phase_weights(cx, a, lds); STEP_END
    STEP_BEGIN(1) if (PHON(18)) phase_modreduce(cx, a, lds); STEP_END
    run_group<0>(a, lds, wave_s);
    run_group<1>(a, lds, wave_s);
    run_group<2>(a, lds, wave_s);
    run_group<3>(a, lds, wave_s);
}


#ifdef PROBE_STEP
__global__ void probe_kernel(const unsigned char* ws, float* out) {
    const size_t n = (size_t)65536 * 1024, q = n / 4;
    const bf16_t* r0 = (const bf16_t*)(ws + PROBE_R0); const bf16_t* r1 = (const bf16_t*)(ws + PROBE_R1); const bf16_t* r2 = (const bf16_t*)(ws + PROBE_R2); const bf16_t* r3 = (const bf16_t*)(ws + PROBE_R3);
    for (size_t i = (size_t)blockIdx.x * blockDim.x + threadIdx.x; i < q; i += (size_t)gridDim.x * blockDim.x) {
        out[i] = bf2f(r0[i]); out[q + i] = bf2f(r1[i]); out[2 * q + i] = bf2f(r2[i]); out[3 * q + i] = bf2f(r3[i]); }
}
#endif
extern "C" void kernel_launch(void* const* d_in, const int* in_sizes, int n_in, void* d_out, int out_size, void* d_ws, size_t ws_size, hipStream_t stream) {
    static int grid = 0;
    if (grid == 0) {
        if (n_in != 26 || ws_size < WS_END) { fprintf(stderr, "kernel_launch: unexpected inputs (n_in %d, ws %zu, need %zu)\n", n_in, ws_size, (size_t)WS_END); grid = -1; return; }
        int dev = 0, cus = 0, per_cu = 0;
        hipGetDevice(&dev); hipDeviceGetAttribute(&cus, hipDeviceAttributeMultiprocessorCount, dev);
        if (hipFuncSetAttribute((const void*)fwd_kernel, hipFuncAttributeMaxDynamicSharedMemorySize, LDS_BYTES) != hipSuccess) { fprintf(stderr, "kernel_launch: hipFuncSetAttribute failed\n"); grid = -1; return; }
        hipOccupancyMaxActiveBlocksPerMultiprocessor(&per_cu, (const void*)fwd_kernel, NTHR, LDS_BYTES);
        (void)hipGetLastError();
        if (per_cu < 1) per_cu = 1;
        grid = cus * 1;
    }
    if (grid < 0) return;
    Args a{};
    for (int i = 0; i < 26; ++i) a.in[i] = (const float*)d_in[i];
    a.out = (float*)d_out; a.ws = (unsigned char*)d_ws;
    const int nsteps = 2 + NG * NPH;
#if ONE_LAUNCH
    (void)hipMemsetAsync(d_ws, 0, 65536, stream);
    a.lo = 0; a.hi = nsteps;
    void* args[] = {&a};
    hipError_t e = hipLaunchCooperativeKernel((const void*)fwd_kernel, dim3(grid), dim3(NTHR), args, LDS_BYTES, stream);
    if (e != hipSuccess) fprintf(stderr, "cooperative launch failed: %s (grid %d)\n", hipGetErrorString(e), grid);
#else
#ifdef PROBE_STEP
    for (int s = 0; s <= PROBE_STEP; ++s) { a.lo = s; a.hi = s + 1; hipLaunchKernelGGL(fwd_kernel, dim3(grid), dim3(NTHR), LDS_BYTES, stream, a); }
    hipLaunchKernelGGL(probe_kernel, dim3(2048), dim3(256), 0, stream, (const unsigned char*)d_ws, (float*)d_out);
#else
    for (int s = 0; s < nsteps; ++s) { a.lo = s; a.hi = s + 1; hipLaunchKernelGGL(fwd_kernel, dim3(grid), dim3(NTHR), LDS_BYTES, stream, a); }
#endif
#endif
}
```

```cpp
#include <hip/hip_runtime.h>
#include <hip/hip_cooperative_groups.h>
#include <cstdio>
#include <cstdint>
namespace cg = cooperative_groups;

#ifndef ONE_LAUNCH
#define ONE_LAUNCH 1
#endif

#ifndef PHMASK
#define PHMASK 0x1fffff
#endif
#define PHON(n) (((PHMASK) >> (n)) & 1)
#define LAS __attribute__((address_space(3)))
typedef unsigned short bf16_t;
typedef short bf16x8 __attribute__((ext_vector_type(8)));
typedef float f32x4 __attribute__((ext_vector_type(4)));
typedef float f32x2 __attribute__((ext_vector_type(2)));
typedef unsigned u32x4 __attribute__((ext_vector_type(4)));
typedef unsigned u32x2 __attribute__((ext_vector_type(2)));

constexpr int D = 1024, NB = 32, T = 2048, CL = 256, FH = 2816, INW = 7200, PN = 7424, NMOD = 9216;
constexpr int NG = 4, BG = NB / NG;
constexpr int RL = BG * T, RC = BG * CL, RG = RL + RC;
constexpr int NCH = 36;
constexpr float EPS = 1e-6f;
constexpr int PQ = 0, PK = 512, PV = 1024, PGG = 2048, PXL = 3072, PYL = 4096, PGA = 5120, PGB = 6144, PFD = 7168;

constexpr size_t al(size_t x) { return (x + 4095) & ~(size_t)4095; }
constexpr size_t WS_WI1 = 1 << 20;
constexpr size_t WS_WO1 = WS_WI1 + al((size_t)2 * FH * D * 2);
constexpr size_t WS_WI2 = WS_WO1 + al((size_t)D * FH * 2);
constexpr size_t WS_WO2 = WS_WI2 + al((size_t)2 * FH * D * 2);
constexpr size_t WS_WIN = WS_WO2 + al((size_t)D * FH * 2);
constexpr size_t WS_WOG = WS_WIN + al((size_t)PN * D * 2);
constexpr size_t WS_WOL = WS_WOG + al((size_t)D * D * 2);
constexpr size_t WS_WOO = WS_WOL + al((size_t)D * D * 2);
constexpr size_t WS_WLG = WS_WOO + al((size_t)D * D * 2);
constexpr size_t WS_MODP = WS_WLG + al((size_t)4096 * 128 * 2);
constexpr size_t WS_MOD = WS_MODP + al((size_t)16 * 33 * NMOD * 4);
constexpr size_t WS_GC = WS_MOD + al((size_t)33 * NMOD * 4);
constexpr size_t WS_H1 = WS_GC + al((size_t)6 * D * 4);
constexpr size_t WS_U = WS_H1 + al((size_t)RG * D * 4);
constexpr size_t WS_BIG = WS_U + al((size_t)RG * D * 2);
constexpr size_t WS_XC = WS_BIG + al((size_t)RG * PN * 2);
constexpr size_t WS_LA = WS_XC + al((size_t)RG * D * 2);
constexpr size_t WS_UU = WS_LA + al((size_t)2 * RG * D * 2);
constexpr size_t WS_HFB = WS_UU + al((size_t)2 * RG * D * 2);
constexpr size_t WS_OFB = WS_HFB + al((size_t)2 * RL * D * 2);
constexpr size_t GT = (size_t)2 * BG * NCH * 4;
constexpr size_t WS_QD = WS_OFB + al((size_t)2 * RL * D * 2);
constexpr size_t WS_KI = WS_QD + al(GT * 8192 * 2);
constexpr size_t WS_KET = WS_KI + al(GT * 8192 * 2);
constexpr size_t WS_VT = WS_KET + al(GT * 8192 * 2);
constexpr size_t WS_BL = WS_VT + al((size_t)BG * NCH * 4 * 16384 * 2);
constexpr size_t WS_H1C = WS_BL + al(GT * 128 * 4);
constexpr size_t WS_END = WS_H1C + al((size_t)NB * CL * D * 4);
static_assert(WS_END <= (size_t)1073741824, "workspace map exceeds 1 GiB");

constexpr int LDS_BYTES = 163840, PTAB = LDS_BYTES - 512;

typedef __bf16 bf16x2_t __attribute__((ext_vector_type(2)));
__device__ __forceinline__ unsigned cvt_pk_bf16(float lo, float hi) { const f32x2 v = {lo, hi}; return __builtin_bit_cast(unsigned, __builtin_convertvector(v, bf16x2_t)); }
__device__ __forceinline__ bf16_t f2bf(float f) { return (bf16_t)(cvt_pk_bf16(f, 0.f) & 0xffffu); }
__device__ __forceinline__ float bf2f(bf16_t h) { return __uint_as_float(((unsigned)h) << 16); }
__device__ __forceinline__ float bflo(unsigned w) { return __uint_as_float(w << 16); }
__device__ __forceinline__ float bfhi(unsigned w) { return __uint_as_float(w & 0xffff0000u); }
__device__ __forceinline__ float sigmoidf_(float x) { return __builtin_amdgcn_rcpf(1.0f + __expf(-x)); }
__device__ __forceinline__ float siluf_(float x) { return x * __builtin_amdgcn_rcpf(1.0f + __expf(-x)); }
__device__ __forceinline__ float geluf_(float x) { const float z = 0.7978845608028654f * (x + 0.044715f * x * x * x); return x * (1.0f - __builtin_amdgcn_rcpf(1.0f + __expf(2.0f * z))); }
__device__ __forceinline__ float logsigf_(float x) { return fminf(x, 0.f) - log1pf(__expf(-fabsf(x))); }
__device__ __forceinline__ float one_minus_exp(float x) {
    const float ser = -x * (1.0f + x * (0.5f + x * (0.16666667f + x * (0.041666668f + x * (0.0083333338f + x * (0.0013888889f + x * 0.0001984127f))))));
    return x > -0.3f ? ser : 1.0f - __expf(x);
}
__device__ __forceinline__ float wave_sum(float v) {
#pragma unroll
    for (int o = 1; o < 64; o <<= 1) v += __shfl_xor(v, o);
    return v;
}
__device__ __forceinline__ void unpack8(const u32x4 w, float (&f)[8]) {
    f[0] = bflo(w.x); f[1] = bfhi(w.x); f[2] = bflo(w.y); f[3] = bfhi(w.y); f[4] = bflo(w.z); f[5] = bfhi(w.z); f[6] = bflo(w.w); f[7] = bfhi(w.w);
}
__device__ __forceinline__ u32x4 pack8(const float (&f)[8]) {
    u32x4 w; w.x = cvt_pk_bf16(f[0], f[1]); w.y = cvt_pk_bf16(f[2], f[3]); w.z = cvt_pk_bf16(f[4], f[5]); w.w = cvt_pk_bf16(f[6], f[7]); return w;
}

namespace pg8 {
constexpr int BM = 256, BK = 64, HALF = 128, HTB = HALF * BK * 2, STAGE_BYTES = 8 * HTB, NXCD = 8, WGM = 8;
__host__ __device__ __forceinline__ int lds_byte(int r, int c) { const int st = (r >> 4) * 2 + (c >> 5), rr = r & 15, cc = c & 31, ob = rr * 64 + cc * 2; return st * 1024 + (ob ^ (((ob >> 9) & 1) << 5)); }
__host__ __device__ __forceinline__ void stage_rc(int b, int& R, int& C) { const int st = b / 1024, sb = b % 1024, swz = sb ^ (((sb >> 9) & 1) << 5); R = (st >> 1) * 16 + swz / 64; C = (st & 1) * 32 + (swz % 64) / 2; }
__host__ __device__ __forceinline__ int perm32(int rho) { const int n = rho >> 4, i = rho & 15; return 8 * (i >> 2) + 4 * n + (i & 3); }
struct Unit { int pm, pn; };
struct Gemm { const bf16_t* A; const bf16_t* Bt; int M, N, K, lda, ldb, a_pn_shift, a_pn_bytes; };
struct StaticOrder {
    int nM, nN, nwg, G, c, ext, ext_pm0;
    __device__ void init(int M, int N, int G_, int c_) { nM = M / BM; nN = N / BM; nwg = nM * nN; G = G_; c = c_; ext = 0; ext_pm0 = 0; }
    __device__ bool next(int i, Unit& u) const {
        const long L = (long)i * G + c;
        if (L >= nwg) { if (L >= nwg + ext) return false; const int idx = (int)(L - nwg), t = idx % 11; u.pm = ext_pm0 + idx / 11; u.pn = t < 6 ? t + 2 : (t < 10 ? t + 6 : 28); return true; }
        int wgid = (int)L; { const int q = nwg / NXCD, r = nwg % NXCD, xcd = wgid % NXCD, off = wgid / NXCD; wgid = (xcd < r ? xcd * (q + 1) : r * (q + 1) + (xcd - r) * q) + off; }
        const int nig = WGM * nN, gid = wgid / nig, fm = gid * WGM, gsz = (nM - fm) < WGM ? (nM - fm) : WGM;
        u.pm = fm + ((wgid % nig) % gsz); u.pn = (wgid % nig) / gsz; return true;
    }
};
template <class Epi, bool ALIGN_EPI>
__device__ __forceinline__ void gemm_phase(const int tid, LAS unsigned char* lds, const Gemm g, const StaticOrder& S, const Epi& E) {
    const int wid = __builtin_amdgcn_readfirstlane(tid >> 6), lane = tid & 63, wr = wid >> 2, wc = wid & 3, fr = lane & 15, fq = lane >> 4;
    const int K = g.K, nt = K / BK;
    unsigned voffA[2], voffB[2];
#pragma unroll
    for (int i = 0; i < 2; ++i) { int R, C; stage_rc(tid * 16 + i * 8192, R, C); const int Rb = Epi::PERM ? ((R & ~31) + perm32(R & 31)) : R;
        voffA[i] = (unsigned)(R * g.lda + C) * 2u; voffB[i] = (unsigned)(Rb * g.ldb + C) * 2u; }
    const size_t kstep = (size_t)(BK * 2);
    const size_t hstepA = (size_t)HALF * g.lda * 2, hstepB = (size_t)HALF * g.ldb * 2;
    const size_t tstepA = 2 * hstepA, tstepB = 2 * hstepB;
    const unsigned ldsw = (unsigned)wid * 1024u;
    const int aoff = lds_byte(wr * 64 + fr, fq * 8), boff = lds_byte(wc * 32 + fr, fq * 8);
#define PG8_SA(b, h) (((b) * 2 + (h)) * HTB)
#define PG8_SB(b, h) ((4 + (b) * 2 + (h)) * HTB)
#define PG8_STAGE(bufoff, gbase, voff) do { _Pragma("unroll") for (int _i = 0; _i < 2; ++_i) \
        __builtin_amdgcn_global_load_lds((const unsigned*)((const char*)(gbase) + (voff)[_i]), (LAS unsigned*)(lds + (bufoff) + ldsw + _i * 8192), 16, 0, 0); } while (0)
#define PG8_LDA(dst, b, h) do { _Pragma("unroll") for (int m = 0; m < 4; ++m) _Pragma("unroll") for (int k = 0; k < 2; ++k) dst[m][k] = *(const LAS bf16x8*)(lds + PG8_SA(b, h) + aoff + m * 2048 + k * 1024); } while (0)
#define PG8_LDB(dst, b, h) do { _Pragma("unroll") for (int n = 0; n < 2; ++n) _Pragma("unroll") for (int k = 0; k < 2; ++k) dst[n][k] = *(const LAS bf16x8*)(lds + PG8_SB(b, h) + boff + n * 2048 + k * 1024); } while (0)
#define PG8_MMA(ai, bj, At, Bt) do { __builtin_amdgcn_s_setprio(1); _Pragma("unroll") for (int m = 0; m < 4; ++m) _Pragma("unroll") for (int n = 0; n < 2; ++n) _Pragma("unroll") for (int k = 0; k < 2; ++k) \
        acc[ai][bj][m][n] = __builtin_amdgcn_mfma_f32_16x16x32_bf16(Bt[n][k], At[m][k], acc[ai][bj][m][n], 0, 0, 0); __builtin_amdgcn_s_setprio(0); } while (0)
#define PG8_WAIT_V(n) asm volatile("s_waitcnt vmcnt(" #n ")" ::: "memory")
#define PG8_WAIT_L(n) asm volatile("s_waitcnt lgkmcnt(" #n ")" ::: "memory")
#define PG8_BAR __builtin_amdgcn_s_barrier()
#define PG8_SCHED __builtin_amdgcn_sched_barrier(0)
    Unit cur, nxt; int ui = 0;
    if (!S.next(0, cur)) return;
    f32x4 acc[2][2][4][2];
#pragma unroll
    for (int a = 0; a < 2; ++a)
#pragma unroll
        for (int b = 0; b < 2; ++b)
#pragma unroll
            for (int m = 0; m < 4; ++m)
#pragma unroll
                for (int n = 0; n < 2; ++n) acc[a][b][m][n] = (f32x4){0.f, 0.f, 0.f, 0.f};
    bf16x8 At[4][2], B0[2][2], B1[2][2];
    const char* cA = (const char*)g.A + (size_t)cur.pm * tstepA + (size_t)((cur.pn >> g.a_pn_shift) * g.a_pn_bytes);
    const char* cB = (const char*)g.Bt + (size_t)cur.pn * tstepB;
    PG8_STAGE(PG8_SB(0, 0), cB, voffB); PG8_STAGE(PG8_SB(0, 1), cB + hstepB, voffB); PG8_STAGE(PG8_SA(0, 0), cA, voffA); PG8_STAGE(PG8_SA(0, 1), cA + hstepA, voffA);
    if (wr == 1) PG8_BAR;
    PG8_WAIT_V(2); PG8_BAR;
    PG8_STAGE(PG8_SB(1, 0), cB + kstep, voffB); PG8_STAGE(PG8_SA(1, 0), cA + kstep, voffA); PG8_STAGE(PG8_SB(1, 1), cB + hstepB + kstep, voffB);
    PG8_WAIT_V(6); PG8_BAR;
    for (;;) {
        const bool has_next = S.next(ui + 1, nxt);
        const char* nA = has_next ? (const char*)g.A + (size_t)nxt.pm * tstepA + (size_t)((nxt.pn >> g.a_pn_shift) * g.a_pn_bytes) : cA;
        const char* nB = has_next ? (const char*)g.Bt + (size_t)nxt.pn * tstepB : cB;
        for (int t = 0; t < nt; t += 2) {
            const bool last = (t == nt - 2);
            const char* a1 = cA + (size_t)(t + 1) * kstep;
            const char* a2 = last ? nA : cA + (size_t)(t + 2) * kstep; const char* b2 = last ? nB : cB + (size_t)(t + 2) * kstep;
            const char* a3 = a2 + kstep; const char* b3 = b2 + kstep;
            PG8_LDB(B0, 0, 0); PG8_LDB(B1, 0, 1); PG8_SCHED; PG8_LDA(At, 0, 0); PG8_STAGE(PG8_SA(1, 1), a1 + hstepA, voffA);
            PG8_WAIT_V(8); PG8_WAIT_L(0); PG8_BAR; PG8_MMA(0, 0, At, B0); PG8_MMA(0, 1, At, B1); PG8_BAR; PG8_SCHED;
            PG8_LDA(At, 0, 1); PG8_STAGE(PG8_SB(0, 0), b2, voffB); PG8_STAGE(PG8_SB(0, 1), b2 + hstepB, voffB); PG8_STAGE(PG8_SA(0, 0), a2, voffA);
            PG8_WAIT_V(8); PG8_WAIT_L(0); PG8_BAR; PG8_MMA(1, 0, At, B0); PG8_MMA(1, 1, At, B1); PG8_BAR; PG8_SCHED;
            PG8_LDB(B0, 1, 0); PG8_LDB(B1, 1, 1); PG8_SCHED; PG8_LDA(At, 1, 0); PG8_STAGE(PG8_SA(0, 1), a2 + hstepA, voffA);
            PG8_WAIT_V(8); PG8_WAIT_L(0); PG8_BAR; PG8_MMA(0, 0, At, B0); PG8_MMA(0, 1, At, B1); PG8_BAR; PG8_SCHED;
            PG8_LDA(At, 1, 1); PG8_STAGE(PG8_SB(1, 0), b3, voffB); PG8_STAGE(PG8_SB(1, 1), b3 + hstepB, voffB); PG8_STAGE(PG8_SA(1, 0), a3, voffA);
            PG8_WAIT_V(8); PG8_WAIT_L(0); PG8_BAR; PG8_MMA(1, 0, At, B0); PG8_MMA(1, 1, At, B1); PG8_BAR; PG8_SCHED;
        }
        if constexpr (ALIGN_EPI) { if (wr == 0) PG8_BAR; }
        { int fr_ = fr, fq_ = fq; asm volatile("" : "+v"(fr_), "+v"(fq_)); E(acc, cur, wr, wc, fr_, fq_); }
        if (!has_next) break;
#pragma unroll
        for (int a = 0; a < 2; ++a)
#pragma unroll
            for (int b = 0; b < 2; ++b)
#pragma unroll
                for (int m = 0; m < 4; ++m)
#pragma unroll
                    for (int n = 0; n < 2; ++n) acc[a][b][m][n] = (f32x4){0.f, 0.f, 0.f, 0.f};
        cur = nxt; cA = nA; cB = nB; ++ui;
        if constexpr (ALIGN_EPI) { if (wr == 1) PG8_BAR; }
    }
    PG8_WAIT_V(0);
    if constexpr (!ALIGN_EPI) { if (wr == 0) PG8_BAR; }
    PG8_BAR;
#undef PG8_SA
#undef PG8_SB
#undef PG8_STAGE
#undef PG8_LDA
#undef PG8_LDB
#undef PG8_MMA
#undef PG8_WAIT_V
#undef PG8_WAIT_L
#undef PG8_BAR
#undef PG8_SCHED
}

struct EpiBf16 {
    static constexpr bool PERM = true;
    bf16_t* O; int ldc;
    __device__ __forceinline__ void operator()(const f32x4 (&acc)[2][2][4][2], const Unit& u, int wr, int wc, int fr, int fq) const {
        const int row0 = u.pm * BM + wr * 64 + fr, col0 = u.pn * BM + wc * 32 + 8 * fq;
#pragma unroll
        for (int ai = 0; ai < 2; ++ai)
#pragma unroll
            for (int m = 0; m < 4; ++m) { bf16_t* rowp = O + (size_t)(row0 + ai * HALF + m * 16) * ldc + col0;
#pragma unroll
                for (int bj = 0; bj < 2; ++bj) { const f32x4 v0 = acc[ai][bj][m][0], v1 = acc[ai][bj][m][1];
                    u32x4 w; w.x = cvt_pk_bf16(v0[0], v0[1]); w.y = cvt_pk_bf16(v0[2], v0[3]); w.z = cvt_pk_bf16(v1[0], v1[1]); w.w = cvt_pk_bf16(v1[2], v1[3]);
                    *(u32x4*)(rowp + bj * HALF) = w; } }
    }
};
struct EpiSwiglu {
    static constexpr bool PERM = true;
    bf16_t* O; int ldc;
    __device__ __forceinline__ void operator()(const f32x4 (&acc)[2][2][4][2], const Unit& u, int wr, int wc, int fr, int fq) const {
        const int row0 = u.pm * BM + wr * 64 + fr, col0 = u.pn * HALF + wc * 32 + 8 * fq;
#pragma unroll
        for (int ai = 0; ai < 2; ++ai)
#pragma unroll
            for (int m = 0; m < 4; ++m) { bf16_t* rowp = O + (size_t)(row0 + ai * HALF + m * 16) * ldc + col0;
                float o[8];
#pragma unroll
                for (int n = 0; n < 2; ++n)
#pragma unroll
                    for (int j = 0; j < 4; ++j) o[4 * n + j] = siluf_(acc[ai][0][m][n][j]) * acc[ai][1][m][n][j];
                *(u32x4*)rowp = pack8(o); }
    }
};
struct EpiResid {
    static constexpr bool PERM = false;
    const float* baseL; const float* baseC; float* outL; float* outC; const float* modL; const float* modC; float scale; int nlat;
    __device__ __forceinline__ void operator()(const f32x4 (&acc)[2][2][4][2], const Unit& u, int wr, int wc, int fr, int fq) const {
        const bool lat = u.pm < nlat;
        const size_t toff = (size_t)(lat ? u.pm : u.pm - nlat) * BM * D + (size_t)(wr * 64 + fr) * D + u.pn * BM + wc * 32 + 4 * fq;
        const float* base = (lat ? baseL : baseC) + toff;
        float* out = (lat ? outL : outC) + toff;
        const float* mg = (lat ? modL + (size_t)(u.pm >> 3) * NMOD : modC) + u.pn * BM + wc * 32 + 4 * fq;
#pragma unroll
        for (int bj = 0; bj < 2; ++bj)
#pragma unroll
            for (int n = 0; n < 2; ++n) { const f32x4 gv = *(const f32x4*)(mg + bj * HALF + n * 16) * scale;
#pragma unroll
                for (int ai = 0; ai < 2; ++ai)
#pragma unroll
                    for (int m = 0; m < 4; ++m) { const size_t off = (size_t)(ai * HALF + m * 16) * D + bj * HALF + n * 16;
                        const f32x4 bs = *(const f32x4*)(base + off); *(f32x4*)(out + off) = bs + gv * acc[ai][bj][m][n]; } }
    }
};
__device__ __forceinline__ float one_minus_exp(float x) {
    const float ser = -x * (1.0f + x * (0.5f + x * (0.16666667f + x * (0.041666668f + x * (0.0083333338f + x * (0.0013888889f + x * 0.0001984127f))))));
    return x > -0.3f ? ser : 1.0f - __expf(x);
}
struct EpiGate {
    static constexpr bool PERM = true;
    bf16_t* LA; bf16_t* UU;
    __device__ __forceinline__ void operator()(const f32x4 (&acc)[2][2][4][2], const Unit& u, int wr, int wc, int fr, int fq) const {
        const int blk = u.pn >> 1, dir = u.pn & 1, ch0 = blk * HALF + wc * 32 + 8 * fq, row0 = u.pm * BM + wr * 64 + fr;
#pragma unroll
        for (int ai = 0; ai < 2; ++ai)
#pragma unroll
            for (int m = 0; m < 4; ++m) { const size_t off = (size_t)dir * RG * D + (size_t)(row0 + ai * HALF + m * 16) * D + ch0;
#pragma unroll
                for (int bj = 0; bj < 2; ++bj) { const f32x4 v0 = acc[ai][bj][m][0], v1 = acc[ai][bj][m][1];
                    u32x4 w; w.x = cvt_pk_bf16(v0[0], v0[1]); w.y = cvt_pk_bf16(v0[2], v0[3]); w.z = cvt_pk_bf16(v1[0], v1[1]); w.w = cvt_pk_bf16(v1[2], v1[3]);
                    *(u32x4*)((bj ? UU : LA) + off) = w; } }
    }
};
template <bool ACCUM> struct EpiMix {
    static constexpr bool PERM = true;
    const bf16_t* PROJ; int gcol; bf16_t* MG;
    __device__ __forceinline__ void operator()(const f32x4 (&acc)[2][2][4][2], const Unit& u, int wr, int wc, int fr, int fq) const {
        const int row0 = u.pm * BM + wr * 64 + fr, col0 = u.pn * BM + wc * 32 + 8 * fq;
#pragma unroll
        for (int ai = 0; ai < 2; ++ai)
#pragma unroll
            for (int m = 0; m < 4; ++m) { const size_t row = (size_t)(row0 + ai * HALF + m * 16);
#pragma unroll
                for (int bj = 0; bj < 2; ++bj) { float gt[8], o[8]; unpack8(*(const u32x4*)(PROJ + row * PN + gcol + col0 + bj * HALF), gt);
                    bf16_t* dst = MG + row * D + col0 + bj * HALF;
                    if (ACCUM) unpack8(*(const u32x4*)dst, o); else {
#pragma unroll
                        for (int i = 0; i < 8; ++i) o[i] = 0.f; }
#pragma unroll
                    for (int n = 0; n < 2; ++n)
#pragma unroll
                        for (int j = 0; j < 4; ++j) o[4 * n + j] += sigmoidf_(gt[4 * n + j]) * acc[ai][bj][m][n][j];
                    *(u32x4*)dst = pack8(o); } }
    }
};
}

struct Args {
    const float* in[26]; float* out; unsigned char* ws; int lo, hi;
};
enum { I_X = 0, I_C, I_CTX, I_CCTX, I_WADA, I_BADA, I_NORMW, I_F1WI, I_F1WO, I_F2WI, I_F2WO, I_WIN, I_FUP, I_FB, I_GNW, I_CONVW, I_CONVB, I_WR, I_BR, I_WI, I_BI, I_LAM, I_WOG, I_WOL, I_WOO, I_FNW };

#define NTHR 512
__device__ __forceinline__ const float* inp(const LAS unsigned char* lds, int i) { const LAS unsigned* t = (const LAS unsigned*)(lds + PTAB) + 2 * i;
    const unsigned lo = __builtin_amdgcn_readfirstlane(t[0]), hi = __builtin_amdgcn_readfirstlane(t[1]); return (const float*)(((unsigned long long)hi << 32) | lo); }
#define AIN(i) inp(lds, (i))
struct Ctx { int tid, bid, G; };
#define GW() (cx.bid * 8 + (cx.tid >> 6))
#define NGW() (cx.G * 8)

__device__ __forceinline__ void transpose_item(const float* W, int ldw, int K, int k0, int n0, bf16_t* WT, int drow, LAS float* scr, int lane) {
#pragma unroll 8
    for (int i = 0; i < 32; ++i) { const int kk = 2 * i + (lane >> 5); scr[kk * 33 + (lane & 31)] = W[(size_t)(k0 + kk) * ldw + n0 + (lane & 31)]; }
    asm volatile("s_waitcnt lgkmcnt(0)" ::: "memory");
    const int c = lane & 7;
#pragma unroll
    for (int j = 0; j < 4; ++j) { const int n = (lane >> 3) + 8 * j; const LAS float* s = scr + (8 * c) * 33 + n;
        u32x4 o; o.x = cvt_pk_bf16(s[0 * 33], s[1 * 33]); o.y = cvt_pk_bf16(s[2 * 33], s[3 * 33]); o.z = cvt_pk_bf16(s[4 * 33], s[5 * 33]); o.w = cvt_pk_bf16(s[6 * 33], s[7 * 33]);
        *(u32x4*)(WT + (size_t)(drow + n) * K + k0 + 8 * c) = o; }
    asm volatile("s_waitcnt lgkmcnt(0)" ::: "memory");
}
__device__ __forceinline__ int wi_drow(int n0) { return n0 < FH ? (n0 >> 7) * 256 + (n0 & 127) : ((n0 - FH) >> 7) * 256 + 128 + ((n0 - FH) & 127); }
__device__ __forceinline__ int win_drow(int n0) { return n0 < 3072 ? n0 : (n0 == 3072 ? PFD : n0 - 32); }

__device__ __forceinline__ void phase_weights(const Ctx cx, const Args& a, LAS unsigned char* lds) {
    const int lane = cx.tid & 63, wave = cx.tid >> 6;
    LAS float* scr = (LAS float*)(lds + wave * 16384);
    unsigned char* ws = a.ws;
    constexpr int I_WI_ = (D / 64) * (2 * FH / 32), I_WO_ = (FH / 64) * (D / 32), I_IN_ = (D / 64) * (INW / 32), I_SQ_ = (D / 64) * (D / 32), I_LG_ = 32 * 8;
    constexpr int NIT = 2 * I_WI_ + 2 * I_WO_ + I_IN_ + 3 * I_SQ_ + I_LG_;
    if (PHON(19)) for (int it = GW(); it < NIT; it += NGW()) {
        int r = it;
        if (r < 2 * I_WI_) { const int w = r / I_WI_; r %= I_WI_; const int nb = 2 * FH / 32, kb = r / nb, n0 = (r % nb) * 32;
            transpose_item(AIN(w ? I_F2WI : I_F1WI), 2 * FH, D, kb * 64, n0, (bf16_t*)(ws + (w ? WS_WI2 : WS_WI1)), wi_drow(n0), scr, lane); continue; }
        r -= 2 * I_WI_;
        if (r < 2 * I_WO_) { const int w = r / I_WO_; r %= I_WO_; const int nb = D / 32, kb = r / nb, n0 = (r % nb) * 32;
            transpose_item(AIN(w ? I_F2WO : I_F1WO), D, FH, kb * 64, n0, (bf16_t*)(ws + (w ? WS_WO2 : WS_WO1)), n0, scr, lane); continue; }
        r -= 2 * I_WO_;
        if (r < I_IN_) { const int nb = INW / 32, kb = r / nb, n0 = (r % nb) * 32;
            transpose_item(AIN(I_WIN), INW, D, kb * 64, n0, (bf16_t*)(ws + WS_WIN), win_drow(n0), scr, lane); continue; }
        r -= I_IN_;
        if (r < 3 * I_SQ_) { const int w = r / I_SQ_; r %= I_SQ_; const int nb = D / 32, kb = r / nb, n0 = (r % nb) * 32;
            transpose_item(AIN(w == 0 ? I_WOG : (w == 1 ? I_WOL : I_WOO)), D, D, kb * 64, n0, (bf16_t*)(ws + (w == 0 ? WS_WOG : (w == 1 ? WS_WOL : WS_WOO))), n0, scr, lane); continue; }
        r -= 3 * I_SQ_;
        { const int mat = r >> 3, sub = r & 7, gate = mat >> 4, dir = (mat >> 3) & 1, blk = mat & 7;
          const float* src = AIN(gate ? I_WI : I_WR) + (size_t)(dir * 8 + blk) * 128 * 128;
          const int kb = sub >> 2, n0 = (sub & 3) * 32;
          transpose_item(src, 128, 128, kb * 64, n0, (bf16_t*)(ws + WS_WLG), ((blk * 2 + dir) * 2 + gate) * 128 + n0, scr, lane); }
    }
    { u32x4* z = (u32x4*)(ws + WS_WIN + (size_t)INW * D * 2); const int n16 = (PN - INW) * D * 2 / 16;
      for (int i = cx.bid * NTHR + cx.tid; i < n16; i += cx.G * NTHR) z[i] = (u32x4){0u, 0u, 0u, 0u}; }
    __syncthreads();
    LAS float* sl = (LAS float*)lds;
    float* MODP = (float*)(ws + WS_MODP);
    if (PHON(20)) for (int item = cx.bid; item < 18 * 16; item += cx.G) {
        const int cb = item % 18, ks = item / 18, col = cb * 512 + cx.tid;
        for (int idx = cx.tid; idx < 33 * 64; idx += NTHR) { const int b = idx >> 6, k = idx & 63; const float cv = b < 32 ? AIN(I_C)[b * D + ks * 64 + k] : AIN(I_CCTX)[ks * 64 + k]; sl[idx] = siluf_(cv); }
        __syncthreads();
        float acc[33];
#pragma unroll
        for (int b = 0; b < 33; ++b) acc[b] = 0.f;
        const float* wp = AIN(I_WADA) + (size_t)(ks * 64) * NMOD + col;
#pragma unroll 4
        for (int k = 0; k < 64; ++k) { const float w = wp[(size_t)k * NMOD];
#pragma unroll
            for (int b = 0; b < 33; ++b) acc[b] += sl[b * 64 + k] * w; }
#pragma unroll
        for (int b = 0; b < 33; ++b) MODP[(size_t)(ks * 33 + b) * NMOD + col] = acc[b];
        __syncthreads();
    }
}
__device__ __forceinline__ void phase_modreduce(const Ctx cx, const Args& a, LAS unsigned char* lds) {
    const float* MODP = (const float*)(a.ws + WS_MODP); float* MOD = (float*)(a.ws + WS_MOD);
    for (int idx = cx.bid * NTHR + cx.tid; idx < 33 * NMOD; idx += cx.G * NTHR) {
        float s = AIN(I_BADA)[idx % NMOD];
#pragma unroll
        for (int ks = 0; ks < 16; ++ks) s += MODP[(size_t)ks * 33 * NMOD + idx];
        MOD[idx] = s;
    }
    float* GC = (float*)(a.ws + WS_GC);
    for (int idx = cx.bid * NTHR + cx.tid; idx < 2 * D; idx += cx.G * NTHR) { GC[idx] = AIN(I_BR)[idx]; GC[2 * D + idx] = AIN(I_BI)[idx]; GC[4 * D + idx] = 8.0f * log1pf(__expf(-AIN(I_LAM)[idx])); }
}

__device__ __forceinline__ void phase_normmod(const Ctx cx, const Args& a, LAS unsigned char* lds, const float* srcL, const float* srcC, int nL, int nrows, int mod_b0, int sub) {
    const int lane = cx.tid & 63;
    const float* MOD = (const float*)(a.ws + WS_MOD); const float* nw = AIN(I_NORMW) + sub * D;
    bf16_t* U = (bf16_t*)(a.ws + WS_U);
    for (int r0 = 2 * GW(); r0 < nrows; r0 += 2 * NGW()) {
        f32x4 v[2][4]; float ss[2];
#pragma unroll
        for (int q = 0; q < 2; ++q) { const int r = r0 + q;
            const float* src = r < nL ? srcL + (size_t)r * D : srcC + (size_t)(r - nL) * D;
            ss[q] = 0.f;
#pragma unroll
            for (int j = 0; j < 4; ++j) { v[q][j] = ((const f32x4*)src)[lane + 64 * j]; } }
#pragma unroll
        for (int q = 0; q < 2; ++q)
#pragma unroll
            for (int j = 0; j < 4; ++j) ss[q] += (v[q][j].x * v[q][j].x + v[q][j].y * v[q][j].y) + (v[q][j].z * v[q][j].z + v[q][j].w * v[q][j].w);
#pragma unroll
        for (int o = 1; o < 64; o <<= 1) { ss[0] += __shfl_xor(ss[0], o); ss[1] += __shfl_xor(ss[1], o); }
#pragma unroll
        for (int q = 0; q < 2; ++q) { const int r = r0 + q; const int mrow = r < nL ? mod_b0 + r / T : 32;
            const float* sh = MOD + (size_t)mrow * NMOD + (3 * sub) * D; const float* sc = sh + D;
            const float rstd = 1.0f / sqrtf(ss[q] * (1.0f / D) + EPS);
#pragma unroll
            for (int j = 0; j < 4; ++j) { const int c4 = lane + 64 * j; const f32x4 w = ((const f32x4*)nw)[c4], s4 = ((const f32x4*)sh)[c4], c1 = ((const f32x4*)sc)[c4];
                const f32x4 o = v[q][j] * rstd * w * (c1 + 1.0f) + s4;
                u32x2 p; p.x = cvt_pk_bf16(o.x, o.y); p.y = cvt_pk_bf16(o.z, o.w); ((u32x2*)(U + (size_t)r * D))[c4] = p; } }
    }
}
__device__ __forceinline__ void phase_final(const Ctx cx, const Args& a, LAS unsigned char* lds, int g) {
    const int lane = cx.tid & 63; const float* fw = AIN(I_FNW);
    for (int r0 = 2 * GW(); r0 < RL; r0 += 2 * NGW()) {
        float* row = a.out + ((size_t)g * RL + r0) * D;
        f32x4 v[2][4]; float ss[2] = {0.f, 0.f};
#pragma unroll
        for (int q = 0; q < 2; ++q)
#pragma unroll
            for (int j = 0; j < 4; ++j) v[q][j] = ((const f32x4*)(row + q * D))[lane + 64 * j];
#pragma unroll
        for (int q = 0; q < 2; ++q)
#pragma unroll
            for (int j = 0; j < 4; ++j) ss[q] += (v[q][j].x * v[q][j].x + v[q][j].y * v[q][j].y) + (v[q][j].z * v[q][j].z + v[q][j].w * v[q][j].w);
#pragma unroll
        for (int o = 1; o < 64; o <<= 1) { ss[0] += __shfl_xor(ss[0], o); ss[1] += __shfl_xor(ss[1], o); }
#pragma unroll
        for (int q = 0; q < 2; ++q) { const float rstd = 1.0f / sqrtf(ss[q] * (1.0f / D) + EPS);
#pragma unroll
            for (int j = 0; j < 4; ++j) { const int c4 = lane + 64 * j; ((f32x4*)(row + q * D))[c4] = v[q][j] * rstd * ((const f32x4*)fw)[c4]; } }
    }
}

__device__ __forceinline__ float logsig_fast(float x) { return fminf(x, 0.f) - __logf(1.0f + __expf(-fabsf(x))); }
__device__ __forceinline__ void phase_prep(const Ctx cx, const Args& a, int g, LAS unsigned char* lds) {
    const bf16_t* PROJ = (const bf16_t*)(a.ws + WS_BIG);
    const int tid = cx.tid;
    {
        LAS bf16_t* qs = (LAS bf16_t*)lds; LAS bf16_t* ks = (LAS bf16_t*)(lds + 16384); LAS float* fdl = (LAS float*)(lds + 32768); LAS float* part = (LAS float*)(lds + 36864);
        LAS bf16_t* qo = (LAS bf16_t*)(lds + 40960); LAS bf16_t* ko = (LAS bf16_t*)(lds + 57344);
        const int d = tid & 127, qt = tid >> 7;
        for (int item = cx.bid; item < BG * NCH * 8; item += cx.G) {
            const int h = item & 3, dir = (item >> 2) & 1, bc = item >> 3, b = bc / NCH, c = bc % NCH;
            const int row0 = c < 4 ? RL + b * CL + c * 64 : b * T + (c - 4) * 64;
            const bool lat = c >= 4;
#pragma unroll
            for (int k = 0; k < 2; ++k) { const int p = tid + 512 * k, r = p >> 4, c8 = (p & 15) * 8;
                *(LAS u32x4*)(ks + r * 128 + c8) = *(const u32x4*)(PROJ + (size_t)(row0 + r) * PN + PK + h * 128 + c8);
                if (lat) *(LAS u32x4*)(qs + r * 128 + c8) = *(const u32x4*)(PROJ + (size_t)(row0 + r) * PN + PQ + h * 128 + c8); }
#pragma unroll
            for (int k = 0; k < 2; ++k) { const int idx = tid + 512 * k; fdl[idx] = bf2f(PROJ[(size_t)(row0 + (idx >> 4)) * PN + PFD + dir * 16 + (idx & 15)]); }
            const int col = h * 128 + d;
            float fw[16];
#pragma unroll
            for (int r = 0; r < 16; ++r) fw[r] = AIN(I_FUP)[(size_t)(dir * 16 + r) * 512 + col];
            const float fbv = AIN(I_FB)[dir * 512 + col];
            __syncthreads();
            float la[16]; float psum = 0.f;
#pragma unroll
            for (int t = 0; t < 16; ++t) { const int i = 16 * qt + t; float dot = fbv;
#pragma unroll
                for (int r = 0; r < 16; ++r) dot += fdl[i * 16 + r] * fw[r];
                la[t] = logsig_fast(dot) * (1.0f / 16.0f); psum += la[t]; }
            part[qt * 128 + d] = psum;
            __syncthreads();
            const float p0 = part[d], p1 = part[128 + d], p2 = part[256 + d], p3 = part[384 + d];
            const float tot = (p0 + p1) + (p2 + p3);
            float run = dir == 0 ? (qt > 0 ? p0 : 0.f) + (qt > 1 ? p1 : 0.f) + (qt > 2 ? p2 : 0.f)
                                 : (qt < 3 ? p3 : 0.f) + (qt < 2 ? p2 : 0.f) + (qt < 1 ? p1 : 0.f);
            float ke[16];
            if (dir == 0) {
#pragma unroll
                for (int t = 0; t < 16; ++t) { const int i = 16 * qt + t; run += la[t];
                    const float kv = bf2f(ks[i * 128 + d]); ke[t] = kv * __expf(tot - run);
                    if (lat) { qo[i * 128 + d] = f2bf(bf2f(qs[i * 128 + d]) * 0.08838834764831845f * __expf(run)); ko[i * 128 + d] = f2bf(kv * __expf(-run)); } }
            } else {
#pragma unroll
                for (int t = 15; t >= 0; --t) { const int i = 16 * qt + t; run += la[t];
                    const float kv = bf2f(ks[i * 128 + d]); ke[t] = kv * __expf(tot - run);
                    if (lat) { qo[i * 128 + d] = f2bf(bf2f(qs[i * 128 + d]) * 0.08838834764831845f * __expf(run)); ko[i * 128 + d] = f2bf(kv * __expf(-run)); } }
            }
            const size_t tb = (((size_t)dir * BG + b) * NCH + c) * 4 + h;
            bf16_t* KET = (bf16_t*)(a.ws + WS_KET) + tb * 8192 + d * 64 + 16 * qt;
            { float k0[8], k1[8];
#pragma unroll
              for (int t = 0; t < 8; ++t) { k0[t] = ke[t]; k1[t] = ke[8 + t]; }
              *(u32x4*)KET = pack8(k0); *(u32x4*)(KET + 8) = pack8(k1); }
            if (qt == 0) ((float*)(a.ws + WS_BL))[tb * 128 + d] = tot;
            __syncthreads();
            if (lat) { bf16_t* QD = (bf16_t*)(a.ws + WS_QD) + tb * 8192; bf16_t* KI = (bf16_t*)(a.ws + WS_KI) + tb * 8192;
#pragma unroll
                for (int k = 0; k < 2; ++k) { const int p = tid + 512 * k; *(u32x4*)(QD + p * 8) = *(const LAS u32x4*)(qo + p * 8); *(u32x4*)(KI + p * 8) = *(const LAS u32x4*)(ko + p * 8); } }
            __syncthreads();
        }
    }
    {
        LAS bf16_t* vs = (LAS bf16_t*)lds;
        const int e = tid & 255, jh = tid >> 8;
        for (int item = cx.bid; item < BG * NCH * 4; item += cx.G) {
            const int h = item & 3, bc = item >> 2, b = bc / NCH, c = bc % NCH;
            const int row0 = c < 4 ? RL + b * CL + c * 64 : b * T + (c - 4) * 64;
#pragma unroll
            for (int k = 0; k < 4; ++k) { const int p = tid + 512 * k, r = p >> 5, c8 = (p & 31) * 8;
                *(LAS u32x4*)(vs + r * 256 + c8) = *(const u32x4*)(PROJ + (size_t)(row0 + r) * PN + PV + h * 256 + c8); }
            __syncthreads();
            bf16_t* VT = (bf16_t*)(a.ws + WS_VT) + ((((size_t)b * NCH + c) * 4 + h) * 256 + e) * 64 + 32 * jh;
#pragma unroll
            for (int jg = 0; jg < 4; ++jg) { float v[8];
#pragma unroll
                for (int jj = 0; jj < 8; ++jj) v[jj] = bf2f(vs[(32 * jh + 8 * jg + jj) * 256 + e]);
                *(u32x4*)(VT + 8 * jg) = pack8(v); }
            __syncthreads();
        }
    }
    bf16_t* XC = (bf16_t*)(a.ws + WS_XC);
    for (int idx = cx.bid * NTHR + cx.tid; idx < RG * 128; idx += cx.G * NTHR) {
        const int row = idx >> 7, c8 = (idx & 127) * 8;
        const int pos = row < RL ? (row & 63) : ((row - RL) & 255), len = row < RL ? 64 : 256;
        float acc[8];
#pragma unroll
        for (int i = 0; i < 8; ++i) acc[i] = AIN(I_CONVB)[c8 + i];
#pragma unroll
        for (int j = 0; j < 4; ++j) { const int p = pos + j - 2;
            if (p >= 0 && p < len) { float xv[8]; unpack8(*(const u32x4*)(PROJ + (size_t)(row + j - 2) * PN + PXL + c8), xv);
#pragma unroll
                for (int i = 0; i < 8; ++i) acc[i] += AIN(I_CONVW)[j * D + c8 + i] * xv[i]; } }
        *(u32x4*)(XC + (size_t)row * D + c8) = pack8(acc);
    }
}

__device__ __forceinline__ void phase_gatefix(const Ctx cx, const Args& a, LAS unsigned char* lds) {
    bf16_t* LA = (bf16_t*)(a.ws + WS_LA); bf16_t* UU = (bf16_t*)(a.ws + WS_UU); const bf16_t* XC = (const bf16_t*)(a.ws + WS_XC); const float* GC = (const float*)(a.ws + WS_GC);
    for (int idx = cx.bid * NTHR + cx.tid; idx < 2 * RG * 128; idx += cx.G * NTHR) {
        const int dir = idx >= RG * 128, rem = idx - dir * RG * 128, row = rem >> 7, c8 = (rem & 127) * 8;
        const size_t off = (size_t)dir * RG * D + (size_t)row * D + c8;
        float r[8], ig[8], xc[8]; unpack8(*(const u32x4*)(LA + off), r); unpack8(*(const u32x4*)(UU + off), ig); unpack8(*(const u32x4*)(XC + (size_t)row * D + c8), xc);
#pragma unroll
        for (int i = 0; i < 8; ++i) { const float l = -GC[(4 + dir) * D + c8 + i] * sigmoidf_(r[i] + GC[dir * D + c8 + i]);
            const float gi = sigmoidf_(ig[i] + GC[(2 + dir) * D + c8 + i]);
            r[i] = l; ig[i] = __builtin_amdgcn_sqrtf(fmaxf(one_minus_exp(2.0f * l), 0.f)) * gi * xc[i]; }
        *(u32x4*)(LA + off) = pack8(r); *(u32x4*)(UU + off) = pack8(ig);
    }
}

__device__ __forceinline__ int img_off(int nkg, int row, int kcol) { const int ob = (row & 15) * 64 + (kcol & 31) * 2; return ((row >> 4) * nkg + (kcol >> 5)) * 1024 + (ob ^ (((ob >> 9) & 1) << 5)); }
__device__ __forceinline__ bf16x8 ldfrag(const LAS unsigned char* img, int nkg, int row, int kcol) { return *(const LAS bf16x8*)(img + img_off(nkg, row, kcol)); }
#define MFMA16(a, b, c) __builtin_amdgcn_mfma_f32_16x16x32_bf16((a), (b), (c), 0, 0, 0)

__device__ __forceinline__ void phase_gla_scan(const Ctx cx, const Args& a, int g, LAS unsigned char* lds) {
    constexpr int XB = 57344, OFF_KI = 16384, OFF_KET = 32768, OFF_VT = 49152, OFF_P = 2 * XB, OFF_ST = OFF_P + 8192, OFF_BL = OFF_ST + 2 * 16384;
    static_assert(OFF_BL + 1024 <= LDS_BYTES, "gla scan LDS");
    const int tid = cx.tid, lane = tid & 63, w = tid >> 6, fr = lane & 15, fq = lane >> 4;
    const bf16_t* QDg = (const bf16_t*)(a.ws + WS_QD); const bf16_t* KIg = (const bf16_t*)(a.ws + WS_KI); const bf16_t* KETg = (const bf16_t*)(a.ws + WS_KET);
    const bf16_t* VTg = (const bf16_t*)(a.ws + WS_VT); const float* BLg = (const float*)(a.ws + WS_BL);
    bf16_t* Og = (bf16_t*)(a.ws + WS_OFB);
    for (int item = cx.bid; item < BG * 32; item += cx.G) {
        const int dvq = item & 3, dir = (item >> 2) & 1, h = (item >> 3) & 3, b = item >> 5;
        { u32x4 z = {0u, 0u, 0u, 0u}; *(LAS u32x4*)(lds + OFF_ST + tid * 32) = z; *(LAS u32x4*)(lds + OFF_ST + tid * 32 + 16) = z; }
        f32x4 accS[4];
#pragma unroll
        for (int t = 0; t < 4; ++t) accS[t] = (f32x4){0.f, 0.f, 0.f, 0.f};
        u32x4 pq[2], pk[2], pe[2], pv; float pbl = 0.f;
#define GLA_LOAD(s_) do { const int c_ = dir == 0 ? (s_) : ((s_) < 4 ? 3 - (s_) : 39 - (s_)); \
            const size_t tb_ = (((size_t)dir * BG + b) * NCH + c_) * 4 + h; \
            if (c_ >= 4) { pq[0] = ((const u32x4*)(QDg + tb_ * 8192))[tid]; pq[1] = ((const u32x4*)(QDg + tb_ * 8192))[tid + 512]; \
                           pk[0] = ((const u32x4*)(KIg + tb_ * 8192))[tid]; pk[1] = ((const u32x4*)(KIg + tb_ * 8192))[tid + 512]; } \
            pe[0] = ((const u32x4*)(KETg + tb_ * 8192))[tid]; pe[1] = ((const u32x4*)(KETg + tb_ * 8192))[tid + 512]; \
            pv = ((const u32x4*)(VTg + ((((size_t)b * NCH + c_) * 4 + h) * 256 + dvq * 64) * 64))[tid]; \
            if (tid < 128) pbl = BLg[tb_ * 128 + tid]; } while (0)
#define GLA_STORE(buf_) do { LAS unsigned char* X_ = lds + (buf_) * XB; \
            _Pragma("unroll") for (int i_ = 0; i_ < 2; ++i_) { const int p_ = tid + 512 * i_; \
                *(LAS u32x4*)(X_ + img_off(4, p_ >> 4, (p_ & 15) * 8)) = pq[i_]; *(LAS u32x4*)(X_ + OFF_KI + img_off(4, p_ >> 4, (p_ & 15) * 8)) = pk[i_]; \
                *(LAS u32x4*)(X_ + OFF_KET + img_off(2, p_ >> 3, (p_ & 7) * 8)) = pe[i_]; } \
            *(LAS u32x4*)(X_ + OFF_VT + img_off(2, tid >> 3, (tid & 7) * 8)) = pv; \
            if (tid < 128) ((LAS float*)(lds + OFF_BL + (buf_) * 512))[tid] = pbl; } while (0)
        pq[0] = pq[1] = pk[0] = pk[1] = (u32x4){0u, 0u, 0u, 0u};
        GLA_LOAD(0); GLA_STORE(0);
        __syncthreads();
        for (int s = 0; s < NCH; ++s) {
            const int cur = s & 1; const bool lat = s >= 4;
            const LAS unsigned char* X = lds + cur * XB;
#ifndef GLA_SAFE
            if (s + 1 < NCH) GLA_LOAD(s + 1);
#endif
            if (lat) {
                const int ti = w >> 1, tj0 = (w & 1) * 2;
                f32x4 sc[2] = {(f32x4){0.f, 0.f, 0.f, 0.f}, (f32x4){0.f, 0.f, 0.f, 0.f}};
#pragma unroll
                for (int kk = 0; kk < 4; ++kk) { const bf16x8 qa = ldfrag(X, 4, 16 * ti + fr, kk * 32 + fq * 8);
#pragma unroll
                    for (int t = 0; t < 2; ++t) { const bf16x8 kb = ldfrag(X + OFF_KI, 4, 16 * (tj0 + t) + fr, kk * 32 + fq * 8); sc[t] = MFMA16(qa, kb, sc[t]); } }
#pragma unroll
                for (int t = 0; t < 2; ++t)
#pragma unroll
                    for (int jj = 0; jj < 4; ++jj) { const int i = 16 * ti + 4 * fq + jj, j = 16 * (tj0 + t) + fr;
                        const bool keep = dir == 0 ? (j <= i) : (j > i);
                        *(LAS bf16_t*)(lds + OFF_P + img_off(2, i, j)) = f2bf(keep ? sc[t][jj] : 0.f); }
            }
            __syncthreads();
            const int te = w >> 1;
            if (lat) {
                const int c = dir == 0 ? s : 39 - s;
                const LAS unsigned char* STc = lds + OFF_ST + cur * 16384;
                f32x4 oc[2] = {(f32x4){0.f, 0.f, 0.f, 0.f}, (f32x4){0.f, 0.f, 0.f, 0.f}};
#pragma unroll
                for (int kk = 0; kk < 2; ++kk) { const bf16x8 va = ldfrag(X + OFF_VT, 2, 16 * te + fr, kk * 32 + fq * 8);
#pragma unroll
                    for (int t = 0; t < 2; ++t) { const bf16x8 pb = ldfrag(lds + OFF_P, 2, 16 * ((w & 1) * 2 + t) + fr, kk * 32 + fq * 8); oc[t] = MFMA16(va, pb, oc[t]); } }
#pragma unroll
                for (int kk = 0; kk < 4; ++kk) { const bf16x8 sa = ldfrag(STc, 4, 16 * te + fr, kk * 32 + fq * 8);
#pragma unroll
                    for (int t = 0; t < 2; ++t) { const bf16x8 qb = ldfrag(X, 4, 16 * ((w & 1) * 2 + t) + fr, kk * 32 + fq * 8); oc[t] = MFMA16(sa, qb, oc[t]); } }
#pragma unroll
                for (int t = 0; t < 2; ++t) { const int i = 16 * ((w & 1) * 2 + t) + fr; const size_t row = (size_t)b * T + (size_t)(c - 4) * 64 + i;
                    u32x2 o2; o2.x = cvt_pk_bf16(oc[t][0], oc[t][1]); o2.y = cvt_pk_bf16(oc[t][2], oc[t][3]);
                    *(u32x2*)(Og + ((size_t)dir * RL + row) * D + h * 256 + dvq * 64 + 16 * te + 4 * fq) = o2; }
            }
#ifdef GLA_SAFE
            __syncthreads();
#endif
            {
                const LAS float* blp = (const LAS float*)(lds + OFF_BL + cur * 512);
                LAS unsigned char* STn = lds + OFF_ST + (cur ^ 1) * 16384;
                bf16x8 vb[2];
#pragma unroll
                for (int kk = 0; kk < 2; ++kk) vb[kk] = ldfrag(X + OFF_VT, 2, 16 * te + fr, kk * 32 + fq * 8);
#pragma unroll
                for (int t = 0; t < 4; ++t) { const int td = (w & 1) * 4 + t;
#pragma unroll
                    for (int jj = 0; jj < 4; ++jj) accS[t][jj] *= __expf(blp[16 * td + 4 * fq + jj]);
#pragma unroll
                    for (int kk = 0; kk < 2; ++kk) { const bf16x8 ka = ldfrag(X + OFF_KET, 2, 16 * td + fr, kk * 32 + fq * 8); accS[t] = MFMA16(ka, vb[kk], accS[t]); }
                    u32x2 s2; s2.x = cvt_pk_bf16(accS[t][0], accS[t][1]); s2.y = cvt_pk_bf16(accS[t][2], accS[t][3]);
                    *(LAS u32x2*)(STn + img_off(4, 16 * te + fr, 16 * td + 4 * fq)) = s2; }
            }
#ifdef GLA_SAFE
            __syncthreads();
            if (s + 1 < NCH) { GLA_LOAD(s + 1); GLA_STORE(cur ^ 1); }
#else
            if (s + 1 < NCH) GLA_STORE(cur ^ 1);
#endif
            __syncthreads();
        }
#undef GLA_LOAD
#undef GLA_STORE
    }
}

__device__ __forceinline__ void phase_lru_scan(const Ctx cx, const Args& a, int g, LAS unsigned char* lds) {
    const int lane = cx.tid & 63, w = cx.tid >> 6;
    LAS f32x2* agg = (LAS f32x2*)lds;
    const float* GC = (const float*)(a.ws + WS_GC);
    for (int item = cx.bid; item < BG * 32; item += cx.G) {
        const int cgp = item & 15, dir = (item >> 4) & 1, b = item >> 5, ch = cgp * 64 + lane;
        const bf16_t* RR = (const bf16_t*)(a.ws + WS_LA) + (size_t)dir * RG * D + ch; const bf16_t* II = (const bf16_t*)(a.ws + WS_UU) + (size_t)dir * RG * D + ch;
        const bf16_t* XCp = (const bf16_t*)(a.ws + WS_XC) + ch;
        bf16_t* Hd = (bf16_t*)(a.ws + WS_HFB) + (size_t)dir * RL * D + ch;
        const float cbr = GC[dir * D + ch], cbi = GC[(2 + dir) * D + ch], csp = GC[(4 + dir) * D + ch];
#define LRU_ROW(s_) ((s_) < CL ? RL + b * CL + (dir ? CL - 1 - (s_) : (s_)) : b * T + (dir ? T - 1 - ((s_) - CL) : (s_) - CL))
#define LRU_GATES(k_) const float l_ = -csp * sigmoidf_(bf2f(rr[k_]) + cbr); const float av = __expf(l_); \
            const float uv = __builtin_amdgcn_sqrtf(fmaxf(one_minus_exp(2.0f * l_), 0.f)) * sigmoidf_(bf2f(ii[k_]) + cbi) * bf2f(xx[k_]);
        float A = 1.f, Z = 0.f;
        for (int blk = 0; blk < 18; ++blk) { const int s0 = 288 * w + 16 * blk; bf16_t rr[16], ii[16], xx[16];
#pragma unroll
            for (int k = 0; k < 16; ++k) { const size_t r = (size_t)LRU_ROW(s0 + k); rr[k] = RR[r * D]; ii[k] = II[r * D]; xx[k] = XCp[r * D]; }
#pragma unroll
            for (int k = 0; k < 16; ++k) { LRU_GATES(k) Z = av * Z + uv; A *= av; } }
        agg[w * 64 + lane] = (f32x2){A, Z};
        __syncthreads();
        float hst = 0.f;
#pragma unroll
        for (int w2 = 0; w2 < 7; ++w2) { const f32x2 p = agg[w2 * 64 + lane]; if (w2 < w) hst = p.x * hst + p.y; }
        for (int blk = 0; blk < 18; ++blk) { const int s0 = 288 * w + 16 * blk; bf16_t rr[16], ii[16], xx[16];
#pragma unroll
            for (int k = 0; k < 16; ++k) { const size_t r = (size_t)LRU_ROW(s0 + k); rr[k] = RR[r * D]; ii[k] = II[r * D]; xx[k] = XCp[r * D]; }
#pragma unroll
            for (int k = 0; k < 16; ++k) { LRU_GATES(k) hst = av * hst + uv;
                if (s0 + k >= CL) Hd[(size_t)LRU_ROW(s0 + k) * D] = f2bf(hst); } }
        __syncthreads();
#undef LRU_ROW
#undef LRU_GATES
    }
}

__device__ __forceinline__ void phase_post(const Ctx cx, const Args& a, LAS unsigned char* lds, int g) {
    const int lane = cx.tid & 63;
    const bf16_t* PROJ = (const bf16_t*)(a.ws + WS_BIG);
    bf16_t* O0 = (bf16_t*)(a.ws + WS_OFB); const bf16_t* O1 = O0 + (size_t)RL * D;
    bf16_t* H0 = (bf16_t*)(a.ws + WS_HFB); const bf16_t* H1b = H0 + (size_t)RL * D;
    const float* gnw = AIN(I_GNW);
    for (int r = GW(); r < RL; r += NGW()) {
        const size_t off = (size_t)r * D + lane * 16;
        float o[16], t[8]; float ss = 0.f;
#pragma unroll
        for (int hf = 0; hf < 2; ++hf) { float x0[8], x1[8]; unpack8(*(const u32x4*)(O0 + off + 8 * hf), x0); unpack8(*(const u32x4*)(O1 + off + 8 * hf), x1);
#pragma unroll
            for (int i = 0; i < 8; ++i) { o[8 * hf + i] = x0[i] + x1[i]; ss += o[8 * hf + i] * o[8 * hf + i]; } }
        ss += __shfl_xor(ss, 1); ss += __shfl_xor(ss, 2); ss += __shfl_xor(ss, 4); ss += __shfl_xor(ss, 8);
        const float rstd = 1.0f / sqrtf(ss * (1.0f / 256.0f) + EPS);
#pragma unroll
        for (int hf = 0; hf < 2; ++hf) { float gg[8]; unpack8(*(const u32x4*)(PROJ + (size_t)r * PN + PGG + lane * 16 + 8 * hf), gg);
#pragma unroll
            for (int i = 0; i < 8; ++i) t[i] = o[8 * hf + i] * rstd * gnw[(lane & 15) * 16 + 8 * hf + i] * siluf_(gg[i]);
            *(u32x4*)(O0 + off + 8 * hf) = pack8(t); }
#pragma unroll
        for (int hf = 0; hf < 2; ++hf) { float x0[8], x1[8], yl[8]; unpack8(*(const u32x4*)(H0 + off + 8 * hf), x0); unpack8(*(const u32x4*)(H1b + off + 8 * hf), x1);
            unpack8(*(const u32x4*)(PROJ + (size_t)r * PN + PYL + lane * 16 + 8 * hf), yl);
#pragma unroll
            for (int i = 0; i < 8; ++i) t[i] = (x0[i] + x1[i]) * geluf_(yl[i]);
            *(u32x4*)(H0 + off + 8 * hf) = pack8(t); }
    }
}


#define XB_TMO      128
#define XB_XCNT(j)  (256  + 64 * (j))
#define XB_XSUB(j)  (1280 + 64 * (j))
#define XB_XGEN(j)  (2304 + 64 * (j))
#define XB_TOP      3328
#define XB_TOPGEN   3392
#define XCD_BAR_WORDS 3456
#define XB_SPIN_CAP (1u << 22)
__device__ __forceinline__ unsigned xb_ld(unsigned* p)              { return __hip_atomic_load(p, __ATOMIC_RELAXED, __HIP_MEMORY_SCOPE_AGENT); }
__device__ __forceinline__ unsigned xb_add(unsigned* p, unsigned v) { return __hip_atomic_fetch_add(p, v, __ATOMIC_RELAXED, __HIP_MEMORY_SCOPE_AGENT); }
__device__ __forceinline__ unsigned xb_xcc_id() { return (unsigned)__builtin_amdgcn_s_getreg((3 << 11) | 20) & 0xFu; }
#define XB_SPIN(cond, bar) do { unsigned _sp = 0; while (cond) { __builtin_amdgcn_s_sleep(1); \
    if ((++_sp & 255u) == 0u) { if (xb_ld(&(bar)[XB_TMO])) break; if (_sp > XB_SPIN_CAP) { atomicAdd(&(bar)[XB_TMO], 1u); break; } } } } while (0)
__device__ __forceinline__ void xcd_barrier_complete(unsigned* bar, unsigned x, unsigned G, unsigned& nloc, unsigned& nx) {
    unsigned sum, cnt, mine, sp = 0u;
    for (;;) {
        sum = 0u; cnt = 0u; mine = 0u;
#pragma unroll
        for (unsigned j = 0; j < 16; ++j) { const unsigned c = xb_ld(&bar[XB_XCNT(j)]); sum += c; cnt += (c > 0u) ? 1u : 0u; mine = (j == x) ? c : mine; }
        if (sum == G) break;
        __builtin_amdgcn_s_sleep(1);
        if ((++sp & 255u) == 0u) { if (xb_ld(&bar[XB_TMO])) break; if (sp > XB_SPIN_CAP) { atomicAdd(&bar[XB_TMO], 1u); break; } }
    }
    nloc = mine > 0u ? mine : 1u; nx = cnt > 0u ? cnt : 1u;
}
__device__ __forceinline__ void xcd_barrier(unsigned* bar, volatile LAS unsigned* st, int tid, unsigned G) {
    asm volatile("s_waitcnt vmcnt(0)" ::: "memory");
    __syncthreads();
    if (tid == 0) {
        __builtin_amdgcn_s_waitcnt(0);
        const unsigned x = xb_xcc_id();
        unsigned nloc = st[0], nx = st[1];
        if (nloc == 0u) { xcd_barrier_complete(bar, x, G, nloc, nx); st[0] = nloc; st[1] = nx; }
        const unsigned old = xb_add(&bar[XB_XSUB(x)], 1u);
        const unsigned gen = old / nloc;
        if (old + 1u == (gen + 1u) * nloc) {
            __builtin_amdgcn_fence(__ATOMIC_RELEASE, "agent");
            asm volatile("s_waitcnt vmcnt(0)" ::: "memory");
            const unsigned og = xb_add(&bar[XB_TOP], 1u);
            const unsigned tg = og / nx;
            if (og + 1u == (tg + 1u) * nx) xb_add(&bar[XB_TOPGEN], 1u);
            else XB_SPIN(xb_ld(&bar[XB_TOPGEN]) == tg, bar);
            __builtin_amdgcn_fence(__ATOMIC_ACQUIRE, "agent");
            xb_add(&bar[XB_XGEN(x)], 1u);
            asm volatile("s_waitcnt vmcnt(0)" ::: "memory");
        } else {
            XB_SPIN(xb_ld(&bar[XB_XGEN(x)]) == gen, bar);
            __builtin_amdgcn_fence(__ATOMIC_ACQUIRE, "agent");
            asm volatile("s_waitcnt vmcnt(0)" ::: "memory");
        }
    }
    __syncthreads();
}

constexpr int NPH = 17;
#ifndef USE_CG_ALL
#define USE_CG_ALL 0
#endif
#if ONE_LAUNCH
#define GRID_SYNC(k) do { if ((k) == 1 || USE_CG_ALL) cg::this_grid().sync(); else xcd_barrier((unsigned*)ws + 4096, (volatile LAS unsigned*)(lds + PTAB + 256), cx.tid, (unsigned)cx.G); } while (0)
#else
#define GRID_SYNC(k) do {} while (0)
#endif
#define STEP_BEGIN(k) if (a.lo <= (k) && (k) < a.hi) { \
        Ctx cx; { int t_ = wave_s * 64 + (int)__builtin_amdgcn_mbcnt_hi(~0u, __builtin_amdgcn_mbcnt_lo(~0u, 0u)), b_ = blockIdx.x, g_ = gridDim.x; asm volatile("" : "+v"(t_)); asm volatile("" : "+s"(b_), "+s"(g_)); cx.tid = t_; cx.bid = b_; cx.G = g_; } \
        const int G = cx.G, cidx = cx.bid; (void)G; (void)cidx; \
        unsigned char* ws = a.ws; asm volatile("" : "+s"(ws)); \
        if ((k) > a.lo) GRID_SYNC(k); \
        const float* MOD = (const float*)(ws + WS_MOD); float* H1 = (float*)(ws + WS_H1); bf16_t* U = (bf16_t*)(ws + WS_U); bf16_t* BIG = (bf16_t*)(ws + WS_BIG); bf16_t* XC = (bf16_t*)(ws + WS_XC); \
        (void)MOD; (void)H1; (void)U; (void)BIG; (void)XC; pg8::StaticOrder S; (void)S;
#define STEP_END }

template <int g>
__device__ __forceinline__ void run_group(const Args& a, LAS unsigned char* lds, const int wave_s) {
    constexpr int s0 = 5 + g * NPH;
    const float* H1r = (const float*)(a.ws + WS_H1); const float* H1Cr = (const float*)(a.ws + WS_H1C) + (size_t)g * RC * D;
    if (g == 0) { STEP_BEGIN(s0 + 0) if (PHON(0)) phase_normmod(cx, a, lds, AIN(I_X), nullptr, RL, RL, 0, 0); STEP_END }
    STEP_BEGIN(s0 + 1) if (PHON(1)) { pg8::Gemm gm{U, (const bf16_t*)(ws + WS_WI1), RL, 2 * FH, D, D, D, 0, 0}; S.init(RL, 2 * FH, G, cidx);
                  pg8::EpiSwiglu E{BIG, FH}; pg8::gemm_phase<pg8::EpiSwiglu, true>(cx.tid, lds, gm, S, E); } STEP_END
    STEP_BEGIN(s0 + 2) if (PHON(2)) { pg8::Gemm gm{BIG, (const bf16_t*)(ws + WS_WO1), RL, D, FH, FH, FH, 0, 0}; S.init(RL, D, G, cidx);
                  pg8::EpiResid E{AIN(I_X) + (size_t)g * RL * D, AIN(I_CTX) + (size_t)g * RC * D, H1, H1 + (size_t)RL * D,
                                  MOD + (size_t)(g * BG) * NMOD + 2 * D, MOD + (size_t)32 * NMOD + 2 * D, 0.5f, RL / 256};
                  pg8::gemm_phase<pg8::EpiResid, true>(cx.tid, lds, gm, S, E); } STEP_END
    STEP_BEGIN(s0 + 3) if (PHON(3)) phase_normmod(cx, a, lds, H1r, H1Cr, RL, RG, g * BG, 1); STEP_END
    STEP_BEGIN(s0 + 4) if (PHON(4)) { pg8::Gemm gm{U, (const bf16_t*)(ws + WS_WIN), RG, PN, D, D, D, 0, 0}; S.init(RL, PN, G, cidx); S.ext = (RC / 256) * 11; S.ext_pm0 = RL / 256;
                  pg8::EpiBf16 E{BIG, PN}; pg8::gemm_phase<pg8::EpiBf16, true>(cx.tid, lds, gm, S, E); } STEP_END
    STEP_BEGIN(s0 + 5) if (PHON(5)) phase_prep(cx, a, g, lds); STEP_END
    STEP_BEGIN(s0 + 6) if (PHON(6)) { pg8::Gemm gm{XC, (const bf16_t*)(ws + WS_WLG), RG, 4096, 128, D, 128, 1, 256}; S.init(RG, 4096, G, cidx);
                  pg8::EpiGate E{(bf16_t*)(ws + WS_LA), (bf16_t*)(ws + WS_UU)};
                  pg8::gemm_phase<pg8::EpiGate, true>(cx.tid, lds, gm, S, E); } STEP_END
    STEP_BEGIN(s0 + 7) if (PHON(7)) { phase_gla_scan(cx, a, g, lds); } STEP_END
    STEP_BEGIN(s0 + 8) if (PHON(8)) phase_lru_scan(cx, a, g, lds); STEP_END
    STEP_BEGIN(s0 + 9) if (PHON(9)) phase_post(cx, a, lds, g); STEP_END
    STEP_BEGIN(s0 + 10) if (PHON(10)) { pg8::Gemm gm{(const bf16_t*)(ws + WS_OFB), (const bf16_t*)(ws + WS_WOG), RL, D, D, D, D, 0, 0}; S.init(RL, D, G, cidx);
                   pg8::EpiMix<false> E{BIG, PGA, XC}; pg8::gemm_phase<pg8::EpiMix<false>, true>(cx.tid, lds, gm, S, E); } STEP_END
    STEP_BEGIN(s0 + 11) if (PHON(11)) { pg8::Gemm gm{(const bf16_t*)(ws + WS_HFB), (const bf16_t*)(ws + WS_WOL), RL, D, D, D, D, 0, 0}; S.init(RL, D, G, cidx);
                   pg8::EpiMix<true> E{BIG, PGB, XC}; pg8::gemm_phase<pg8::EpiMix<true>, true>(cx.tid, lds, gm, S, E); } STEP_END
    STEP_BEGIN(s0 + 12) if (PHON(12)) { pg8::Gemm gm{XC, (const bf16_t*)(ws + WS_WOO), RL, D, D, D, D, 0, 0}; S.init(RL, D, G, cidx);
                   pg8::EpiResid E{H1, H1, H1, H1, MOD + (size_t)(g * BG) * NMOD + 5 * D, MOD, 1.0f, RL / 256};
                   pg8::gemm_phase<pg8::EpiResid, true>(cx.tid, lds, gm, S, E); } STEP_END
    STEP_BEGIN(s0 + 13) if (PHON(13)) phase_normmod(cx, a, lds, H1r, nullptr, RL, RL, g * BG, 2); STEP_END
    STEP_BEGIN(s0 + 14) if (PHON(14)) { pg8::Gemm gm{U, (const bf16_t*)(ws + WS_WI2), RL, 2 * FH, D, D, D, 0, 0}; S.init(RL, 2 * FH, G, cidx);
                   pg8::EpiSwiglu E{BIG, FH}; pg8::gemm_phase<pg8::EpiSwiglu, true>(cx.tid, lds, gm, S, E); } STEP_END
    STEP_BEGIN(s0 + 15) if (PHON(15)) { pg8::Gemm gm{BIG, (const bf16_t*)(ws + WS_WO2), RL, D, FH, FH, FH, 0, 0}; S.init(RL, D, G, cidx);
                   float* og = a.out + (size_t)g * RL * D;
                   pg8::EpiResid E{H1, H1, og, og, MOD + (size_t)(g * BG) * NMOD + 8 * D, MOD, 0.5f, RL / 256};
                   pg8::gemm_phase<pg8::EpiResid, true>(cx.tid, lds, gm, S, E); } STEP_END
    STEP_BEGIN(s0 + 16) if (PHON(16)) { phase_final(cx, a, lds, g); if (g + 1 < NG) phase_normmod(cx, a, lds, AIN(I_X) + (size_t)(g + 1) * RL * D, nullptr, RL, RL, (g + 1) * BG, 0); } STEP_END
}

__global__ void __launch_bounds__(NTHR, 2) fwd_kernel(Args a) {
    extern __shared__ __attribute__((aligned(16))) unsigned char lds_raw[];
    LAS unsigned char* lds = (LAS unsigned char*)lds_raw;
    if (threadIdx.x < 26) ((LAS unsigned long long*)(lds + PTAB))[threadIdx.x] = (unsigned long long)a.in[threadIdx.x];
    if (threadIdx.x == 32) { ((LAS unsigned*)(lds + PTAB + 256))[0] = 0u; ((LAS unsigned*)(lds + PTAB + 256))[1] = 0u; }
#if ONE_LAUNCH
    if (threadIdx.x == 0) (void)xb_add((unsigned*)a.ws + 4096 + XB_XCNT(xb_xcc_id()), 1u);
#endif
    const int wave_s = __builtin_amdgcn_readfirstlane(threadIdx.x >> 6);
    __syncthreads();
    STEP_BEGIN(0) if (PHON(17)) phase_weights(cx, a, lds); STEP_END
    STEP_BEGIN(1) if (PHON(18)) phase_modreduce(cx, a, lds); STEP_END
    STEP_BEGIN(2) if (PHON(0)) phase_normmod(cx, a, lds, nullptr, AIN(I_CTX), 0, NB * CL, 0, 0); STEP_END
    STEP_BEGIN(3) if (PHON(1)) { pg8::Gemm gm{U, (const bf16_t*)(ws + WS_WI1), NB * CL, 2 * FH, D, D, D, 0, 0}; S.init(NB * CL, 2 * FH, G, cidx);
                  pg8::EpiSwiglu E{BIG, FH}; pg8::gemm_phase<pg8::EpiSwiglu, true>(cx.tid, lds, gm, S, E); } STEP_END
    STEP_BEGIN(4) if (PHON(2)) { pg8::Gemm gm{BIG, (const bf16_t*)(ws + WS_WO1), NB * CL, D, FH, FH, FH, 0, 0}; S.init(NB * CL, D, G, cidx);
                  float* h1c = (float*)(ws + WS_H1C);
                  pg8::EpiResid E{AIN(I_CTX), AIN(I_CTX), h1c, h1c, MOD, MOD + (size_t)32 * NMOD + 2 * D, 0.5f, 0};
                  pg8::gemm_phase<pg8::EpiResid, true>(cx.tid, lds, gm, S, E); } STEP_END
    run_group<0>(a, lds, wave_s);
    run_group<1>(a, lds, wave_s);
    run_group<2>(a, lds, wave_s);
    run_group<3>(a, lds, wave_s);
}


#ifdef PROBE_STEP
__global__ void probe_kernel(const unsigned char* ws, float* out) {
    const size_t n = (size_t)65536 * 1024, q = n / 4;
    const bf16_t* r0 = (const bf16_t*)(ws + PROBE_R0); const bf16_t* r1 = (const bf16_t*)(ws + PROBE_R1); const bf16_t* r2 = (const bf16_t*)(ws + PROBE_R2); const bf16_t* r3 = (const bf16_t*)(ws + PROBE_R3);
    for (size_t i = (size_t)blockIdx.x * blockDim.x + threadIdx.x; i < q; i += (size_t)gridDim.x * blockDim.x) {
        out[i] = bf2f(r0[i]); out[q + i] = bf2f(r1[i]); out[2 * q + i] = bf2f(r2[i]); out[3 * q + i] = bf2f(r3[i]); }
}
#endif
extern "C" void kernel_launch(void* const* d_in, const int* in_sizes, int n_in, void* d_out, int out_size, void* d_ws, size_t ws_size, hipStream_t stream) {
    static int grid = 0;
    if (grid == 0) {
        if (n_in != 26 || ws_size < WS_END) { fprintf(stderr, "kernel_launch: unexpected inputs (n_in %d, ws %zu, need %zu)\n", n_in, ws_size, (size_t)WS_END); grid = -1; return; }
        int dev = 0, cus = 0, per_cu = 0;
        hipGetDevice(&dev); hipDeviceGetAttribute(&cus, hipDeviceAttributeMultiprocessorCount, dev);
        if (hipFuncSetAttribute((const void*)fwd_kernel, hipFuncAttributeMaxDynamicSharedMemorySize, LDS_BYTES) != hipSuccess) { fprintf(stderr, "kernel_launch: hipFuncSetAttribute failed\n"); grid = -1; return; }
        hipOccupancyMaxActiveBlocksPerMultiprocessor(&per_cu, (const void*)fwd_kernel, NTHR, LDS_BYTES);
        (void)hipGetLastError();
        if (per_cu < 1) per_cu = 1;
        grid = cus * 1;
    }
    if (grid < 0) return;
    Args a{};
    for (int i = 0; i < 26; ++i) a.in[i] = (const float*)d_in[i];
    a.out = (float*)d_out; a.ws = (unsigned char*)d_ws;
    const int nsteps = 5 + NG * NPH;
#if ONE_LAUNCH
    (void)hipMemsetAsync(d_ws, 0, 65536, stream);
    a.lo = 0; a.hi = nsteps;
    void* args[] = {&a};
    hipError_t e = hipLaunchCooperativeKernel((const void*)fwd_kernel, dim3(grid), dim3(NTHR), args, LDS_BYTES, stream);
    if (e != hipSuccess) fprintf(stderr, "cooperative launch failed: %s (grid %d)\n", hipGetErrorString(e), grid);
#else
#ifdef PROBE_STEP
    for (int s = 0; s <= PROBE_STEP; ++s) { a.lo = s; a.hi = s + 1; hipLaunchKernelGGL(fwd_kernel, dim3(grid), dim3(NTHR), LDS_BYTES, stream, a); }
    hipLaunchKernelGGL(probe_kernel, dim3(2048), dim3(256), 0, stream, (const unsigned char*)d_ws, (float*)d_out);
#else
    for (int s = 0; s < nsteps; ++s) { a.lo = s; a.hi = s + 1; hipLaunchKernelGGL(fwd_kernel, dim3(grid), dim3(NTHR), LDS_BYTES, stream, a); }
#endif
#endif
}
```

```cpp
#include <hip/hip_runtime.h>
#include <hip/hip_cooperative_groups.h>
#include <cstdio>
#include <cstdint>
namespace cg = cooperative_groups;

#ifndef ONE_LAUNCH
#define ONE_LAUNCH 1
#endif

#ifndef PHMASK
#define PHMASK 0x1fffff
#endif
#define PHON(n) (((PHMASK) >> (n)) & 1)
#define LAS __attribute__((address_space(3)))
typedef unsigned short bf16_t;
typedef short bf16x8 __attribute__((ext_vector_type(8)));
typedef float f32x4 __attribute__((ext_vector_type(4)));
typedef float f32x2 __attribute__((ext_vector_type(2)));
typedef unsigned u32x4 __attribute__((ext_vector_type(4)));
typedef unsigned u32x2 __attribute__((ext_vector_type(2)));

constexpr int D = 1024, NB = 32, T = 2048, CL = 256, FH = 2816, INW = 7200, PN = 7424, NMOD = 9216;
constexpr int NG = 4, BG = NB / NG;
constexpr int RL = BG * T, RC = BG * CL, RG = RL + RC;
constexpr int NCH = 36;
constexpr float EPS = 1e-6f;
constexpr int PQ = 0, PK = 512, PV = 1024, PGG = 2048, PXL = 3072, PYL = 4096, PGA = 5120, PGB = 6144, PFD = 7168;

constexpr size_t al(size_t x) { return (x + 4095) & ~(size_t)4095; }
constexpr size_t WS_WI1 = 1 << 20;
constexpr size_t WS_WO1 = WS_WI1 + al((size_t)2 * FH * D * 2);
constexpr size_t WS_WI2 = WS_WO1 + al((size_t)D * FH * 2);
constexpr size_t WS_WO2 = WS_WI2 + al((size_t)2 * FH * D * 2);
constexpr size_t WS_WIN = WS_WO2 + al((size_t)D * FH * 2);
constexpr size_t WS_WOG = WS_WIN + al((size_t)PN * D * 2);
constexpr size_t WS_WOL = WS_WOG + al((size_t)D * D * 2);
constexpr size_t WS_WOO = WS_WOL + al((size_t)D * D * 2);
constexpr size_t WS_WLG = WS_WOO + al((size_t)D * D * 2);
constexpr size_t WS_MODP = WS_WLG + al((size_t)4096 * 128 * 2);
constexpr size_t WS_MOD = WS_MODP + al((size_t)16 * 33 * NMOD * 4);
constexpr size_t WS_GC = WS_MOD + al((size_t)33 * NMOD * 4);
constexpr size_t WS_H1 = WS_GC + al((size_t)6 * D * 4);
constexpr size_t WS_U = WS_H1 + al((size_t)RG * D * 4);
constexpr size_t WS_BIG = WS_U + al((size_t)RG * D * 2);
constexpr size_t WS_XC = WS_BIG + al((size_t)RG * PN * 2);
constexpr size_t WS_LA = WS_XC + al((size_t)RG * D * 2);
constexpr size_t WS_UU = WS_LA + al((size_t)2 * RG * D * 2);
constexpr size_t WS_HFB = WS_UU + al((size_t)2 * RG * D * 2);
constexpr size_t WS_OFB = WS_HFB + al((size_t)2 * RL * D * 2);
constexpr size_t GT = (size_t)2 * BG * NCH * 4;
constexpr size_t WS_QD = WS_OFB + al((size_t)2 * RL * D * 2);
constexpr size_t WS_KI = WS_QD + al(GT * 8192 * 2);
constexpr size_t WS_KET = WS_KI + al(GT * 8192 * 2);
constexpr size_t WS_VT = WS_KET + al(GT * 8192 * 2);
constexpr size_t WS_BL = WS_VT + al((size_t)BG * NCH * 4 * 16384 * 2);
constexpr size_t WS_H1C = WS_BL + al(GT * 128 * 4);
constexpr size_t WS_END = WS_H1C + al((size_t)NB * CL * D * 4);
static_assert(WS_END <= (size_t)1073741824, "workspace map exceeds 1 GiB");

constexpr int LDS_BYTES = 163840, PTAB = LDS_BYTES - 512;

typedef __bf16 bf16x2_t __attribute__((ext_vector_type(2)));
__device__ __forceinline__ unsigned cvt_pk_bf16(float lo, float hi) { const f32x2 v = {lo, hi}; return __builtin_bit_cast(unsigned, __builtin_convertvector(v, bf16x2_t)); }
__device__ __forceinline__ bf16_t f2bf(float f) { return (bf16_t)(cvt_pk_bf16(f, 0.f) & 0xffffu); }
__device__ __forceinline__ float bf2f(bf16_t h) { return __uint_as_float(((unsigned)h) << 16); }
__device__ __forceinline__ float bflo(unsigned w) { return __uint_as_float(w << 16); }
__device__ __forceinline__ float bfhi(unsigned w) { return __uint_as_float(w & 0xffff0000u); }
__device__ __forceinline__ float sigmoidf_(float x) { return __builtin_amdgcn_rcpf(1.0f + __expf(-x)); }
__device__ __forceinline__ float siluf_(float x) { return x * __builtin_amdgcn_rcpf(1.0f + __expf(-x)); }
__device__ __forceinline__ float geluf_(float x) { const float z = 0.7978845608028654f * (x + 0.044715f * x * x * x); return x * (1.0f - __builtin_amdgcn_rcpf(1.0f + __expf(2.0f * z))); }
__device__ __forceinline__ float logsigf_(float x) { return fminf(x, 0.f) - log1pf(__expf(-fabsf(x))); }
__device__ __forceinline__ float one_minus_exp(float x) {
    const float ser = -x * (1.0f + x * (0.5f + x * (0.16666667f + x * (0.041666668f + x * (0.0083333338f + x * (0.0013888889f + x * 0.0001984127f))))));
    return x > -0.3f ? ser : 1.0f - __expf(x);
}
__device__ __forceinline__ float wave_sum(float v) {
#pragma unroll
    for (int o = 1; o < 64; o <<= 1) v += __shfl_xor(v, o);
    return v;
}
__device__ __forceinline__ void unpack8(const u32x4 w, float (&f)[8]) {
    f[0] = bflo(w.x); f[1] = bfhi(w.x); f[2] = bflo(w.y); f[3] = bfhi(w.y); f[4] = bflo(w.z); f[5] = bfhi(w.z); f[6] = bflo(w.w); f[7] = bfhi(w.w);
}
__device__ __forceinline__ u32x4 pack8(const float (&f)[8]) {
    u32x4 w; w.x = cvt_pk_bf16(f[0], f[1]); w.y = cvt_pk_bf16(f[2], f[3]); w.z = cvt_pk_bf16(f[4], f[5]); w.w = cvt_pk_bf16(f[6], f[7]); return w;
}

namespace pg8 {
constexpr int BM = 256, BK = 64, HALF = 128, HTB = HALF * BK * 2, STAGE_BYTES = 8 * HTB, NXCD = 8, WGM = 8;
__host__ __device__ __forceinline__ int lds_byte(int r, int c) { const int st = (r >> 4) * 2 + (c >> 5), rr = r & 15, cc = c & 31, ob = rr * 64 + cc * 2; return st * 1024 + (ob ^ (((ob >> 9) & 1) << 5)); }
__host__ __device__ __forceinline__ void stage_rc(int b, int& R, int& C) { const int st = b / 1024, sb = b % 1024, swz = sb ^ (((sb >> 9) & 1) << 5); R = (st >> 1) * 16 + swz / 64; C = (st & 1) * 32 + (swz % 64) / 2; }
__host__ __device__ __forceinline__ int perm32(int rho) { const int n = rho >> 4, i = rho & 15; return 8 * (i >> 2) + 4 * n + (i & 3); }
struct Unit { int pm, pn; };
struct Gemm { const bf16_t* A; const bf16_t* Bt; int M, N, K, lda, ldb, a_pn_shift, a_pn_bytes; };
struct StaticOrder {
    int nM, nN, nwg, G, c, ext, ext_pm0;
    __device__ void init(int M, int N, int G_, int c_) { nM = M / BM; nN = N / BM; nwg = nM * nN; G = G_; c = c_; ext = 0; ext_pm0 = 0; }
    __device__ bool next(int i, Unit& u) const {
        const long L = (long)i * G + c;
        if (L >= nwg) { if (L >= nwg + ext) return false; const int idx = (int)(L - nwg), t = idx % 11; u.pm = ext_pm0 + idx / 11; u.pn = t < 6 ? t + 2 : (t < 10 ? t + 6 : 28); return true; }
        int wgid = (int)L; { const int q = nwg / NXCD, r = nwg % NXCD, xcd = wgid % NXCD, off = wgid / NXCD; wgid = (xcd < r ? xcd * (q + 1) : r * (q + 1) + (xcd - r) * q) + off; }
        const int nig = WGM * nN, gid = wgid / nig, fm = gid * WGM, gsz = (nM - fm) < WGM ? (nM - fm) : WGM;
        u.pm = fm + ((wgid % nig) % gsz); u.pn = (wgid % nig) / gsz; return true;
    }
};
template <class Epi, bool ALIGN_EPI>
__device__ __forceinline__ void gemm_phase(const int tid, LAS unsigned char* lds, const Gemm g, const StaticOrder& S, const Epi& E) {
    const int wid = __builtin_amdgcn_readfirstlane(tid >> 6), lane = tid & 63, wr = wid >> 2, wc = wid & 3, fr = lane & 15, fq = lane >> 4;
    const int K = g.K, nt = K / BK;
    unsigned voffA[2], voffB[2];
#pragma unroll
    for (int i = 0; i < 2; ++i) { int R, C; stage_rc(tid * 16 + i * 8192, R, C); const int Rb = Epi::PERM ? ((R & ~31) + perm32(R & 31)) : R;
        voffA[i] = (unsigned)(R * g.lda + C) * 2u; voffB[i] = (unsigned)(Rb * g.ldb + C) * 2u; }
    const size_t kstep = (size_t)(BK * 2);
    const size_t hstepA = (size_t)HALF * g.lda * 2, hstepB = (size_t)HALF * g.ldb * 2;
    const size_t tstepA = 2 * hstepA, tstepB = 2 * hstepB;
    const unsigned ldsw = (unsigned)wid * 1024u;
    const int aoff = lds_byte(wr * 64 + fr, fq * 8), boff = lds_byte(wc * 32 + fr, fq * 8);
#define PG8_SA(b, h) (((b) * 2 + (h)) * HTB)
#define PG8_SB(b, h) ((4 + (b) * 2 + (h)) * HTB)
#define PG8_STAGE(bufoff, gbase, voff) do { _Pragma("unroll") for (int _i = 0; _i < 2; ++_i) \
        __builtin_amdgcn_global_load_lds((const unsigned*)((const char*)(gbase) + (voff)[_i]), (LAS unsigned*)(lds + (bufoff) + ldsw + _i * 8192), 16, 0, 0); } while (0)
#define PG8_LDA(dst, b, h) do { _Pragma("unroll") for (int m = 0; m < 4; ++m) _Pragma("unroll") for (int k = 0; k < 2; ++k) dst[m][k] = *(const LAS bf16x8*)(lds + PG8_SA(b, h) + aoff + m * 2048 + k * 1024); } while (0)
#define PG8_LDB(dst, b, h) do { _Pragma("unroll") for (int n = 0; n < 2; ++n) _Pragma("unroll") for (int k = 0; k < 2; ++k) dst[n][k] = *(const LAS bf16x8*)(lds + PG8_SB(b, h) + boff + n * 2048 + k * 1024); } while (0)
#define PG8_MMA(ai, bj, At, Bt) do { __builtin_amdgcn_s_setprio(1); _Pragma("unroll") for (int m = 0; m < 4; ++m) _Pragma("unroll") for (int n = 0; n < 2; ++n) _Pragma("unroll") for (int k = 0; k < 2; ++k) \
        acc[ai][bj][m][n] = __builtin_amdgcn_mfma_f32_16x16x32_bf16(Bt[n][k], At[m][k], acc[ai][bj][m][n], 0, 0, 0); __builtin_amdgcn_s_setprio(0); } while (0)
#define PG8_WAIT_V(n) asm volatile("s_waitcnt vmcnt(" #n ")" ::: "memory")
#define PG8_WAIT_L(n) asm volatile("s_waitcnt lgkmcnt(" #n ")" ::: "memory")
#define PG8_BAR __builtin_amdgcn_s_barrier()
#define PG8_SCHED __builtin_amdgcn_sched_barrier(0)
    Unit cur, nxt; int ui = 0;
    if (!S.next(0, cur)) return;
    f32x4 acc[2][2][4][2];
#pragma unroll
    for (int a = 0; a < 2; ++a)
#pragma unroll
        for (int b = 0; b < 2; ++b)
#pragma unroll
            for (int m = 0; m < 4; ++m)
#pragma unroll
                for (int n = 0; n < 2; ++n) acc[a][b][m][n] = (f32x4){0.f, 0.f, 0.f, 0.f};
    bf16x8 At[4][2], B0[2][2], B1[2][2];
    const char* cA = (const char*)g.A + (size_t)cur.pm * tstepA + (size_t)((cur.pn >> g.a_pn_shift) * g.a_pn_bytes);
    const char* cB = (const char*)g.Bt + (size_t)cur.pn * tstepB;
    PG8_STAGE(PG8_SB(0, 0), cB, voffB); PG8_STAGE(PG8_SB(0, 1), cB + hstepB, voffB); PG8_STAGE(PG8_SA(0, 0), cA, voffA); PG8_STAGE(PG8_SA(0, 1), cA + hstepA, voffA);
    if (wr == 1) PG8_BAR;
    PG8_WAIT_V(2); PG8_BAR;
    PG8_STAGE(PG8_SB(1, 0), cB + kstep, voffB); PG8_STAGE(PG8_SA(1, 0), cA + kstep, voffA); PG8_STAGE(PG8_SB(1, 1), cB + hstepB + kstep, voffB);
    PG8_WAIT_V(6); PG8_BAR;
    for (;;) {
        const bool has_next = S.next(ui + 1, nxt);
        const char* nA = has_next ? (const char*)g.A + (size_t)nxt.pm * tstepA + (size_t)((nxt.pn >> g.a_pn_shift) * g.a_pn_bytes) : cA;
        const char* nB = has_next ? (const char*)g.Bt + (size_t)nxt.pn * tstepB : cB;
        for (int t = 0; t < nt; t += 2) {
            const bool last = (t == nt - 2);
            const char* a1 = cA + (size_t)(t + 1) * kstep;
            const char* a2 = last ? nA : cA + (size_t)(t + 2) * kstep; const char* b2 = last ? nB : cB + (size_t)(t + 2) * kstep;
            const char* a3 = a2 + kstep; const char* b3 = b2 + kstep;
            PG8_LDB(B0, 0, 0); PG8_LDB(B1, 0, 1); PG8_SCHED; PG8_LDA(At, 0, 0); PG8_STAGE(PG8_SA(1, 1), a1 + hstepA, voffA);
            PG8_WAIT_V(8); PG8_WAIT_L(0); PG8_BAR; PG8_MMA(0, 0, At, B0); PG8_MMA(0, 1, At, B1); PG8_BAR; PG8_SCHED;
            PG8_LDA(At, 0, 1); PG8_STAGE(PG8_SB(0, 0), b2, voffB); PG8_STAGE(PG8_SB(0, 1), b2 + hstepB, voffB); PG8_STAGE(PG8_SA(0, 0), a2, voffA);
            PG8_WAIT_V(8); PG8_WAIT_L(0); PG8_BAR; PG8_MMA(1, 0, At, B0); PG8_MMA(1, 1, At, B1); PG8_BAR; PG8_SCHED;
            PG8_LDB(B0, 1, 0); PG8_LDB(B1, 1, 1); PG8_SCHED; PG8_LDA(At, 1, 0); PG8_STAGE(PG8_SA(0, 1), a2 + hstepA, voffA);
            PG8_WAIT_V(8); PG8_WAIT_L(0); PG8_BAR; PG8_MMA(0, 0, At, B0); PG8_MMA(0, 1, At, B1); PG8_BAR; PG8_SCHED;
            PG8_LDA(At, 1, 1); PG8_STAGE(PG8_SB(1, 0), b3, voffB); PG8_STAGE(PG8_SB(1, 1), b3 + hstepB, voffB); PG8_STAGE(PG8_SA(1, 0), a3, voffA);
            PG8_WAIT_V(8); PG8_WAIT_L(0); PG8_BAR; PG8_MMA(1, 0, At, B0); PG8_MMA(1, 1, At, B1); PG8_BAR; PG8_SCHED;
        }
        if constexpr (ALIGN_EPI) { if (wr == 0) PG8_BAR; }
        { int fr_ = fr, fq_ = fq; asm volatile("" : "+v"(fr_), "+v"(fq_)); E(acc, cur, wr, wc, fr_, fq_); }
        if (!has_next) break;
#pragma unroll
        for (int a = 0; a < 2; ++a)
#pragma unroll
            for (int b = 0; b < 2; ++b)
#pragma unroll
                for (int m = 0; m < 4; ++m)
#pragma unroll
                    for (int n = 0; n < 2; ++n) acc[a][b][m][n] = (f32x4){0.f, 0.f, 0.f, 0.f};
        cur = nxt; cA = nA; cB = nB; ++ui;
        if constexpr (ALIGN_EPI) { if (wr == 1) PG8_BAR; }
    }
    PG8_WAIT_V(0);
    if constexpr (!ALIGN_EPI) { if (wr == 0) PG8_BAR; }
    PG8_BAR;
#undef PG8_SA
#undef PG8_SB
#undef PG8_STAGE
#undef PG8_LDA
#undef PG8_LDB
#undef PG8_MMA
#undef PG8_WAIT_V
#undef PG8_WAIT_L
#undef PG8_BAR
#undef PG8_SCHED
}

struct EpiBf16 {
    static constexpr bool PERM = true;
    bf16_t* O; int ldc;
    __device__ __forceinline__ void operator()(const f32x4 (&acc)[2][2][4][2], const Unit& u, int wr, int wc, int fr, int fq) const {
        const int row0 = u.pm * BM + wr * 64 + fr, col0 = u.pn * BM + wc * 32 + 8 * fq;
#pragma unroll
        for (int ai = 0; ai < 2; ++ai)
#pragma unroll
            for (int m = 0; m < 4; ++m) { bf16_t* rowp = O + (size_t)(row0 + ai * HALF + m * 16) * ldc + col0;
#pragma unroll
                for (int bj = 0; bj < 2; ++bj) { const f32x4 v0 = acc[ai][bj][m][0], v1 = acc[ai][bj][m][1];
                    u32x4 w; w.x = cvt_pk_bf16(v0[0], v0[1]); w.y = cvt_pk_bf16(v0[2], v0[3]); w.z = cvt_pk_bf16(v1[0], v1[1]); w.w = cvt_pk_bf16(v1[2], v1[3]);
                    *(u32x4*)(rowp + bj * HALF) = w; } }
    }
};
struct EpiSwiglu {
    static constexpr bool PERM = true;
    bf16_t* O; int ldc;
    __device__ __forceinline__ void operator()(const f32x4 (&acc)[2][2][4][2], const Unit& u, int wr, int wc, int fr, int fq) const {
        const int row0 = u.pm * BM + wr * 64 + fr, col0 = u.pn * HALF + wc * 32 + 8 * fq;
#pragma unroll
        for (int ai = 0; ai < 2; ++ai)
#pragma unroll
            for (int m = 0; m < 4; ++m) { bf16_t* rowp = O + (size_t)(row0 + ai * HALF + m * 16) * ldc + col0;
                float o[8];
#pragma unroll
                for (int n = 0; n < 2; ++n)
#pragma unroll
                    for (int j = 0; j < 4; ++j) o[4 * n + j] = siluf_(acc[ai][0][m][n][j]) * acc[ai][1][m][n][j];
                *(u32x4*)rowp = pack8(o); }
    }
};
struct EpiResid {
    static constexpr bool PERM = false;
    const float* baseL; const float* baseC; float* outL; float* outC; const float* modL; const float* modC; float scale; int nlat;
    __device__ __forceinline__ void operator()(const f32x4 (&acc)[2][2][4][2], const Unit& u, int wr, int wc, int fr, int fq) const {
        const bool lat = u.pm < nlat;
        const size_t toff = (size_t)(lat ? u.pm : u.pm - nlat) * BM * D + (size_t)(wr * 64 + fr) * D + u.pn * BM + wc * 32 + 4 * fq;
        const float* base = (lat ? baseL : baseC) + toff;
        float* out = (lat ? outL : outC) + toff;
        const float* mg = (lat ? modL + (size_t)(u.pm >> 3) * NMOD : modC) + u.pn * BM + wc * 32 + 4 * fq;
#pragma unroll
        for (int bj = 0; bj < 2; ++bj)
#pragma unroll
            for (int n = 0; n < 2; ++n) { const f32x4 gv = *(const f32x4*)(mg + bj * HALF + n * 16) * scale;
#pragma unroll
                for (int ai = 0; ai < 2; ++ai)
#pragma unroll
                    for (int m = 0; m < 4; ++m) { const size_t off = (size_t)(ai * HALF + m * 16) * D + bj * HALF + n * 16;
                        const f32x4 bs = *(const f32x4*)(base + off); *(f32x4*)(out + off) = bs + gv * acc[ai][bj][m][n]; } }
    }
};
__device__ __forceinline__ float one_minus_exp(float x) {
    const float ser = -x * (1.0f + x * (0.5f + x * (0.16666667f + x * (0.041666668f + x * (0.0083333338f + x * (0.0013888889f + x * 0.0001984127f))))));
    return x > -0.3f ? ser : 1.0f - __expf(x);
}
struct EpiGate {
    static constexpr bool PERM = true;
    bf16_t* LA; bf16_t* UU;
    __device__ __forceinline__ void operator()(const f32x4 (&acc)[2][2][4][2], const Unit& u, int wr, int wc, int fr, int fq) const {
        const int blk = u.pn >> 1, dir = u.pn & 1, ch0 = blk * HALF + wc * 32 + 8 * fq, row0 = u.pm * BM + wr * 64 + fr;
#pragma unroll
        for (int ai = 0; ai < 2; ++ai)
#pragma unroll
            for (int m = 0; m < 4; ++m) { const size_t off = (size_t)dir * RG * D + (size_t)(row0 + ai * HALF + m * 16) * D + ch0;
#pragma unroll
                for (int bj = 0; bj < 2; ++bj) { const f32x4 v0 = acc[ai][bj][m][0], v1 = acc[ai][bj][m][1];
                    u32x4 w; w.x = cvt_pk_bf16(v0[0], v0[1]); w.y = cvt_pk_bf16(v0[2], v0[3]); w.z = cvt_pk_bf16(v1[0], v1[1]); w.w = cvt_pk_bf16(v1[2], v1[3]);
                    *(u32x4*)((bj ? UU : LA) + off) = w; } }
    }
};
template <bool ACCUM> struct EpiMix {
    static constexpr bool PERM = true;
    const bf16_t* PROJ; int gcol; bf16_t* MG;
    __device__ __forceinline__ void operator()(const f32x4 (&acc)[2][2][4][2], const Unit& u, int wr, int wc, int fr, int fq) const {
        const int row0 = u.pm * BM + wr * 64 + fr, col0 = u.pn * BM + wc * 32 + 8 * fq;
#pragma unroll
        for (int ai = 0; ai < 2; ++ai)
#pragma unroll
            for (int m = 0; m < 4; ++m) { const size_t row = (size_t)(row0 + ai * HALF + m * 16);
#pragma unroll
                for (int bj = 0; bj < 2; ++bj) { float gt[8], o[8]; unpack8(*(const u32x4*)(PROJ + row * PN + gcol + col0 + bj * HALF), gt);
                    bf16_t* dst = MG + row * D + col0 + bj * HALF;
                    if (ACCUM) unpack8(*(const u32x4*)dst, o); else {
#pragma unroll
                        for (int i = 0; i < 8; ++i) o[i] = 0.f; }
#pragma unroll
                    for (int n = 0; n < 2; ++n)
#pragma unroll
                        for (int j = 0; j < 4; ++j) o[4 * n + j] += sigmoidf_(gt[4 * n + j]) * acc[ai][bj][m][n][j];
                    *(u32x4*)dst = pack8(o); } }
    }
};
}

struct Args {
    const float* in[26]; float* out; unsigned char* ws; int lo, hi;
};
enum { I_X = 0, I_C, I_CTX, I_CCTX, I_WADA, I_BADA, I_NORMW, I_F1WI, I_F1WO, I_F2WI, I_F2WO, I_WIN, I_FUP, I_FB, I_GNW, I_CONVW, I_CONVB, I_WR, I_BR, I_WI, I_BI, I_LAM, I_WOG, I_WOL, I_WOO, I_FNW };

#define NTHR 512
__device__ __forceinline__ const float* inp(const LAS unsigned char* lds, int i) { const LAS unsigned* t = (const LAS unsigned*)(lds + PTAB) + 2 * i;
    const unsigned lo = __builtin_amdgcn_readfirstlane(t[0]), hi = __builtin_amdgcn_readfirstlane(t[1]); return (const float*)(((unsigned long long)hi << 32) | lo); }
#define AIN(i) inp(lds, (i))
struct Ctx { int tid, bid, G; };
#define GW() (cx.bid * 8 + (cx.tid >> 6))
#define NGW() (cx.G * 8)

__device__ __forceinline__ void transpose_item(const float* W, int ldw, int K, int k0, int n0, bf16_t* WT, int drow, LAS float* scr, int lane) {
#pragma unroll 8
    for (int i = 0; i < 32; ++i) { const int kk = 2 * i + (lane >> 5); scr[kk * 33 + (lane & 31)] = W[(size_t)(k0 + kk) * ldw + n0 + (lane & 31)]; }
    asm volatile("s_waitcnt lgkmcnt(0)" ::: "memory");
    const int c = lane & 7;
#pragma unroll
    for (int j = 0; j < 4; ++j) { const int n = (lane >> 3) + 8 * j; const LAS float* s = scr + (8 * c) * 33 + n;
        u32x4 o; o.x = cvt_pk_bf16(s[0 * 33], s[1 * 33]); o.y = cvt_pk_bf16(s[2 * 33], s[3 * 33]); o.z = cvt_pk_bf16(s[4 * 33], s[5 * 33]); o.w = cvt_pk_bf16(s[6 * 33], s[7 * 33]);
        *(u32x4*)(WT + (size_t)(drow + n) * K + k0 + 8 * c) = o; }
    asm volatile("s_waitcnt lgkmcnt(0)" ::: "memory");
}
__device__ __forceinline__ int wi_drow(int n0) { return n0 < FH ? (n0 >> 7) * 256 + (n0 & 127) : ((n0 - FH) >> 7) * 256 + 128 + ((n0 - FH) & 127); }
__device__ __forceinline__ int win_drow(int n0) { return n0 < 3072 ? n0 : (n0 == 3072 ? PFD : n0 - 32); }

__device__ __forceinline__ void phase_weights(const Ctx cx, const Args& a, LAS unsigned char* lds) {
    const int lane = cx.tid & 63, wave = cx.tid >> 6;
    LAS float* scr = (LAS float*)(lds + wave * 16384);
    unsigned char* ws = a.ws;
    constexpr int I_WI_ = (D / 64) * (2 * FH / 32), I_WO_ = (FH / 64) * (D / 32), I_IN_ = (D / 64) * (INW / 32), I_SQ_ = (D / 64) * (D / 32), I_LG_ = 32 * 8;
    constexpr int NIT = 2 * I_WI_ + 2 * I_WO_ + I_IN_ + 3 * I_SQ_ + I_LG_;
    if (PHON(19)) for (int it = GW(); it < NIT; it += NGW()) {
        int r = it;
        if (r < 2 * I_WI_) { const int w = r / I_WI_; r %= I_WI_; const int nb = 2 * FH / 32, kb = r / nb, n0 = (r % nb) * 32;
            transpose_item(AIN(w ? I_F2WI : I_F1WI), 2 * FH, D, kb * 64, n0, (bf16_t*)(ws + (w ? WS_WI2 : WS_WI1)), wi_drow(n0), scr, lane); continue; }
        r -= 2 * I_WI_;
        if (r < 2 * I_WO_) { const int w = r / I_WO_; r %= I_WO_; const int nb = D / 32, kb = r / nb, n0 = (r % nb) * 32;
            transpose_item(AIN(w ? I_F2WO : I_F1WO), D, FH, kb * 64, n0, (bf16_t*)(ws + (w ? WS_WO2 : WS_WO1)), n0, scr, lane); continue; }
        r -= 2 * I_WO_;
        if (r < I_IN_) { const int nb = INW / 32, kb = r / nb, n0 = (r % nb) * 32;
            transpose_item(AIN(I_WIN), INW, D, kb * 64, n0, (bf16_t*)(ws + WS_WIN), win_drow(n0), scr, lane); continue; }
        r -= I_IN_;
        if (r < 3 * I_SQ_) { const int w = r / I_SQ_; r %= I_SQ_; const int nb = D / 32, kb = r / nb, n0 = (r % nb) * 32;
            transpose_item(AIN(w == 0 ? I_WOG : (w == 1 ? I_WOL : I_WOO)), D, D, kb * 64, n0, (bf16_t*)(ws + (w == 0 ? WS_WOG : (w == 1 ? WS_WOL : WS_WOO))), n0, scr, lane); continue; }
        r -= 3 * I_SQ_;
        { const int mat = r >> 3, sub = r & 7, gate = mat >> 4, dir = (mat >> 3) & 1, blk = mat & 7;
          const float* src = AIN(gate ? I_WI : I_WR) + (size_t)(dir * 8 + blk) * 128 * 128;
          const int kb = sub >> 2, n0 = (sub & 3) * 32;
          transpose_item(src, 128, 128, kb * 64, n0, (bf16_t*)(ws + WS_WLG), ((blk * 2 + dir) * 2 + gate) * 128 + n0, scr, lane); }
    }
    { u32x4* z = (u32x4*)(ws + WS_WIN + (size_t)INW * D * 2); const int n16 = (PN - INW) * D * 2 / 16;
      for (int i = cx.bid * NTHR + cx.tid; i < n16; i += cx.G * NTHR) z[i] = (u32x4){0u, 0u, 0u, 0u}; }
    __syncthreads();
    LAS float* sl = (LAS float*)lds;
    float* MODP = (float*)(ws + WS_MODP);
    if (PHON(20)) for (int item = cx.bid; item < 18 * 16; item += cx.G) {
        const int cb = item % 18, ks = item / 18, col = cb * 512 + cx.tid;
        for (int idx = cx.tid; idx < 33 * 64; idx += NTHR) { const int b = idx >> 6, k = idx & 63; const float cv = b < 32 ? AIN(I_C)[b * D + ks * 64 + k] : AIN(I_CCTX)[ks * 64 + k]; sl[idx] = siluf_(cv); }
        __syncthreads();
        float acc[33];
#pragma unroll
        for (int b = 0; b < 33; ++b) acc[b] = 0.f;
        const float* wp = AIN(I_WADA) + (size_t)(ks * 64) * NMOD + col;
#pragma unroll 4
        for (int k = 0; k < 64; ++k) { const float w = wp[(size_t)k * NMOD];
#pragma unroll
            for (int b = 0; b < 33; ++b) acc[b] += sl[b * 64 + k] * w; }
#pragma unroll
        for (int b = 0; b < 33; ++b) MODP[(size_t)(ks * 33 + b) * NMOD + col] = acc[b];
        __syncthreads();
    }
}
__device__ __forceinline__ void phase_modreduce(const Ctx cx, const Args& a, LAS unsigned char* lds) {
    const float* MODP = (const float*)(a.ws + WS_MODP); float* MOD = (float*)(a.ws + WS_MOD);
    for (int idx = cx.bid * NTHR + cx.tid; idx < 33 * NMOD; idx += cx.G * NTHR) {
        float s = AIN(I_BADA)[idx % NMOD];
#pragma unroll
        for (int ks = 0; ks < 16; ++ks) s += MODP[(size_t)ks * 33 * NMOD + idx];
        MOD[idx] = s;
    }
    float* GC = (float*)(a.ws + WS_GC);
    for (int idx = cx.bid * NTHR + cx.tid; idx < 2 * D; idx += cx.G * NTHR) { GC[idx] = AIN(I_BR)[idx]; GC[2 * D + idx] = AIN(I_BI)[idx]; GC[4 * D + idx] = 8.0f * log1pf(__expf(-AIN(I_LAM)[idx])); }
}

__device__ __forceinline__ void phase_normmod(const Ctx cx, const Args& a, LAS unsigned char* lds, const float* srcL, const float* srcC, int nL, int nrows, int mod_b0, int sub) {
    const int lane = cx.tid & 63;
    const float* MOD = (const float*)(a.ws + WS_MOD); const float* nw = AIN(I_NORMW) + sub * D;
    bf16_t* U = (bf16_t*)(a.ws + WS_U);
    for (int r0 = 2 * GW(); r0 < nrows; r0 += 2 * NGW()) {
        f32x4 v[2][4]; float ss[2];
#pragma unroll
        for (int q = 0; q < 2; ++q) { const int r = r0 + q;
            const float* src = r < nL ? srcL + (size_t)r * D : srcC + (size_t)(r - nL) * D;
            ss[q] = 0.f;
#pragma unroll
            for (int j = 0; j < 4; ++j) { v[q][j] = ((const f32x4*)src)[lane + 64 * j]; } }
#pragma unroll
        for (int q = 0; q < 2; ++q)
#pragma unroll
            for (int j = 0; j < 4; ++j) ss[q] += (v[q][j].x * v[q][j].x + v[q][j].y * v[q][j].y) + (v[q][j].z * v[q][j].z + v[q][j].w * v[q][j].w);
#pragma unroll
        for (int o = 1; o < 64; o <<= 1) { ss[0] += __shfl_xor(ss[0], o); ss[1] += __shfl_xor(ss[1], o); }
#pragma unroll
        for (int q = 0; q < 2; ++q) { const int r = r0 + q; const int mrow = r < nL ? mod_b0 + r / T : 32;
            const float* sh = MOD + (size_t)mrow * NMOD + (3 * sub) * D; const float* sc = sh + D;
            const float rstd = 1.0f / sqrtf(ss[q] * (1.0f / D) + EPS);
#pragma unroll
            for (int j = 0; j < 4; ++j) { const int c4 = lane + 64 * j; const f32x4 w = ((const f32x4*)nw)[c4], s4 = ((const f32x4*)sh)[c4], c1 = ((const f32x4*)sc)[c4];
                const f32x4 o = v[q][j] * rstd * w * (c1 + 1.0f) + s4;
                u32x2 p; p.x = cvt_pk_bf16(o.x, o.y); p.y = cvt_pk_bf16(o.z, o.w); ((u32x2*)(U + (size_t)r * D))[c4] = p; } }
    }
}
__device__ __forceinline__ void phase_final(const Ctx cx, const Args& a, LAS unsigned char* lds, int g) {
    const int lane = cx.tid & 63; const float* fw = AIN(I_FNW);
    for (int r0 = 2 * GW(); r0 < RL; r0 += 2 * NGW()) {
        float* row = a.out + ((size_t)g * RL + r0) * D;
        f32x4 v[2][4]; float ss[2] = {0.f, 0.f};
#pragma unroll
        for (int q = 0; q < 2; ++q)
#pragma unroll
            for (int j = 0; j < 4; ++j) v[q][j] = ((const f32x4*)(row + q * D))[lane + 64 * j];
#pragma unroll
        for (int q = 0; q < 2; ++q)
#pragma unroll
            for (int j = 0; j < 4; ++j) ss[q] += (v[q][j].x * v[q][j].x + v[q][j].y * v[q][j].y) + (v[q][j].z * v[q][j].z + v[q][j].w * v[q][j].w);
#pragma unroll
        for (int o = 1; o < 64; o <<= 1) { ss[0] += __shfl_xor(ss[0], o); ss[1] += __shfl_xor(ss[1], o); }
#pragma unroll
        for (int q = 0; q < 2; ++q) { const float rstd = 1.0f / sqrtf(ss[q] * (1.0f / D) + EPS);
#pragma unroll
            for (int j = 0; j < 4; ++j) { const int c4 = lane + 64 * j; ((f32x4*)(row + q * D))[c4] = v[q][j] * rstd * ((const f32x4*)fw)[c4]; } }
    }
}

__device__ __forceinline__ float logsig_fast(float x) { return fminf(x, 0.f) - __logf(1.0f + __expf(-fabsf(x))); }
__device__ __forceinline__ void phase_prep(const Ctx cx, const Args& a, int g, LAS unsigned char* lds) {
    const bf16_t* PROJ = (const bf16_t*)(a.ws + WS_BIG);
    const int tid = cx.tid;
    {
        LAS bf16_t* qs = (LAS bf16_t*)lds; LAS bf16_t* ks = (LAS bf16_t*)(lds + 16384); LAS float* fdl = (LAS float*)(lds + 32768); LAS float* part = (LAS float*)(lds + 36864);
        LAS bf16_t* qo = (LAS bf16_t*)(lds + 40960); LAS bf16_t* ko = (LAS bf16_t*)(lds + 57344);
        const int d = tid & 127, qt = tid >> 7;
        for (int item = cx.bid; item < BG * NCH * 8; item += cx.G) {
            const int h = item & 3, dir = (item >> 2) & 1, bc = item >> 3, b = bc / NCH, c = bc % NCH;
            const int row0 = c < 4 ? RL + b * CL + c * 64 : b * T + (c - 4) * 64;
            const bool lat = c >= 4;
#pragma unroll
            for (int k = 0; k < 2; ++k) { const int p = tid + 512 * k, r = p >> 4, c8 = (p & 15) * 8;
                *(LAS u32x4*)(ks + r * 128 + c8) = *(const u32x4*)(PROJ + (size_t)(row0 + r) * PN + PK + h * 128 + c8);
                if (lat) *(LAS u32x4*)(qs + r * 128 + c8) = *(const u32x4*)(PROJ + (size_t)(row0 + r) * PN + PQ + h * 128 + c8); }
#pragma unroll
            for (int k = 0; k < 2; ++k) { const int idx = tid + 512 * k; fdl[idx] = bf2f(PROJ[(size_t)(row0 + (idx >> 4)) * PN + PFD + dir * 16 + (idx & 15)]); }
            const int col = h * 128 + d;
            float fw[16];
#pragma unroll
            for (int r = 0; r < 16; ++r) fw[r] = AIN(I_FUP)[(size_t)(dir * 16 + r) * 512 + col];
            const float fbv = AIN(I_FB)[dir * 512 + col];
            __syncthreads();
            float la[16]; float psum = 0.f;
#pragma unroll
            for (int t = 0; t < 16; ++t) { const int i = 16 * qt + t; float dot = fbv;
#pragma unroll
                for (int r = 0; r < 16; ++r) dot += fdl[i * 16 + r] * fw[r];
                la[t] = logsig_fast(dot) * (1.0f / 16.0f); psum += la[t]; }
            part[qt * 128 + d] = psum;
            __syncthreads();
            const float p0 = part[d], p1 = part[128 + d], p2 = part[256 + d], p3 = part[384 + d];
            const float tot = (p0 + p1) + (p2 + p3);
            float run = dir == 0 ? (qt > 0 ? p0 : 0.f) + (qt > 1 ? p1 : 0.f) + (qt > 2 ? p2 : 0.f)
                                 : (qt < 3 ? p3 : 0.f) + (qt < 2 ? p2 : 0.f) + (qt < 1 ? p1 : 0.f);
            float ke[16];
            if (dir == 0) {
#pragma unroll
                for (int t = 0; t < 16; ++t) { const int i = 16 * qt + t; run += la[t];
                    const float kv = bf2f(ks[i * 128 + d]); ke[t] = kv * __expf(tot - run);
                    if (lat) { qo[i * 128 + d] = f2bf(bf2f(qs[i * 128 + d]) * 0.08838834764831845f * __expf(run)); ko[i * 128 + d] = f2bf(kv * __expf(-run)); } }
            } else {
#pragma unroll
                for (int t = 15; t >= 0; --t) { const int i = 16 * qt + t; run += la[t];
                    const float kv = bf2f(ks[i * 128 + d]); ke[t] = kv * __expf(tot - run);
                    if (lat) { qo[i * 128 + d] = f2bf(bf2f(qs[i * 128 + d]) * 0.08838834764831845f * __expf(run)); ko[i * 128 + d] = f2bf(kv * __expf(-run)); } }
            }
            const size_t tb = (((size_t)dir * BG + b) * NCH + c) * 4 + h;
            bf16_t* KET = (bf16_t*)(a.ws + WS_KET) + tb * 8192 + d * 64 + 16 * qt;
            { float k0[8], k1[8];
#pragma unroll
              for (int t = 0; t < 8; ++t) { k0[t] = ke[t]; k1[t] = ke[8 + t]; }
              *(u32x4*)KET = pack8(k0); *(u32x4*)(KET + 8) = pack8(k1); }
            if (qt == 0) ((float*)(a.ws + WS_BL))[tb * 128 + d] = tot;
            __syncthreads();
            if (lat) { bf16_t* QD = (bf16_t*)(a.ws + WS_QD) + tb * 8192; bf16_t* KI = (bf16_t*)(a.ws + WS_KI) + tb * 8192;
#pragma unroll
                for (int k = 0; k < 2; ++k) { const int p = tid + 512 * k; *(u32x4*)(QD + p * 8) = *(const LAS u32x4*)(qo + p * 8); *(u32x4*)(KI + p * 8) = *(const LAS u32x4*)(ko + p * 8); } }
            __syncthreads();
        }
    }
    {
        LAS bf16_t* vs = (LAS bf16_t*)lds;
        const int e = tid & 255, jh = tid >> 8;
        for (int item = cx.bid; item < BG * NCH * 4; item += cx.G) {
            const int h = item & 3, bc = item >> 2, b = bc / NCH, c = bc % NCH;
            const int row0 = c < 4 ? RL + b * CL + c * 64 : b * T + (c - 4) * 64;
#pragma unroll
            for (int k = 0; k < 4; ++k) { const int p = tid + 512 * k, r = p >> 5, c8 = (p & 31) * 8;
                *(LAS u32x4*)(vs + r * 256 + c8) = *(const u32x4*)(PROJ + (size_t)(row0 + r) * PN + PV + h * 256 + c8); }
            __syncthreads();
            bf16_t* VT = (bf16_t*)(a.ws + WS_VT) + ((((size_t)b * NCH + c) * 4 + h) * 256 + e) * 64 + 32 * jh;
#pragma unroll
            for (int jg = 0; jg < 4; ++jg) { float v[8];
#pragma unroll
                for (int jj = 0; jj < 8; ++jj) v[jj] = bf2f(vs[(32 * jh + 8 * jg + jj) * 256 + e]);
                *(u32x4*)(VT + 8 * jg) = pack8(v); }
            __syncthreads();
        }
    }
    bf16_t* XC = (bf16_t*)(a.ws + WS_XC);
    const float* cvb = AIN(I_CONVB); const float* cvw = AIN(I_CONVW);
    for (int idx0 = cx.bid * NTHR + cx.tid; idx0 < RG * 128; idx0 += 4 * cx.G * NTHR) {
        u32x4 xw[4][4];
#pragma unroll
        for (int q = 0; q < 4; ++q) { const int idx = idx0 + q * cx.G * NTHR; const int row = idx >> 7, c8 = (idx & 127) * 8;
            const int pos = row < RL ? (row & 63) : ((row - RL) & 255), len = row < RL ? 64 : 256;
#pragma unroll
            for (int j = 0; j < 4; ++j) { const int p = pos + j - 2; xw[q][j] = (u32x4){0u, 0u, 0u, 0u};
                if (idx < RG * 128 && p >= 0 && p < len) xw[q][j] = *(const u32x4*)(PROJ + (size_t)(row + j - 2) * PN + PXL + c8); } }
#pragma unroll
        for (int q = 0; q < 4; ++q) { const int idx = idx0 + q * cx.G * NTHR; const int row = idx >> 7, c8 = (idx & 127) * 8;
            if (idx < RG * 128) { float acc[8];
#pragma unroll
                for (int i = 0; i < 8; ++i) acc[i] = cvb[c8 + i];
#pragma unroll
                for (int j = 0; j < 4; ++j) { float xv[8]; unpack8(xw[q][j], xv);
#pragma unroll
                    for (int i = 0; i < 8; ++i) acc[i] += cvw[j * D + c8 + i] * xv[i]; }
                *(u32x4*)(XC + (size_t)row * D + c8) = pack8(acc); } }
    }
}

__device__ __forceinline__ void phase_gatefix(const Ctx cx, const Args& a, LAS unsigned char* lds) {
    bf16_t* LA = (bf16_t*)(a.ws + WS_LA); bf16_t* UU = (bf16_t*)(a.ws + WS_UU); const bf16_t* XC = (const bf16_t*)(a.ws + WS_XC); const float* GC = (const float*)(a.ws + WS_GC);
    for (int idx = cx.bid * NTHR + cx.tid; idx < 2 * RG * 128; idx += cx.G * NTHR) {
        const int dir = idx >= RG * 128, rem = idx - dir * RG * 128, row = rem >> 7, c8 = (rem & 127) * 8;
        const size_t off = (size_t)dir * RG * D + (size_t)row * D + c8;
        float r[8], ig[8], xc[8]; unpack8(*(const u32x4*)(LA + off), r); unpack8(*(const u32x4*)(UU + off), ig); unpack8(*(const u32x4*)(XC + (size_t)row * D + c8), xc);
#pragma unroll
        for (int i = 0; i < 8; ++i) { const float l = -GC[(4 + dir) * D + c8 + i] * sigmoidf_(r[i] + GC[dir * D + c8 + i]);
            const float gi = sigmoidf_(ig[i] + GC[(2 + dir) * D + c8 + i]);
            r[i] = l; ig[i] = __builtin_amdgcn_sqrtf(fmaxf(one_minus_exp(2.0f * l), 0.f)) * gi * xc[i]; }
        *(u32x4*)(LA + off) = pack8(r); *(u32x4*)(UU + off) = pack8(ig);
    }
}

__device__ __forceinline__ int img_off(int nkg, int row, int kcol) { const int ob = (row & 15) * 64 + (kcol & 31) * 2; return ((row >> 4) * nkg + (kcol >> 5)) * 1024 + (ob ^ (((ob >> 9) & 1) << 5)); }
__device__ __forceinline__ bf16x8 ldfrag(const LAS unsigned char* img, int nkg, int row, int kcol) { return *(const LAS bf16x8*)(img + img_off(nkg, row, kcol)); }
#define MFMA16(a, b, c) __builtin_amdgcn_mfma_f32_16x16x32_bf16((a), (b), (c), 0, 0, 0)

__device__ __forceinline__ void phase_gla_scan(const Ctx cx, const Args& a, int g, LAS unsigned char* lds) {
    constexpr int XB = 57344, OFF_KI = 16384, OFF_KET = 32768, OFF_VT = 49152, OFF_P = 2 * XB, OFF_ST = OFF_P + 8192, OFF_BL = OFF_ST + 2 * 16384;
    static_assert(OFF_BL + 1024 <= LDS_BYTES, "gla scan LDS");
    const int tid = cx.tid, lane = tid & 63, w = tid >> 6, fr = lane & 15, fq = lane >> 4;
    const bf16_t* QDg = (const bf16_t*)(a.ws + WS_QD); const bf16_t* KIg = (const bf16_t*)(a.ws + WS_KI); const bf16_t* KETg = (const bf16_t*)(a.ws + WS_KET);
    const bf16_t* VTg = (const bf16_t*)(a.ws + WS_VT); const float* BLg = (const float*)(a.ws + WS_BL);
    bf16_t* Og = (bf16_t*)(a.ws + WS_OFB);
    for (int item = cx.bid; item < BG * 32; item += cx.G) {
        const int dvq = item & 3, dir = (item >> 2) & 1, h = (item >> 3) & 3, b = item >> 5;
        { u32x4 z = {0u, 0u, 0u, 0u}; *(LAS u32x4*)(lds + OFF_ST + tid * 32) = z; *(LAS u32x4*)(lds + OFF_ST + tid * 32 + 16) = z; }
        f32x4 accS[4];
#pragma unroll
        for (int t = 0; t < 4; ++t) accS[t] = (f32x4){0.f, 0.f, 0.f, 0.f};
        u32x4 pq[2], pk[2], pe[2], pv; float pbl = 0.f;
#define GLA_LOAD(s_) do { const int c_ = dir == 0 ? (s_) : ((s_) < 4 ? 3 - (s_) : 39 - (s_)); \
            const size_t tb_ = (((size_t)dir * BG + b) * NCH + c_) * 4 + h; \
            if (c_ >= 4) { pq[0] = ((const u32x4*)(QDg + tb_ * 8192))[tid]; pq[1] = ((const u32x4*)(QDg + tb_ * 8192))[tid + 512]; \
                           pk[0] = ((const u32x4*)(KIg + tb_ * 8192))[tid]; pk[1] = ((const u32x4*)(KIg + tb_ * 8192))[tid + 512]; } \
            pe[0] = ((const u32x4*)(KETg + tb_ * 8192))[tid]; pe[1] = ((const u32x4*)(KETg + tb_ * 8192))[tid + 512]; \
            pv = ((const u32x4*)(VTg + ((((size_t)b * NCH + c_) * 4 + h) * 256 + dvq * 64) * 64))[tid]; \
            if (tid < 128) pbl = BLg[tb_ * 128 + tid]; } while (0)
#define GLA_STORE(buf_) do { LAS unsigned char* X_ = lds + (buf_) * XB; \
            _Pragma("unroll") for (int i_ = 0; i_ < 2; ++i_) { const int p_ = tid + 512 * i_; \
                *(LAS u32x4*)(X_ + img_off(4, p_ >> 4, (p_ & 15) * 8)) = pq[i_]; *(LAS u32x4*)(X_ + OFF_KI + img_off(4, p_ >> 4, (p_ & 15) * 8)) = pk[i_]; \
                *(LAS u32x4*)(X_ + OFF_KET + img_off(2, p_ >> 3, (p_ & 7) * 8)) = pe[i_]; } \
            *(LAS u32x4*)(X_ + OFF_VT + img_off(2, tid >> 3, (tid & 7) * 8)) = pv; \
            if (tid < 128) ((LAS float*)(lds + OFF_BL + (buf_) * 512))[tid] = pbl; } while (0)
        pq[0] = pq[1] = pk[0] = pk[1] = (u32x4){0u, 0u, 0u, 0u};
        GLA_LOAD(0); GLA_STORE(0);
        __syncthreads();
        for (int s = 0; s < NCH; ++s) {
            const int cur = s & 1; const bool lat = s >= 4;
            const LAS unsigned char* X = lds + cur * XB;
#ifndef GLA_SAFE
            if (s + 1 < NCH) GLA_LOAD(s + 1);
#endif
            if (lat) {
                const int ti = w >> 1, tj0 = (w & 1) * 2;
                f32x4 sc[2] = {(f32x4){0.f, 0.f, 0.f, 0.f}, (f32x4){0.f, 0.f, 0.f, 0.f}};
#pragma unroll
                for (int kk = 0; kk < 4; ++kk) { const bf16x8 qa = ldfrag(X, 4, 16 * ti + fr, kk * 32 + fq * 8);
#pragma unroll
                    for (int t = 0; t < 2; ++t) { const bf16x8 kb = ldfrag(X + OFF_KI, 4, 16 * (tj0 + t) + fr, kk * 32 + fq * 8); sc[t] = MFMA16(qa, kb, sc[t]); } }
#pragma unroll
                for (int t = 0; t < 2; ++t)
#pragma unroll
                    for (int jj = 0; jj < 4; ++jj) { const int i = 16 * ti + 4 * fq + jj, j = 16 * (tj0 + t) + fr;
                        const bool keep = dir == 0 ? (j <= i) : (j > i);
                        *(LAS bf16_t*)(lds + OFF_P + img_off(2, i, j)) = f2bf(keep ? sc[t][jj] : 0.f); }
            }
            __syncthreads();
            const int te = w >> 1;
            if (lat) {
                const int c = dir == 0 ? s : 39 - s;
                const LAS unsigned char* STc = lds + OFF_ST + cur * 16384;
                f32x4 oc[2] = {(f32x4){0.f, 0.f, 0.f, 0.f}, (f32x4){0.f, 0.f, 0.f, 0.f}};
#pragma unroll
                for (int kk = 0; kk < 2; ++kk) { const bf16x8 va = ldfrag(X + OFF_VT, 2, 16 * te + fr, kk * 32 + fq * 8);
#pragma unroll
                    for (int t = 0; t < 2; ++t) { const bf16x8 pb = ldfrag(lds + OFF_P, 2, 16 * ((w & 1) * 2 + t) + fr, kk * 32 + fq * 8); oc[t] = MFMA16(va, pb, oc[t]); } }
#pragma unroll
                for (int kk = 0; kk < 4; ++kk) { const bf16x8 sa = ldfrag(STc, 4, 16 * te + fr, kk * 32 + fq * 8);
#pragma unroll
                    for (int t = 0; t < 2; ++t) { const bf16x8 qb = ldfrag(X, 4, 16 * ((w & 1) * 2 + t) + fr, kk * 32 + fq * 8); oc[t] = MFMA16(sa, qb, oc[t]); } }
#pragma unroll
                for (int t = 0; t < 2; ++t) { const int i = 16 * ((w & 1) * 2 + t) + fr; const size_t row = (size_t)b * T + (size_t)(c - 4) * 64 + i;
                    u32x2 o2; o2.x = cvt_pk_bf16(oc[t][0], oc[t][1]); o2.y = cvt_pk_bf16(oc[t][2], oc[t][3]);
                    *(u32x2*)(Og + ((size_t)dir * RL + row) * D + h * 256 + dvq * 64 + 16 * te + 4 * fq) = o2; }
            }
#ifdef GLA_SAFE
            __syncthreads();
#endif
            {
                const LAS float* blp = (const LAS float*)(lds + OFF_BL + cur * 512);
                LAS unsigned char* STn = lds + OFF_ST + (cur ^ 1) * 16384;
                bf16x8 vb[2];
#pragma unroll
                for (int kk = 0; kk < 2; ++kk) vb[kk] = ldfrag(X + OFF_VT, 2, 16 * te + fr, kk * 32 + fq * 8);
#pragma unroll
                for (int t = 0; t < 4; ++t) { const int td = (w & 1) * 4 + t;
#pragma unroll
                    for (int jj = 0; jj < 4; ++jj) accS[t][jj] *= __expf(blp[16 * td + 4 * fq + jj]);
#pragma unroll
                    for (int kk = 0; kk < 2; ++kk) { const bf16x8 ka = ldfrag(X + OFF_KET, 2, 16 * td + fr, kk * 32 + fq * 8); accS[t] = MFMA16(ka, vb[kk], accS[t]); }
                    u32x2 s2; s2.x = cvt_pk_bf16(accS[t][0], accS[t][1]); s2.y = cvt_pk_bf16(accS[t][2], accS[t][3]);
                    *(LAS u32x2*)(STn + img_off(4, 16 * te + fr, 16 * td + 4 * fq)) = s2; }
            }
#ifdef GLA_SAFE
            __syncthreads();
            if (s + 1 < NCH) { GLA_LOAD(s + 1); GLA_STORE(cur ^ 1); }
#else
            if (s + 1 < NCH) GLA_STORE(cur ^ 1);
#endif
            __syncthreads();
        }
#undef GLA_LOAD
#undef GLA_STORE
    }
}

__device__ __forceinline__ void phase_lru_scan(const Ctx cx, const Args& a, int g, LAS unsigned char* lds) {
    const int lane = cx.tid & 63, w = cx.tid >> 6;
    LAS f32x2* agg = (LAS f32x2*)lds;
    const float* GC = (const float*)(a.ws + WS_GC);
    for (int item = cx.bid; item < BG * 32; item += cx.G) {
        const int cgp = item & 15, dir = (item >> 4) & 1, b = item >> 5, ch = cgp * 64 + lane;
        const bf16_t* RR = (const bf16_t*)(a.ws + WS_LA) + (size_t)dir * RG * D + ch; const bf16_t* II = (const bf16_t*)(a.ws + WS_UU) + (size_t)dir * RG * D + ch;
        const bf16_t* XCp = (const bf16_t*)(a.ws + WS_XC) + ch;
        bf16_t* Hd = (bf16_t*)(a.ws + WS_HFB) + (size_t)dir * RL * D + ch;
        const float cbr = GC[dir * D + ch], cbi = GC[(2 + dir) * D + ch], csp = GC[(4 + dir) * D + ch];
#define LRU_ROW(s_) ((s_) < CL ? RL + b * CL + (dir ? CL - 1 - (s_) : (s_)) : b * T + (dir ? T - 1 - ((s_) - CL) : (s_) - CL))
#define LRU_GATES(k_) const float l_ = -csp * sigmoidf_(bf2f(rr[k_]) + cbr); const float av = __expf(l_); \
            const float uv = __builtin_amdgcn_sqrtf(fmaxf(one_minus_exp(2.0f * l_), 0.f)) * sigmoidf_(bf2f(ii[k_]) + cbi) * bf2f(xx[k_]);
        float A = 1.f, Z = 0.f;
        for (int blk = 0; blk < 9; ++blk) { const int s0 = 288 * w + 32 * blk; bf16_t rr[32], ii[32], xx[32];
#pragma unroll
            for (int k = 0; k < 32; ++k) { const size_t r = (size_t)LRU_ROW(s0 + k); rr[k] = RR[r * D]; ii[k] = II[r * D]; xx[k] = XCp[r * D]; }
#pragma unroll
            for (int k = 0; k < 32; ++k) { LRU_GATES(k) Z = av * Z + uv; A *= av; } }
        agg[w * 64 + lane] = (f32x2){A, Z};
        __syncthreads();
        float hst = 0.f;
#pragma unroll
        for (int w2 = 0; w2 < 7; ++w2) { const f32x2 p = agg[w2 * 64 + lane]; if (w2 < w) hst = p.x * hst + p.y; }
        for (int blk = 0; blk < 9; ++blk) { const int s0 = 288 * w + 32 * blk; bf16_t rr[32], ii[32], xx[32];
#pragma unroll
            for (int k = 0; k < 32; ++k) { const size_t r = (size_t)LRU_ROW(s0 + k); rr[k] = RR[r * D]; ii[k] = II[r * D]; xx[k] = XCp[r * D]; }
#pragma unroll
            for (int k = 0; k < 32; ++k) { LRU_GATES(k) hst = av * hst + uv;
                if (s0 + k >= CL) Hd[(size_t)LRU_ROW(s0 + k) * D] = f2bf(hst); } }
        __syncthreads();
#undef LRU_ROW
#undef LRU_GATES
    }
}

__device__ __forceinline__ void phase_post(const Ctx cx, const Args& a, LAS unsigned char* lds, int g) {
    const int lane = cx.tid & 63;
    const bf16_t* PROJ = (const bf16_t*)(a.ws + WS_BIG);
    bf16_t* O0 = (bf16_t*)(a.ws + WS_OFB); const bf16_t* O1 = O0 + (size_t)RL * D;
    bf16_t* H0 = (bf16_t*)(a.ws + WS_HFB); const bf16_t* H1b = H0 + (size_t)RL * D;
    const float* gnw = AIN(I_GNW);
    for (int r = GW(); r < RL; r += NGW()) {
        const size_t off = (size_t)r * D + lane * 16;
        float o[16], t[8]; float ss = 0.f;
#pragma unroll
        for (int hf = 0; hf < 2; ++hf) { float x0[8], x1[8]; unpack8(*(const u32x4*)(O0 + off + 8 * hf), x0); unpack8(*(const u32x4*)(O1 + off + 8 * hf), x1);
#pragma unroll
            for (int i = 0; i < 8; ++i) { o[8 * hf + i] = x0[i] + x1[i]; ss += o[8 * hf + i] * o[8 * hf + i]; } }
        ss += __shfl_xor(ss, 1); ss += __shfl_xor(ss, 2); ss += __shfl_xor(ss, 4); ss += __shfl_xor(ss, 8);
        const float rstd = 1.0f / sqrtf(ss * (1.0f / 256.0f) + EPS);
#pragma unroll
        for (int hf = 0; hf < 2; ++hf) { float gg[8]; unpack8(*(const u32x4*)(PROJ + (size_t)r * PN + PGG + lane * 16 + 8 * hf), gg);
#pragma unroll
            for (int i = 0; i < 8; ++i) t[i] = o[8 * hf + i] * rstd * gnw[(lane & 15) * 16 + 8 * hf + i] * siluf_(gg[i]);
            *(u32x4*)(O0 + off + 8 * hf) = pack8(t); }
#pragma unroll
        for (int hf = 0; hf < 2; ++hf) { float x0[8], x1[8], yl[8]; unpack8(*(const u32x4*)(H0 + off + 8 * hf), x0); unpack8(*(const u32x4*)(H1b + off + 8 * hf), x1);
            unpack8(*(const u32x4*)(PROJ + (size_t)r * PN + PYL + lane * 16 + 8 * hf), yl);
#pragma unroll
            for (int i = 0; i < 8; ++i) t[i] = (x0[i] + x1[i]) * geluf_(yl[i]);
            *(u32x4*)(H0 + off + 8 * hf) = pack8(t); }
    }
}


#define XB_TMO      128
#define XB_XCNT(j)  (256  + 64 * (j))
#define XB_XSUB(j)  (1280 + 64 * (j))
#define XB_XGEN(j)  (2304 + 64 * (j))
#define XB_TOP      3328
#define XB_TOPGEN   3392
#define XCD_BAR_WORDS 3456
#define XB_SPIN_CAP (1u << 22)
__device__ __forceinline__ unsigned xb_ld(unsigned* p)              { return __hip_atomic_load(p, __ATOMIC_RELAXED, __HIP_MEMORY_SCOPE_AGENT); }
__device__ __forceinline__ unsigned xb_add(unsigned* p, unsigned v) { return __hip_atomic_fetch_add(p, v, __ATOMIC_RELAXED, __HIP_MEMORY_SCOPE_AGENT); }
__device__ __forceinline__ unsigned xb_xcc_id() { return (unsigned)__builtin_amdgcn_s_getreg((3 << 11) | 20) & 0xFu; }
#define XB_SPIN(cond, bar) do { unsigned _sp = 0; while (cond) { __builtin_amdgcn_s_sleep(1); \
    if ((++_sp & 255u) == 0u) { if (xb_ld(&(bar)[XB_TMO])) break; if (_sp > XB_SPIN_CAP) { atomicAdd(&(bar)[XB_TMO], 1u); break; } } } } while (0)
__device__ __forceinline__ void xcd_barrier_complete(unsigned* bar, unsigned x, unsigned G, unsigned& nloc, unsigned& nx) {
    unsigned sum, cnt, mine, sp = 0u;
    for (;;) {
        sum = 0u; cnt = 0u; mine = 0u;
#pragma unroll
        for (unsigned j = 0; j < 16; ++j) { const unsigned c = xb_ld(&bar[XB_XCNT(j)]); sum += c; cnt += (c > 0u) ? 1u : 0u; mine = (j == x) ? c : mine; }
        if (sum == G) break;
        __builtin_amdgcn_s_sleep(1);
        if ((++sp & 255u) == 0u) { if (xb_ld(&bar[XB_TMO])) break; if (sp > XB_SPIN_CAP) { atomicAdd(&bar[XB_TMO], 1u); break; } }
    }
    nloc = mine > 0u ? mine : 1u; nx = cnt > 0u ? cnt : 1u;
}
__device__ __forceinline__ void xcd_barrier(unsigned* bar, volatile LAS unsigned* st, int tid, unsigned G) {
    asm volatile("s_waitcnt vmcnt(0)" ::: "memory");
    __syncthreads();
    if (tid == 0) {
        __builtin_amdgcn_s_waitcnt(0);
        const unsigned x = xb_xcc_id();
        unsigned nloc = st[0], nx = st[1];
        if (nloc == 0u) { xcd_barrier_complete(bar, x, G, nloc, nx); st[0] = nloc; st[1] = nx; }
        const unsigned old = xb_add(&bar[XB_XSUB(x)], 1u);
        const unsigned gen = old / nloc;
        if (old + 1u == (gen + 1u) * nloc) {
            __builtin_amdgcn_fence(__ATOMIC_RELEASE, "agent");
            asm volatile("s_waitcnt vmcnt(0)" ::: "memory");
            const unsigned og = xb_add(&bar[XB_TOP], 1u);
            const unsigned tg = og / nx;
            if (og + 1u == (tg + 1u) * nx) xb_add(&bar[XB_TOPGEN], 1u);
            else XB_SPIN(xb_ld(&bar[XB_TOPGEN]) == tg, bar);
            __builtin_amdgcn_fence(__ATOMIC_ACQUIRE, "agent");
            xb_add(&bar[XB_XGEN(x)], 1u);
            asm volatile("s_waitcnt vmcnt(0)" ::: "memory");
        } else {
            XB_SPIN(xb_ld(&bar[XB_XGEN(x)]) == gen, bar);
            __builtin_amdgcn_fence(__ATOMIC_ACQUIRE, "agent");
            asm volatile("s_waitcnt vmcnt(0)" ::: "memory");
        }
    }
    __syncthreads();
}

constexpr int NPH = 17;
#ifndef USE_CG_ALL
#define USE_CG_ALL 0
#endif
#if ONE_LAUNCH
#define GRID_SYNC(k) do { if ((k) == 1 || USE_CG_ALL) cg::this_grid().sync(); else xcd_barrier((unsigned*)ws + 4096, (volatile LAS unsigned*)(lds + PTAB + 256), cx.tid, (unsigned)cx.G); } while (0)
#else
#define GRID_SYNC(k) do {} while (0)
#endif
#define STEP_BEGIN(k) if (a.lo <= (k) && (k) < a.hi) { \
        Ctx cx; { int t_ = wave_s * 64 + (int)__builtin_amdgcn_mbcnt_hi(~0u, __builtin_amdgcn_mbcnt_lo(~0u, 0u)), b_ = blockIdx.x, g_ = gridDim.x; asm volatile("" : "+v"(t_)); asm volatile("" : "+s"(b_), "+s"(g_)); cx.tid = t_; cx.bid = b_; cx.G = g_; } \
        const int G = cx.G, cidx = cx.bid; (void)G; (void)cidx; \
        unsigned char* ws = a.ws; asm volatile("" : "+s"(ws)); \
        if ((k) > a.lo) GRID_SYNC(k); \
        const float* MOD = (const float*)(ws + WS_MOD); float* H1 = (float*)(ws + WS_H1); bf16_t* U = (bf16_t*)(ws + WS_U); bf16_t* BIG = (bf16_t*)(ws + WS_BIG); bf16_t* XC = (bf16_t*)(ws + WS_XC); \
        (void)MOD; (void)H1; (void)U; (void)BIG; (void)XC; pg8::StaticOrder S; (void)S;
#define STEP_END }

template <int g>
__device__ __forceinline__ void run_group(const Args& a, LAS unsigned char* lds, const int wave_s) {
    constexpr int s0 = 5 + g * NPH;
    const float* H1r = (const float*)(a.ws + WS_H1); const float* H1Cr = (const float*)(a.ws + WS_H1C) + (size_t)g * RC * D;
    if (g == 0) { STEP_BEGIN(s0 + 0) if (PHON(0)) phase_normmod(cx, a, lds, AIN(I_X), nullptr, RL, RL, 0, 0); STEP_END }
    STEP_BEGIN(s0 + 1) if (PHON(1)) { pg8::Gemm gm{U, (const bf16_t*)(ws + WS_WI1), RL, 2 * FH, D, D, D, 0, 0}; S.init(RL, 2 * FH, G, cidx);
                  pg8::EpiSwiglu E{BIG, FH}; pg8::gemm_phase<pg8::EpiSwiglu, true>(cx.tid, lds, gm, S, E); } STEP_END
    STEP_BEGIN(s0 + 2) if (PHON(2)) { pg8::Gemm gm{BIG, (const bf16_t*)(ws + WS_WO1), RL, D, FH, FH, FH, 0, 0}; S.init(RL, D, G, cidx);
                  pg8::EpiResid E{AIN(I_X) + (size_t)g * RL * D, AIN(I_CTX) + (size_t)g * RC * D, H1, H1 + (size_t)RL * D,
                                  MOD + (size_t)(g * BG) * NMOD + 2 * D, MOD + (size_t)32 * NMOD + 2 * D, 0.5f, RL / 256};
                  pg8::gemm_phase<pg8::EpiResid, true>(cx.tid, lds, gm, S, E); } STEP_END
    STEP_BEGIN(s0 + 3) if (PHON(3)) phase_normmod(cx, a, lds, H1r, H1Cr, RL, RG, g * BG, 1); STEP_END
    STEP_BEGIN(s0 + 4) if (PHON(4)) { pg8::Gemm gm{U, (const bf16_t*)(ws + WS_WIN), RG, PN, D, D, D, 0, 0}; S.init(RL, PN, G, cidx); S.ext = (RC / 256) * 11; S.ext_pm0 = RL / 256;
                  pg8::EpiBf16 E{BIG, PN}; pg8::gemm_phase<pg8::EpiBf16, true>(cx.tid, lds, gm, S, E); } STEP_END
    STEP_BEGIN(s0 + 5) if (PHON(5)) phase_prep(cx, a, g, lds); STEP_END
    STEP_BEGIN(s0 + 6) if (PHON(6)) { pg8::Gemm gm{XC, (const bf16_t*)(ws + WS_WLG), RG, 4096, 128, D, 128, 1, 256}; S.init(RG, 4096, G, cidx);
                  pg8::EpiGate E{(bf16_t*)(ws + WS_LA), (bf16_t*)(ws + WS_UU)};
                  pg8::gemm_phase<pg8::EpiGate, true>(cx.tid, lds, gm, S, E); } STEP_END
    STEP_BEGIN(s0 + 7) if (PHON(7)) { phase_gla_scan(cx, a, g, lds); } STEP_END
    STEP_BEGIN(s0 + 8) if (PHON(8)) phase_lru_scan(cx, a, g, lds); STEP_END
    STEP_BEGIN(s0 + 9) if (PHON(9)) phase_post(cx, a, lds, g); STEP_END
    STEP_BEGIN(s0 + 10) if (PHON(10)) { pg8::Gemm gm{(const bf16_t*)(ws + WS_OFB), (const bf16_t*)(ws + WS_WOG), RL, D, D, D, D, 0, 0}; S.init(RL, D, G, cidx);
                   pg8::EpiMix<false> E{BIG, PGA, XC}; pg8::gemm_phase<pg8::EpiMix<false>, true>(cx.tid, lds, gm, S, E); } STEP_END
    STEP_BEGIN(s0 + 11) if (PHON(11)) { pg8::Gemm gm{(const bf16_t*)(ws + WS_HFB), (const bf16_t*)(ws + WS_WOL), RL, D, D, D, D, 0, 0}; S.init(RL, D, G, cidx);
                   pg8::EpiMix<true> E{BIG, PGB, XC}; pg8::gemm_phase<pg8::EpiMix<true>, true>(cx.tid, lds, gm, S, E); } STEP_END
    STEP_BEGIN(s0 + 12) if (PHON(12)) { pg8::Gemm gm{XC, (const bf16_t*)(ws + WS_WOO), RL, D, D, D, D, 0, 0}; S.init(RL, D, G, cidx);
                   pg8::EpiResid E{H1, H1, H1, H1, MOD + (size_t)(g * BG) * NMOD + 5 * D, MOD, 1.0f, RL / 256};
                   pg8::gemm_phase<pg8::EpiResid, true>(cx.tid, lds, gm, S, E); } STEP_END
    STEP_BEGIN(s0 + 13) if (PHON(13)) phase_normmod(cx, a, lds, H1r, nullptr, RL, RL, g * BG, 2); STEP_END
    STEP_BEGIN(s0 + 14) if (PHON(14)) { pg8::Gemm gm{U, (const bf16_t*)(ws + WS_WI2), RL, 2 * FH, D, D, D, 0, 0}; S.init(RL, 2 * FH, G, cidx);
                   pg8::EpiSwiglu E{BIG, FH}; pg8::gemm_phase<pg8::EpiSwiglu, true>(cx.tid, lds, gm, S, E); } STEP_END
    STEP_BEGIN(s0 + 15) if (PHON(15)) { pg8::Gemm gm{BIG, (const bf16_t*)(ws + WS_WO2), RL, D, FH, FH, FH, 0, 0}; S.init(RL, D, G, cidx);
                   float* og = a.out + (size_t)g * RL * D;
                   pg8::EpiResid E{H1, H1, og, og, MOD + (size_t)(g * BG) * NMOD + 8 * D, MOD, 0.5f, RL / 256};
                   pg8::gemm_phase<pg8::EpiResid, true>(cx.tid, lds, gm, S, E); } STEP_END
    STEP_BEGIN(s0 + 16) if (PHON(16)) { phase_final(cx, a, lds, g); if (g + 1 < NG) phase_normmod(cx, a, lds, AIN(I_X) + (size_t)(g + 1) * RL * D, nullptr, RL, RL, (g + 1) * BG, 0); } STEP_END
}

__global__ void __launch_bounds__(NTHR, 2) fwd_kernel(Args a) {
    extern __shared__ __attribute__((aligned(16))) unsigned char lds_raw[];
    LAS unsigned char* lds = (LAS unsigned char*)lds_raw;
    if (threadIdx.x < 26) ((LAS unsigned long long*)(lds + PTAB))[threadIdx.x] = (unsigned long long)a.in[threadIdx.x];
    if (threadIdx.x == 32) { ((LAS unsigned*)(lds + PTAB + 256))[0] = 0u; ((LAS unsigned*)(lds + PTAB + 256))[1] = 0u; }
#if ONE_LAUNCH
    if (threadIdx.x == 0) (void)xb_add((unsigned*)a.ws + 4096 + XB_XCNT(xb_xcc_id()), 1u);
#endif
    const int wave_s = __builtin_amdgcn_readfirstlane(threadIdx.x >> 6);
    __syncthreads();
    STEP_BEGIN(0) if (PHON(17)) phase_weights(cx, a, lds); STEP_END
    STEP_BEGIN(1) if (PHON(18)) phase_modreduce(cx, a, lds); STEP_END
    STEP_BEGIN(2) if (PHON(0)) phase_normmod(cx, a, lds, nullptr, AIN(I_CTX), 0, NB * CL, 0, 0); STEP_END
    STEP_BEGIN(3) if (PHON(1)) { pg8::Gemm gm{U, (const bf16_t*)(ws + WS_WI1), NB * CL, 2 * FH, D, D, D, 0, 0}; S.init(NB * CL, 2 * FH, G, cidx);
                  pg8::EpiSwiglu E{BIG, FH}; pg8::gemm_phase<pg8::EpiSwiglu, true>(cx.tid, lds, gm, S, E); } STEP_END
    STEP_BEGIN(4) if (PHON(2)) { pg8::Gemm gm{BIG, (const bf16_t*)(ws + WS_WO1), NB * CL, D, FH, FH, FH, 0, 0}; S.init(NB * CL, D, G, cidx);
                  float* h1c = (float*)(ws + WS_H1C);
                  pg8::EpiResid E{AIN(I_CTX), AIN(I_CTX), h1c, h1c, MOD, MOD + (size_t)32 * NMOD + 2 * D, 0.5f, 0};
                  pg8::gemm_phase<pg8::EpiResid, true>(cx.tid, lds, gm, S, E); } STEP_END
    run_group<0>(a, lds, wave_s);
    run_group<1>(a, lds, wave_s);
    run_group<2>(a, lds, wave_s);
    run_group<3>(a, lds, wave_s);
}


#ifdef PROBE_STEP
__global__ void probe_kernel(const unsigned char* ws, float* out) {
    const size_t n = (size_t)65536 * 1024, q = n / 4;
    const bf16_t* r0 = (const bf16_t*)(ws + PROBE_R0); const bf16_t* r1 = (const bf16_t*)(ws + PROBE_R1); const bf16_t* r2 = (const bf16_t*)(ws + PROBE_R2); const bf16_t* r3 = (const bf16_t*)(ws + PROBE_R3);
    for (size_t i = (size_t)blockIdx.x * blockDim.x + threadIdx.x; i < q; i += (size_t)gridDim.x * blockDim.x) {
        out[i] = bf2f(r0[i]); out[q + i] = bf2f(r1[i]); out[2 * q + i] = bf2f(r2[i]); out[3 * q + i] = bf2f(r3[i]); }
}
#endif
extern "C" void kernel_launch(void* const* d_in, const int* in_sizes, int n_in, void* d_out, int out_size, void* d_ws, size_t ws_size, hipStream_t stream) {
    static int grid = 0;
    if (grid == 0) {
        if (n_in != 26 || ws_size < WS_END) { fprintf(stderr, "kernel_launch: unexpected inputs (n_in %d, ws %zu, need %zu)\n", n_in, ws_size, (size_t)WS_END); grid = -1; return; }
        int dev = 0, cus = 0, per_cu = 0;
        hipGetDevice(&dev); hipDeviceGetAttribute(&cus, hipDeviceAttributeMultiprocessorCount, dev);
        if (hipFuncSetAttribute((const void*)fwd_kernel, hipFuncAttributeMaxDynamicSharedMemorySize, LDS_BYTES) != hipSuccess) { fprintf(stderr, "kernel_launch: hipFuncSetAttribute failed\n"); grid = -1; return; }
        hipOccupancyMaxActiveBlocksPerMultiprocessor(&per_cu, (const void*)fwd_kernel, NTHR, LDS_BYTES);
        (void)hipGetLastError();
        if (per_cu < 1) per_cu = 1;
        grid = cus * 1;
    }
    if (grid < 0) return;
    Args a{};
    for (int i = 0; i < 26; ++i) a.in[i] = (const float*)d_in[i];
    a.out = (float*)d_out; a.ws = (unsigned char*)d_ws;
    const int nsteps = 5 + NG * NPH;
#if ONE_LAUNCH
    (void)hipMemsetAsync(d_ws, 0, 65536, stream);
    a.lo = 0; a.hi = nsteps;
    void* args[] = {&a};
    hipError_t e = hipLaunchCooperativeKernel((const void*)fwd_kernel, dim3(grid), dim3(NTHR), args, LDS_BYTES, stream);
    if (e != hipSuccess) fprintf(stderr, "cooperative launch failed: %s (grid %d)\n", hipGetErrorString(e), grid);
#else
#ifdef PROBE_STEP
    for (int s = 0; s <= PROBE_STEP; ++s) { a.lo = s; a.hi = s + 1; hipLaunchKernelGGL(fwd_kernel, dim3(grid), dim3(NTHR), LDS_BYTES, stream, a); }
    hipLaunchKernelGGL(probe_kernel, dim3(2048), dim3(256), 0, stream, (const unsigned char*)d_ws, (float*)d_out);
#else
    for (int s = 0; s < nsteps; ++s) { a.lo = s; a.hi = s + 1; hipLaunchKernelGGL(fwd_kernel, dim3(grid), dim3(NTHR), LDS_BYTES, stream, a); }
#endif
#endif
}
```

```cpp
#include <hip/hip_runtime.h>
#include <hip/hip_cooperative_groups.h>
#include <cstdio>
#include <cstdint>
namespace cg = cooperative_groups;

#ifndef ONE_LAUNCH
#define ONE_LAUNCH 1
#endif

#ifndef PHMASK
#define PHMASK 0x1fffff
#endif
#define PHON(n) (((PHMASK) >> (n)) & 1)
#define LAS __attribute__((address_space(3)))
typedef unsigned short bf16_t;
typedef short bf16x8 __attribute__((ext_vector_type(8)));
typedef float f32x4 __attribute__((ext_vector_type(4)));
typedef float f32x2 __attribute__((ext_vector_type(2)));
typedef unsigned u32x4 __attribute__((ext_vector_type(4)));
typedef unsigned u32x2 __attribute__((ext_vector_type(2)));

constexpr int D = 1024, NB = 32, T = 2048, CL = 256, FH = 2816, INW = 7200, PN = 7424, NMOD = 9216;
constexpr int NG = 4, BG = NB / NG;
constexpr int RL = BG * T, RC = BG * CL, RG = RL + RC;
constexpr int NCH = 36;
constexpr float EPS = 1e-6f;
constexpr int PQ = 0, PK = 512, PV = 1024, PGG = 2048, PXL = 3072, PYL = 4096, PGA = 5120, PGB = 6144, PFD = 7168;

constexpr size_t al(size_t x) { return (x + 4095) & ~(size_t)4095; }
constexpr size_t WS_WI1 = 1 << 20;
constexpr size_t WS_WO1 = WS_WI1 + al((size_t)2 * FH * D * 2);
constexpr size_t WS_WI2 = WS_WO1 + al((size_t)D * FH * 2);
constexpr size_t WS_WO2 = WS_WI2 + al((size_t)2 * FH * D * 2);
constexpr size_t WS_WIN = WS_WO2 + al((size_t)D * FH * 2);
constexpr size_t WS_WOG = WS_WIN + al((size_t)PN * D * 2);
constexpr size_t WS_WOL = WS_WOG + al((size_t)D * D * 2);
constexpr size_t WS_WOO = WS_WOL + al((size_t)D * D * 2);
constexpr size_t WS_WLG = WS_WOO + al((size_t)D * D * 2);
constexpr size_t WS_MODP = WS_WLG + al((size_t)4096 * 128 * 2);
constexpr size_t WS_MOD = WS_MODP + al((size_t)16 * 33 * NMOD * 4);
constexpr size_t WS_GC = WS_MOD + al((size_t)33 * NMOD * 4);
constexpr size_t WS_H1 = WS_GC + al((size_t)6 * D * 4);
constexpr size_t WS_U = WS_H1 + al((size_t)RG * D * 4);
constexpr size_t WS_BIG = WS_U + al((size_t)RG * D * 2);
constexpr size_t WS_XC = WS_BIG + al((size_t)RG * PN * 2);
constexpr size_t WS_LA = WS_XC + al((size_t)RG * D * 2);
constexpr size_t WS_UU = WS_LA + al((size_t)2 * RG * D * 2);
constexpr size_t WS_HFB = WS_UU + al((size_t)2 * RG * D * 2);
constexpr size_t WS_OFB = WS_HFB + al((size_t)2 * RL * D * 2);
constexpr size_t GT = (size_t)2 * BG * NCH * 4;
constexpr size_t WS_QD = WS_OFB + al((size_t)2 * RL * D * 2);
constexpr size_t WS_KI = WS_QD + al(GT * 8192 * 2);
constexpr size_t WS_KET = WS_KI + al(GT * 8192 * 2);
constexpr size_t WS_VT = WS_KET + al(GT * 8192 * 2);
constexpr size_t WS_BL = WS_VT + al((size_t)BG * NCH * 4 * 16384 * 2);
constexpr size_t WS_H1C = WS_BL + al(GT * 128 * 4);
constexpr size_t WS_END = WS_H1C + al((size_t)NB * CL * D * 4);
static_assert(WS_END <= (size_t)1073741824, "workspace map exceeds 1 GiB");

constexpr int LDS_BYTES = 163840, PTAB = LDS_BYTES - 512;

typedef __bf16 bf16x2_t __attribute__((ext_vector_type(2)));
__device__ __forceinline__ unsigned cvt_pk_bf16(float lo, float hi) { const f32x2 v = {lo, hi}; return __builtin_bit_cast(unsigned, __builtin_convertvector(v, bf16x2_t)); }
__device__ __forceinline__ bf16_t f2bf(float f) { return (bf16_t)(cvt_pk_bf16(f, 0.f) & 0xffffu); }
__device__ __forceinline__ float bf2f(bf16_t h) { return __uint_as_float(((unsigned)h) << 16); }
__device__ __forceinline__ float bflo(unsigned w) { return __uint_as_float(w << 16); }
__device__ __forceinline__ float bfhi(unsigned w) { return __uint_as_float(w & 0xffff0000u); }
__device__ __forceinline__ float sigmoidf_(float x) { return __builtin_amdgcn_rcpf(1.0f + __expf(-x)); }
__device__ __forceinline__ float siluf_(float x) { return x * __builtin_amdgcn_rcpf(1.0f + __expf(-x)); }
__device__ __forceinline__ float geluf_(float x) { const float z = 0.7978845608028654f * (x + 0.044715f * x * x * x); return x * (1.0f - __builtin_amdgcn_rcpf(1.0f + __expf(2.0f * z))); }
__device__ __forceinline__ float logsigf_(float x) { return fminf(x, 0.f) - log1pf(__expf(-fabsf(x))); }
__device__ __forceinline__ float one_minus_exp(float x) {
    const float ser = -x * (1.0f + x * (0.5f + x * (0.16666667f + x * (0.041666668f + x * (0.0083333338f + x * (0.0013888889f + x * 0.0001984127f))))));
    return x > -0.3f ? ser : 1.0f - __expf(x);
}
__device__ __forceinline__ float wave_sum(float v) {
#pragma unroll
    for (int o = 1; o < 64; o <<= 1) v += __shfl_xor(v, o);
    return v;
}
__device__ __forceinline__ void unpack8(const u32x4 w, float (&f)[8]) {
    f[0] = bflo(w.x); f[1] = bfhi(w.x); f[2] = bflo(w.y); f[3] = bfhi(w.y); f[4] = bflo(w.z); f[5] = bfhi(w.z); f[6] = bflo(w.w); f[7] = bfhi(w.w);
}
__device__ __forceinline__ u32x4 pack8(const float (&f)[8]) {
    u32x4 w; w.x = cvt_pk_bf16(f[0], f[1]); w.y = cvt_pk_bf16(f[2], f[3]); w.z = cvt_pk_bf16(f[4], f[5]); w.w = cvt_pk_bf16(f[6], f[7]); return w;
}

namespace pg8 {
constexpr int BM = 256, BK = 64, HALF = 128, HTB = HALF * BK * 2, STAGE_BYTES = 8 * HTB, NXCD = 8, WGM = 8;
__host__ __device__ __forceinline__ int lds_byte(int r, int c) { const int st = (r >> 4) * 2 + (c >> 5), rr = r & 15, cc = c & 31, ob = rr * 64 + cc * 2; return st * 1024 + (ob ^ (((ob >> 9) & 1) << 5)); }
__host__ __device__ __forceinline__ void stage_rc(int b, int& R, int& C) { const int st = b / 1024, sb = b % 1024, swz = sb ^ (((sb >> 9) & 1) << 5); R = (st >> 1) * 16 + swz / 64; C = (st & 1) * 32 + (swz % 64) / 2; }
__host__ __device__ __forceinline__ int perm32(int rho) { const int n = rho >> 4, i = rho & 15; return 8 * (i >> 2) + 4 * n + (i & 3); }
struct Unit { int pm, pn; };
struct Gemm { const bf16_t* A; const bf16_t* Bt; int M, N, K, lda, ldb, a_pn_shift, a_pn_bytes; };
struct StaticOrder {
    int nM, nN, nwg, G, c, ext, ext_pm0;
    __device__ void init(int M, int N, int G_, int c_) { nM = M / BM; nN = N / BM; nwg = nM * nN; G = G_; c = c_; ext = 0; ext_pm0 = 0; }
    __device__ bool next(int i, Unit& u) const {
        const long L = (long)i * G + c;
        if (L >= nwg) { if (L >= nwg + ext) return false; const int idx = (int)(L - nwg), t = idx % 11; u.pm = ext_pm0 + idx / 11; u.pn = t < 6 ? t + 2 : (t < 10 ? t + 6 : 28); return true; }
        int wgid = (int)L; { const int q = nwg / NXCD, r = nwg % NXCD, xcd = wgid % NXCD, off = wgid / NXCD; wgid = (xcd < r ? xcd * (q + 1) : r * (q + 1) + (xcd - r) * q) + off; }
        const int nig = WGM * nN, gid = wgid / nig, fm = gid * WGM, gsz = (nM - fm) < WGM ? (nM - fm) : WGM;
        u.pm = fm + ((wgid % nig) % gsz); u.pn = (wgid % nig) / gsz; return true;
    }
};
template <class Epi, bool ALIGN_EPI>
__device__ __forceinline__ void gemm_phase(const int tid, LAS unsigned char* lds, const Gemm g, const StaticOrder& S, const Epi& E) {
    const int wid = __builtin_amdgcn_readfirstlane(tid >> 6), lane = tid & 63, wr = wid >> 2, wc = wid & 3, fr = lane & 15, fq = lane >> 4;
    const int K = g.K, nt = K / BK;
    unsigned voffA[2], voffB[2];
#pragma unroll
    for (int i = 0; i < 2; ++i) { int R, C; stage_rc(tid * 16 + i * 8192, R, C); const int Rb = Epi::PERM ? ((R & ~31) + perm32(R & 31)) : R;
        voffA[i] = (unsigned)(R * g.lda + C) * 2u; voffB[i] = (unsigned)(Rb * g.ldb + C) * 2u; }
    const size_t kstep = (size_t)(BK * 2);
    const size_t hstepA = (size_t)HALF * g.lda * 2, hstepB = (size_t)HALF * g.ldb * 2;
    const size_t tstepA = 2 * hstepA, tstepB = 2 * hstepB;
    const unsigned ldsw = (unsigned)wid * 1024u;
    const int aoff = lds_byte(wr * 64 + fr, fq * 8), boff = lds_byte(wc * 32 + fr, fq * 8);
#define PG8_SA(b, h) (((b) * 2 + (h)) * HTB)
#define PG8_SB(b, h) ((4 + (b) * 2 + (h)) * HTB)
#define PG8_STAGE(bufoff, gbase, voff) do { _Pragma("unroll") for (int _i = 0; _i < 2; ++_i) \
        __builtin_amdgcn_global_load_lds((const unsigned*)((const char*)(gbase) + (voff)[_i]), (LAS unsigned*)(lds + (bufoff) + ldsw + _i * 8192), 16, 0, 0); } while (0)
#define PG8_LDA(dst, b, h) do { _Pragma("unroll") for (int m = 0; m < 4; ++m) _Pragma("unroll") for (int k = 0; k < 2; ++k) dst[m][k] = *(const LAS bf16x8*)(lds + PG8_SA(b, h) + aoff + m * 2048 + k * 1024); } while (0)
#define PG8_LDB(dst, b, h) do { _Pragma("unroll") for (int n = 0; n < 2; ++n) _Pragma("unroll") for (int k = 0; k < 2; ++k) dst[n][k] = *(const LAS bf16x8*)(lds + PG8_SB(b, h) + boff + n * 2048 + k * 1024); } while (0)
#define PG8_MMA(ai, bj, At, Bt) do { __builtin_amdgcn_s_setprio(1); _Pragma("unroll") for (int m = 0; m < 4; ++m) _Pragma("unroll") for (int n = 0; n < 2; ++n) _Pragma("unroll") for (int k = 0; k < 2; ++k) \
        acc[ai][bj][m][n] = __builtin_amdgcn_mfma_f32_16x16x32_bf16(Bt[n][k], At[m][k], acc[ai][bj][m][n], 0, 0, 0); __builtin_amdgcn_s_setprio(0); } while (0)
#define PG8_WAIT_V(n) asm volatile("s_waitcnt vmcnt(" #n ")" ::: "memory")
#define PG8_WAIT_L(n) asm volatile("s_waitcnt lgkmcnt(" #n ")" ::: "memory")
#define PG8_BAR __builtin_amdgcn_s_barrier()
#define PG8_SCHED __builtin_amdgcn_sched_barrier(0)
    Unit cur, nxt; int ui = 0;
    if (!S.next(0, cur)) return;
    f32x4 acc[2][2][4][2];
#pragma unroll
    for (int a = 0; a < 2; ++a)
#pragma unroll
        for (int b = 0; b < 2; ++b)
#pragma unroll
            for (int m = 0; m < 4; ++m)
#pragma unroll
                for (int n = 0; n < 2; ++n) acc[a][b][m][n] = (f32x4){0.f, 0.f, 0.f, 0.f};
    bf16x8 At[4][2], B0[2][2], B1[2][2];
    const char* cA = (const char*)g.A + (size_t)cur.pm * tstepA + (size_t)((cur.pn >> g.a_pn_shift) * g.a_pn_bytes);
    const char* cB = (const char*)g.Bt + (size_t)cur.pn * tstepB;
    PG8_STAGE(PG8_SB(0, 0), cB, voffB); PG8_STAGE(PG8_SB(0, 1), cB + hstepB, voffB); PG8_STAGE(PG8_SA(0, 0), cA, voffA); PG8_STAGE(PG8_SA(0, 1), cA + hstepA, voffA);
    if (wr == 1) PG8_BAR;
    PG8_WAIT_V(2); PG8_BAR;
    PG8_STAGE(PG8_SB(1, 0), cB + kstep, voffB); PG8_STAGE(PG8_SA(1, 0), cA + kstep, voffA); PG8_STAGE(PG8_SB(1, 1), cB + hstepB + kstep, voffB);
    PG8_WAIT_V(6); PG8_BAR;
    for (;;) {
        const bool has_next = S.next(ui + 1, nxt);
        const char* nA = has_next ? (const char*)g.A + (size_t)nxt.pm * tstepA + (size_t)((nxt.pn >> g.a_pn_shift) * g.a_pn_bytes) : cA;
        const char* nB = has_next ? (const char*)g.Bt + (size_t)nxt.pn * tstepB : cB;
        for (int t = 0; t < nt; t += 2) {
            const bool last = (t == nt - 2);
            const char* a1 = cA + (size_t)(t + 1) * kstep;
            const char* a2 = last ? nA : cA + (size_t)(t + 2) * kstep; const char* b2 = last ? nB : cB + (size_t)(t + 2) * kstep;
            const char* a3 = a2 + kstep; const char* b3 = b2 + kstep;
            PG8_LDB(B0, 0, 0); PG8_LDB(B1, 0, 1); PG8_SCHED; PG8_LDA(At, 0, 0); PG8_STAGE(PG8_SA(1, 1), a1 + hstepA, voffA);
            PG8_WAIT_V(8); PG8_WAIT_L(0); PG8_BAR; PG8_MMA(0, 0, At, B0); PG8_MMA(0, 1, At, B1); PG8_BAR; PG8_SCHED;
            PG8_LDA(At, 0, 1); PG8_STAGE(PG8_SB(0, 0), b2, voffB); PG8_STAGE(PG8_SB(0, 1), b2 + hstepB, voffB); PG8_STAGE(PG8_SA(0, 0), a2, voffA);
            PG8_WAIT_V(8); PG8_WAIT_L(0); PG8_BAR; PG8_MMA(1, 0, At, B0); PG8_MMA(1, 1, At, B1); PG8_BAR; PG8_SCHED;
            PG8_LDB(B0, 1, 0); PG8_LDB(B1, 1, 1); PG8_SCHED; PG8_LDA(At, 1, 0); PG8_STAGE(PG8_SA(0, 1), a2 + hstepA, voffA);
            PG8_WAIT_V(8); PG8_WAIT_L(0); PG8_BAR; PG8_MMA(0, 0, At, B0); PG8_MMA(0, 1, At, B1); PG8_BAR; PG8_SCHED;
            PG8_LDA(At, 1, 1); PG8_STAGE(PG8_SB(1, 0), b3, voffB); PG8_STAGE(PG8_SB(1, 1), b3 + hstepB, voffB); PG8_STAGE(PG8_SA(1, 0), a3, voffA);
            PG8_WAIT_V(8); PG8_WAIT_L(0); PG8_BAR; PG8_MMA(1, 0, At, B0); PG8_MMA(1, 1, At, B1); PG8_BAR; PG8_SCHED;
        }
        if constexpr (ALIGN_EPI) { if (wr == 0) PG8_BAR; }
        { int fr_ = fr, fq_ = fq; asm volatile("" : "+v"(fr_), "+v"(fq_)); E(acc, cur, wr, wc, fr_, fq_); }
        if (!has_next) break;
#pragma unroll
        for (int a = 0; a < 2; ++a)
#pragma unroll
            for (int b = 0; b < 2; ++b)
#pragma unroll
                for (int m = 0; m < 4; ++m)
#pragma unroll
                    for (int n = 0; n < 2; ++n) acc[a][b][m][n] = (f32x4){0.f, 0.f, 0.f, 0.f};
        cur = nxt; cA = nA; cB = nB; ++ui;
        if constexpr (ALIGN_EPI) { if (wr == 1) PG8_BAR; }
    }
    PG8_WAIT_V(0);
    if constexpr (!ALIGN_EPI) { if (wr == 0) PG8_BAR; }
    PG8_BAR;
#undef PG8_SA
#undef PG8_SB
#undef PG8_STAGE
#undef PG8_LDA
#undef PG8_LDB
#undef PG8_MMA
#undef PG8_WAIT_V
#undef PG8_WAIT_L
#undef PG8_BAR
#undef PG8_SCHED
}

struct EpiBf16 {
    static constexpr bool PERM = true;
    bf16_t* O; int ldc;
    __device__ __forceinline__ void operator()(const f32x4 (&acc)[2][2][4][2], const Unit& u, int wr, int wc, int fr, int fq) const {
        const int row0 = u.pm * BM + wr * 64 + fr, col0 = u.pn * BM + wc * 32 + 8 * fq;
#pragma unroll
        for (int ai = 0; ai < 2; ++ai)
#pragma unroll
            for (int m = 0; m < 4; ++m) { bf16_t* rowp = O + (size_t)(row0 + ai * HALF + m * 16) * ldc + col0;
#pragma unroll
                for (int bj = 0; bj < 2; ++bj) { const f32x4 v0 = acc[ai][bj][m][0], v1 = acc[ai][bj][m][1];
                    u32x4 w; w.x = cvt_pk_bf16(v0[0], v0[1]); w.y = cvt_pk_bf16(v0[2], v0[3]); w.z = cvt_pk_bf16(v1[0], v1[1]); w.w = cvt_pk_bf16(v1[2], v1[3]);
                    *(u32x4*)(rowp + bj * HALF) = w; } }
    }
};
struct EpiSwiglu {
    static constexpr bool PERM = true;
    bf16_t* O; int ldc;
    __device__ __forceinline__ void operator()(const f32x4 (&acc)[2][2][4][2], const Unit& u, int wr, int wc, int fr, int fq) const {
        const int row0 = u.pm * BM + wr * 64 + fr, col0 = u.pn * HALF + wc * 32 + 8 * fq;
#pragma unroll
        for (int ai = 0; ai < 2; ++ai)
#pragma unroll
            for (int m = 0; m < 4; ++m) { bf16_t* rowp = O + (size_t)(row0 + ai * HALF + m * 16) * ldc + col0;
                float o[8];
#pragma unroll
                for (int n = 0; n < 2; ++n)
#pragma unroll
                    for (int j = 0; j < 4; ++j) o[4 * n + j] = siluf_(acc[ai][0][m][n][j]) * acc[ai][1][m][n][j];
                *(u32x4*)rowp = pack8(o); }
    }
};
struct EpiResid {
    static constexpr bool PERM = false;
    const float* baseL; const float* baseC; float* outL; float* outC; const float* modL; const float* modC; float scale; int nlat;
    __device__ __forceinline__ void operator()(const f32x4 (&acc)[2][2][4][2], const Unit& u, int wr, int wc, int fr, int fq) const {
        const bool lat = u.pm < nlat;
        const size_t toff = (size_t)(lat ? u.pm : u.pm - nlat) * BM * D + (size_t)(wr * 64 + fr) * D + u.pn * BM + wc * 32 + 4 * fq;
        const float* base = (lat ? baseL : baseC) + toff;
        float* out = (lat ? outL : outC) + toff;
        const float* mg = (lat ? modL + (size_t)(u.pm >> 3) * NMOD : modC) + u.pn * BM + wc * 32 + 4 * fq;
#pragma unroll
        for (int bj = 0; bj < 2; ++bj)
#pragma unroll
            for (int n = 0; n < 2; ++n) { const f32x4 gv = *(const f32x4*)(mg + bj * HALF + n * 16) * scale;
#pragma unroll
                for (int ai = 0; ai < 2; ++ai)
#pragma unroll
                    for (int m = 0; m < 4; ++m) { const size_t off = (size_t)(ai * HALF + m * 16) * D + bj * HALF + n * 16;
                        const f32x4 bs = *(const f32x4*)(base + off); *(f32x4*)(out + off) = bs + gv * acc[ai][bj][m][n]; } }
    }
};
__device__ __forceinline__ float one_minus_exp(float x) {
    const float ser = -x * (1.0f + x * (0.5f + x * (0.16666667f + x * (0.041666668f + x * (0.0083333338f + x * (0.0013888889f + x * 0.0001984127f))))));
    return x > -0.3f ? ser : 1.0f - __expf(x);
}
struct EpiGate {
    static constexpr bool PERM = true;
    bf16_t* LA; bf16_t* UU;
    __device__ __forceinline__ void operator()(const f32x4 (&acc)[2][2][4][2], const Unit& u, int wr, int wc, int fr, int fq) const {
        const int blk = u.pn >> 1, dir = u.pn & 1, ch0 = blk * HALF + wc * 32 + 8 * fq, row0 = u.pm * BM + wr * 64 + fr;
#pragma unroll
        for (int ai = 0; ai < 2; ++ai)
#pragma unroll
            for (int m = 0; m < 4; ++m) { const size_t off = (size_t)dir * RG * D + (size_t)(row0 + ai * HALF + m * 16) * D + ch0;
#pragma unroll
                for (int bj = 0; bj < 2; ++bj) { const f32x4 v0 = acc[ai][bj][m][0], v1 = acc[ai][bj][m][1];
                    u32x4 w; w.x = cvt_pk_bf16(v0[0], v0[1]); w.y = cvt_pk_bf16(v0[2], v0[3]); w.z = cvt_pk_bf16(v1[0], v1[1]); w.w = cvt_pk_bf16(v1[2], v1[3]);
                    *(u32x4*)((bj ? UU : LA) + off) = w; } }
    }
};
template <bool ACCUM> struct EpiMix {
    static constexpr bool PERM = true;
    const bf16_t* PROJ; int gcol; bf16_t* MG;
    __device__ __forceinline__ void operator()(const f32x4 (&acc)[2][2][4][2], const Unit& u, int wr, int wc, int fr, int fq) const {
        const int row0 = u.pm * BM + wr * 64 + fr, col0 = u.pn * BM + wc * 32 + 8 * fq;
#pragma unroll
        for (int ai = 0; ai < 2; ++ai)
#pragma unroll
            for (int m = 0; m < 4; ++m) { const size_t row = (size_t)(row0 + ai * HALF + m * 16);
#pragma unroll
                for (int bj = 0; bj < 2; ++bj) { float gt[8], o[8]; unpack8(*(const u32x4*)(PROJ + row * PN + gcol + col0 + bj * HALF), gt);
                    bf16_t* dst = MG + row * D + col0 + bj * HALF;
                    if (ACCUM) unpack8(*(const u32x4*)dst, o); else {
#pragma unroll
                        for (int i = 0; i < 8; ++i) o[i] = 0.f; }
#pragma unroll
                    for (int n = 0; n < 2; ++n)
#pragma unroll
                        for (int j = 0; j < 4; ++j) o[4 * n + j] += sigmoidf_(gt[4 * n + j]) * acc[ai][bj][m][n][j];
                    *(u32x4*)dst = pack8(o); } }
    }
};
}

struct Args {
    const float* in[26]; float* out; unsigned char* ws; int lo, hi;
};
enum { I_X = 0, I_C, I_CTX, I_CCTX, I_WADA, I_BADA, I_NORMW, I_F1WI, I_F1WO, I_F2WI, I_F2WO, I_WIN, I_FUP, I_FB, I_GNW, I_CONVW, I_CONVB, I_WR, I_BR, I_WI, I_BI, I_LAM, I_WOG, I_WOL, I_WOO, I_FNW };

#define NTHR 512
__device__ __forceinline__ const float* inp(const LAS unsigned char* lds, int i) { const LAS unsigned* t = (const LAS unsigned*)(lds + PTAB) + 2 * i;
    const unsigned lo = __builtin_amdgcn_readfirstlane(t[0]), hi = __builtin_amdgcn_readfirstlane(t[1]); return (const float*)(((unsigned long long)hi << 32) | lo); }
#define AIN(i) inp(lds, (i))
struct Ctx { int tid, bid, G; };
#define GW() (cx.bid * 8 + (cx.tid >> 6))
#define NGW() (cx.G * 8)

__device__ __forceinline__ void transpose_item(const float* W, int ldw, int K, int k0, int n0, bf16_t* WT, int drow, LAS float* scr, int lane) {
#pragma unroll 8
    for (int i = 0; i < 32; ++i) { const int kk = 2 * i + (lane >> 5); scr[kk * 33 + (lane & 31)] = W[(size_t)(k0 + kk) * ldw + n0 + (lane & 31)]; }
    asm volatile("s_waitcnt lgkmcnt(0)" ::: "memory");
    const int c = lane & 7;
#pragma unroll
    for (int j = 0; j < 4; ++j) { const int n = (lane >> 3) + 8 * j; const LAS float* s = scr + (8 * c) * 33 + n;
        u32x4 o; o.x = cvt_pk_bf16(s[0 * 33], s[1 * 33]); o.y = cvt_pk_bf16(s[2 * 33], s[3 * 33]); o.z = cvt_pk_bf16(s[4 * 33], s[5 * 33]); o.w = cvt_pk_bf16(s[6 * 33], s[7 * 33]);
        *(u32x4*)(WT + (size_t)(drow + n) * K + k0 + 8 * c) = o; }
    asm volatile("s_waitcnt lgkmcnt(0)" ::: "memory");
}
__device__ __forceinline__ int wi_drow(int n0) { return n0 < FH ? (n0 >> 7) * 256 + (n0 & 127) : ((n0 - FH) >> 7) * 256 + 128 + ((n0 - FH) & 127); }
__device__ __forceinline__ int win_drow(int n0) { return n0 < 3072 ? n0 : (n0 == 3072 ? PFD : n0 - 32); }

__device__ __forceinline__ void phase_weights(const Ctx cx, const Args& a, LAS unsigned char* lds) {
    const int lane = cx.tid & 63, wave = cx.tid >> 6;
    LAS float* scr = (LAS float*)(lds + wave * 16384);
    unsigned char* ws = a.ws;
    constexpr int I_WI_ = (D / 64) * (2 * FH / 32), I_WO_ = (FH / 64) * (D / 32), I_IN_ = (D / 64) * (INW / 32), I_SQ_ = (D / 64) * (D / 32), I_LG_ = 32 * 8;
    constexpr int NIT = 2 * I_WI_ + 2 * I_WO_ + I_IN_ + 3 * I_SQ_ + I_LG_;
    if (PHON(19)) for (int it = GW(); it < NIT; it += NGW()) {
        int r = it;
        if (r < 2 * I_WI_) { const int w = r / I_WI_; r %= I_WI_; const int nb = 2 * FH / 32, kb = r / nb, n0 = (r % nb) * 32;
            transpose_item(AIN(w ? I_F2WI : I_F1WI), 2 * FH, D, kb * 64, n0, (bf16_t*)(ws + (w ? WS_WI2 : WS_WI1)), wi_drow(n0), scr, lane); continue; }
        r -= 2 * I_WI_;
        if (r < 2 * I_WO_) { const int w = r / I_WO_; r %= I_WO_; const int nb = D / 32, kb = r / nb, n0 = (r % nb) * 32;
            transpose_item(AIN(w ? I_F2WO : I_F1WO), D, FH, kb * 64, n0, (bf16_t*)(ws + (w ? WS_WO2 : WS_WO1)), n0, scr, lane); continue; }
        r -= 2 * I_WO_;
        if (r < I_IN_) { const int nb = INW / 32, kb = r / nb, n0 = (r % nb) * 32;
            transpose_item(AIN(I_WIN), INW, D, kb * 64, n0, (bf16_t*)(ws + WS_WIN), win_drow(n0), scr, lane); continue; }
        r -= I_IN_;
        if (r < 3 * I_SQ_) { const int w = r / I_SQ_; r %= I_SQ_; const int nb = D / 32, kb = r / nb, n0 = (r % nb) * 32;
            transpose_item(AIN(w == 0 ? I_WOG : (w == 1 ? I_WOL : I_WOO)), D, D, kb * 64, n0, (bf16_t*)(ws + (w == 0 ? WS_WOG : (w == 1 ? WS_WOL : WS_WOO))), n0, scr, lane); continue; }
        r -= 3 * I_SQ_;
        { const int mat = r >> 3, sub = r & 7, gate = mat >> 4, dir = (mat >> 3) & 1, blk = mat & 7;
          const float* src = AIN(gate ? I_WI : I_WR) + (size_t)(dir * 8 + blk) * 128 * 128;
          const int kb = sub >> 2, n0 = (sub & 3) * 32;
          transpose_item(src, 128, 128, kb * 64, n0, (bf16_t*)(ws + WS_WLG), ((blk * 2 + dir) * 2 + gate) * 128 + n0, scr, lane); }
    }
    { u32x4* z = (u32x4*)(ws + WS_WIN + (size_t)INW * D * 2); const int n16 = (PN - INW) * D * 2 / 16;
      for (int i = cx.bid * NTHR + cx.tid; i < n16; i += cx.G * NTHR) z[i] = (u32x4){0u, 0u, 0u, 0u}; }
    __syncthreads();
    LAS float* sl = (LAS float*)lds;
    float* MODP = (float*)(ws + WS_MODP);
    if (PHON(20)) for (int item = cx.bid; item < 18 * 16; item += cx.G) {
        const int cb = item % 18, ks = item / 18, col = cb * 512 + cx.tid;
        for (int idx = cx.tid; idx < 33 * 64; idx += NTHR) { const int b = idx >> 6, k = idx & 63; const float cv = b < 32 ? AIN(I_C)[b * D + ks * 64 + k] : AIN(I_CCTX)[ks * 64 + k]; sl[idx] = siluf_(cv); }
        __syncthreads();
        float acc[33];
#pragma unroll
        for (int b = 0; b < 33; ++b) acc[b] = 0.f;
        const float* wp = AIN(I_WADA) + (size_t)(ks * 64) * NMOD + col;
#pragma unroll 4
        for (int k = 0; k < 64; ++k) { const float w = wp[(size_t)k * NMOD];
#pragma unroll
            for (int b = 0; b < 33; ++b) acc[b] += sl[b * 64 + k] * w; }
#pragma unroll
        for (int b = 0; b < 33; ++b) MODP[(size_t)(ks * 33 + b) * NMOD + col] = acc[b];
        __syncthreads();
    }
}
__device__ __forceinline__ void phase_modreduce(const Ctx cx, const Args& a, LAS unsigned char* lds) {
    const float* MODP = (const float*)(a.ws + WS_MODP); float* MOD = (float*)(a.ws + WS_MOD);
    for (int idx = cx.bid * NTHR + cx.tid; idx < 33 * NMOD; idx += cx.G * NTHR) {
        float s = AIN(I_BADA)[idx % NMOD];
#pragma unroll
        for (int ks = 0; ks < 16; ++ks) s += MODP[(size_t)ks * 33 * NMOD + idx];
        MOD[idx] = s;
    }
    float* GC = (float*)(a.ws + WS_GC);
    for (int idx = cx.bid * NTHR + cx.tid; idx < 2 * D; idx += cx.G * NTHR) { GC[idx] = AIN(I_BR)[idx]; GC[2 * D + idx] = AIN(I_BI)[idx]; GC[4 * D + idx] = 8.0f * log1pf(__expf(-AIN(I_LAM)[idx])); }
}

__device__ __forceinline__ void phase_normmod(const Ctx cx, const Args& a, LAS unsigned char* lds, const float* srcL, const float* srcC, int nL, int nrows, int mod_b0, int sub) {
    const int lane = cx.tid & 63;
    const float* MOD = (const float*)(a.ws + WS_MOD); const float* nw = AIN(I_NORMW) + sub * D;
    bf16_t* U = (bf16_t*)(a.ws + WS_U);
    for (int r0 = 2 * GW(); r0 < nrows; r0 += 2 * NGW()) {
        f32x4 v[2][4]; float ss[2];
#pragma unroll
        for (int q = 0; q < 2; ++q) { const int r = r0 + q;
            const float* src = r < nL ? srcL + (size_t)r * D : srcC + (size_t)(r - nL) * D;
            ss[q] = 0.f;
#pragma unroll
            for (int j = 0; j < 4; ++j) { v[q][j] = ((const f32x4*)src)[lane + 64 * j]; } }
#pragma unroll
        for (int q = 0; q < 2; ++q)
#pragma unroll
            for (int j = 0; j < 4; ++j) ss[q] += (v[q][j].x * v[q][j].x + v[q][j].y * v[q][j].y) + (v[q][j].z * v[q][j].z + v[q][j].w * v[q][j].w);
#pragma unroll
        for (int o = 1; o < 64; o <<= 1) { ss[0] += __shfl_xor(ss[0], o); ss[1] += __shfl_xor(ss[1], o); }
#pragma unroll
        for (int q = 0; q < 2; ++q) { const int r = r0 + q; const int mrow = r < nL ? mod_b0 + r / T : 32;
            const float* sh = MOD + (size_t)mrow * NMOD + (3 * sub) * D; const float* sc = sh + D;
            const float rstd = 1.0f / sqrtf(ss[q] * (1.0f / D) + EPS);
#pragma unroll
            for (int j = 0; j < 4; ++j) { const int c4 = lane + 64 * j; const f32x4 w = ((const f32x4*)nw)[c4], s4 = ((const f32x4*)sh)[c4], c1 = ((const f32x4*)sc)[c4];
                const f32x4 o = v[q][j] * rstd * w * (c1 + 1.0f) + s4;
                u32x2 p; p.x = cvt_pk_bf16(o.x, o.y); p.y = cvt_pk_bf16(o.z, o.w); ((u32x2*)(U + (size_t)r * D))[c4] = p; } }
    }
}
__device__ __forceinline__ void phase_final(const Ctx cx, const Args& a, LAS unsigned char* lds, int g) {
    const int lane = cx.tid & 63; const float* fw = AIN(I_FNW);
    for (int r0 = 2 * GW(); r0 < RL; r0 += 2 * NGW()) {
        float* row = a.out + ((size_t)g * RL + r0) * D;
        f32x4 v[2][4]; float ss[2] = {0.f, 0.f};
#pragma unroll
        for (int q = 0; q < 2; ++q)
#pragma unroll
            for (int j = 0; j < 4; ++j) v[q][j] = ((const f32x4*)(row + q * D))[lane + 64 * j];
#pragma unroll
        for (int q = 0; q < 2; ++q)
#pragma unroll
            for (int j = 0; j < 4; ++j) ss[q] += (v[q][j].x * v[q][j].x + v[q][j].y * v[q][j].y) + (v[q][j].z * v[q][j].z + v[q][j].w * v[q][j].w);
#pragma unroll
        for (int o = 1; o < 64; o <<= 1) { ss[0] += __shfl_xor(ss[0], o); ss[1] += __shfl_xor(ss[1], o); }
#pragma unroll
        for (int q = 0; q < 2; ++q) { const float rstd = 1.0f / sqrtf(ss[q] * (1.0f / D) + EPS);
#pragma unroll
            for (int j = 0; j < 4; ++j) { const int c4 = lane + 64 * j; ((f32x4*)(row + q * D))[c4] = v[q][j] * rstd * ((const f32x4*)fw)[c4]; } }
    }
}

__device__ __forceinline__ float logsig_fast(float x) { return fminf(x, 0.f) - __logf(1.0f + __expf(-fabsf(x))); }
__device__ __forceinline__ void phase_prep(const Ctx cx, const Args& a, int g, LAS unsigned char* lds) {
    const bf16_t* PROJ = (const bf16_t*)(a.ws + WS_BIG);
    const int tid = cx.tid;
    {
        LAS bf16_t* qs = (LAS bf16_t*)lds; LAS bf16_t* ks = (LAS bf16_t*)(lds + 16384); LAS float* fdl = (LAS float*)(lds + 32768); LAS float* part = (LAS float*)(lds + 36864);
        LAS bf16_t* qo = (LAS bf16_t*)(lds + 40960); LAS bf16_t* ko = (LAS bf16_t*)(lds + 57344);
        const int d = tid & 127, qt = tid >> 7;
        for (int item = cx.bid; item < BG * NCH * 8; item += cx.G) {
            const int h = item & 3, dir = (item >> 2) & 1, bc = item >> 3, b = bc / NCH, c = bc % NCH;
            const int row0 = c < 4 ? RL + b * CL + c * 64 : b * T + (c - 4) * 64;
            const bool lat = c >= 4;
#pragma unroll
            for (int k = 0; k < 2; ++k) { const int p = tid + 512 * k, r = p >> 4, c8 = (p & 15) * 8;
                *(LAS u32x4*)(ks + r * 128 + c8) = *(const u32x4*)(PROJ + (size_t)(row0 + r) * PN + PK + h * 128 + c8);
                if (lat) *(LAS u32x4*)(qs + r * 128 + c8) = *(const u32x4*)(PROJ + (size_t)(row0 + r) * PN + PQ + h * 128 + c8); }
#pragma unroll
            for (int k = 0; k < 2; ++k) { const int idx = tid + 512 * k; fdl[idx] = bf2f(PROJ[(size_t)(row0 + (idx >> 4)) * PN + PFD + dir * 16 + (idx & 15)]); }
            const int col = h * 128 + d;
            float fw[16];
#pragma unroll
            for (int r = 0; r < 16; ++r) fw[r] = AIN(I_FUP)[(size_t)(dir * 16 + r) * 512 + col];
            const float fbv = AIN(I_FB)[dir * 512 + col];
            __syncthreads();
            float la[16]; float psum = 0.f;
#pragma unroll
            for (int t = 0; t < 16; ++t) { const int i = 16 * qt + t; float dot = fbv;
#pragma unroll
                for (int r = 0; r < 16; ++r) dot += fdl[i * 16 + r] * fw[r];
                la[t] = logsig_fast(dot) * (1.0f / 16.0f); psum += la[t]; }
            part[qt * 128 + d] = psum;
            __syncthreads();
            const float p0 = part[d], p1 = part[128 + d], p2 = part[256 + d], p3 = part[384 + d];
            const float tot = (p0 + p1) + (p2 + p3);
            float run = dir == 0 ? (qt > 0 ? p0 : 0.f) + (qt > 1 ? p1 : 0.f) + (qt > 2 ? p2 : 0.f)
                                 : (qt < 3 ? p3 : 0.f) + (qt < 2 ? p2 : 0.f) + (qt < 1 ? p1 : 0.f);
            float ke[16];
            if (dir == 0) {
#pragma unroll
                for (int t = 0; t < 16; ++t) { const int i = 16 * qt + t; run += la[t];
                    const float kv = bf2f(ks[i * 128 + d]); ke[t] = kv * __expf(tot - run);
                    if (lat) { qo[i * 128 + d] = f2bf(bf2f(qs[i * 128 + d]) * 0.08838834764831845f * __expf(run)); ko[i * 128 + d] = f2bf(kv * __expf(-run)); } }
            } else {
#pragma unroll
                for (int t = 15; t >= 0; --t) { const int i = 16 * qt + t; run += la[t];
                    const float kv = bf2f(ks[i * 128 + d]); ke[t] = kv * __expf(tot - run);
                    if (lat) { qo[i * 128 + d] = f2bf(bf2f(qs[i * 128 + d]) * 0.08838834764831845f * __expf(run)); ko[i * 128 + d] = f2bf(kv * __expf(-run)); } }
            }
            const size_t tb = (((size_t)dir * BG + b) * NCH + c) * 4 + h;
            bf16_t* KET = (bf16_t*)(a.ws + WS_KET) + tb * 8192 + d * 64 + 16 * qt;
            { float k0[8], k1[8];
#pragma unroll
              for (int t = 0; t < 8; ++t) { k0[t] = ke[t]; k1[t] = ke[8 + t]; }
              *(u32x4*)KET = pack8(k0); *(u32x4*)(KET + 8) = pack8(k1); }
            if (qt == 0) ((float*)(a.ws + WS_BL))[tb * 128 + d] = tot;
            __syncthreads();
            if (lat) { bf16_t* QD = (bf16_t*)(a.ws + WS_QD) + tb * 8192; bf16_t* KI = (bf16_t*)(a.ws + WS_KI) + tb * 8192;
#pragma unroll
                for (int k = 0; k < 2; ++k) { const int p = tid + 512 * k; *(u32x4*)(QD + p * 8) = *(const LAS u32x4*)(qo + p * 8); *(u32x4*)(KI + p * 8) = *(const LAS u32x4*)(ko + p * 8); } }
            __syncthreads();
        }
    }
    {
        LAS bf16_t* vs = (LAS bf16_t*)lds;
        const int e = tid & 255, jh = tid >> 8;
        for (int item = cx.bid; item < BG * NCH * 4; item += cx.G) {
            const int h = item & 3, bc = item >> 2, b = bc / NCH, c = bc % NCH;
            const int row0 = c < 4 ? RL + b * CL + c * 64 : b * T + (c - 4) * 64;
#pragma unroll
            for (int k = 0; k < 4; ++k) { const int p = tid + 512 * k, r = p >> 5, c8 = (p & 31) * 8;
                *(LAS u32x4*)(vs + r * 256 + c8) = *(const u32x4*)(PROJ + (size_t)(row0 + r) * PN + PV + h * 256 + c8); }
            __syncthreads();
            bf16_t* VT = (bf16_t*)(a.ws + WS_VT) + ((((size_t)b * NCH + c) * 4 + h) * 256 + e) * 64 + 32 * jh;
#pragma unroll
            for (int jg = 0; jg < 4; ++jg) { float v[8];
#pragma unroll
                for (int jj = 0; jj < 8; ++jj) v[jj] = bf2f(vs[(32 * jh + 8 * jg + jj) * 256 + e]);
                *(u32x4*)(VT + 8 * jg) = pack8(v); }
            __syncthreads();
        }
    }
    bf16_t* XC = (bf16_t*)(a.ws + WS_XC);
    const float* cvb = AIN(I_CONVB); const float* cvw = AIN(I_CONVW);
    for (int idx0 = cx.bid * NTHR + cx.tid; idx0 < RG * 128; idx0 += 4 * cx.G * NTHR) {
        u32x4 xw[4][4];
#pragma unroll
        for (int q = 0; q < 4; ++q) { const int idx = idx0 + q * cx.G * NTHR; const int row = idx >> 7, c8 = (idx & 127) * 8;
            const int pos = row < RL ? (row & 63) : ((row - RL) & 255), len = row < RL ? 64 : 256;
#pragma unroll
            for (int j = 0; j < 4; ++j) { const int p = pos + j - 2; xw[q][j] = (u32x4){0u, 0u, 0u, 0u};
                if (idx < RG * 128 && p >= 0 && p < len) xw[q][j] = *(const u32x4*)(PROJ + (size_t)(row + j - 2) * PN + PXL + c8); } }
#pragma unroll
        for (int q = 0; q < 4; ++q) { const int idx = idx0 + q * cx.G * NTHR; const int row = idx >> 7, c8 = (idx & 127) * 8;
            if (idx < RG * 128) { float acc[8];
#pragma unroll
                for (int i = 0; i < 8; ++i) acc[i] = cvb[c8 + i];
#pragma unroll
                for (int j = 0; j < 4; ++j) { float xv[8]; unpack8(xw[q][j], xv);
#pragma unroll
                    for (int i = 0; i < 8; ++i) acc[i] += cvw[j * D + c8 + i] * xv[i]; }
                *(u32x4*)(XC + (size_t)row * D + c8) = pack8(acc); } }
    }
}

__device__ __forceinline__ void phase_gatefix(const Ctx cx, const Args& a, LAS unsigned char* lds) {
    bf16_t* LA = (bf16_t*)(a.ws + WS_LA); bf16_t* UU = (bf16_t*)(a.ws + WS_UU); const bf16_t* XC = (const bf16_t*)(a.ws + WS_XC); const float* GC = (const float*)(a.ws + WS_GC);
    for (int idx = cx.bid * NTHR + cx.tid; idx < 2 * RG * 128; idx += cx.G * NTHR) {
        const int dir = idx >= RG * 128, rem = idx - dir * RG * 128, row = rem >> 7, c8 = (rem & 127) * 8;
        const size_t off = (size_t)dir * RG * D + (size_t)row * D + c8;
        float r[8], ig[8], xc[8]; unpack8(*(const u32x4*)(LA + off), r); unpack8(*(const u32x4*)(UU + off), ig); unpack8(*(const u32x4*)(XC + (size_t)row * D + c8), xc);
#pragma unroll
        for (int i = 0; i < 8; ++i) { const float l = -GC[(4 + dir) * D + c8 + i] * sigmoidf_(r[i] + GC[dir * D + c8 + i]);
            const float gi = sigmoidf_(ig[i] + GC[(2 + dir) * D + c8 + i]);
            r[i] = l; ig[i] = __builtin_amdgcn_sqrtf(fmaxf(one_minus_exp(2.0f * l), 0.f)) * gi * xc[i]; }
        *(u32x4*)(LA + off) = pack8(r); *(u32x4*)(UU + off) = pack8(ig);
    }
}

__device__ __forceinline__ int img_off(int nkg, int row, int kcol) { const int ob = (row & 15) * 64 + (kcol & 31) * 2; return ((row >> 4) * nkg + (kcol >> 5)) * 1024 + (ob ^ (((ob >> 9) & 1) << 5)); }
__device__ __forceinline__ bf16x8 ldfrag(const LAS unsigned char* img, int nkg, int row, int kcol) { return *(const LAS bf16x8*)(img + img_off(nkg, row, kcol)); }
#define MFMA16(a, b, c) __builtin_amdgcn_mfma_f32_16x16x32_bf16((a), (b), (c), 0, 0, 0)

__device__ __forceinline__ void phase_gla_scan(const Ctx cx, const Args& a, int g, LAS unsigned char* lds) {
    constexpr int XB = 57344, OFF_KI = 16384, OFF_KET = 32768, OFF_VT = 49152, OFF_P = 2 * XB, OFF_ST = OFF_P + 8192, OFF_BL = OFF_ST + 2 * 16384;
    static_assert(OFF_BL + 1024 <= LDS_BYTES, "gla scan LDS");
    const int tid = cx.tid, lane = tid & 63, w = tid >> 6, fr = lane & 15, fq = lane >> 4;
    const bf16_t* QDg = (const bf16_t*)(a.ws + WS_QD); const bf16_t* KIg = (const bf16_t*)(a.ws + WS_KI); const bf16_t* KETg = (const bf16_t*)(a.ws + WS_KET);
    const bf16_t* VTg = (const bf16_t*)(a.ws + WS_VT); const float* BLg = (const float*)(a.ws + WS_BL);
    bf16_t* Og = (bf16_t*)(a.ws + WS_OFB);
    for (int item = cx.bid; item < BG * 32; item += cx.G) {
        const int dvq = item & 3, dir = (item >> 2) & 1, h = (item >> 3) & 3, b = item >> 5;
        { u32x4 z = {0u, 0u, 0u, 0u}; *(LAS u32x4*)(lds + OFF_ST + tid * 32) = z; *(LAS u32x4*)(lds + OFF_ST + tid * 32 + 16) = z; }
        f32x4 accS[4];
#pragma unroll
        for (int t = 0; t < 4; ++t) accS[t] = (f32x4){0.f, 0.f, 0.f, 0.f};
        u32x4 pq[2], pk[2], pe[2], pv; float pbl = 0.f;
#define GLA_LOAD(s_) do { const int c_ = dir == 0 ? (s_) : ((s_) < 4 ? 3 - (s_) : 39 - (s_)); \
            const size_t tb_ = (((size_t)dir * BG + b) * NCH + c_) * 4 + h; \
            if (c_ >= 4) { pq[0] = ((const u32x4*)(QDg + tb_ * 8192))[tid]; pq[1] = ((const u32x4*)(QDg + tb_ * 8192))[tid + 512]; \
                           pk[0] = ((const u32x4*)(KIg + tb_ * 8192))[tid]; pk[1] = ((const u32x4*)(KIg + tb_ * 8192))[tid + 512]; } \
            pe[0] = ((const u32x4*)(KETg + tb_ * 8192))[tid]; pe[1] = ((const u32x4*)(KETg + tb_ * 8192))[tid + 512]; \
            pv = ((const u32x4*)(VTg + ((((size_t)b * NCH + c_) * 4 + h) * 256 + dvq * 64) * 64))[tid]; \
            if (tid < 128) pbl = BLg[tb_ * 128 + tid]; } while (0)
#define GLA_STORE(buf_) do { LAS unsigned char* X_ = lds + (buf_) * XB; \
            _Pragma("unroll") for (int i_ = 0; i_ < 2; ++i_) { const int p_ = tid + 512 * i_; \
                *(LAS u32x4*)(X_ + img_off(4, p_ >> 4, (p_ & 15) * 8)) = pq[i_]; *(LAS u32x4*)(X_ + OFF_KI + img_off(4, p_ >> 4, (p_ & 15) * 8)) = pk[i_]; \
                *(LAS u32x4*)(X_ + OFF_KET + img_off(2, p_ >> 3, (p_ & 7) * 8)) = pe[i_]; } \
            *(LAS u32x4*)(X_ + OFF_VT + img_off(2, tid >> 3, (tid & 7) * 8)) = pv; \
            if (tid < 128) ((LAS float*)(lds + OFF_BL + (buf_) * 512))[tid] = pbl; } while (0)
        pq[0] = pq[1] = pk[0] = pk[1] = (u32x4){0u, 0u, 0u, 0u};
        GLA_LOAD(0); GLA_STORE(0);
        __syncthreads();
        for (int s = 0; s < NCH; ++s) {
            const int cur = s & 1; const bool lat = s >= 4;
            const LAS unsigned char* X = lds + cur * XB;
#ifndef GLA_SAFE
            if (s + 1 < NCH) GLA_LOAD(s + 1);
#endif
            if (lat) {
                const int ti = w >> 1, tj0 = (w & 1) * 2;
                f32x4 sc[2] = {(f32x4){0.f, 0.f, 0.f, 0.f}, (f32x4){0.f, 0.f, 0.f, 0.f}};
#pragma unroll
                for (int kk = 0; kk < 4; ++kk) { const bf16x8 qa = ldfrag(X, 4, 16 * ti + fr, kk * 32 + fq * 8);
#pragma unroll
                    for (int t = 0; t < 2; ++t) { const bf16x8 kb = ldfrag(X + OFF_KI, 4, 16 * (tj0 + t) + fr, kk * 32 + fq * 8); sc[t] = MFMA16(qa, kb, sc[t]); } }
#pragma unroll
                for (int t = 0; t < 2; ++t)
#pragma unroll
                    for (int jj = 0; jj < 4; ++jj) { const int i = 16 * ti + 4 * fq + jj, j = 16 * (tj0 + t) + fr;
                        const bool keep = dir == 0 ? (j <= i) : (j > i);
                        *(LAS bf16_t*)(lds + OFF_P + img_off(2, i, j)) = f2bf(keep ? sc[t][jj] : 0.f); }
            }
            __syncthreads();
            const int te = w >> 1;
            if (lat) {
                const int c = dir == 0 ? s : 39 - s;
                const LAS unsigned char* STc = lds + OFF_ST + cur * 16384;
                f32x4 oc[2] = {(f32x4){0.f, 0.f, 0.f, 0.f}, (f32x4){0.f, 0.f, 0.f, 0.f}};
#pragma unroll
                for (int kk = 0; kk < 2; ++kk) { const bf16x8 va = ldfrag(X + OFF_VT, 2, 16 * te + fr, kk * 32 + fq * 8);
#pragma unroll
                    for (int t = 0; t < 2; ++t) { const bf16x8 pb = ldfrag(lds + OFF_P, 2, 16 * ((w & 1) * 2 + t) + fr, kk * 32 + fq * 8); oc[t] = MFMA16(va, pb, oc[t]); } }
#pragma unroll
                for (int kk = 0; kk < 4; ++kk) { const bf16x8 sa = ldfrag(STc, 4, 16 * te + fr, kk * 32 + fq * 8);
#pragma unroll
                    for (int t = 0; t < 2; ++t) { const bf16x8 qb = ldfrag(X, 4, 16 * ((w & 1) * 2 + t) + fr, kk * 32 + fq * 8); oc[t] = MFMA16(sa, qb, oc[t]); } }
#pragma unroll
                for (int t = 0; t < 2; ++t) { const int i = 16 * ((w & 1) * 2 + t) + fr; const size_t row = (size_t)b * T + (size_t)(c - 4) * 64 + i;
                    u32x2 o2; o2.x = cvt_pk_bf16(oc[t][0], oc[t][1]); o2.y = cvt_pk_bf16(oc[t][2], oc[t][3]);
                    *(u32x2*)(Og + ((size_t)dir * RL + row) * D + h * 256 + dvq * 64 + 16 * te + 4 * fq) = o2; }
            }
#ifdef GLA_SAFE
            __syncthreads();
#endif
            {
                const LAS float* blp = (const LAS float*)(lds + OFF_BL + cur * 512);
                LAS unsigned char* STn = lds + OFF_ST + (cur ^ 1) * 16384;
                bf16x8 vb[2];
#pragma unroll
                for (int kk = 0; kk < 2; ++kk) vb[kk] = ldfrag(X + OFF_VT, 2, 16 * te + fr, kk * 32 + fq * 8);
#pragma unroll
                for (int t = 0; t < 4; ++t) { const int td = (w & 1) * 4 + t;
#pragma unroll
                    for (int jj = 0; jj < 4; ++jj) accS[t][jj] *= __expf(blp[16 * td + 4 * fq + jj]);
#pragma unroll
                    for (int kk = 0; kk < 2; ++kk) { const bf16x8 ka = ldfrag(X + OFF_KET, 2, 16 * td + fr, kk * 32 + fq * 8); accS[t] = MFMA16(ka, vb[kk], accS[t]); }
                    u32x2 s2; s2.x = cvt_pk_bf16(accS[t][0], accS[t][1]); s2.y = cvt_pk_bf16(accS[t][2], accS[t][3]);
                    *(LAS u32x2*)(STn + img_off(4, 16 * te + fr, 16 * td + 4 * fq)) = s2; }
            }
#ifdef GLA_SAFE
            __syncthreads();
            if (s + 1 < NCH) { GLA_LOAD(s + 1); GLA_STORE(cur ^ 1); }
#else
            if (s + 1 < NCH) GLA_STORE(cur ^ 1);
#endif
            __syncthreads();
        }
#undef GLA_LOAD
#undef GLA_STORE
    }
}

__device__ __forceinline__ void phase_lru_scan(const Ctx cx, const Args& a, int g, LAS unsigned char* lds) {
    const int lane = cx.tid & 63, w = cx.tid >> 6;
    LAS f32x2* agg = (LAS f32x2*)lds;
    const float* GC = (const float*)(a.ws + WS_GC);
    for (int item = cx.bid; item < BG * 32; item += cx.G) {
        const int cgp = item & 15, dir = (item >> 4) & 1, b = item >> 5, ch = cgp * 64 + lane;
        const bf16_t* RR = (const bf16_t*)(a.ws + WS_LA) + (size_t)dir * RG * D + ch; const bf16_t* II = (const bf16_t*)(a.ws + WS_UU) + (size_t)dir * RG * D + ch;
        const bf16_t* XCp = (const bf16_t*)(a.ws + WS_XC) + ch;
        bf16_t* Hd = (bf16_t*)(a.ws + WS_HFB) + (size_t)dir * RL * D + ch;
        const float cbr = GC[dir * D + ch], cbi = GC[(2 + dir) * D + ch], csp = GC[(4 + dir) * D + ch];
#define LRU_ROW(s_) ((s_) < CL ? RL + b * CL + (dir ? CL - 1 - (s_) : (s_)) : b * T + (dir ? T - 1 - ((s_) - CL) : (s_) - CL))
#define LRU_GATES(k_) const float l_ = -csp * sigmoidf_(bf2f(rr[k_]) + cbr); const float av = __expf(l_); \
            const float uv = __builtin_amdgcn_sqrtf(fmaxf(one_minus_exp(2.0f * l_), 0.f)) * sigmoidf_(bf2f(ii[k_]) + cbi) * bf2f(xx[k_]);
        float A = 1.f, Z = 0.f;
        for (int blk = 0; blk < 9; ++blk) { const int s0 = 288 * w + 32 * blk; bf16_t rr[32], ii[32], xx[32];
#pragma unroll
            for (int k = 0; k < 32; ++k) { const size_t r = (size_t)LRU_ROW(s0 + k); rr[k] = RR[r * D]; ii[k] = II[r * D]; xx[k] = XCp[r * D]; }
#pragma unroll
            for (int k = 0; k < 32; ++k) { LRU_GATES(k) Z = av * Z + uv; A *= av; } }
        agg[w * 64 + lane] = (f32x2){A, Z};
        __syncthreads();
        float hst = 0.f;
#pragma unroll
        for (int w2 = 0; w2 < 7; ++w2) { const f32x2 p = agg[w2 * 64 + lane]; if (w2 < w) hst = p.x * hst + p.y; }
        for (int blk = 0; blk < 9; ++blk) { const int s0 = 288 * w + 32 * blk; bf16_t rr[32], ii[32], xx[32];
#pragma unroll
            for (int k = 0; k < 32; ++k) { const size_t r = (size_t)LRU_ROW(s0 + k); rr[k] = RR[r * D]; ii[k] = II[r * D]; xx[k] = XCp[r * D]; }
#pragma unroll
            for (int k = 0; k < 32; ++k) { LRU_GATES(k) hst = av * hst + uv;
                if (s0 + k >= CL) Hd[(size_t)LRU_ROW(s0 + k) * D] = f2bf(hst); } }
        __syncthreads();
#undef LRU_ROW
#undef LRU_GATES
    }
}

__device__ __forceinline__ void phase_post(const Ctx cx, const Args& a, LAS unsigned char* lds, int g) {
    const int lane = cx.tid & 63;
    const bf16_t* PROJ = (const bf16_t*)(a.ws + WS_BIG);
    bf16_t* O0 = (bf16_t*)(a.ws + WS_OFB); const bf16_t* O1 = O0 + (size_t)RL * D;
    bf16_t* H0 = (bf16_t*)(a.ws + WS_HFB); const bf16_t* H1b = H0 + (size_t)RL * D;
    const float* gnw = AIN(I_GNW);
    for (int r = GW(); r < RL; r += NGW()) {
        const size_t off = (size_t)r * D + lane * 16;
        float o[16], t[8]; float ss = 0.f;
#pragma unroll
        for (int hf = 0; hf < 2; ++hf) { float x0[8], x1[8]; unpack8(*(const u32x4*)(O0 + off + 8 * hf), x0); unpack8(*(const u32x4*)(O1 + off + 8 * hf), x1);
#pragma unroll
            for (int i = 0; i < 8; ++i) { o[8 * hf + i] = x0[i] + x1[i]; ss += o[8 * hf + i] * o[8 * hf + i]; } }
        ss += __shfl_xor(ss, 1); ss += __shfl_xor(ss, 2); ss += __shfl_xor(ss, 4); ss += __shfl_xor(ss, 8);
        const float rstd = 1.0f / sqrtf(ss * (1.0f / 256.0f) + EPS);
#pragma unroll
        for (int hf = 0; hf < 2; ++hf) { float gg[8]; unpack8(*(const u32x4*)(PROJ + (size_t)r * PN + PGG + lane * 16 + 8 * hf), gg);
#pragma unroll
            for (int i = 0; i < 8; ++i) t[i] = o[8 * hf + i] * rstd * gnw[(lane & 15) * 16 + 8 * hf + i] * siluf_(gg[i]);
            *(u32x4*)(O0 + off + 8 * hf) = pack8(t); }
#pragma unroll
        for (int hf = 0; hf < 2; ++hf) { float x0[8], x1[8], yl[8]; unpack8(*(const u32x4*)(H0 + off + 8 * hf), x0); unpack8(*(const u32x4*)(H1b + off + 8 * hf), x1);
            unpack8(*(const u32x4*)(PROJ + (size_t)r * PN + PYL + lane * 16 + 8 * hf), yl);
#pragma unroll
            for (int i = 0; i < 8; ++i) t[i] = (x0[i] + x1[i]) * geluf_(yl[i]);
            *(u32x4*)(H0 + off + 8 * hf) = pack8(t); }
    }
}


#define XB_TMO      128
#define XB_XCNT(j)  (256  + 64 * (j))
#define XB_XSUB(j)  (1280 + 64 * (j))
#define XB_XGEN(j)  (2304 + 64 * (j))
#define XB_TOP      3328
#define XB_TOPGEN   3392
#define XCD_BAR_WORDS 3456
#define XB_SPIN_CAP (1u << 22)
__device__ __forceinline__ unsigned xb_ld(unsigned* p)              { return __hip_atomic_load(p, __ATOMIC_RELAXED, __HIP_MEMORY_SCOPE_AGENT); }
__device__ __forceinline__ unsigned xb_add(unsigned* p, unsigned v) { return __hip_atomic_fetch_add(p, v, __ATOMIC_RELAXED, __HIP_MEMORY_SCOPE_AGENT); }
__device__ __forceinline__ unsigned xb_xcc_id() { return (unsigned)__builtin_amdgcn_s_getreg((3 << 11) | 20) & 0xFu; }
#define XB_SPIN(cond, bar) do { unsigned _sp = 0; while (cond) { __builtin_amdgcn_s_sleep(1); \
    if ((++_sp & 255u) == 0u) { if (xb_ld(&(bar)[XB_TMO])) break; if (_sp > XB_SPIN_CAP) { atomicAdd(&(bar)[XB_TMO], 1u); break; } } } } while (0)
__device__ __forceinline__ void xcd_barrier_complete(unsigned* bar, unsigned x, unsigned G, unsigned& nloc, unsigned& nx) {
    unsigned sum, cnt, mine, sp = 0u;
    for (;;) {
        sum = 0u; cnt = 0u; mine = 0u;
#pragma unroll
        for (unsigned j = 0; j < 16; ++j) { const unsigned c = xb_ld(&bar[XB_XCNT(j)]); sum += c; cnt += (c > 0u) ? 1u : 0u; mine = (j == x) ? c : mine; }
        if (sum == G) break;
        __builtin_amdgcn_s_sleep(1);
        if ((++sp & 255u) == 0u) { if (xb_ld(&bar[XB_TMO])) break; if (sp > XB_SPIN_CAP) { atomicAdd(&bar[XB_TMO], 1u); break; } }
    }
    nloc = mine > 0u ? mine : 1u; nx = cnt > 0u ? cnt : 1u;
}
__device__ __forceinline__ void xcd_barrier(unsigned* bar, volatile LAS unsigned* st, int tid, unsigned G) {
    asm volatile("s_waitcnt vmcnt(0)" ::: "memory");
    __syncthreads();
    if (tid == 0) {
        __builtin_amdgcn_s_waitcnt(0);
        const unsigned x = xb_xcc_id();
        unsigned nloc = st[0], nx = st[1];
        if (nloc == 0u) { xcd_barrier_complete(bar, x, G, nloc, nx); st[0] = nloc; st[1] = nx; }
        const unsigned old = xb_add(&bar[XB_XSUB(x)], 1u);
        const unsigned gen = old / nloc;
        if (old + 1u == (gen + 1u) * nloc) {
            __builtin_amdgcn_fence(__ATOMIC_RELEASE, "agent");
            asm volatile("s_waitcnt vmcnt(0)" ::: "memory");
            const unsigned og = xb_add(&bar[XB_TOP], 1u);
            const unsigned tg = og / nx;
            if (og + 1u == (tg + 1u) * nx) xb_add(&bar[XB_TOPGEN], 1u);
            else XB_SPIN(xb_ld(&bar[XB_TOPGEN]) == tg, bar);
            __builtin_amdgcn_fence(__ATOMIC_ACQUIRE, "agent");
            xb_add(&bar[XB_XGEN(x)], 1u);
            asm volatile("s_waitcnt vmcnt(0)" ::: "memory");
        } else {
            XB_SPIN(xb_ld(&bar[XB_XGEN(x)]) == gen, bar);
            __builtin_amdgcn_fence(__ATOMIC_ACQUIRE, "agent");
            asm volatile("s_waitcnt vmcnt(0)" ::: "memory");
        }
    }
    __syncthreads();
}

constexpr int NPH = 17;
#ifndef USE_CG_ALL
#define USE_CG_ALL 0
#endif
#if ONE_LAUNCH
#define GRID_SYNC(k) do { if ((k) == 1 || USE_CG_ALL) cg::this_grid().sync(); else xcd_barrier((unsigned*)ws + 4096, (volatile LAS unsigned*)(lds + PTAB + 256), cx.tid, (unsigned)cx.G); } while (0)
#else
#define GRID_SYNC(k) do {} while (0)
#endif
#define STEP_BEGIN(k) if (a.lo <= (k) && (k) < a.hi) { \
        Ctx cx; { int t_ = wave_s * 64 + (int)__builtin_amdgcn_mbcnt_hi(~0u, __builtin_amdgcn_mbcnt_lo(~0u, 0u)), b_ = blockIdx.x, g_ = gridDim.x; asm volatile("" : "+v"(t_)); asm volatile("" : "+s"(b_), "+s"(g_)); cx.tid = t_; cx.bid = b_; cx.G = g_; } \
        const int G = cx.G, cidx = cx.bid; (void)G; (void)cidx; \
        unsigned char* ws = a.ws; asm volatile("" : "+s"(ws)); \
        if ((k) > a.lo) GRID_SYNC(k); \
        const float* MOD = (const float*)(ws + WS_MOD); float* H1 = (float*)(ws + WS_H1); bf16_t* U = (bf16_t*)(ws + WS_U); bf16_t* BIG = (bf16_t*)(ws + WS_BIG); bf16_t* XC = (bf16_t*)(ws + WS_XC); \
        (void)MOD; (void)H1; (void)U; (void)BIG; (void)XC; pg8::StaticOrder S; (void)S;
#define STEP_BEGIN_NS(k) if (a.lo <= (k) && (k) < a.hi) { \
        Ctx cx; { int t_ = wave_s * 64 + (int)__builtin_amdgcn_mbcnt_hi(~0u, __builtin_amdgcn_mbcnt_lo(~0u, 0u)), b_ = blockIdx.x, g_ = gridDim.x; asm volatile("" : "+v"(t_)); asm volatile("" : "+s"(b_), "+s"(g_)); cx.tid = t_; cx.bid = b_; cx.G = g_; } \
        const int G = cx.G, cidx = cx.bid; (void)G; (void)cidx; \
        unsigned char* ws = a.ws; asm volatile("" : "+s"(ws)); \
        asm volatile("s_waitcnt vmcnt(0)" ::: "memory"); __syncthreads(); \
        const float* MOD = (const float*)(ws + WS_MOD); float* H1 = (float*)(ws + WS_H1); bf16_t* U = (bf16_t*)(ws + WS_U); bf16_t* BIG = (bf16_t*)(ws + WS_BIG); bf16_t* XC = (bf16_t*)(ws + WS_XC); \
        (void)MOD; (void)H1; (void)U; (void)BIG; (void)XC; pg8::StaticOrder S; (void)S;
#define STEP_END }

template <int g>
__device__ __forceinline__ void run_group(const Args& a, LAS unsigned char* lds, const int wave_s) {
    constexpr int s0 = 5 + g * NPH;
    const float* H1r = (const float*)(a.ws + WS_H1); const float* H1Cr = (const float*)(a.ws + WS_H1C) + (size_t)g * RC * D;
    if (g == 0) { STEP_BEGIN(s0 + 0) if (PHON(0)) phase_normmod(cx, a, lds, AIN(I_X), nullptr, RL, RL, 0, 0); STEP_END }
    STEP_BEGIN(s0 + 1) if (PHON(1)) { pg8::Gemm gm{U, (const bf16_t*)(ws + WS_WI1), RL, 2 * FH, D, D, D, 0, 0}; S.init(RL, 2 * FH, G, cidx);
                  pg8::EpiSwiglu E{BIG, FH}; pg8::gemm_phase<pg8::EpiSwiglu, true>(cx.tid, lds, gm, S, E); } STEP_END
    STEP_BEGIN(s0 + 2) if (PHON(2)) { pg8::Gemm gm{BIG, (const bf16_t*)(ws + WS_WO1), RL, D, FH, FH, FH, 0, 0}; S.init(RL, D, G, cidx);
                  pg8::EpiResid E{AIN(I_X) + (size_t)g * RL * D, AIN(I_CTX) + (size_t)g * RC * D, H1, H1 + (size_t)RL * D,
                                  MOD + (size_t)(g * BG) * NMOD + 2 * D, MOD + (size_t)32 * NMOD + 2 * D, 0.5f, RL / 256};
                  pg8::gemm_phase<pg8::EpiResid, true>(cx.tid, lds, gm, S, E); } STEP_END
    STEP_BEGIN(s0 + 3) if (PHON(3)) phase_normmod(cx, a, lds, H1r, H1Cr, RL, RG, g * BG, 1); STEP_END
    STEP_BEGIN(s0 + 4) if (PHON(4)) { pg8::Gemm gm{U, (const bf16_t*)(ws + WS_WIN), RG, PN, D, D, D, 0, 0}; S.init(RL, PN, G, cidx); S.ext = (RC / 256) * 11; S.ext_pm0 = RL / 256;
                  pg8::EpiBf16 E{BIG, PN}; pg8::gemm_phase<pg8::EpiBf16, true>(cx.tid, lds, gm, S, E); } STEP_END
    STEP_BEGIN(s0 + 5) if (PHON(5)) phase_prep(cx, a, g, lds); STEP_END
    STEP_BEGIN(s0 + 6) if (PHON(6)) { pg8::Gemm gm{XC, (const bf16_t*)(ws + WS_WLG), RG, 4096, 128, D, 128, 1, 256}; S.init(RG, 4096, G, cidx);
                  pg8::EpiGate E{(bf16_t*)(ws + WS_LA), (bf16_t*)(ws + WS_UU)};
                  pg8::gemm_phase<pg8::EpiGate, true>(cx.tid, lds, gm, S, E); } STEP_END
    STEP_BEGIN_NS(s0 + 6) if (PHON(7)) { phase_gla_scan(cx, a, g, lds); } STEP_END
    STEP_BEGIN(s0 + 8) if (PHON(8)) phase_lru_scan(cx, a, g, lds); STEP_END
    STEP_BEGIN(s0 + 9) if (PHON(9)) phase_post(cx, a, lds, g); STEP_END
    STEP_BEGIN(s0 + 10) if (PHON(10)) { pg8::Gemm gm{(const bf16_t*)(ws + WS_OFB), (const bf16_t*)(ws + WS_WOG), RL, D, D, D, D, 0, 0}; S.init(RL, D, G, cidx);
                   pg8::EpiMix<false> E{BIG, PGA, XC}; pg8::gemm_phase<pg8::EpiMix<false>, true>(cx.tid, lds, gm, S, E); } STEP_END
    STEP_BEGIN_NS(s0 + 10) if (PHON(11)) { pg8::Gemm gm{(const bf16_t*)(ws + WS_HFB), (const bf16_t*)(ws + WS_WOL), RL, D, D, D, D, 0, 0}; S.init(RL, D, G, cidx);
                   pg8::EpiMix<true> E{BIG, PGB, XC}; pg8::gemm_phase<pg8::EpiMix<true>, true>(cx.tid, lds, gm, S, E); } STEP_END
    STEP_BEGIN(s0 + 12) if (PHON(12)) { pg8::Gemm gm{XC, (const bf16_t*)(ws + WS_WOO), RL, D, D, D, D, 0, 0}; S.init(RL, D, G, cidx);
                   pg8::EpiResid E{H1, H1, H1, H1, MOD + (size_t)(g * BG) * NMOD + 5 * D, MOD, 1.0f, RL / 256};
                   pg8::gemm_phase<pg8::EpiResid, true>(cx.tid, lds, gm, S, E); } STEP_END
    STEP_BEGIN(s0 + 13) if (PHON(13)) phase_normmod(cx, a, lds, H1r, nullptr, RL, RL, g * BG, 2); STEP_END
    STEP_BEGIN(s0 + 14) if (PHON(14)) { pg8::Gemm gm{U, (const bf16_t*)(ws + WS_WI2), RL, 2 * FH, D, D, D, 0, 0}; S.init(RL, 2 * FH, G, cidx);
                   pg8::EpiSwiglu E{BIG, FH}; pg8::gemm_phase<pg8::EpiSwiglu, true>(cx.tid, lds, gm, S, E); } STEP_END
    STEP_BEGIN(s0 + 15) if (PHON(15)) { pg8::Gemm gm{BIG, (const bf16_t*)(ws + WS_WO2), RL, D, FH, FH, FH, 0, 0}; S.init(RL, D, G, cidx);
                   float* og = a.out + (size_t)g * RL * D;
                   pg8::EpiResid E{H1, H1, og, og, MOD + (size_t)(g * BG) * NMOD + 8 * D, MOD, 0.5f, RL / 256};
                   pg8::gemm_phase<pg8::EpiResid, true>(cx.tid, lds, gm, S, E); } STEP_END
    STEP_BEGIN(s0 + 16) if (PHON(16)) { phase_final(cx, a, lds, g); if (g + 1 < NG) phase_normmod(cx, a, lds, AIN(I_X) + (size_t)(g + 1) * RL * D, nullptr, RL, RL, (g + 1) * BG, 0); } STEP_END
}

__global__ void __launch_bounds__(NTHR, 2) fwd_kernel(Args a) {
    extern __shared__ __attribute__((aligned(16))) unsigned char lds_raw[];
    LAS unsigned char* lds = (LAS unsigned char*)lds_raw;
    if (threadIdx.x < 26) ((LAS unsigned long long*)(lds + PTAB))[threadIdx.x] = (unsigned long long)a.in[threadIdx.x];
    if (threadIdx.x == 32) { ((LAS unsigned*)(lds + PTAB + 256))[0] = 0u; ((LAS unsigned*)(lds + PTAB + 256))[1] = 0u; }
#if ONE_LAUNCH
    if (threadIdx.x == 0) (void)xb_add((unsigned*)a.ws + 4096 + XB_XCNT(xb_xcc_id()), 1u);
#endif
    const int wave_s = __builtin_amdgcn_readfirstlane(threadIdx.x >> 6);
    __syncthreads();
    STEP_BEGIN(0) if (PHON(17)) phase_weights(cx, a, lds); STEP_END
    STEP_BEGIN(1) if (PHON(18)) phase_modreduce(cx, a, lds); STEP_END
    STEP_BEGIN(2) if (PHON(0)) phase_normmod(cx, a, lds, nullptr, AIN(I_CTX), 0, NB * CL, 0, 0); STEP_END
    STEP_BEGIN(3) if (PHON(1)) { pg8::Gemm gm{U, (const bf16_t*)(ws + WS_WI1), NB * CL, 2 * FH, D, D, D, 0, 0}; S.init(NB * CL, 2 * FH, G, cidx);
                  pg8::EpiSwiglu E{BIG, FH}; pg8::gemm_phase<pg8::EpiSwiglu, true>(cx.tid, lds, gm, S, E); } STEP_END
    STEP_BEGIN(4) if (PHON(2)) { pg8::Gemm gm{BIG, (const bf16_t*)(ws + WS_WO1), NB * CL, D, FH, FH, FH, 0, 0}; S.init(NB * CL, D, G, cidx);
                  float* h1c = (float*)(ws + WS_H1C);
                  pg8::EpiResid E{AIN(I_CTX), AIN(I_CTX), h1c, h1c, MOD, MOD + (size_t)32 * NMOD + 2 * D, 0.5f, 0};
                  pg8::gemm_phase<pg8::EpiResid, true>(cx.tid, lds, gm, S, E); } STEP_END
    run_group<0>(a, lds, wave_s);
    run_group<1>(a, lds, wave_s);
    run_group<2>(a, lds, wave_s);
    run_group<3>(a, lds, wave_s);
}


#ifdef PROBE_STEP
__global__ void probe_kernel(const unsigned char* ws, float* out) {
    const size_t n = (size_t)65536 * 1024, q = n / 4;
    const bf16_t* r0 = (const bf16_t*)(ws + PROBE_R0); const bf16_t* r1 = (const bf16_t*)(ws + PROBE_R1); const bf16_t* r2 = (const bf16_t*)(ws + PROBE_R2); const bf16_t* r3 = (const bf16_t*)(ws + PROBE_R3);
    for (size_t i = (size_t)blockIdx.x * blockDim.x + threadIdx.x; i < q; i += (size_t)gridDim.x * blockDim.x) {
        out[i] = bf2f(r0[i]); out[q + i] = bf2f(r1[i]); out[2 * q + i] = bf2f(r2[i]); out[3 * q + i] = bf2f(r3[i]); }
}
#endif
extern "C" void kernel_launch(void* const* d_in, const int* in_sizes, int n_in, void* d_out, int out_size, void* d_ws, size_t ws_size, hipStream_t stream) {
    static int grid = 0;
    if (grid == 0) {
        if (n_in != 26 || ws_size < WS_END) { fprintf(stderr, "kernel_launch: unexpected inputs (n_in %d, ws %zu, need %zu)\n", n_in, ws_size, (size_t)WS_END); grid = -1; return; }
        int dev = 0, cus = 0, per_cu = 0;
        hipGetDevice(&dev); hipDeviceGetAttribute(&cus, hipDeviceAttributeMultiprocessorCount, dev);
        if (hipFuncSetAttribute((const void*)fwd_kernel, hipFuncAttributeMaxDynamicSharedMemorySize, LDS_BYTES) != hipSuccess) { fprintf(stderr, "kernel_launch: hipFuncSetAttribute failed\n"); grid = -1; return; }
        hipOccupancyMaxActiveBlocksPerMultiprocessor(&per_cu, (const void*)fwd_kernel, NTHR, LDS_BYTES);
        (void)hipGetLastError();
        if (per_cu < 1) per_cu = 1;
        grid = cus * 1;
    }
    if (grid < 0) return;
    Args a{};
    for (int i = 0; i < 26; ++i) a.in[i] = (const float*)d_in[i];
    a.out = (float*)d_out; a.ws = (unsigned char*)d_ws;
    const int nsteps = 5 + NG * NPH;
#if ONE_LAUNCH
    (void)hipMemsetAsync(d_ws, 0, 65536, stream);
    a.lo = 0; a.hi = nsteps;
    void* args[] = {&a};
    hipError_t e = hipLaunchCooperativeKernel((const void*)fwd_kernel, dim3(grid), dim3(NTHR), args, LDS_BYTES, stream);
    if (e != hipSuccess) fprintf(stderr, "cooperative launch failed: %s (grid %d)\n", hipGetErrorString(e), grid);
#else
#ifdef PROBE_STEP
    for (int s = 0; s <= PROBE_STEP; ++s) { a.lo = s; a.hi = s + 1; hipLaunchKernelGGL(fwd_kernel, dim3(grid), dim3(NTHR), LDS_BYTES, stream, a); }
    hipLaunchKernelGGL(probe_kernel, dim3(2048), dim3(256), 0, stream, (const unsigned char*)d_ws, (float*)d_out);
#else
    for (int s = 0; s < nsteps; ++s) { a.lo = s; a.hi = s + 1; hipLaunchKernelGGL(fwd_kernel, dim3(grid), dim3(NTHR), LDS_BYTES, stream, a); }
#endif
#endif
}
```

```cpp
#include <hip/hip_runtime.h>
#include <hip/hip_cooperative_groups.h>
#include <cstdio>
#include <cstdint>
namespace cg = cooperative_groups;

#ifndef ONE_LAUNCH
#define ONE_LAUNCH 1
#endif

#ifndef PHMASK
#define PHMASK 0x1fffff
#endif
#define PHON(n) (((PHMASK) >> (n)) & 1)
#define LAS __attribute__((address_space(3)))
typedef unsigned short bf16_t;
typedef short bf16x8 __attribute__((ext_vector_type(8)));
typedef float f32x4 __attribute__((ext_vector_type(4)));
typedef float f32x2 __attribute__((ext_vector_type(2)));
typedef unsigned u32x4 __attribute__((ext_vector_type(4)));
typedef unsigned u32x2 __attribute__((ext_vector_type(2)));

constexpr int D = 1024, NB = 32, T = 2048, CL = 256, FH = 2816, INW = 7200, PN = 7424, NMOD = 9216;
constexpr int NG = 4, BG = NB / NG;
constexpr int RL = BG * T, RC = BG * CL, RG = RL + RC;
constexpr int NCH = 36;
constexpr float EPS = 1e-6f;
constexpr int PQ = 0, PK = 512, PV = 1024, PGG = 2048, PXL = 3072, PYL = 4096, PGA = 5120, PGB = 6144, PFD = 7168;

constexpr size_t al(size_t x) { return (x + 4095) & ~(size_t)4095; }
constexpr size_t WS_WI1 = 1 << 20;
constexpr size_t WS_WO1 = WS_WI1 + al((size_t)2 * FH * D * 2);
constexpr size_t WS_WI2 = WS_WO1 + al((size_t)D * FH * 2);
constexpr size_t WS_WO2 = WS_WI2 + al((size_t)2 * FH * D * 2);
constexpr size_t WS_WIN = WS_WO2 + al((size_t)D * FH * 2);
constexpr size_t WS_WOG = WS_WIN + al((size_t)PN * D * 2);
constexpr size_t WS_WOL = WS_WOG + al((size_t)D * D * 2);
constexpr size_t WS_WOO = WS_WOL + al((size_t)D * D * 2);
constexpr size_t WS_WLG = WS_WOO + al((size_t)D * D * 2);
constexpr size_t WS_MODP = WS_WLG + al((size_t)4096 * 128 * 2);
constexpr size_t WS_MOD = WS_MODP + al((size_t)16 * 33 * NMOD * 4);
constexpr size_t WS_GC = WS_MOD + al((size_t)33 * NMOD * 4);
constexpr size_t WS_H1 = WS_GC + al((size_t)6 * D * 4);
constexpr size_t WS_U = WS_H1 + al((size_t)RG * D * 4);
constexpr size_t WS_BIG = WS_U + al((size_t)RG * D * 2);
constexpr size_t WS_XC = WS_BIG + al((size_t)RG * PN * 2);
constexpr size_t WS_LA = WS_XC + al((size_t)RG * D * 2);
constexpr size_t WS_UU = WS_LA + al((size_t)2 * RG * D * 2);
constexpr size_t WS_HFB = WS_UU + al((size_t)2 * RG * D * 2);
constexpr size_t WS_OFB = WS_HFB + al((size_t)2 * RL * D * 2);
constexpr size_t GT = (size_t)2 * BG * NCH * 4;
constexpr size_t WS_QD = WS_OFB + al((size_t)2 * RL * D * 2);
constexpr size_t WS_KI = WS_QD + al(GT * 8192 * 2);
constexpr size_t WS_KET = WS_KI + al(GT * 8192 * 2);
constexpr size_t WS_VT = WS_KET + al(GT * 8192 * 2);
constexpr size_t WS_BL = WS_VT + al((size_t)BG * NCH * 4 * 16384 * 2);
constexpr size_t WS_H1C = WS_BL + al(GT * 128 * 4);
constexpr size_t WS_END = WS_H1C + al((size_t)NB * CL * D * 4);
static_assert(WS_END <= (size_t)1073741824, "workspace map exceeds 1 GiB");

constexpr int LDS_BYTES = 163840, PTAB = LDS_BYTES - 512;

typedef __bf16 bf16x2_t __attribute__((ext_vector_type(2)));
__device__ __forceinline__ unsigned cvt_pk_bf16(float lo, float hi) { const f32x2 v = {lo, hi}; return __builtin_bit_cast(unsigned, __builtin_convertvector(v, bf16x2_t)); }
__device__ __forceinline__ bf16_t f2bf(float f) { return (bf16_t)(cvt_pk_bf16(f, 0.f) & 0xffffu); }
__device__ __forceinline__ float bf2f(bf16_t h) { return __uint_as_float(((unsigned)h) << 16); }
__device__ __forceinline__ float bflo(unsigned w) { return __uint_as_float(w << 16); }
__device__ __forceinline__ float bfhi(unsigned w) { return __uint_as_float(w & 0xffff0000u); }
__device__ __forceinline__ float sigmoidf_(float x) { return __builtin_amdgcn_rcpf(1.0f + __expf(-x)); }
__device__ __forceinline__ float siluf_(float x) { return x * __builtin_amdgcn_rcpf(1.0f + __expf(-x)); }
__device__ __forceinline__ float geluf_(float x) { const float z = 0.7978845608028654f * (x + 0.044715f * x * x * x); return x * (1.0f - __builtin_amdgcn_rcpf(1.0f + __expf(2.0f * z))); }
__device__ __forceinline__ float logsigf_(float x) { return fminf(x, 0.f) - log1pf(__expf(-fabsf(x))); }
__device__ __forceinline__ float one_minus_exp(float x) {
    const float ser = -x * (1.0f + x * (0.5f + x * (0.16666667f + x * (0.041666668f + x * (0.0083333338f + x * (0.0013888889f + x * 0.0001984127f))))));
    return x > -0.3f ? ser : 1.0f - __expf(x);
}
__device__ __forceinline__ float wave_sum(float v) {
#pragma unroll
    for (int o = 1; o < 64; o <<= 1) v += __shfl_xor(v, o);
    return v;
}
__device__ __forceinline__ void unpack8(const u32x4 w, float (&f)[8]) {
    f[0] = bflo(w.x); f[1] = bfhi(w.x); f[2] = bflo(w.y); f[3] = bfhi(w.y); f[4] = bflo(w.z); f[5] = bfhi(w.z); f[6] = bflo(w.w); f[7] = bfhi(w.w);
}
__device__ __forceinline__ u32x4 pack8(const float (&f)[8]) {
    u32x4 w; w.x = cvt_pk_bf16(f[0], f[1]); w.y = cvt_pk_bf16(f[2], f[3]); w.z = cvt_pk_bf16(f[4], f[5]); w.w = cvt_pk_bf16(f[6], f[7]); return w;
}

namespace pg8 {
constexpr int BM = 256, BK = 64, HALF = 128, HTB = HALF * BK * 2, STAGE_BYTES = 8 * HTB, NXCD = 8, WGM = 8;
__host__ __device__ __forceinline__ int lds_byte(int r, int c) { const int st = (r >> 4) * 2 + (c >> 5), rr = r & 15, cc = c & 31, ob = rr * 64 + cc * 2; return st * 1024 + (ob ^ (((ob >> 9) & 1) << 5)); }
__host__ __device__ __forceinline__ void stage_rc(int b, int& R, int& C) { const int st = b / 1024, sb = b % 1024, swz = sb ^ (((sb >> 9) & 1) << 5); R = (st >> 1) * 16 + swz / 64; C = (st & 1) * 32 + (swz % 64) / 2; }
__host__ __device__ __forceinline__ int perm32(int rho) { const int n = rho >> 4, i = rho & 15; return 8 * (i >> 2) + 4 * n + (i & 3); }
struct Unit { int pm, pn; };
struct Gemm { const bf16_t* A; const bf16_t* Bt; int M, N, K, lda, ldb, a_pn_shift, a_pn_bytes; };
struct StaticOrder {
    int nM, nN, nwg, G, c, ext, ext_pm0;
    __device__ void init(int M, int N, int G_, int c_) { nM = M / BM; nN = N / BM; nwg = nM * nN; G = G_; c = c_; ext = 0; ext_pm0 = 0; }
    __device__ bool next(int i, Unit& u) const {
        const long L = (long)i * G + c;
        if (L >= nwg) { if (L >= nwg + ext) return false; const int idx = (int)(L - nwg), t = idx % 11; u.pm = ext_pm0 + idx / 11; u.pn = t < 6 ? t + 2 : (t < 10 ? t + 6 : 28); return true; }
        int wgid = (int)L; { const int q = nwg / NXCD, r = nwg % NXCD, xcd = wgid % NXCD, off = wgid / NXCD; wgid = (xcd < r ? xcd * (q + 1) : r * (q + 1) + (xcd - r) * q) + off; }
        const int nig = WGM * nN, gid = wgid / nig, fm = gid * WGM, gsz = (nM - fm) < WGM ? (nM - fm) : WGM;
        u.pm = fm + ((wgid % nig) % gsz); u.pn = (wgid % nig) / gsz; return true;
    }
};
template <class Epi, bool ALIGN_EPI>
__device__ __forceinline__ void gemm_phase(const int tid, LAS unsigned char* lds, const Gemm g, const StaticOrder& S, const Epi& E) {
    const int wid = __builtin_amdgcn_readfirstlane(tid >> 6), lane = tid & 63, wr = wid >> 2, wc = wid & 3, fr = lane & 15, fq = lane >> 4;
    const int K = g.K, nt = K / BK;
    unsigned voffA[2], voffB[2];
#pragma unroll
    for (int i = 0; i < 2; ++i) { int R, C; stage_rc(tid * 16 + i * 8192, R, C); const int Rb = Epi::PERM ? ((R & ~31) + perm32(R & 31)) : R;
        voffA[i] = (unsigned)(R * g.lda + C) * 2u; voffB[i] = (unsigned)(Rb * g.ldb + C) * 2u; }
    const size_t kstep = (size_t)(BK * 2);
    const size_t hstepA = (size_t)HALF * g.lda * 2, hstepB = (size_t)HALF * g.ldb * 2;
    const size_t tstepA = 2 * hstepA, tstepB = 2 * hstepB;
    const unsigned ldsw = (unsigned)wid * 1024u;
    const int aoff = lds_byte(wr * 64 + fr, fq * 8), boff = lds_byte(wc * 32 + fr, fq * 8);
#define PG8_SA(b, h) (((b) * 2 + (h)) * HTB)
#define PG8_SB(b, h) ((4 + (b) * 2 + (h)) * HTB)
#define PG8_STAGE(bufoff, gbase, voff) do { _Pragma("unroll") for (int _i = 0; _i < 2; ++_i) \
        __builtin_amdgcn_global_load_lds((const unsigned*)((const char*)(gbase) + (voff)[_i]), (LAS unsigned*)(lds + (bufoff) + ldsw + _i * 8192), 16, 0, 0); } while (0)
#define PG8_LDA(dst, b, h) do { _Pragma("unroll") for (int m = 0; m < 4; ++m) _Pragma("unroll") for (int k = 0; k < 2; ++k) dst[m][k] = *(const LAS bf16x8*)(lds + PG8_SA(b, h) + aoff + m * 2048 + k * 1024); } while (0)
#define PG8_LDB(dst, b, h) do { _Pragma("unroll") for (int n = 0; n < 2; ++n) _Pragma("unroll") for (int k = 0; k < 2; ++k) dst[n][k] = *(const LAS bf16x8*)(lds + PG8_SB(b, h) + boff + n * 2048 + k * 1024); } while (0)
#define PG8_MMA(ai, bj, At, Bt) do { __builtin_amdgcn_s_setprio(1); _Pragma("unroll") for (int m = 0; m < 4; ++m) _Pragma("unroll") for (int n = 0; n < 2; ++n) _Pragma("unroll") for (int k = 0; k < 2; ++k) \
        acc[ai][bj][m][n] = __builtin_amdgcn_mfma_f32_16x16x32_bf16(Bt[n][k], At[m][k], acc[ai][bj][m][n], 0, 0, 0); __builtin_amdgcn_s_setprio(0); } while (0)
#define PG8_WAIT_V(n) asm volatile("s_waitcnt vmcnt(" #n ")" ::: "memory")
#define PG8_WAIT_L(n) asm volatile("s_waitcnt lgkmcnt(" #n ")" ::: "memory")
#define PG8_BAR __builtin_amdgcn_s_barrier()
#define PG8_SCHED __builtin_amdgcn_sched_barrier(0)
    Unit cur, nxt; int ui = 0;
    if (!S.next(0, cur)) return;
    f32x4 acc[2][2][4][2];
#pragma unroll
    for (int a = 0; a < 2; ++a)
#pragma unroll
        for (int b = 0; b < 2; ++b)
#pragma unroll
            for (int m = 0; m < 4; ++m)
#pragma unroll
                for (int n = 0; n < 2; ++n) acc[a][b][m][n] = (f32x4){0.f, 0.f, 0.f, 0.f};
    bf16x8 At[4][2], B0[2][2], B1[2][2];
    const char* cA = (const char*)g.A + (size_t)cur.pm * tstepA + (size_t)((cur.pn >> g.a_pn_shift) * g.a_pn_bytes);
    const char* cB = (const char*)g.Bt + (size_t)cur.pn * tstepB;
    PG8_STAGE(PG8_SB(0, 0), cB, voffB); PG8_STAGE(PG8_SB(0, 1), cB + hstepB, voffB); PG8_STAGE(PG8_SA(0, 0), cA, voffA); PG8_STAGE(PG8_SA(0, 1), cA + hstepA, voffA);
    if (wr == 1) PG8_BAR;
    PG8_WAIT_V(2); PG8_BAR;
    PG8_STAGE(PG8_SB(1, 0), cB + kstep, voffB); PG8_STAGE(PG8_SA(1, 0), cA + kstep, voffA); PG8_STAGE(PG8_SB(1, 1), cB + hstepB + kstep, voffB);
    PG8_WAIT_V(6); PG8_BAR;
    for (;;) {
        const bool has_next = S.next(ui + 1, nxt);
        const char* nA = has_next ? (const char*)g.A + (size_t)nxt.pm * tstepA + (size_t)((nxt.pn >> g.a_pn_shift) * g.a_pn_bytes) : cA;
        const char* nB = has_next ? (const char*)g.Bt + (size_t)nxt.pn * tstepB : cB;
        for (int t = 0; t < nt; t += 2) {
            const bool last = (t == nt - 2);
            const char* a1 = cA + (size_t)(t + 1) * kstep;
            const char* a2 = last ? nA : cA + (size_t)(t + 2) * kstep; const char* b2 = last ? nB : cB + (size_t)(t + 2) * kstep;
            const char* a3 = a2 + kstep; const char* b3 = b2 + kstep;
            PG8_LDB(B0, 0, 0); PG8_LDB(B1, 0, 1); PG8_SCHED; PG8_LDA(At, 0, 0); PG8_STAGE(PG8_SA(1, 1), a1 + hstepA, voffA);
            PG8_WAIT_V(8); PG8_WAIT_L(0); PG8_BAR; PG8_MMA(0, 0, At, B0); PG8_MMA(0, 1, At, B1); PG8_BAR; PG8_SCHED;
            PG8_LDA(At, 0, 1); PG8_STAGE(PG8_SB(0, 0), b2, voffB); PG8_STAGE(PG8_SB(0, 1), b2 + hstepB, voffB); PG8_STAGE(PG8_SA(0, 0), a2, voffA);
            PG8_WAIT_V(8); PG8_WAIT_L(0); PG8_BAR; PG8_MMA(1, 0, At, B0); PG8_MMA(1, 1, At, B1); PG8_BAR; PG8_SCHED;
            PG8_LDB(B0, 1, 0); PG8_LDB(B1, 1, 1); PG8_SCHED; PG8_LDA(At, 1, 0); PG8_STAGE(PG8_SA(0, 1), a2 + hstepA, voffA);
            PG8_WAIT_V(8); PG8_WAIT_L(0); PG8_BAR; PG8_MMA(0, 0, At, B0); PG8_MMA(0, 1, At, B1); PG8_BAR; PG8_SCHED;
            PG8_LDA(At, 1, 1); PG8_STAGE(PG8_SB(1, 0), b3, voffB); PG8_STAGE(PG8_SB(1, 1), b3 + hstepB, voffB); PG8_STAGE(PG8_SA(1, 0), a3, voffA);
            PG8_WAIT_V(8); PG8_WAIT_L(0); PG8_BAR; PG8_MMA(1, 0, At, B0); PG8_MMA(1, 1, At, B1); PG8_BAR; PG8_SCHED;
        }
        if constexpr (ALIGN_EPI) { if (wr == 0) PG8_BAR; }
        { int fr_ = fr, fq_ = fq; asm volatile("" : "+v"(fr_), "+v"(fq_)); E(acc, cur, wr, wc, fr_, fq_); }
        if (!has_next) break;
#pragma unroll
        for (int a = 0; a < 2; ++a)
#pragma unroll
            for (int b = 0; b < 2; ++b)
#pragma unroll
                for (int m = 0; m < 4; ++m)
#pragma unroll
                    for (int n = 0; n < 2; ++n) acc[a][b][m][n] = (f32x4){0.f, 0.f, 0.f, 0.f};
        cur = nxt; cA = nA; cB = nB; ++ui;
        if constexpr (ALIGN_EPI) { if (wr == 1) PG8_BAR; }
    }
    PG8_WAIT_V(0);
    if constexpr (!ALIGN_EPI) { if (wr == 0) PG8_BAR; }
    PG8_BAR;
#undef PG8_SA
#undef PG8_SB
#undef PG8_STAGE
#undef PG8_LDA
#undef PG8_LDB
#undef PG8_MMA
#undef PG8_WAIT_V
#undef PG8_WAIT_L
#undef PG8_BAR
#undef PG8_SCHED
}

struct EpiBf16 {
    static constexpr bool PERM = true;
    bf16_t* O; int ldc;
    __device__ __forceinline__ void operator()(const f32x4 (&acc)[2][2][4][2], const Unit& u, int wr, int wc, int fr, int fq) const {
        const int row0 = u.pm * BM + wr * 64 + fr, col0 = u.pn * BM + wc * 32 + 8 * fq;
#pragma unroll
        for (int ai = 0; ai < 2; ++ai)
#pragma unroll
            for (int m = 0; m < 4; ++m) { bf16_t* rowp = O + (size_t)(row0 + ai * HALF + m * 16) * ldc + col0;
#pragma unroll
                for (int bj = 0; bj < 2; ++bj) { const f32x4 v0 = acc[ai][bj][m][0], v1 = acc[ai][bj][m][1];
                    u32x4 w; w.x = cvt_pk_bf16(v0[0], v0[1]); w.y = cvt_pk_bf16(v0[2], v0[3]); w.z = cvt_pk_bf16(v1[0], v1[1]); w.w = cvt_pk_bf16(v1[2], v1[3]);
                    *(u32x4*)(rowp + bj * HALF) = w; } }
    }
};
struct EpiSwiglu {
    static constexpr bool PERM = true;
    bf16_t* O; int ldc;
    __device__ __forceinline__ void operator()(const f32x4 (&acc)[2][2][4][2], const Unit& u, int wr, int wc, int fr, int fq) const {
        const int row0 = u.pm * BM + wr * 64 + fr, col0 = u.pn * HALF + wc * 32 + 8 * fq;
#pragma unroll
        for (int ai = 0; ai < 2; ++ai)
#pragma unroll
            for (int m = 0; m < 4; ++m) { bf16_t* rowp = O + (size_t)(row0 + ai * HALF + m * 16) * ldc + col0;
                float o[8];
#pragma unroll
                for (int n = 0; n < 2; ++n)
#pragma unroll
                    for (int j = 0; j < 4; ++j) o[4 * n + j] = siluf_(acc[ai][0][m][n][j]) * acc[ai][1][m][n][j];
                *(u32x4*)rowp = pack8(o); }
    }
};
struct EpiResid {
    static constexpr bool PERM = false;
    const float* baseL; const float* baseC; float* outL; float* outC; const float* modL; const float* modC; float scale; int nlat;
    __device__ __forceinline__ void operator()(const f32x4 (&acc)[2][2][4][2], const Unit& u, int wr, int wc, int fr, int fq) const {
        const bool lat = u.pm < nlat;
        const size_t toff = (size_t)(lat ? u.pm : u.pm - nlat) * BM * D + (size_t)(wr * 64 + fr) * D + u.pn * BM + wc * 32 + 4 * fq;
        const float* base = (lat ? baseL : baseC) + toff;
        float* out = (lat ? outL : outC) + toff;
        const float* mg = (lat ? modL + (size_t)(u.pm >> 3) * NMOD : modC) + u.pn * BM + wc * 32 + 4 * fq;
#pragma unroll
        for (int bj = 0; bj < 2; ++bj)
#pragma unroll
            for (int n = 0; n < 2; ++n) { const f32x4 gv = *(const f32x4*)(mg + bj * HALF + n * 16) * scale;
#pragma unroll
                for (int ai = 0; ai < 2; ++ai)
#pragma unroll
                    for (int m = 0; m < 4; ++m) { const size_t off = (size_t)(ai * HALF + m * 16) * D + bj * HALF + n * 16;
                        const f32x4 bs = *(const f32x4*)(base + off); *(f32x4*)(out + off) = bs + gv * acc[ai][bj][m][n]; } }
    }
};
__device__ __forceinline__ float one_minus_exp(float x) {
    const float ser = -x * (1.0f + x * (0.5f + x * (0.16666667f + x * (0.041666668f + x * (0.0083333338f + x * (0.0013888889f + x * 0.0001984127f))))));
    return x > -0.3f ? ser : 1.0f - __expf(x);
}
struct EpiGate {
    static constexpr bool PERM = true;
    bf16_t* LA; bf16_t* UU;
    __device__ __forceinline__ void operator()(const f32x4 (&acc)[2][2][4][2], const Unit& u, int wr, int wc, int fr, int fq) const {
        const int blk = u.pn >> 1, dir = u.pn & 1, ch0 = blk * HALF + wc * 32 + 8 * fq, row0 = u.pm * BM + wr * 64 + fr;
#pragma unroll
        for (int ai = 0; ai < 2; ++ai)
#pragma unroll
            for (int m = 0; m < 4; ++m) { const size_t off = (size_t)dir * RG * D + (size_t)(row0 + ai * HALF + m * 16) * D + ch0;
#pragma unroll
                for (int bj = 0; bj < 2; ++bj) { const f32x4 v0 = acc[ai][bj][m][0], v1 = acc[ai][bj][m][1];
                    u32x4 w; w.x = cvt_pk_bf16(v0[0], v0[1]); w.y = cvt_pk_bf16(v0[2], v0[3]); w.z = cvt_pk_bf16(v1[0], v1[1]); w.w = cvt_pk_bf16(v1[2], v1[3]);
                    *(u32x4*)((bj ? UU : LA) + off) = w; } }
    }
};
template <bool ACCUM> struct EpiMix {
    static constexpr bool PERM = true;
    const bf16_t* PROJ; int gcol; bf16_t* MG;
    __device__ __forceinline__ void operator()(const f32x4 (&acc)[2][2][4][2], const Unit& u, int wr, int wc, int fr, int fq) const {
        const int row0 = u.pm * BM + wr * 64 + fr, col0 = u.pn * BM + wc * 32 + 8 * fq;
#pragma unroll
        for (int ai = 0; ai < 2; ++ai)
#pragma unroll
            for (int m = 0; m < 4; ++m) { const size_t row = (size_t)(row0 + ai * HALF + m * 16);
#pragma unroll
                for (int bj = 0; bj < 2; ++bj) { float gt[8], o[8]; unpack8(*(const u32x4*)(PROJ + row * PN + gcol + col0 + bj * HALF), gt);
                    bf16_t* dst = MG + row * D + col0 + bj * HALF;
                    if (ACCUM) unpack8(*(const u32x4*)dst, o); else {
#pragma unroll
                        for (int i = 0; i < 8; ++i) o[i] = 0.f; }
#pragma unroll
                    for (int n = 0; n < 2; ++n)
#pragma unroll
                        for (int j = 0; j < 4; ++j) o[4 * n + j] += sigmoidf_(gt[4 * n + j]) * acc[ai][bj][m][n][j];
                    *(u32x4*)dst = pack8(o); } }
    }
};
}

struct Args {
    const float* in[26]; float* out; unsigned char* ws; int lo, hi;
};
enum { I_X = 0, I_C, I_CTX, I_CCTX, I_WADA, I_BADA, I_NORMW, I_F1WI, I_F1WO, I_F2WI, I_F2WO, I_WIN, I_FUP, I_FB, I_GNW, I_CONVW, I_CONVB, I_WR, I_BR, I_WI, I_BI, I_LAM, I_WOG, I_WOL, I_WOO, I_FNW };

#define NTHR 512
__device__ __forceinline__ const float* inp(const LAS unsigned char* lds, int i) { const LAS unsigned* t = (const LAS unsigned*)(lds + PTAB) + 2 * i;
    const unsigned lo = __builtin_amdgcn_readfirstlane(t[0]), hi = __builtin_amdgcn_readfirstlane(t[1]); return (const float*)(((unsigned long long)hi << 32) | lo); }
#define AIN(i) inp(lds, (i))
struct Ctx { int tid, bid, G; };
#define GW() (cx.bid * 8 + (cx.tid >> 6))
#define NGW() (cx.G * 8)

__device__ __forceinline__ void transpose_item(const float* W, int ldw, int K, int k0, int n0, bf16_t* WT, int drow, LAS float* scr, int lane) {
#pragma unroll 8
    for (int i = 0; i < 32; ++i) { const int kk = 2 * i + (lane >> 5); scr[kk * 33 + (lane & 31)] = W[(size_t)(k0 + kk) * ldw + n0 + (lane & 31)]; }
    asm volatile("s_waitcnt lgkmcnt(0)" ::: "memory");
    const int c = lane & 7;
#pragma unroll
    for (int j = 0; j < 4; ++j) { const int n = (lane >> 3) + 8 * j; const LAS float* s = scr + (8 * c) * 33 + n;
        u32x4 o; o.x = cvt_pk_bf16(s[0 * 33], s[1 * 33]); o.y = cvt_pk_bf16(s[2 * 33], s[3 * 33]); o.z = cvt_pk_bf16(s[4 * 33], s[5 * 33]); o.w = cvt_pk_bf16(s[6 * 33], s[7 * 33]);
        *(u32x4*)(WT + (size_t)(drow + n) * K + k0 + 8 * c) = o; }
    asm volatile("s_waitcnt lgkmcnt(0)" ::: "memory");
}
__device__ __forceinline__ int wi_drow(int n0) { return n0 < FH ? (n0 >> 7) * 256 + (n0 & 127) : ((n0 - FH) >> 7) * 256 + 128 + ((n0 - FH) & 127); }
__device__ __forceinline__ int win_drow(int n0) { return n0 < 3072 ? n0 : (n0 == 3072 ? PFD : n0 - 32); }

__device__ __forceinline__ void phase_weights(const Ctx cx, const Args& a, LAS unsigned char* lds) {
    const int lane = cx.tid & 63, wave = cx.tid >> 6;
    LAS float* scr = (LAS float*)(lds + wave * 16384);
    unsigned char* ws = a.ws;
    constexpr int I_WI_ = (D / 64) * (2 * FH / 32), I_WO_ = (FH / 64) * (D / 32), I_IN_ = (D / 64) * (INW / 32), I_SQ_ = (D / 64) * (D / 32), I_LG_ = 32 * 8;
    constexpr int NIT = 2 * I_WI_ + 2 * I_WO_ + I_IN_ + 3 * I_SQ_ + I_LG_;
    if (PHON(19)) for (int it = GW(); it < NIT; it += NGW()) {
        int r = it;
        if (r < 2 * I_WI_) { const int w = r / I_WI_; r %= I_WI_; const int nb = 2 * FH / 32, kb = r / nb, n0 = (r % nb) * 32;
            transpose_item(AIN(w ? I_F2WI : I_F1WI), 2 * FH, D, kb * 64, n0, (bf16_t*)(ws + (w ? WS_WI2 : WS_WI1)), wi_drow(n0), scr, lane); continue; }
        r -= 2 * I_WI_;
        if (r < 2 * I_WO_) { const int w = r / I_WO_; r %= I_WO_; const int nb = D / 32, kb = r / nb, n0 = (r % nb) * 32;
            transpose_item(AIN(w ? I_F2WO : I_F1WO), D, FH, kb * 64, n0, (bf16_t*)(ws + (w ? WS_WO2 : WS_WO1)), n0, scr, lane); continue; }
        r -= 2 * I_WO_;
        if (r < I_IN_) { const int nb = INW / 32, kb = r / nb, n0 = (r % nb) * 32;
            transpose_item(AIN(I_WIN), INW, D, kb * 64, n0, (bf16_t*)(ws + WS_WIN), win_drow(n0), scr, lane); continue; }
        r -= I_IN_;
        if (r < 3 * I_SQ_) { const int w = r / I_SQ_; r %= I_SQ_; const int nb = D / 32, kb = r / nb, n0 = (r % nb) * 32;
            transpose_item(AIN(w == 0 ? I_WOG : (w == 1 ? I_WOL : I_WOO)), D, D, kb * 64, n0, (bf16_t*)(ws + (w == 0 ? WS_WOG : (w == 1 ? WS_WOL : WS_WOO))), n0, scr, lane); continue; }
        r -= 3 * I_SQ_;
        { const int mat = r >> 3, sub = r & 7, gate = mat >> 4, dir = (mat >> 3) & 1, blk = mat & 7;
          const float* src = AIN(gate ? I_WI : I_WR) + (size_t)(dir * 8 + blk) * 128 * 128;
          const int kb = sub >> 2, n0 = (sub & 3) * 32;
          transpose_item(src, 128, 128, kb * 64, n0, (bf16_t*)(ws + WS_WLG), ((blk * 2 + dir) * 2 + gate) * 128 + n0, scr, lane); }
    }
    { u32x4* z = (u32x4*)(ws + WS_WIN + (size_t)INW * D * 2); const int n16 = (PN - INW) * D * 2 / 16;
      for (int i = cx.bid * NTHR + cx.tid; i < n16; i += cx.G * NTHR) z[i] = (u32x4){0u, 0u, 0u, 0u}; }
    __syncthreads();
    LAS float* sl = (LAS float*)lds;
    float* MODP = (float*)(ws + WS_MODP);
    if (PHON(20)) for (int item = cx.bid; item < 18 * 16; item += cx.G) {
        const int cb = item % 18, ks = item / 18, col = cb * 512 + cx.tid;
        for (int idx = cx.tid; idx < 33 * 64; idx += NTHR) { const int b = idx >> 6, k = idx & 63; const float cv = b < 32 ? AIN(I_C)[b * D + ks * 64 + k] : AIN(I_CCTX)[ks * 64 + k]; sl[idx] = siluf_(cv); }
        __syncthreads();
        float acc[33];
#pragma unroll
        for (int b = 0; b < 33; ++b) acc[b] = 0.f;
        const float* wp = AIN(I_WADA) + (size_t)(ks * 64) * NMOD + col;
#pragma unroll 4
        for (int k = 0; k < 64; ++k) { const float w = wp[(size_t)k * NMOD];
#pragma unroll
            for (int b = 0; b < 33; ++b) acc[b] += sl[b * 64 + k] * w; }
#pragma unroll
        for (int b = 0; b < 33; ++b) MODP[(size_t)(ks * 33 + b) * NMOD + col] = acc[b];
        __syncthreads();
    }
}
__device__ __forceinline__ void phase_modreduce(const Ctx cx, const Args& a, LAS unsigned char* lds) {
    const float* MODP = (const float*)(a.ws + WS_MODP); float* MOD = (float*)(a.ws + WS_MOD);
    for (int idx = cx.bid * NTHR + cx.tid; idx < 33 * NMOD; idx += cx.G * NTHR) {
        float s = AIN(I_BADA)[idx % NMOD];
#pragma unroll
        for (int ks = 0; ks < 16; ++ks) s += MODP[(size_t)ks * 33 * NMOD + idx];
        MOD[idx] = s;
    }
    float* GC = (float*)(a.ws + WS_GC);
    for (int idx = cx.bid * NTHR + cx.tid; idx < 2 * D; idx += cx.G * NTHR) { GC[idx] = AIN(I_BR)[idx]; GC[2 * D + idx] = AIN(I_BI)[idx]; GC[4 * D + idx] = 8.0f * log1pf(__expf(-AIN(I_LAM)[idx])); }
}

__device__ __forceinline__ void phase_normmod(const Ctx cx, const Args& a, LAS unsigned char* lds, const float* srcL, const float* srcC, int nL, int nrows, int mod_b0, int sub) {
    const int lane = cx.tid & 63;
    const float* MOD = (const float*)(a.ws + WS_MOD); const float* nw = AIN(I_NORMW) + sub * D;
    bf16_t* U = (bf16_t*)(a.ws + WS_U);
    for (int r0 = 2 * GW(); r0 < nrows; r0 += 2 * NGW()) {
        f32x4 v[2][4]; float ss[2];
#pragma unroll
        for (int q = 0; q < 2; ++q) { const int r = r0 + q;
            const float* src = r < nL ? srcL + (size_t)r * D : srcC + (size_t)(r - nL) * D;
            ss[q] = 0.f;
#pragma unroll
            for (int j = 0; j < 4; ++j) { v[q][j] = ((const f32x4*)src)[lane + 64 * j]; } }
#pragma unroll
        for (int q = 0; q < 2; ++q)
#pragma unroll
            for (int j = 0; j < 4; ++j) ss[q] += (v[q][j].x * v[q][j].x + v[q][j].y * v[q][j].y) + (v[q][j].z * v[q][j].z + v[q][j].w * v[q][j].w);
#pragma unroll
        for (int o = 1; o < 64; o <<= 1) { ss[0] += __shfl_xor(ss[0], o); ss[1] += __shfl_xor(ss[1], o); }
#pragma unroll
        for (int q = 0; q < 2; ++q) { const int r = r0 + q; const int mrow = r < nL ? mod_b0 + r / T : 32;
            const float* sh = MOD + (size_t)mrow * NMOD + (3 * sub) * D; const float* sc = sh + D;
            const float rstd = 1.0f / sqrtf(ss[q] * (1.0f / D) + EPS);
#pragma unroll
            for (int j = 0; j < 4; ++j) { const int c4 = lane + 64 * j; const f32x4 w = ((const f32x4*)nw)[c4], s4 = ((const f32x4*)sh)[c4], c1 = ((const f32x4*)sc)[c4];
                const f32x4 o = v[q][j] * rstd * w * (c1 + 1.0f) + s4;
                u32x2 p; p.x = cvt_pk_bf16(o.x, o.y); p.y = cvt_pk_bf16(o.z, o.w); ((u32x2*)(U + (size_t)r * D))[c4] = p; } }
    }
}
__device__ __forceinline__ void phase_final(const Ctx cx, const Args& a, LAS unsigned char* lds, int g) {
    const int lane = cx.tid & 63; const float* fw = AIN(I_FNW);
    for (int r0 = 2 * GW(); r0 < RL; r0 += 2 * NGW()) {
        float* row = a.out + ((size_t)g * RL + r0) * D;
        f32x4 v[2][4]; float ss[2] = {0.f, 0.f};
#pragma unroll
        for (int q = 0; q < 2; ++q)
#pragma unroll
            for (int j = 0; j < 4; ++j) v[q][j] = ((const f32x4*)(row + q * D))[lane + 64 * j];
#pragma unroll
        for (int q = 0; q < 2; ++q)
#pragma unroll
            for (int j = 0; j < 4; ++j) ss[q] += (v[q][j].x * v[q][j].x + v[q][j].y * v[q][j].y) + (v[q][j].z * v[q][j].z + v[q][j].w * v[q][j].w);
#pragma unroll
        for (int o = 1; o < 64; o <<= 1) { ss[0] += __shfl_xor(ss[0], o); ss[1] += __shfl_xor(ss[1], o); }
#pragma unroll
        for (int q = 0; q < 2; ++q) { const float rstd = 1.0f / sqrtf(ss[q] * (1.0f / D) + EPS);
#pragma unroll
            for (int j = 0; j < 4; ++j) { const int c4 = lane + 64 * j; ((f32x4*)(row + q * D))[c4] = v[q][j] * rstd * ((const f32x4*)fw)[c4]; } }
    }
}

__device__ __forceinline__ float logsig_fast(float x) { return fminf(x, 0.f) - __logf(1.0f + __expf(-fabsf(x))); }
__device__ __forceinline__ void phase_prep(const Ctx cx, const Args& a, int g, LAS unsigned char* lds) {
    const bf16_t* PROJ = (const bf16_t*)(a.ws + WS_BIG);
    const int tid = cx.tid;
    {
        LAS bf16_t* qs = (LAS bf16_t*)lds; LAS bf16_t* ks = (LAS bf16_t*)(lds + 16384); LAS float* fdl = (LAS float*)(lds + 32768); LAS float* part = (LAS float*)(lds + 36864);
        LAS bf16_t* qo = (LAS bf16_t*)(lds + 40960); LAS bf16_t* ko = (LAS bf16_t*)(lds + 57344);
        const int d = tid & 127, qt = tid >> 7;
        for (int item = cx.bid; item < BG * NCH * 8; item += cx.G) {
            const int h = item & 3, dir = (item >> 2) & 1, bc = item >> 3, b = bc / NCH, c = bc % NCH;
            const int row0 = c < 4 ? RL + b * CL + c * 64 : b * T + (c - 4) * 64;
            const bool lat = c >= 4;
#pragma unroll
            for (int k = 0; k < 2; ++k) { const int p = tid + 512 * k, r = p >> 4, c8 = (p & 15) * 8;
                *(LAS u32x4*)(ks + r * 128 + c8) = *(const u32x4*)(PROJ + (size_t)(row0 + r) * PN + PK + h * 128 + c8);
                if (lat) *(LAS u32x4*)(qs + r * 128 + c8) = *(const u32x4*)(PROJ + (size_t)(row0 + r) * PN + PQ + h * 128 + c8); }
#pragma unroll
            for (int k = 0; k < 2; ++k) { const int idx = tid + 512 * k; fdl[idx] = bf2f(PROJ[(size_t)(row0 + (idx >> 4)) * PN + PFD + dir * 16 + (idx & 15)]); }
            const int col = h * 128 + d;
            float fw[16];
#pragma unroll
            for (int r = 0; r < 16; ++r) fw[r] = AIN(I_FUP)[(size_t)(dir * 16 + r) * 512 + col];
            const float fbv = AIN(I_FB)[dir * 512 + col];
            __syncthreads();
            float la[16]; float psum = 0.f;
#pragma unroll
            for (int t = 0; t < 16; ++t) { const int i = 16 * qt + t; float dot = fbv;
#pragma unroll
                for (int r = 0; r < 16; ++r) dot += fdl[i * 16 + r] * fw[r];
                la[t] = logsig_fast(dot) * (1.0f / 16.0f); psum += la[t]; }
            part[qt * 128 + d] = psum;
            __syncthreads();
            const float p0 = part[d], p1 = part[128 + d], p2 = part[256 + d], p3 = part[384 + d];
            const float tot = (p0 + p1) + (p2 + p3);
            float run = dir == 0 ? (qt > 0 ? p0 : 0.f) + (qt > 1 ? p1 : 0.f) + (qt > 2 ? p2 : 0.f)
                                 : (qt < 3 ? p3 : 0.f) + (qt < 2 ? p2 : 0.f) + (qt < 1 ? p1 : 0.f);
            float ke[16];
            if (dir == 0) {
#pragma unroll
                for (int t = 0; t < 16; ++t) { const int i = 16 * qt + t; run += la[t];
                    const float kv = bf2f(ks[i * 128 + d]); ke[t] = kv * __expf(tot - run);
                    if (lat) { qo[i * 128 + d] = f2bf(bf2f(qs[i * 128 + d]) * 0.08838834764831845f * __expf(run)); ko[i * 128 + d] = f2bf(kv * __expf(-run)); } }
            } else {
#pragma unroll
                for (int t = 15; t >= 0; --t) { const int i = 16 * qt + t; run += la[t];
                    const float kv = bf2f(ks[i * 128 + d]); ke[t] = kv * __expf(tot - run);
                    if (lat) { qo[i * 128 + d] = f2bf(bf2f(qs[i * 128 + d]) * 0.08838834764831845f * __expf(run)); ko[i * 128 + d] = f2bf(kv * __expf(-run)); } }
            }
            const size_t tb = (((size_t)dir * BG + b) * NCH + c) * 4 + h;
            bf16_t* KET = (bf16_t*)(a.ws + WS_KET) + tb * 8192 + d * 64 + 16 * qt;
            { float k0[8], k1[8];
#pragma unroll
              for (int t = 0; t < 8; ++t) { k0[t] = ke[t]; k1[t] = ke[8 + t]; }
              *(u32x4*)KET = pack8(k0); *(u32x4*)(KET + 8) = pack8(k1); }
            if (qt == 0) ((float*)(a.ws + WS_BL))[tb * 128 + d] = tot;
            __syncthreads();
            if (lat) { bf16_t* QD = (bf16_t*)(a.ws + WS_QD) + tb * 8192; bf16_t* KI = (bf16_t*)(a.ws + WS_KI) + tb * 8192;
#pragma unroll
                for (int k = 0; k < 2; ++k) { const int p = tid + 512 * k; *(u32x4*)(QD + p * 8) = *(const LAS u32x4*)(qo + p * 8); *(u32x4*)(KI + p * 8) = *(const LAS u32x4*)(ko + p * 8); } }
            __syncthreads();
        }
    }
    {
        LAS bf16_t* vs = (LAS bf16_t*)lds;
        const int e = tid & 255, jh = tid >> 8;
        for (int item = cx.bid; item < BG * NCH * 4; item += cx.G) {
            const int h = item & 3, bc = item >> 2, b = bc / NCH, c = bc % NCH;
            const int row0 = c < 4 ? RL + b * CL + c * 64 : b * T + (c - 4) * 64;
#pragma unroll
            for (int k = 0; k < 4; ++k) { const int p = tid + 512 * k, r = p >> 5, c8 = (p & 31) * 8;
                *(LAS u32x4*)(vs + r * 256 + c8) = *(const u32x4*)(PROJ + (size_t)(row0 + r) * PN + PV + h * 256 + c8); }
            __syncthreads();
            bf16_t* VT = (bf16_t*)(a.ws + WS_VT) + ((((size_t)b * NCH + c) * 4 + h) * 256 + e) * 64 + 32 * jh;
#pragma unroll
            for (int jg = 0; jg < 4; ++jg) { float v[8];
#pragma unroll
                for (int jj = 0; jj < 8; ++jj) v[jj] = bf2f(vs[(32 * jh + 8 * jg + jj) * 256 + e]);
                *(u32x4*)(VT + 8 * jg) = pack8(v); }
            __syncthreads();
        }
    }
    bf16_t* XC = (bf16_t*)(a.ws + WS_XC);
    const float* cvb = AIN(I_CONVB); const float* cvw = AIN(I_CONVW);
    for (int idx0 = cx.bid * NTHR + cx.tid; idx0 < RG * 128; idx0 += 4 * cx.G * NTHR) {
        u32x4 xw[4][4];
#pragma unroll
        for (int q = 0; q < 4; ++q) { const int idx = idx0 + q * cx.G * NTHR; const int row = idx >> 7, c8 = (idx & 127) * 8;
            const int pos = row < RL ? (row & 63) : ((row - RL) & 255), len = row < RL ? 64 : 256;
#pragma unroll
            for (int j = 0; j < 4; ++j) { const int p = pos + j - 2; xw[q][j] = (u32x4){0u, 0u, 0u, 0u};
                if (idx < RG * 128 && p >= 0 && p < len) xw[q][j] = *(const u32x4*)(PROJ + (size_t)(row + j - 2) * PN + PXL + c8); } }
#pragma unroll
        for (int q = 0; q < 4; ++q) { const int idx = idx0 + q * cx.G * NTHR; const int row = idx >> 7, c8 = (idx & 127) * 8;
            if (idx < RG * 128) { float acc[8];
#pragma unroll
                for (int i = 0; i < 8; ++i) acc[i] = cvb[c8 + i];
#pragma unroll
                for (int j = 0; j < 4; ++j) { float xv[8]; unpack8(xw[q][j], xv);
#pragma unroll
                    for (int i = 0; i < 8; ++i) acc[i] += cvw[j * D + c8 + i] * xv[i]; }
                *(u32x4*)(XC + (size_t)row * D + c8) = pack8(acc); } }
    }
}

__device__ __forceinline__ void phase_gatefix(const Ctx cx, const Args& a, LAS unsigned char* lds) {
    bf16_t* LA = (bf16_t*)(a.ws + WS_LA); bf16_t* UU = (bf16_t*)(a.ws + WS_UU); const bf16_t* XC = (const bf16_t*)(a.ws + WS_XC); const float* GC = (const float*)(a.ws + WS_GC);
    for (int idx = cx.bid * NTHR + cx.tid; idx < 2 * RG * 128; idx += cx.G * NTHR) {
        const int dir = idx >= RG * 128, rem = idx - dir * RG * 128, row = rem >> 7, c8 = (rem & 127) * 8;
        const size_t off = (size_t)dir * RG * D + (size_t)row * D + c8;
        float r[8], ig[8], xc[8]; unpack8(*(const u32x4*)(LA + off), r); unpack8(*(const u32x4*)(UU + off), ig); unpack8(*(const u32x4*)(XC + (size_t)row * D + c8), xc);
#pragma unroll
        for (int i = 0; i < 8; ++i) { const float l = -GC[(4 + dir) * D + c8 + i] * sigmoidf_(r[i] + GC[dir * D + c8 + i]);
            const float gi = sigmoidf_(ig[i] + GC[(2 + dir) * D + c8 + i]);
            r[i] = l; ig[i] = __builtin_amdgcn_sqrtf(fmaxf(one_minus_exp(2.0f * l), 0.f)) * gi * xc[i]; }
        *(u32x4*)(LA + off) = pack8(r); *(u32x4*)(UU + off) = pack8(ig);
    }
}

__device__ __forceinline__ int img_off(int nkg, int row, int kcol) { const int ob = (row & 15) * 64 + (kcol & 31) * 2; return ((row >> 4) * nkg + (kcol >> 5)) * 1024 + (ob ^ (((ob >> 9) & 1) << 5)); }
__device__ __forceinline__ bf16x8 ldfrag(const LAS unsigned char* img, int nkg, int row, int kcol) { return *(const LAS bf16x8*)(img + img_off(nkg, row, kcol)); }
#define MFMA16(a, b, c) __builtin_amdgcn_mfma_f32_16x16x32_bf16((a), (b), (c), 0, 0, 0)

__device__ __forceinline__ void phase_gla_scan(const Ctx cx, const Args& a, int g, LAS unsigned char* lds) {
    constexpr int XB = 57344, OFF_KI = 16384, OFF_KET = 32768, OFF_VT = 49152, OFF_P = 2 * XB, OFF_ST = OFF_P + 8192, OFF_BL = OFF_ST + 2 * 16384;
    static_assert(OFF_BL + 1024 <= LDS_BYTES, "gla scan LDS");
    const int tid = cx.tid, lane = tid & 63, w = tid >> 6, fr = lane & 15, fq = lane >> 4;
    const bf16_t* QDg = (const bf16_t*)(a.ws + WS_QD); const bf16_t* KIg = (const bf16_t*)(a.ws + WS_KI); const bf16_t* KETg = (const bf16_t*)(a.ws + WS_KET);
    const bf16_t* VTg = (const bf16_t*)(a.ws + WS_VT); const float* BLg = (const float*)(a.ws + WS_BL);
    bf16_t* Og = (bf16_t*)(a.ws + WS_OFB);
    for (int item = cx.bid; item < BG * 32; item += cx.G) {
        const int dvq = item & 3, dir = (item >> 2) & 1, h = (item >> 3) & 3, b = item >> 5;
        { u32x4 z = {0u, 0u, 0u, 0u}; *(LAS u32x4*)(lds + OFF_ST + tid * 32) = z; *(LAS u32x4*)(lds + OFF_ST + tid * 32 + 16) = z; }
        f32x4 accS[4];
#pragma unroll
        for (int t = 0; t < 4; ++t) accS[t] = (f32x4){0.f, 0.f, 0.f, 0.f};
        u32x4 pq[2], pk[2], pe[2], pv; float pbl = 0.f;
#define GLA_LOAD(s_) do { const int c_ = dir == 0 ? (s_) : ((s_) < 4 ? 3 - (s_) : 39 - (s_)); \
            const size_t tb_ = (((size_t)dir * BG + b) * NCH + c_) * 4 + h; \
            if (c_ >= 4) { pq[0] = ((const u32x4*)(QDg + tb_ * 8192))[tid]; pq[1] = ((const u32x4*)(QDg + tb_ * 8192))[tid + 512]; \
                           pk[0] = ((const u32x4*)(KIg + tb_ * 8192))[tid]; pk[1] = ((const u32x4*)(KIg + tb_ * 8192))[tid + 512]; } \
            pe[0] = ((const u32x4*)(KETg + tb_ * 8192))[tid]; pe[1] = ((const u32x4*)(KETg + tb_ * 8192))[tid + 512]; \
            pv = ((const u32x4*)(VTg + ((((size_t)b * NCH + c_) * 4 + h) * 256 + dvq * 64) * 64))[tid]; \
            if (tid < 128) pbl = BLg[tb_ * 128 + tid]; } while (0)
#define GLA_STORE(buf_) do { LAS unsigned char* X_ = lds + (buf_) * XB; \
            _Pragma("unroll") for (int i_ = 0; i_ < 2; ++i_) { const int p_ = tid + 512 * i_; \
                *(LAS u32x4*)(X_ + img_off(4, p_ >> 4, (p_ & 15) * 8)) = pq[i_]; *(LAS u32x4*)(X_ + OFF_KI + img_off(4, p_ >> 4, (p_ & 15) * 8)) = pk[i_]; \
                *(LAS u32x4*)(X_ + OFF_KET + img_off(2, p_ >> 3, (p_ & 7) * 8)) = pe[i_]; } \
            *(LAS u32x4*)(X_ + OFF_VT + img_off(2, tid >> 3, (tid & 7) * 8)) = pv; \
            if (tid < 128) ((LAS float*)(lds + OFF_BL + (buf_) * 512))[tid] = pbl; } while (0)
        pq[0] = pq[1] = pk[0] = pk[1] = (u32x4){0u, 0u, 0u, 0u};
        GLA_LOAD(0); GLA_STORE(0);
        __syncthreads();
        for (int s = 0; s < NCH; ++s) {
            const int cur = s & 1; const bool lat = s >= 4;
            const LAS unsigned char* X = lds + cur * XB;
#ifndef GLA_SAFE
            if (s + 1 < NCH) GLA_LOAD(s + 1);
#endif
            if (lat) {
                const int ti = w >> 1, tj0 = (w & 1) * 2;
                f32x4 sc[2] = {(f32x4){0.f, 0.f, 0.f, 0.f}, (f32x4){0.f, 0.f, 0.f, 0.f}};
#pragma unroll
                for (int kk = 0; kk < 4; ++kk) { const bf16x8 qa = ldfrag(X, 4, 16 * ti + fr, kk * 32 + fq * 8);
#pragma unroll
                    for (int t = 0; t < 2; ++t) { const bf16x8 kb = ldfrag(X + OFF_KI, 4, 16 * (tj0 + t) + fr, kk * 32 + fq * 8); sc[t] = MFMA16(qa, kb, sc[t]); } }
#pragma unroll
                for (int t = 0; t < 2; ++t)
#pragma unroll
                    for (int jj = 0; jj < 4; ++jj) { const int i = 16 * ti + 4 * fq + jj, j = 16 * (tj0 + t) + fr;
                        const bool keep = dir == 0 ? (j <= i) : (j > i);
                        *(LAS bf16_t*)(lds + OFF_P + img_off(2, i, j)) = f2bf(keep ? sc[t][jj] : 0.f); }
            }
            __syncthreads();
            const int te = w >> 1;
            if (lat) {
                const int c = dir == 0 ? s : 39 - s;
                const LAS unsigned char* STc = lds + OFF_ST + cur * 16384;
                f32x4 oc[2] = {(f32x4){0.f, 0.f, 0.f, 0.f}, (f32x4){0.f, 0.f, 0.f, 0.f}};
#pragma unroll
                for (int kk = 0; kk < 2; ++kk) { const bf16x8 va = ldfrag(X + OFF_VT, 2, 16 * te + fr, kk * 32 + fq * 8);
#pragma unroll
                    for (int t = 0; t < 2; ++t) { const bf16x8 pb = ldfrag(lds + OFF_P, 2, 16 * ((w & 1) * 2 + t) + fr, kk * 32 + fq * 8); oc[t] = MFMA16(va, pb, oc[t]); } }
#pragma unroll
                for (int kk = 0; kk < 4; ++kk) { const bf16x8 sa = ldfrag(STc, 4, 16 * te + fr, kk * 32 + fq * 8);
#pragma unroll
                    for (int t = 0; t < 2; ++t) { const bf16x8 qb = ldfrag(X, 4, 16 * ((w & 1) * 2 + t) + fr, kk * 32 + fq * 8); oc[t] = MFMA16(sa, qb, oc[t]); } }
#pragma unroll
                for (int t = 0; t < 2; ++t) { const int i = 16 * ((w & 1) * 2 + t) + fr; const size_t row = (size_t)b * T + (size_t)(c - 4) * 64 + i;
                    u32x2 o2; o2.x = cvt_pk_bf16(oc[t][0], oc[t][1]); o2.y = cvt_pk_bf16(oc[t][2], oc[t][3]);
                    *(u32x2*)(Og + ((size_t)dir * RL + row) * D + h * 256 + dvq * 64 + 16 * te + 4 * fq) = o2; }
            }
#ifdef GLA_SAFE
            __syncthreads();
#endif
            {
                const LAS float* blp = (const LAS float*)(lds + OFF_BL + cur * 512);
                LAS unsigned char* STn = lds + OFF_ST + (cur ^ 1) * 16384;
                bf16x8 vb[2];
#pragma unroll
                for (int kk = 0; kk < 2; ++kk) vb[kk] = ldfrag(X + OFF_VT, 2, 16 * te + fr, kk * 32 + fq * 8);
#pragma unroll
                for (int t = 0; t < 4; ++t) { const int td = (w & 1) * 4 + t;
#pragma unroll
                    for (int jj = 0; jj < 4; ++jj) accS[t][jj] *= __expf(blp[16 * td + 4 * fq + jj]);
#pragma unroll
                    for (int kk = 0; kk < 2; ++kk) { const bf16x8 ka = ldfrag(X + OFF_KET, 2, 16 * td + fr, kk * 32 + fq * 8); accS[t] = MFMA16(ka, vb[kk], accS[t]); }
                    u32x2 s2; s2.x = cvt_pk_bf16(accS[t][0], accS[t][1]); s2.y = cvt_pk_bf16(accS[t][2], accS[t][3]);
                    *(LAS u32x2*)(STn + img_off(4, 16 * te + fr, 16 * td + 4 * fq)) = s2; }
            }
#ifdef GLA_SAFE
            __syncthreads();
            if (s + 1 < NCH) { GLA_LOAD(s + 1); GLA_STORE(cur ^ 1); }
#else
            if (s + 1 < NCH) GLA_STORE(cur ^ 1);
#endif
            __syncthreads();
        }
#undef GLA_LOAD
#undef GLA_STORE
    }
}

__device__ __forceinline__ void phase_lru_scan(const Ctx cx, const Args& a, int g, LAS unsigned char* lds) {
    const int lane = cx.tid & 63, w = cx.tid >> 6;
    LAS f32x2* agg = (LAS f32x2*)lds;
    const float* GC = (const float*)(a.ws + WS_GC);
    for (int item = cx.bid; item < BG * 32; item += cx.G) {
        const int cgp = item & 15, dir = (item >> 4) & 1, b = item >> 5, ch = cgp * 64 + lane;
        const bf16_t* RR = (const bf16_t*)(a.ws + WS_LA) + (size_t)dir * RG * D + ch; const bf16_t* II = (const bf16_t*)(a.ws + WS_UU) + (size_t)dir * RG * D + ch;
        const bf16_t* XCp = (const bf16_t*)(a.ws + WS_XC) + ch;
        bf16_t* Hd = (bf16_t*)(a.ws + WS_HFB) + (size_t)dir * RL * D + ch;
        const float cbr = GC[dir * D + ch], cbi = GC[(2 + dir) * D + ch], csp = GC[(4 + dir) * D + ch];
#define LRU_ROW(s_) ((s_) < CL ? RL + b * CL + (dir ? CL - 1 - (s_) : (s_)) : b * T + (dir ? T - 1 - ((s_) - CL) : (s_) - CL))
#define LRU_GATES(k_) const float l_ = -csp * sigmoidf_(bf2f(rr[k_]) + cbr); const float av = __expf(l_); \
            const float uv = __builtin_amdgcn_sqrtf(fmaxf(one_minus_exp(2.0f * l_), 0.f)) * sigmoidf_(bf2f(ii[k_]) + cbi) * bf2f(xx[k_]);
        unsigned* SC = (unsigned*)(a.ws + WS_QD) + (size_t)dir * RG * D + ch;
        float A = 1.f, Z = 0.f;
        for (int blk = 0; blk < 9; ++blk) { const int s0 = 288 * w + 32 * blk; bf16_t rr[32], ii[32], xx[32];
#pragma unroll
            for (int k = 0; k < 32; ++k) { const size_t r = (size_t)LRU_ROW(s0 + k); rr[k] = RR[r * D]; ii[k] = II[r * D]; xx[k] = XCp[r * D]; }
#pragma unroll
            for (int k = 0; k < 32; ++k) { const float l_ = -csp * sigmoidf_(bf2f(rr[k]) + cbr);
                const float u_ = __builtin_amdgcn_sqrtf(fmaxf(one_minus_exp(2.0f * l_), 0.f)) * sigmoidf_(bf2f(ii[k]) + cbi) * bf2f(xx[k]);
                const unsigned pk = cvt_pk_bf16(l_, u_);
                SC[(size_t)LRU_ROW(s0 + k) * D] = pk;
                const float av = __expf(bflo(pk)); Z = av * Z + bfhi(pk); A *= av; } }
        agg[w * 64 + lane] = (f32x2){A, Z};
        __syncthreads();
        float hst = 0.f;
#pragma unroll
        for (int w2 = 0; w2 < 7; ++w2) { const f32x2 p = agg[w2 * 64 + lane]; if (w2 < w) hst = p.x * hst + p.y; }
        for (int blk = 0; blk < 9; ++blk) { const int s0 = 288 * w + 32 * blk; unsigned pk[32];
#pragma unroll
            for (int k = 0; k < 32; ++k) pk[k] = SC[(size_t)LRU_ROW(s0 + k) * D];
#pragma unroll
            for (int k = 0; k < 32; ++k) { hst = __expf(bflo(pk[k])) * hst + bfhi(pk[k]);
                if (s0 + k >= CL) Hd[(size_t)LRU_ROW(s0 + k) * D] = f2bf(hst); } }
        __syncthreads();
#undef LRU_ROW
#undef LRU_GATES
    }
}

__device__ __forceinline__ void phase_post(const Ctx cx, const Args& a, LAS unsigned char* lds, int g) {
    const int lane = cx.tid & 63;
    const bf16_t* PROJ = (const bf16_t*)(a.ws + WS_BIG);
    bf16_t* O0 = (bf16_t*)(a.ws + WS_OFB); const bf16_t* O1 = O0 + (size_t)RL * D;
    bf16_t* H0 = (bf16_t*)(a.ws + WS_HFB); const bf16_t* H1b = H0 + (size_t)RL * D;
    const float* gnw = AIN(I_GNW);
    for (int r = GW(); r < RL; r += NGW()) {
        const size_t off = (size_t)r * D + lane * 16;
        float o[16], t[8]; float ss = 0.f;
#pragma unroll
        for (int hf = 0; hf < 2; ++hf) { float x0[8], x1[8]; unpack8(*(const u32x4*)(O0 + off + 8 * hf), x0); unpack8(*(const u32x4*)(O1 + off + 8 * hf), x1);
#pragma unroll
            for (int i = 0; i < 8; ++i) { o[8 * hf + i] = x0[i] + x1[i]; ss += o[8 * hf + i] * o[8 * hf + i]; } }
        ss += __shfl_xor(ss, 1); ss += __shfl_xor(ss, 2); ss += __shfl_xor(ss, 4); ss += __shfl_xor(ss, 8);
        const float rstd = 1.0f / sqrtf(ss * (1.0f / 256.0f) + EPS);
#pragma unroll
        for (int hf = 0; hf < 2; ++hf) { float gg[8]; unpack8(*(const u32x4*)(PROJ + (size_t)r * PN + PGG + lane * 16 + 8 * hf), gg);
#pragma unroll
            for (int i = 0; i < 8; ++i) t[i] = o[8 * hf + i] * rstd * gnw[(lane & 15) * 16 + 8 * hf + i] * siluf_(gg[i]);
            *(u32x4*)(O0 + off + 8 * hf) = pack8(t); }
#pragma unroll
        for (int hf = 0; hf < 2; ++hf) { float x0[8], x1[8], yl[8]; unpack8(*(const u32x4*)(H0 + off + 8 * hf), x0); unpack8(*(const u32x4*)(H1b + off + 8 * hf), x1);
            unpack8(*(const u32x4*)(PROJ + (size_t)r * PN + PYL + lane * 16 + 8 * hf), yl);
#pragma unroll
            for (int i = 0; i < 8; ++i) t[i] = (x0[i] + x1[i]) * geluf_(yl[i]);
            *(u32x4*)(H0 + off + 8 * hf) = pack8(t); }
    }
}


#define XB_TMO      128
#define XB_XCNT(j)  (256  + 64 * (j))
#define XB_XSUB(j)  (1280 + 64 * (j))
#define XB_XGEN(j)  (2304 + 64 * (j))
#define XB_TOP      3328
#define XB_TOPGEN   3392
#define XCD_BAR_WORDS 3456
#define XB_SPIN_CAP (1u << 22)
__device__ __forceinline__ unsigned xb_ld(unsigned* p)              { return __hip_atomic_load(p, __ATOMIC_RELAXED, __HIP_MEMORY_SCOPE_AGENT); }
__device__ __forceinline__ unsigned xb_add(unsigned* p, unsigned v) { return __hip_atomic_fetch_add(p, v, __ATOMIC_RELAXED, __HIP_MEMORY_SCOPE_AGENT); }
__device__ __forceinline__ unsigned xb_xcc_id() { return (unsigned)__builtin_amdgcn_s_getreg((3 << 11) | 20) & 0xFu; }
#define XB_SPIN(cond, bar) do { unsigned _sp = 0; while (cond) { __builtin_amdgcn_s_sleep(1); \
    if ((++_sp & 255u) == 0u) { if (xb_ld(&(bar)[XB_TMO])) break; if (_sp > XB_SPIN_CAP) { atomicAdd(&(bar)[XB_TMO], 1u); break; } } } } while (0)
__device__ __forceinline__ void xcd_barrier_complete(unsigned* bar, unsigned x, unsigned G, unsigned& nloc, unsigned& nx) {
    unsigned sum, cnt, mine, sp = 0u;
    for (;;) {
        sum = 0u; cnt = 0u; mine = 0u;
#pragma unroll
        for (unsigned j = 0; j < 16; ++j) { const unsigned c = xb_ld(&bar[XB_XCNT(j)]); sum += c; cnt += (c > 0u) ? 1u : 0u; mine = (j == x) ? c : mine; }
        if (sum == G) break;
        __builtin_amdgcn_s_sleep(1);
        if ((++sp & 255u) == 0u) { if (xb_ld(&bar[XB_TMO])) break; if (sp > XB_SPIN_CAP) { atomicAdd(&bar[XB_TMO], 1u); break; } }
    }
    nloc = mine > 0u ? mine : 1u; nx = cnt > 0u ? cnt : 1u;
}
__device__ __forceinline__ void xcd_barrier(unsigned* bar, volatile LAS unsigned* st, int tid, unsigned G) {
    asm volatile("s_waitcnt vmcnt(0)" ::: "memory");
    __syncthreads();
    if (tid == 0) {
        __builtin_amdgcn_s_waitcnt(0);
        const unsigned x = xb_xcc_id();
        unsigned nloc = st[0], nx = st[1];
        if (nloc == 0u) { xcd_barrier_complete(bar, x, G, nloc, nx); st[0] = nloc; st[1] = nx; }
        const unsigned old = xb_add(&bar[XB_XSUB(x)], 1u);
        const unsigned gen = old / nloc;
        if (old + 1u == (gen + 1u) * nloc) {
            __builtin_amdgcn_fence(__ATOMIC_RELEASE, "agent");
            asm volatile("s_waitcnt vmcnt(0)" ::: "memory");
            const unsigned og = xb_add(&bar[XB_TOP], 1u);
            const unsigned tg = og / nx;
            if (og + 1u == (tg + 1u) * nx) xb_add(&bar[XB_TOPGEN], 1u);
            else XB_SPIN(xb_ld(&bar[XB_TOPGEN]) == tg, bar);
            __builtin_amdgcn_fence(__ATOMIC_ACQUIRE, "agent");
            xb_add(&bar[XB_XGEN(x)], 1u);
            asm volatile("s_waitcnt vmcnt(0)" ::: "memory");
        } else {
            XB_SPIN(xb_ld(&bar[XB_XGEN(x)]) == gen, bar);
            __builtin_amdgcn_fence(__ATOMIC_ACQUIRE, "agent");
            asm volatile("s_waitcnt vmcnt(0)" ::: "memory");
        }
    }
    __syncthreads();
}

constexpr int NPH = 17;
#ifndef USE_CG_ALL
#define USE_CG_ALL 0
#endif
#if ONE_LAUNCH
#define GRID_SYNC(k) do { if ((k) == 1 || USE_CG_ALL) cg::this_grid().sync(); else xcd_barrier((unsigned*)ws + 4096, (volatile LAS unsigned*)(lds + PTAB + 256), cx.tid, (unsigned)cx.G); } while (0)
#else
#define GRID_SYNC(k) do {} while (0)
#endif
#define STEP_BEGIN(k) if (a.lo <= (k) && (k) < a.hi) { \
        Ctx cx; { int t_ = wave_s * 64 + (int)__builtin_amdgcn_mbcnt_hi(~0u, __builtin_amdgcn_mbcnt_lo(~0u, 0u)), b_ = blockIdx.x, g_ = gridDim.x; asm volatile("" : "+v"(t_)); asm volatile("" : "+s"(b_), "+s"(g_)); cx.tid = t_; cx.bid = b_; cx.G = g_; } \
        const int G = cx.G, cidx = cx.bid; (void)G; (void)cidx; \
        unsigned char* ws = a.ws; asm volatile("" : "+s"(ws)); \
        if ((k) > a.lo) GRID_SYNC(k); \
        const float* MOD = (const float*)(ws + WS_MOD); float* H1 = (float*)(ws + WS_H1); bf16_t* U = (bf16_t*)(ws + WS_U); bf16_t* BIG = (bf16_t*)(ws + WS_BIG); bf16_t* XC = (bf16_t*)(ws + WS_XC); \
        (void)MOD; (void)H1; (void)U; (void)BIG; (void)XC; pg8::StaticOrder S; (void)S;
#define STEP_BEGIN_NS(k) if (a.lo <= (k) && (k) < a.hi) { \
        Ctx cx; { int t_ = wave_s * 64 + (int)__builtin_amdgcn_mbcnt_hi(~0u, __builtin_amdgcn_mbcnt_lo(~0u, 0u)), b_ = blockIdx.x, g_ = gridDim.x; asm volatile("" : "+v"(t_)); asm volatile("" : "+s"(b_), "+s"(g_)); cx.tid = t_; cx.bid = b_; cx.G = g_; } \
        const int G = cx.G, cidx = cx.bid; (void)G; (void)cidx; \
        unsigned char* ws = a.ws; asm volatile("" : "+s"(ws)); \
        asm volatile("s_waitcnt vmcnt(0)" ::: "memory"); __syncthreads(); \
        const float* MOD = (const float*)(ws + WS_MOD); float* H1 = (float*)(ws + WS_H1); bf16_t* U = (bf16_t*)(ws + WS_U); bf16_t* BIG = (bf16_t*)(ws + WS_BIG); bf16_t* XC = (bf16_t*)(ws + WS_XC); \
        (void)MOD; (void)H1; (void)U; (void)BIG; (void)XC; pg8::StaticOrder S; (void)S;
#define STEP_END }

template <int g>
__device__ __forceinline__ void run_group(const Args& a, LAS unsigned char* lds, const int wave_s) {
    constexpr int s0 = 5 + g * NPH;
    const float* H1r = (const float*)(a.ws + WS_H1); const float* H1Cr = (const float*)(a.ws + WS_H1C) + (size_t)g * RC * D;
    if (g == 0) { STEP_BEGIN(s0 + 0) if (PHON(0)) phase_normmod(cx, a, lds, AIN(I_X), nullptr, RL, RL, 0, 0); STEP_END }
    STEP_BEGIN(s0 + 1) if (PHON(1)) { pg8::Gemm gm{U, (const bf16_t*)(ws + WS_WI1), RL, 2 * FH, D, D, D, 0, 0}; S.init(RL, 2 * FH, G, cidx);
                  pg8::EpiSwiglu E{BIG, FH}; pg8::gemm_phase<pg8::EpiSwiglu, true>(cx.tid, lds, gm, S, E); } STEP_END
    STEP_BEGIN(s0 + 2) if (PHON(2)) { pg8::Gemm gm{BIG, (const bf16_t*)(ws + WS_WO1), RL, D, FH, FH, FH, 0, 0}; S.init(RL, D, G, cidx);
                  pg8::EpiResid E{AIN(I_X) + (size_t)g * RL * D, AIN(I_CTX) + (size_t)g * RC * D, H1, H1 + (size_t)RL * D,
                                  MOD + (size_t)(g * BG) * NMOD + 2 * D, MOD + (size_t)32 * NMOD + 2 * D, 0.5f, RL / 256};
                  pg8::gemm_phase<pg8::EpiResid, true>(cx.tid, lds, gm, S, E); } STEP_END
    STEP_BEGIN(s0 + 3) if (PHON(3)) phase_normmod(cx, a, lds, H1r, H1Cr, RL, RG, g * BG, 1); STEP_END
    STEP_BEGIN(s0 + 4) if (PHON(4)) { pg8::Gemm gm{U, (const bf16_t*)(ws + WS_WIN), RG, PN, D, D, D, 0, 0}; S.init(RL, PN, G, cidx); S.ext = (RC / 256) * 11; S.ext_pm0 = RL / 256;
                  pg8::EpiBf16 E{BIG, PN}; pg8::gemm_phase<pg8::EpiBf16, true>(cx.tid, lds, gm, S, E); } STEP_END
    STEP_BEGIN(s0 + 5) if (PHON(5)) phase_prep(cx, a, g, lds); STEP_END
    STEP_BEGIN(s0 + 6) if (PHON(6)) { pg8::Gemm gm{XC, (const bf16_t*)(ws + WS_WLG), RG, 4096, 128, D, 128, 1, 256}; S.init(RG, 4096, G, cidx);
                  pg8::EpiGate E{(bf16_t*)(ws + WS_LA), (bf16_t*)(ws + WS_UU)};
                  pg8::gemm_phase<pg8::EpiGate, true>(cx.tid, lds, gm, S, E); } STEP_END
    STEP_BEGIN_NS(s0 + 6) if (PHON(7)) { phase_gla_scan(cx, a, g, lds); } STEP_END
    STEP_BEGIN(s0 + 8) if (PHON(8)) phase_lru_scan(cx, a, g, lds); STEP_END
    STEP_BEGIN(s0 + 9) if (PHON(9)) phase_post(cx, a, lds, g); STEP_END
    STEP_BEGIN(s0 + 10) if (PHON(10)) { pg8::Gemm gm{(const bf16_t*)(ws + WS_OFB), (const bf16_t*)(ws + WS_WOG), RL, D, D, D, D, 0, 0}; S.init(RL, D, G, cidx);
                   pg8::EpiMix<false> E{BIG, PGA, XC}; pg8::gemm_phase<pg8::EpiMix<false>, true>(cx.tid, lds, gm, S, E); } STEP_END
    STEP_BEGIN_NS(s0 + 10) if (PHON(11)) { pg8::Gemm gm{(const bf16_t*)(ws + WS_HFB), (const bf16_t*)(ws + WS_WOL), RL, D, D, D, D, 0, 0}; S.init(RL, D, G, cidx);
                   pg8::EpiMix<true> E{BIG, PGB, XC}; pg8::gemm_phase<pg8::EpiMix<true>, true>(cx.tid, lds, gm, S, E); } STEP_END
    STEP_BEGIN(s0 + 12) if (PHON(12)) { pg8::Gemm gm{XC, (const bf16_t*)(ws + WS_WOO), RL, D, D, D, D, 0, 0}; S.init(RL, D, G, cidx);
                   pg8::EpiResid E{H1, H1, H1, H1, MOD + (size_t)(g * BG) * NMOD + 5 * D, MOD, 1.0f, RL / 256};
                   pg8::gemm_phase<pg8::EpiResid, true>(cx.tid, lds, gm, S, E); } STEP_END
    STEP_BEGIN(s0 + 13) if (PHON(13)) phase_normmod(cx, a, lds, H1r, nullptr, RL, RL, g * BG, 2); STEP_END
    STEP_BEGIN(s0 + 14) if (PHON(14)) { pg8::Gemm gm{U, (const bf16_t*)(ws + WS_WI2), RL, 2 * FH, D, D, D, 0, 0}; S.init(RL, 2 * FH, G, cidx);
                   pg8::EpiSwiglu E{BIG, FH}; pg8::gemm_phase<pg8::EpiSwiglu, true>(cx.tid, lds, gm, S, E); } STEP_END
    STEP_BEGIN(s0 + 15) if (PHON(15)) { pg8::Gemm gm{BIG, (const bf16_t*)(ws + WS_WO2), RL, D, FH, FH, FH, 0, 0}; S.init(RL, D, G, cidx);
                   float* og = a.out + (size_t)g * RL * D;
                   pg8::EpiResid E{H1, H1, og, og, MOD + (size_t)(g * BG) * NMOD + 8 * D, MOD, 0.5f, RL / 256};
                   pg8::gemm_phase<pg8::EpiResid, true>(cx.tid, lds, gm, S, E); } STEP_END
    STEP_BEGIN(s0 + 16) if (PHON(16)) { phase_final(cx, a, lds, g); if (g + 1 < NG) phase_normmod(cx, a, lds, AIN(I_X) + (size_t)(g + 1) * RL * D, nullptr, RL, RL, (g + 1) * BG, 0); } STEP_END
}

__global__ void __launch_bounds__(NTHR, 2) fwd_kernel(Args a) {
    extern __shared__ __attribute__((aligned(16))) unsigned char lds_raw[];
    LAS unsigned char* lds = (LAS unsigned char*)lds_raw;
    if (threadIdx.x < 26) ((LAS unsigned long long*)(lds + PTAB))[threadIdx.x] = (unsigned long long)a.in[threadIdx.x];
    if (threadIdx.x == 32) { ((LAS unsigned*)(lds + PTAB + 256))[0] = 0u; ((LAS unsigned*)(lds + PTAB + 256))[1] = 0u; }
#if ONE_LAUNCH
    if (threadIdx.x == 0) (void)xb_add((unsigned*)a.ws + 4096 + XB_XCNT(xb_xcc_id()), 1u);
#endif
    const int wave_s = __builtin_amdgcn_readfirstlane(threadIdx.x >> 6);
    __syncthreads();
    STEP_BEGIN(0) if (PHON(17)) phase_weights(cx, a, lds); STEP_END
    STEP_BEGIN(1) if (PHON(18)) phase_modreduce(cx, a, lds); STEP_END
    STEP_BEGIN(2) if (PHON(0)) phase_normmod(cx, a, lds, nullptr, AIN(I_CTX), 0, NB * CL, 0, 0); STEP_END
    STEP_BEGIN(3) if (PHON(1)) { pg8::Gemm gm{U, (const bf16_t*)(ws + WS_WI1), NB * CL, 2 * FH, D, D, D, 0, 0}; S.init(NB * CL, 2 * FH, G, cidx);
                  pg8::EpiSwiglu E{BIG, FH}; pg8::gemm_phase<pg8::EpiSwiglu, true>(cx.tid, lds, gm, S, E); } STEP_END
    STEP_BEGIN(4) if (PHON(2)) { pg8::Gemm gm{BIG, (const bf16_t*)(ws + WS_WO1), NB * CL, D, FH, FH, FH, 0, 0}; S.init(NB * CL, D, G, cidx);
                  float* h1c = (float*)(ws + WS_H1C);
                  pg8::EpiResid E{AIN(I_CTX), AIN(I_CTX), h1c, h1c, MOD, MOD + (size_t)32 * NMOD + 2 * D, 0.5f, 0};
                  pg8::gemm_phase<pg8::EpiResid, true>(cx.tid, lds, gm, S, E); } STEP_END
    run_group<0>(a, lds, wave_s);
    run_group<1>(a, lds, wave_s);
    run_group<2>(a, lds, wave_s);
    run_group<3>(a, lds, wave_s);
}


#ifdef PROBE_STEP
__global__ void probe_kernel(const unsigned char* ws, float* out) {
    const size_t n = (size_t)65536 * 1024, q = n / 4;
    const bf16_t* r0 = (const bf16_t*)(ws + PROBE_R0); const bf16_t* r1 = (const bf16_t*)(ws + PROBE_R1); const bf16_t* r2 = (const bf16_t*)(ws + PROBE_R2); const bf16_t* r3 = (const bf16_t*)(ws + PROBE_R3);
    for (size_t i = (size_t)blockIdx.x * blockDim.x + threadIdx.x; i < q; i += (size_t)gridDim.x * blockDim.x) {
        out[i] = bf2f(r0[i]); out[q + i] = bf2f(r1[i]); out[2 * q + i] = bf2f(r2[i]); out[3 * q + i] = bf2f(r3[i]); }
}
#endif
extern "C" void kernel_launch(void* const* d_in, const int* in_sizes, int n_in, void* d_out, int out_size, void* d_ws, size_t ws_size, hipStream_t stream) {
    static int grid = 0;
    if (grid == 0) {
        if (n_in != 26 || ws_size < WS_END) { fprintf(stderr, "kernel_launch: unexpected inputs (n_in %d, ws %zu, need %zu)\n", n_in, ws_size, (size_t)WS_END); grid = -1; return; }
        int dev = 0, cus = 0, per_cu = 0;
        hipGetDevice(&dev); hipDeviceGetAttribute(&cus, hipDeviceAttributeMultiprocessorCount, dev);
        if (hipFuncSetAttribute((const void*)fwd_kernel, hipFuncAttributeMaxDynamicSharedMemorySize, LDS_BYTES) != hipSuccess) { fprintf(stderr, "kernel_launch: hipFuncSetAttribute failed\n"); grid = -1; return; }
        hipOccupancyMaxActiveBlocksPerMultiprocessor(&per_cu, (const void*)fwd_kernel, NTHR, LDS_BYTES);
        (void)hipGetLastError();
        if (per_cu < 1) per_cu = 1;
        grid = cus * 1;
    }
    if (grid < 0) return;
    Args a{};
    for (int i = 0; i < 26; ++i) a.in[i] = (const float*)d_in[i];
    a.out = (float*)d_out; a.ws = (unsigned char*)d_ws;
    const int nsteps = 5 + NG * NPH;
#if ONE_LAUNCH
    (void)hipMemsetAsync(d_ws, 0, 65536, stream);
    a.lo = 0; a.hi = nsteps;
    void* args[] = {&a};
    hipError_t e = hipLaunchCooperativeKernel((const void*)fwd_kernel, dim3(grid), dim3(NTHR), args, LDS_BYTES, stream);
    if (e != hipSuccess) fprintf(stderr, "cooperative launch failed: %s (grid %d)\n", hipGetErrorString(e), grid);
#else
#ifdef PROBE_STEP
    for (int s = 0; s <= PROBE_STEP; ++s) { a.lo = s; a.hi = s + 1; hipLaunchKernelGGL(fwd_kernel, dim3(grid), dim3(NTHR), LDS_BYTES, stream, a); }
    hipLaunchKernelGGL(probe_kernel, dim3(2048), dim3(256), 0, stream, (const unsigned char*)d_ws, (float*)d_out);
#else
    for (int s = 0; s < nsteps; ++s) { a.lo = s; a.hi = s + 1; hipLaunchKernelGGL(fwd_kernel, dim3(grid), dim3(NTHR), LDS_BYTES, stream, a); }
#endif
#endif
}
```

```cpp
#include <hip/hip_runtime.h>
#include <hip/hip_cooperative_groups.h>
#include <cstdio>
#include <cstdint>
namespace cg = cooperative_groups;

#ifndef ONE_LAUNCH
#define ONE_LAUNCH 1
#endif

#ifndef PHMASK
#define PHMASK 0x1fffff
#endif
#define PHON(n) (((PHMASK) >> (n)) & 1)
#define LAS __attribute__((address_space(3)))
typedef unsigned short bf16_t;
typedef short bf16x8 __attribute__((ext_vector_type(8)));
typedef float f32x4 __attribute__((ext_vector_type(4)));
typedef float f32x2 __attribute__((ext_vector_type(2)));
typedef unsigned u32x4 __attribute__((ext_vector_type(4)));
typedef unsigned u32x2 __attribute__((ext_vector_type(2)));

constexpr int D = 1024, NB = 32, T = 2048, CL = 256, FH = 2816, INW = 7200, PN = 7424, NMOD = 9216;
constexpr int NG = 4, BG = NB / NG;
constexpr int RL = BG * T, RC = BG * CL, RG = RL + RC;
constexpr int NCH = 36;
constexpr float EPS = 1e-6f;
constexpr int PQ = 0, PK = 512, PV = 1024, PGG = 2048, PXL = 3072, PYL = 4096, PGA = 5120, PGB = 6144, PFD = 7168;

constexpr size_t al(size_t x) { return (x + 4095) & ~(size_t)4095; }
constexpr size_t WS_WI1 = 1 << 20;
constexpr size_t WS_WO1 = WS_WI1 + al((size_t)2 * FH * D * 2);
constexpr size_t WS_WI2 = WS_WO1 + al((size_t)D * FH * 2);
constexpr size_t WS_WO2 = WS_WI2 + al((size_t)2 * FH * D * 2);
constexpr size_t WS_WIN = WS_WO2 + al((size_t)D * FH * 2);
constexpr size_t WS_WOG = WS_WIN + al((size_t)PN * D * 2);
constexpr size_t WS_WOL = WS_WOG + al((size_t)D * D * 2);
constexpr size_t WS_WOO = WS_WOL + al((size_t)D * D * 2);
constexpr size_t WS_WLG = WS_WOO + al((size_t)D * D * 2);
constexpr size_t WS_MODP = WS_WLG + al((size_t)4096 * 128 * 2);
constexpr size_t WS_MOD = WS_MODP + al((size_t)16 * 33 * NMOD * 4);
constexpr size_t WS_GC = WS_MOD + al((size_t)33 * NMOD * 4);
constexpr size_t WS_H1 = WS_GC + al((size_t)6 * D * 4);
constexpr size_t WS_U = WS_H1 + al((size_t)RG * D * 4);
constexpr size_t WS_BIG = WS_U + al((size_t)RG * D * 2);
constexpr size_t WS_XC = WS_BIG + al((size_t)RG * PN * 2);
constexpr size_t WS_LA = WS_XC + al((size_t)RG * D * 2);
constexpr size_t WS_UU = WS_LA + al((size_t)2 * RG * D * 2);
constexpr size_t WS_HFB = WS_UU + al((size_t)2 * RG * D * 2);
constexpr size_t WS_OFB = WS_HFB + al((size_t)2 * RL * D * 2);
constexpr size_t GT = (size_t)2 * BG * NCH * 4;
constexpr size_t WS_QD = WS_OFB + al((size_t)2 * RL * D * 2);
constexpr size_t WS_KI = WS_QD + al(GT * 8192 * 2);
constexpr size_t WS_KET = WS_KI + al(GT * 8192 * 2);
constexpr size_t WS_VT = WS_KET + al(GT * 8192 * 2);
constexpr size_t WS_BL = WS_VT + al((size_t)BG * NCH * 4 * 16384 * 2);
constexpr size_t WS_H1C = WS_BL + al(GT * 128 * 4);
constexpr size_t WS_END = WS_H1C + al((size_t)NB * CL * D * 4);
static_assert(WS_END <= (size_t)1073741824, "workspace map exceeds 1 GiB");

constexpr int LDS_BYTES = 163840, PTAB = LDS_BYTES - 512;

typedef __bf16 bf16x2_t __attribute__((ext_vector_type(2)));
__device__ __forceinline__ unsigned cvt_pk_bf16(float lo, float hi) { const f32x2 v = {lo, hi}; return __builtin_bit_cast(unsigned, __builtin_convertvector(v, bf16x2_t)); }
__device__ __forceinline__ bf16_t f2bf(float f) { return (bf16_t)(cvt_pk_bf16(f, 0.f) & 0xffffu); }
__device__ __forceinline__ float bf2f(bf16_t h) { return __uint_as_float(((unsigned)h) << 16); }
__device__ __forceinline__ float bflo(unsigned w) { return __uint_as_float(w << 16); }
__device__ __forceinline__ float bfhi(unsigned w) { return __uint_as_float(w & 0xffff0000u); }
__device__ __forceinline__ float sigmoidf_(float x) { return __builtin_amdgcn_rcpf(1.0f + __expf(-x)); }
__device__ __forceinline__ float siluf_(float x) { return x * __builtin_amdgcn_rcpf(1.0f + __expf(-x)); }
__device__ __forceinline__ float geluf_(float x) { const float z = 0.7978845608028654f * (x + 0.044715f * x * x * x); return x * (1.0f - __builtin_amdgcn_rcpf(1.0f + __expf(2.0f * z))); }
__device__ __forceinline__ float logsigf_(float x) { return fminf(x, 0.f) - log1pf(__expf(-fabsf(x))); }
__device__ __forceinline__ float one_minus_exp(float x) {
    const float ser = -x * (1.0f + x * (0.5f + x * (0.16666667f + x * (0.041666668f + x * (0.0083333338f + x * (0.0013888889f + x * 0.0001984127f))))));
    return x > -0.3f ? ser : 1.0f - __expf(x);
}
__device__ __forceinline__ float wave_sum(float v) {
#pragma unroll
    for (int o = 1; o < 64; o <<= 1) v += __shfl_xor(v, o);
    return v;
}
__device__ __forceinline__ void unpack8(const u32x4 w, float (&f)[8]) {
    f[0] = bflo(w.x); f[1] = bfhi(w.x); f[2] = bflo(w.y); f[3] = bfhi(w.y); f[4] = bflo(w.z); f[5] = bfhi(w.z); f[6] = bflo(w.w); f[7] = bfhi(w.w);
}
__device__ __forceinline__ u32x4 pack8(const float (&f)[8]) {
    u32x4 w; w.x = cvt_pk_bf16(f[0], f[1]); w.y = cvt_pk_bf16(f[2], f[3]); w.z = cvt_pk_bf16(f[4], f[5]); w.w = cvt_pk_bf16(f[6], f[7]); return w;
}

namespace pg8 {
constexpr int BM = 256, BK = 64, HALF = 128, HTB = HALF * BK * 2, STAGE_BYTES = 8 * HTB, NXCD = 8, WGM = 8;
__host__ __device__ __forceinline__ int lds_byte(int r, int c) { const int st = (r >> 4) * 2 + (c >> 5), rr = r & 15, cc = c & 31, ob = rr * 64 + cc * 2; return st * 1024 + (ob ^ (((ob >> 9) & 1) << 5)); }
__host__ __device__ __forceinline__ void stage_rc(int b, int& R, int& C) { const int st = b / 1024, sb = b % 1024, swz = sb ^ (((sb >> 9) & 1) << 5); R = (st >> 1) * 16 + swz / 64; C = (st & 1) * 32 + (swz % 64) / 2; }
__host__ __device__ __forceinline__ int perm32(int rho) { const int n = rho >> 4, i = rho & 15; return 8 * (i >> 2) + 4 * n + (i & 3); }
struct Unit { int pm, pn; };
struct Gemm { const bf16_t* A; const bf16_t* Bt; int M, N, K, lda, ldb, a_pn_shift, a_pn_bytes; };
struct StaticOrder {
    int nM, nN, nwg, G, c, ext, ext_pm0;
    __device__ void init(int M, int N, int G_, int c_) { nM = M / BM; nN = N / BM; nwg = nM * nN; G = G_; c = c_; ext = 0; ext_pm0 = 0; }
    __device__ bool next(int i, Unit& u) const {
        const long L = (long)i * G + c;
        if (L >= nwg) { if (L >= nwg + ext) return false; const int idx = (int)(L - nwg), t = idx % 11; u.pm = ext_pm0 + idx / 11; u.pn = t < 6 ? t + 2 : (t < 10 ? t + 6 : 28); return true; }
        int wgid = (int)L; { const int q = nwg / NXCD, r = nwg % NXCD, xcd = wgid % NXCD, off = wgid / NXCD; wgid = (xcd < r ? xcd * (q + 1) : r * (q + 1) + (xcd - r) * q) + off; }
        const int nig = WGM * nN, gid = wgid / nig, fm = gid * WGM, gsz = (nM - fm) < WGM ? (nM - fm) : WGM;
        u.pm = fm + ((wgid % nig) % gsz); u.pn = (wgid % nig) / gsz; return true;
    }
};
template <class Epi, bool ALIGN_EPI>
__device__ __forceinline__ void gemm_phase(const int tid, LAS unsigned char* lds, const Gemm g, const StaticOrder& S, const Epi& E) {
    const int wid = __builtin_amdgcn_readfirstlane(tid >> 6), lane = tid & 63, wr = wid >> 2, wc = wid & 3, fr = lane & 15, fq = lane >> 4;
    const int K = g.K, nt = K / BK;
    unsigned voffA[2], voffB[2];
#pragma unroll
    for (int i = 0; i < 2; ++i) { int R, C; stage_rc(tid * 16 + i * 8192, R, C); const int Rb = Epi::PERM ? ((R & ~31) + perm32(R & 31)) : R;
        voffA[i] = (unsigned)(R * g.lda + C) * 2u; voffB[i] = (unsigned)(Rb * g.ldb + C) * 2u; }
    const size_t kstep = (size_t)(BK * 2);
    const size_t hstepA = (size_t)HALF * g.lda * 2, hstepB = (size_t)HALF * g.ldb * 2;
    const size_t tstepA = 2 * hstepA, tstepB = 2 * hstepB;
    const unsigned ldsw = (unsigned)wid * 1024u;
    const int aoff = lds_byte(wr * 64 + fr, fq * 8), boff = lds_byte(wc * 32 + fr, fq * 8);
#define PG8_SA(b, h) (((b) * 2 + (h)) * HTB)
#define PG8_SB(b, h) ((4 + (b) * 2 + (h)) * HTB)
#define PG8_STAGE(bufoff, gbase, voff) do { _Pragma("unroll") for (int _i = 0; _i < 2; ++_i) \
        __builtin_amdgcn_global_load_lds((const unsigned*)((const char*)(gbase) + (voff)[_i]), (LAS unsigned*)(lds + (bufoff) + ldsw + _i * 8192), 16, 0, 0); } while (0)
#define PG8_LDA(dst, b, h) do { _Pragma("unroll") for (int m = 0; m < 4; ++m) _Pragma("unroll") for (int k = 0; k < 2; ++k) dst[m][k] = *(const LAS bf16x8*)(lds + PG8_SA(b, h) + aoff + m * 2048 + k * 1024); } while (0)
#define PG8_LDB(dst, b, h) do { _Pragma("unroll") for (int n = 0; n < 2; ++n) _Pragma("unroll") for (int k = 0; k < 2; ++k) dst[n][k] = *(const LAS bf16x8*)(lds + PG8_SB(b, h) + boff + n * 2048 + k * 1024); } while (0)
#define PG8_MMA(ai, bj, At, Bt) do { __builtin_amdgcn_s_setprio(1); _Pragma("unroll") for (int m = 0; m < 4; ++m) _Pragma("unroll") for (int n = 0; n < 2; ++n) _Pragma("unroll") for (int k = 0; k < 2; ++k) \
        acc[ai][bj][m][n] = __builtin_amdgcn_mfma_f32_16x16x32_bf16(Bt[n][k], At[m][k], acc[ai][bj][m][n], 0, 0, 0); __builtin_amdgcn_s_setprio(0); } while (0)
#define PG8_WAIT_V(n) asm volatile("s_waitcnt vmcnt(" #n ")" ::: "memory")
#define PG8_WAIT_L(n) asm volatile("s_waitcnt lgkmcnt(" #n ")" ::: "memory")
#define PG8_BAR __builtin_amdgcn_s_barrier()
#define PG8_SCHED __builtin_amdgcn_sched_barrier(0)
    Unit cur, nxt; int ui = 0;
    if (!S.next(0, cur)) return;
    f32x4 acc[2][2][4][2];
#pragma unroll
    for (int a = 0; a < 2; ++a)
#pragma unroll
        for (int b = 0; b < 2; ++b)
#pragma unroll
            for (int m = 0; m < 4; ++m)
#pragma unroll
                for (int n = 0; n < 2; ++n) acc[a][b][m][n] = (f32x4){0.f, 0.f, 0.f, 0.f};
    bf16x8 At[4][2], B0[2][2], B1[2][2];
    const char* cA = (const char*)g.A + (size_t)cur.pm * tstepA + (size_t)((cur.pn >> g.a_pn_shift) * g.a_pn_bytes);
    const char* cB = (const char*)g.Bt + (size_t)cur.pn * tstepB;
    PG8_STAGE(PG8_SB(0, 0), cB, voffB); PG8_STAGE(PG8_SB(0, 1), cB + hstepB, voffB); PG8_STAGE(PG8_SA(0, 0), cA, voffA); PG8_STAGE(PG8_SA(0, 1), cA + hstepA, voffA);
    if (wr == 1) PG8_BAR;
    PG8_WAIT_V(2); PG8_BAR;
    PG8_STAGE(PG8_SB(1, 0), cB + kstep, voffB); PG8_STAGE(PG8_SA(1, 0), cA + kstep, voffA); PG8_STAGE(PG8_SB(1, 1), cB + hstepB + kstep, voffB);
    PG8_WAIT_V(6); PG8_BAR;
    for (;;) {
        const bool has_next = S.next(ui + 1, nxt);
        const char* nA = has_next ? (const char*)g.A + (size_t)nxt.pm * tstepA + (size_t)((nxt.pn >> g.a_pn_shift) * g.a_pn_bytes) : cA;
        const char* nB = has_next ? (const char*)g.Bt + (size_t)nxt.pn * tstepB : cB;
        for (int t = 0; t < nt; t += 2) {
            const bool last = (t == nt - 2);
            const char* a1 = cA + (size_t)(t + 1) * kstep;
            const char* a2 = last ? nA : cA + (size_t)(t + 2) * kstep; const char* b2 = last ? nB : cB + (size_t)(t + 2) * kstep;
            const char* a3 = a2 + kstep; const char* b3 = b2 + kstep;
            PG8_LDB(B0, 0, 0); PG8_LDB(B1, 0, 1); PG8_SCHED; PG8_LDA(At, 0, 0); PG8_STAGE(PG8_SA(1, 1), a1 + hstepA, voffA);
            PG8_WAIT_V(8); PG8_WAIT_L(0); PG8_BAR; PG8_MMA(0, 0, At, B0); PG8_MMA(0, 1, At, B1); PG8_BAR; PG8_SCHED;
            PG8_LDA(At, 0, 1); PG8_STAGE(PG8_SB(0, 0), b2, voffB); PG8_STAGE(PG8_SB(0, 1), b2 + hstepB, voffB); PG8_STAGE(PG8_SA(0, 0), a2, voffA);
            PG8_WAIT_V(8); PG8_WAIT_L(0); PG8_BAR; PG8_MMA(1, 0, At, B0); PG8_MMA(1, 1, At, B1); PG8_BAR; PG8_SCHED;
            PG8_LDB(B0, 1, 0); PG8_LDB(B1, 1, 1); PG8_SCHED; PG8_LDA(At, 1, 0); PG8_STAGE(PG8_SA(0, 1), a2 + hstepA, voffA);
            PG8_WAIT_V(8); PG8_WAIT_L(0); PG8_BAR; PG8_MMA(0, 0, At, B0); PG8_MMA(0, 1, At, B1); PG8_BAR; PG8_SCHED;
            PG8_LDA(At, 1, 1); PG8_STAGE(PG8_SB(1, 0), b3, voffB); PG8_STAGE(PG8_SB(1, 1), b3 + hstepB, voffB); PG8_STAGE(PG8_SA(1, 0), a3, voffA);
            PG8_WAIT_V(8); PG8_WAIT_L(0); PG8_BAR; PG8_MMA(1, 0, At, B0); PG8_MMA(1, 1, At, B1); PG8_BAR; PG8_SCHED;
        }
        if constexpr (ALIGN_EPI) { if (wr == 0) PG8_BAR; }
        { int fr_ = fr, fq_ = fq; asm volatile("" : "+v"(fr_), "+v"(fq_)); E(acc, cur, wr, wc, fr_, fq_); }
        if (!has_next) break;
#pragma unroll
        for (int a = 0; a < 2; ++a)
#pragma unroll
            for (int b = 0; b < 2; ++b)
#pragma unroll
                for (int m = 0; m < 4; ++m)
#pragma unroll
                    for (int n = 0; n < 2; ++n) acc[a][b][m][n] = (f32x4){0.f, 0.f, 0.f, 0.f};
        cur = nxt; cA = nA; cB = nB; ++ui;
        if constexpr (ALIGN_EPI) { if (wr == 1) PG8_BAR; }
    }
    PG8_WAIT_V(0);
    if constexpr (!ALIGN_EPI) { if (wr == 0) PG8_BAR; }
    PG8_BAR;
#undef PG8_SA
#undef PG8_SB
#undef PG8_STAGE
#undef PG8_LDA
#undef PG8_LDB
#undef PG8_MMA
#undef PG8_WAIT_V
#undef PG8_WAIT_L
#undef PG8_BAR
#undef PG8_SCHED
}

struct EpiBf16 {
    static constexpr bool PERM = true;
    bf16_t* O; int ldc;
    __device__ __forceinline__ void operator()(const f32x4 (&acc)[2][2][4][2], const Unit& u, int wr, int wc, int fr, int fq) const {
        const int row0 = u.pm * BM + wr * 64 + fr, col0 = u.pn * BM + wc * 32 + 8 * fq;
#pragma unroll
        for (int ai = 0; ai < 2; ++ai)
#pragma unroll
            for (int m = 0; m < 4; ++m) { bf16_t* rowp = O + (size_t)(row0 + ai * HALF + m * 16) * ldc + col0;
#pragma unroll
                for (int bj = 0; bj < 2; ++bj) { const f32x4 v0 = acc[ai][bj][m][0], v1 = acc[ai][bj][m][1];
                    u32x4 w; w.x = cvt_pk_bf16(v0[0], v0[1]); w.y = cvt_pk_bf16(v0[2], v0[3]); w.z = cvt_pk_bf16(v1[0], v1[1]); w.w = cvt_pk_bf16(v1[2], v1[3]);
                    *(u32x4*)(rowp + bj * HALF) = w; } }
    }
};
struct EpiSwiglu {
    static constexpr bool PERM = true;
    bf16_t* O; int ldc;
    __device__ __forceinline__ void operator()(const f32x4 (&acc)[2][2][4][2], const Unit& u, int wr, int wc, int fr, int fq) const {
        const int row0 = u.pm * BM + wr * 64 + fr, col0 = u.pn * HALF + wc * 32 + 8 * fq;
#pragma unroll
        for (int ai = 0; ai < 2; ++ai)
#pragma unroll
            for (int m = 0; m < 4; ++m) { bf16_t* rowp = O + (size_t)(row0 + ai * HALF + m * 16) * ldc + col0;
                float o[8];
#pragma unroll
                for (int n = 0; n < 2; ++n)
#pragma unroll
                    for (int j = 0; j < 4; ++j) o[4 * n + j] = siluf_(acc[ai][0][m][n][j]) * acc[ai][1][m][n][j];
                *(u32x4*)rowp = pack8(o); }
    }
};
struct EpiResid {
    static constexpr bool PERM = false;
    const float* baseL; const float* baseC; float* outL; float* outC; const float* modL; const float* modC; float scale; int nlat;
    __device__ __forceinline__ void operator()(const f32x4 (&acc)[2][2][4][2], const Unit& u, int wr, int wc, int fr, int fq) const {
        const bool lat = u.pm < nlat;
        const size_t toff = (size_t)(lat ? u.pm : u.pm - nlat) * BM * D + (size_t)(wr * 64 + fr) * D + u.pn * BM + wc * 32 + 4 * fq;
        const float* base = (lat ? baseL : baseC) + toff;
        float* out = (lat ? outL : outC) + toff;
        const float* mg = (lat ? modL + (size_t)(u.pm >> 3) * NMOD : modC) + u.pn * BM + wc * 32 + 4 * fq;
#pragma unroll
        for (int bj = 0; bj < 2; ++bj)
#pragma unroll
            for (int n = 0; n < 2; ++n) { const f32x4 gv = *(const f32x4*)(mg + bj * HALF + n * 16) * scale;
#pragma unroll
                for (int ai = 0; ai < 2; ++ai)
#pragma unroll
                    for (int m = 0; m < 4; ++m) { const size_t off = (size_t)(ai * HALF + m * 16) * D + bj * HALF + n * 16;
                        const f32x4 bs = *(const f32x4*)(base + off); *(f32x4*)(out + off) = bs + gv * acc[ai][bj][m][n]; } }
    }
};
__device__ __forceinline__ float one_minus_exp(float x) {
    const float ser = -x * (1.0f + x * (0.5f + x * (0.16666667f + x * (0.041666668f + x * (0.0083333338f + x * (0.0013888889f + x * 0.0001984127f))))));
    return x > -0.3f ? ser : 1.0f - __expf(x);
}
struct EpiGate {
    static constexpr bool PERM = true;
    bf16_t* LA; bf16_t* UU;
    __device__ __forceinline__ void operator()(const f32x4 (&acc)[2][2][4][2], const Unit& u, int wr, int wc, int fr, int fq) const {
        const int blk = u.pn >> 1, dir = u.pn & 1, ch0 = blk * HALF + wc * 32 + 8 * fq, row0 = u.pm * BM + wr * 64 + fr;
#pragma unroll
        for (int ai = 0; ai < 2; ++ai)
#pragma unroll
            for (int m = 0; m < 4; ++m) { const size_t off = (size_t)dir * RG * D + (size_t)(row0 + ai * HALF + m * 16) * D + ch0;
#pragma unroll
                for (int bj = 0; bj < 2; ++bj) { const f32x4 v0 = acc[ai][bj][m][0], v1 = acc[ai][bj][m][1];
                    u32x4 w; w.x = cvt_pk_bf16(v0[0], v0[1]); w.y = cvt_pk_bf16(v0[2], v0[3]); w.z = cvt_pk_bf16(v1[0], v1[1]); w.w = cvt_pk_bf16(v1[2], v1[3]);
                    *(u32x4*)((bj ? UU : LA) + off) = w; } }
    }
};
template <bool ACCUM> struct EpiMix {
    static constexpr bool PERM = true;
    const bf16_t* PROJ; int gcol; bf16_t* MG;
    __device__ __forceinline__ void operator()(const f32x4 (&acc)[2][2][4][2], const Unit& u, int wr, int wc, int fr, int fq) const {
        const int row0 = u.pm * BM + wr * 64 + fr, col0 = u.pn * BM + wc * 32 + 8 * fq;
#pragma unroll
        for (int ai = 0; ai < 2; ++ai)
#pragma unroll
            for (int m = 0; m < 4; ++m) { const size_t row = (size_t)(row0 + ai * HALF + m * 16);
#pragma unroll
                for (int bj = 0; bj < 2; ++bj) { float gt[8], o[8]; unpack8(*(const u32x4*)(PROJ + row * PN + gcol + col0 + bj * HALF), gt);
                    bf16_t* dst = MG + row * D + col0 + bj * HALF;
                    if (ACCUM) unpack8(*(const u32x4*)dst, o); else {
#pragma unroll
                        for (int i = 0; i < 8; ++i) o[i] = 0.f; }
#pragma unroll
                    for (int n = 0; n < 2; ++n)
#pragma unroll
                        for (int j = 0; j < 4; ++j) o[4 * n + j] += sigmoidf_(gt[4 * n + j]) * acc[ai][bj][m][n][j];
                    *(u32x4*)dst = pack8(o); } }
    }
};
}

struct Args {
    const float* in[26]; float* out; unsigned char* ws; int lo, hi;
};
enum { I_X = 0, I_C, I_CTX, I_CCTX, I_WADA, I_BADA, I_NORMW, I_F1WI, I_F1WO, I_F2WI, I_F2WO, I_WIN, I_FUP, I_FB, I_GNW, I_CONVW, I_CONVB, I_WR, I_BR, I_WI, I_BI, I_LAM, I_WOG, I_WOL, I_WOO, I_FNW };

#define NTHR 512
__device__ __forceinline__ const float* inp(const LAS unsigned char* lds, int i) { const LAS unsigned* t = (const LAS unsigned*)(lds + PTAB) + 2 * i;
    const unsigned lo = __builtin_amdgcn_readfirstlane(t[0]), hi = __builtin_amdgcn_readfirstlane(t[1]); return (const float*)(((unsigned long long)hi << 32) | lo); }
#define AIN(i) inp(lds, (i))
struct Ctx { int tid, bid, G; };
#define GW() (cx.bid * 8 + (cx.tid >> 6))
#define NGW() (cx.G * 8)

__device__ __forceinline__ void transpose_item(const float* W, int ldw, int K, int k0, int n0, bf16_t* WT, int drow, LAS float* scr, int lane) {
#pragma unroll 8
    for (int i = 0; i < 32; ++i) { const int kk = 2 * i + (lane >> 5); scr[kk * 33 + (lane & 31)] = W[(size_t)(k0 + kk) * ldw + n0 + (lane & 31)]; }
    asm volatile("s_waitcnt lgkmcnt(0)" ::: "memory");
    const int c = lane & 7;
#pragma unroll
    for (int j = 0; j < 4; ++j) { const int n = (lane >> 3) + 8 * j; const LAS float* s = scr + (8 * c) * 33 + n;
        u32x4 o; o.x = cvt_pk_bf16(s[0 * 33], s[1 * 33]); o.y = cvt_pk_bf16(s[2 * 33], s[3 * 33]); o.z = cvt_pk_bf16(s[4 * 33], s[5 * 33]); o.w = cvt_pk_bf16(s[6 * 33], s[7 * 33]);
        *(u32x4*)(WT + (size_t)(drow + n) * K + k0 + 8 * c) = o; }
    asm volatile("s_waitcnt lgkmcnt(0)" ::: "memory");
}
__device__ __forceinline__ int wi_drow(int n0) { return n0 < FH ? (n0 >> 7) * 256 + (n0 & 127) : ((n0 - FH) >> 7) * 256 + 128 + ((n0 - FH) & 127); }
__device__ __forceinline__ int win_drow(int n0) { return n0 < 3072 ? n0 : (n0 == 3072 ? PFD : n0 - 32); }

__device__ __forceinline__ void phase_weights(const Ctx cx, const Args& a, LAS unsigned char* lds) {
    const int lane = cx.tid & 63, wave = cx.tid >> 6;
    LAS float* scr = (LAS float*)(lds + wave * 16384);
    unsigned char* ws = a.ws;
    constexpr int I_WI_ = (D / 64) * (2 * FH / 32), I_WO_ = (FH / 64) * (D / 32), I_IN_ = (D / 64) * (INW / 32), I_SQ_ = (D / 64) * (D / 32), I_LG_ = 32 * 8;
    constexpr int NIT = 2 * I_WI_ + 2 * I_WO_ + I_IN_ + 3 * I_SQ_ + I_LG_;
    if (PHON(19)) for (int it = GW(); it < NIT; it += NGW()) {
        int r = it;
        if (r < 2 * I_WI_) { const int w = r / I_WI_; r %= I_WI_; const int nb = 2 * FH / 32, kb = r / nb, n0 = (r % nb) * 32;
            transpose_item(AIN(w ? I_F2WI : I_F1WI), 2 * FH, D, kb * 64, n0, (bf16_t*)(ws + (w ? WS_WI2 : WS_WI1)), wi_drow(n0), scr, lane); continue; }
        r -= 2 * I_WI_;
        if (r < 2 * I_WO_) { const int w = r / I_WO_; r %= I_WO_; const int nb = D / 32, kb = r / nb, n0 = (r % nb) * 32;
            transpose_item(AIN(w ? I_F2WO : I_F1WO), D, FH, kb * 64, n0, (bf16_t*)(ws + (w ? WS_WO2 : WS_WO1)), n0, scr, lane); continue; }
        r -= 2 * I_WO_;
        if (r < I_IN_) { const int nb = INW / 32, kb = r / nb, n0 = (r % nb) * 32;
            transpose_item(AIN(I_WIN), INW, D, kb * 64, n0, (bf16_t*)(ws + WS_WIN), win_drow(n0), scr, lane); continue; }
        r -= I_IN_;
        if (r < 3 * I_SQ_) { const int w = r / I_SQ_; r %= I_SQ_; const int nb = D / 32, kb = r / nb, n0 = (r % nb) * 32;
            transpose_item(AIN(w == 0 ? I_WOG : (w == 1 ? I_WOL : I_WOO)), D, D, kb * 64, n0, (bf16_t*)(ws + (w == 0 ? WS_WOG : (w == 1 ? WS_WOL : WS_WOO))), n0, scr, lane); continue; }
        r -= 3 * I_SQ_;
        { const int mat = r >> 3, sub = r & 7, gate = mat >> 4, dir = (mat >> 3) & 1, blk = mat & 7;
          const float* src = AIN(gate ? I_WI : I_WR) + (size_t)(dir * 8 + blk) * 128 * 128;
          const int kb = sub >> 2, n0 = (sub & 3) * 32;
          transpose_item(src, 128, 128, kb * 64, n0, (bf16_t*)(ws + WS_WLG), ((blk * 2 + dir) * 2 + gate) * 128 + n0, scr, lane); }
    }
    { u32x4* z = (u32x4*)(ws + WS_WIN + (size_t)INW * D * 2); const int n16 = (PN - INW) * D * 2 / 16;
      for (int i = cx.bid * NTHR + cx.tid; i < n16; i += cx.G * NTHR) z[i] = (u32x4){0u, 0u, 0u, 0u}; }
    __syncthreads();
    LAS float* sl = (LAS float*)lds;
    float* MODP = (float*)(ws + WS_MODP);
    if (PHON(20)) for (int item = cx.bid; item < 18 * 16; item += cx.G) {
        const int cb = item % 18, ks = item / 18, col = cb * 512 + cx.tid;
        for (int idx = cx.tid; idx < 33 * 64; idx += NTHR) { const int b = idx >> 6, k = idx & 63; const float cv = b < 32 ? AIN(I_C)[b * D + ks * 64 + k] : AIN(I_CCTX)[ks * 64 + k]; sl[idx] = siluf_(cv); }
        __syncthreads();
        float acc[33];
#pragma unroll
        for (int b = 0; b < 33; ++b) acc[b] = 0.f;
        const float* wp = AIN(I_WADA) + (size_t)(ks * 64) * NMOD + col;
#pragma unroll 4
        for (int k = 0; k < 64; ++k) { const float w = wp[(size_t)k * NMOD];
#pragma unroll
            for (int b = 0; b < 33; ++b) acc[b] += sl[b * 64 + k] * w; }
#pragma unroll
        for (int b = 0; b < 33; ++b) MODP[(size_t)(ks * 33 + b) * NMOD + col] = acc[b];
        __syncthreads();
    }
}
__device__ __forceinline__ void phase_modreduce(const Ctx cx, const Args& a, LAS unsigned char* lds) {
    const float* MODP = (const float*)(a.ws + WS_MODP); float* MOD = (float*)(a.ws + WS_MOD);
    for (int idx = cx.bid * NTHR + cx.tid; idx < 33 * NMOD; idx += cx.G * NTHR) {
        float s = AIN(I_BADA)[idx % NMOD];
#pragma unroll
        for (int ks = 0; ks < 16; ++ks) s += MODP[(size_t)ks * 33 * NMOD + idx];
        MOD[idx] = s;
    }
    float* GC = (float*)(a.ws + WS_GC);
    for (int idx = cx.bid * NTHR + cx.tid; idx < 2 * D; idx += cx.G * NTHR) { GC[idx] = AIN(I_BR)[idx]; GC[2 * D + idx] = AIN(I_BI)[idx]; GC[4 * D + idx] = 8.0f * log1pf(__expf(-AIN(I_LAM)[idx])); }
}

__device__ __forceinline__ void phase_normmod(const Ctx cx, const Args& a, LAS unsigned char* lds, const float* srcL, const float* srcC, int nL, int nrows, int mod_b0, int sub) {
    const int lane = cx.tid & 63;
    const float* MOD = (const float*)(a.ws + WS_MOD); const float* nw = AIN(I_NORMW) + sub * D;
    bf16_t* U = (bf16_t*)(a.ws + WS_U);
    for (int r0 = 2 * GW(); r0 < nrows; r0 += 2 * NGW()) {
        f32x4 v[2][4]; float ss[2];
#pragma unroll
        for (int q = 0; q < 2; ++q) { const int r = r0 + q;
            const float* src = r < nL ? srcL + (size_t)r * D : srcC + (size_t)(r - nL) * D;
            ss[q] = 0.f;
#pragma unroll
            for (int j = 0; j < 4; ++j) { v[q][j] = ((const f32x4*)src)[lane + 64 * j]; } }
#pragma unroll
        for (int q = 0; q < 2; ++q)
#pragma unroll
            for (int j = 0; j < 4; ++j) ss[q] += (v[q][j].x * v[q][j].x + v[q][j].y * v[q][j].y) + (v[q][j].z * v[q][j].z + v[q][j].w * v[q][j].w);
#pragma unroll
        for (int o = 1; o < 64; o <<= 1) { ss[0] += __shfl_xor(ss[0], o); ss[1] += __shfl_xor(ss[1], o); }
#pragma unroll
        for (int q = 0; q < 2; ++q) { const int r = r0 + q; const int mrow = r < nL ? mod_b0 + r / T : 32;
            const float* sh = MOD + (size_t)mrow * NMOD + (3 * sub) * D; const float* sc = sh + D;
            const float rstd = 1.0f / sqrtf(ss[q] * (1.0f / D) + EPS);
#pragma unroll
            for (int j = 0; j < 4; ++j) { const int c4 = lane + 64 * j; const f32x4 w = ((const f32x4*)nw)[c4], s4 = ((const f32x4*)sh)[c4], c1 = ((const f32x4*)sc)[c4];
                const f32x4 o = v[q][j] * rstd * w * (c1 + 1.0f) + s4;
                u32x2 p; p.x = cvt_pk_bf16(o.x, o.y); p.y = cvt_pk_bf16(o.z, o.w); ((u32x2*)(U + (size_t)r * D))[c4] = p; } }
    }
}
__device__ __forceinline__ void phase_final(const Ctx cx, const Args& a, LAS unsigned char* lds, int g) {
    const int lane = cx.tid & 63; const float* fw = AIN(I_FNW);
    for (int r0 = 2 * GW(); r0 < RL; r0 += 2 * NGW()) {
        float* row = a.out + ((size_t)g * RL + r0) * D;
        f32x4 v[2][4]; float ss[2] = {0.f, 0.f};
#pragma unroll
        for (int q = 0; q < 2; ++q)
#pragma unroll
            for (int j = 0; j < 4; ++j) v[q][j] = ((const f32x4*)(row + q * D))[lane + 64 * j];
#pragma unroll
        for (int q = 0; q < 2; ++q)
#pragma unroll
            for (int j = 0; j < 4; ++j) ss[q] += (v[q][j].x * v[q][j].x + v[q][j].y * v[q][j].y) + (v[q][j].z * v[q][j].z + v[q][j].w * v[q][j].w);
#pragma unroll
        for (int o = 1; o < 64; o <<= 1) { ss[0] += __shfl_xor(ss[0], o); ss[1] += __shfl_xor(ss[1], o); }
#pragma unroll
        for (int q = 0; q < 2; ++q) { const float rstd = 1.0f / sqrtf(ss[q] * (1.0f / D) + EPS);
#pragma unroll
            for (int j = 0; j < 4; ++j) { const int c4 = lane + 64 * j; ((f32x4*)(row + q * D))[c4] = v[q][j] * rstd * ((const f32x4*)fw)[c4]; } }
    }
}

__device__ __forceinline__ float logsig_fast(float x) { return fminf(x, 0.f) - __logf(1.0f + __expf(-fabsf(x))); }
__device__ __forceinline__ void phase_prep(const Ctx cx, const Args& a, int g, LAS unsigned char* lds) {
    const bf16_t* PROJ = (const bf16_t*)(a.ws + WS_BIG);
    const int tid = cx.tid;
    {
        LAS bf16_t* qs = (LAS bf16_t*)lds; LAS bf16_t* ks = (LAS bf16_t*)(lds + 16384); LAS float* fdl = (LAS float*)(lds + 32768); LAS float* part = (LAS float*)(lds + 36864);
        LAS bf16_t* qo = (LAS bf16_t*)(lds + 40960); LAS bf16_t* ko = (LAS bf16_t*)(lds + 57344);
        const int d = tid & 127, qt = tid >> 7;
        for (int item = cx.bid; item < BG * NCH * 8; item += cx.G) {
            const int h = item & 3, dir = (item >> 2) & 1, bc = item >> 3, b = bc / NCH, c = bc % NCH;
            const int row0 = c < 4 ? RL + b * CL + c * 64 : b * T + (c - 4) * 64;
            const bool lat = c >= 4;
#pragma unroll
            for (int k = 0; k < 2; ++k) { const int p = tid + 512 * k, r = p >> 4, c8 = (p & 15) * 8;
                *(LAS u32x4*)(ks + r * 128 + c8) = *(const u32x4*)(PROJ + (size_t)(row0 + r) * PN + PK + h * 128 + c8);
                if (lat) *(LAS u32x4*)(qs + r * 128 + c8) = *(const u32x4*)(PROJ + (size_t)(row0 + r) * PN + PQ + h * 128 + c8); }
#pragma unroll
            for (int k = 0; k < 2; ++k) { const int idx = tid + 512 * k; fdl[idx] = bf2f(PROJ[(size_t)(row0 + (idx >> 4)) * PN + PFD + dir * 16 + (idx & 15)]); }
            const int col = h * 128 + d;
            float fw[16];
#pragma unroll
            for (int r = 0; r < 16; ++r) fw[r] = AIN(I_FUP)[(size_t)(dir * 16 + r) * 512 + col];
            const float fbv = AIN(I_FB)[dir * 512 + col];
            __syncthreads();
            float la[16]; float psum = 0.f;
#pragma unroll
            for (int t = 0; t < 16; ++t) { const int i = 16 * qt + t; float dot = fbv;
#pragma unroll
                for (int r = 0; r < 16; ++r) dot += fdl[i * 16 + r] * fw[r];
                la[t] = logsig_fast(dot) * (1.0f / 16.0f); psum += la[t]; }
            part[qt * 128 + d] = psum;
            __syncthreads();
            const float p0 = part[d], p1 = part[128 + d], p2 = part[256 + d], p3 = part[384 + d];
            const float tot = (p0 + p1) + (p2 + p3);
            float run = dir == 0 ? (qt > 0 ? p0 : 0.f) + (qt > 1 ? p1 : 0.f) + (qt > 2 ? p2 : 0.f)
                                 : (qt < 3 ? p3 : 0.f) + (qt < 2 ? p2 : 0.f) + (qt < 1 ? p1 : 0.f);
            float ke[16];
            if (dir == 0) {
#pragma unroll
                for (int t = 0; t < 16; ++t) { const int i = 16 * qt + t; run += la[t];
                    const float kv = bf2f(ks[i * 128 + d]); ke[t] = kv * __expf(tot - run);
                    if (lat) { qo[i * 128 + d] = f2bf(bf2f(qs[i * 128 + d]) * 0.08838834764831845f * __expf(run)); ko[i * 128 + d] = f2bf(kv * __expf(-run)); } }
            } else {
#pragma unroll
                for (int t = 15; t >= 0; --t) { const int i = 16 * qt + t; run += la[t];
                    const float kv = bf2f(ks[i * 128 + d]); ke[t] = kv * __expf(tot - run);
                    if (lat) { qo[i * 128 + d] = f2bf(bf2f(qs[i * 128 + d]) * 0.08838834764831845f * __expf(run)); ko[i * 128 + d] = f2bf(kv * __expf(-run)); } }
            }
            const size_t tb = (((size_t)dir * BG + b) * NCH + c) * 4 + h;
            bf16_t* KET = (bf16_t*)(a.ws + WS_KET) + tb * 8192 + d * 64 + 16 * qt;
            { float k0[8], k1[8];
#pragma unroll
              for (int t = 0; t < 8; ++t) { k0[t] = ke[t]; k1[t] = ke[8 + t]; }
              *(u32x4*)KET = pack8(k0); *(u32x4*)(KET + 8) = pack8(k1); }
            if (qt == 0) ((float*)(a.ws + WS_BL))[tb * 128 + d] = tot;
            __syncthreads();
            if (lat) { bf16_t* QD = (bf16_t*)(a.ws + WS_QD) + tb * 8192; bf16_t* KI = (bf16_t*)(a.ws + WS_KI) + tb * 8192;
#pragma unroll
                for (int k = 0; k < 2; ++k) { const int p = tid + 512 * k; *(u32x4*)(QD + p * 8) = *(const LAS u32x4*)(qo + p * 8); *(u32x4*)(KI + p * 8) = *(const LAS u32x4*)(ko + p * 8); } }
            __syncthreads();
        }
    }
    {
        LAS bf16_t* vs = (LAS bf16_t*)lds;
        const int e = tid & 255, jh = tid >> 8;
        for (int item = cx.bid; item < BG * NCH * 4; item += cx.G) {
            const int h = item & 3, bc = item >> 2, b = bc / NCH, c = bc % NCH;
            const int row0 = c < 4 ? RL + b * CL + c * 64 : b * T + (c - 4) * 64;
#pragma unroll
            for (int k = 0; k < 4; ++k) { const int p = tid + 512 * k, r = p >> 5, c8 = (p & 31) * 8;
                *(LAS u32x4*)(vs + r * 256 + c8) = *(const u32x4*)(PROJ + (size_t)(row0 + r) * PN + PV + h * 256 + c8); }
            __syncthreads();
            bf16_t* VT = (bf16_t*)(a.ws + WS_VT) + ((((size_t)b * NCH + c) * 4 + h) * 256 + e) * 64 + 32 * jh;
#pragma unroll
            for (int jg = 0; jg < 4; ++jg) { float v[8];
#pragma unroll
                for (int jj = 0; jj < 8; ++jj) v[jj] = bf2f(vs[(32 * jh + 8 * jg + jj) * 256 + e]);
                *(u32x4*)(VT + 8 * jg) = pack8(v); }
            __syncthreads();
        }
    }
    bf16_t* XC = (bf16_t*)(a.ws + WS_XC);
    const float* cvb = AIN(I_CONVB); const float* cvw = AIN(I_CONVW);
    for (int idx0 = cx.bid * NTHR + cx.tid; idx0 < RG * 128; idx0 += 4 * cx.G * NTHR) {
        u32x4 xw[4][4];
#pragma unroll
        for (int q = 0; q < 4; ++q) { const int idx = idx0 + q * cx.G * NTHR; const int row = idx >> 7, c8 = (idx & 127) * 8;
            const int pos = row < RL ? (row & 63) : ((row - RL) & 255), len = row < RL ? 64 : 256;
#pragma unroll
            for (int j = 0; j < 4; ++j) { const int p = pos + j - 2; xw[q][j] = (u32x4){0u, 0u, 0u, 0u};
                if (idx < RG * 128 && p >= 0 && p < len) xw[q][j] = *(const u32x4*)(PROJ + (size_t)(row + j - 2) * PN + PXL + c8); } }
#pragma unroll
        for (int q = 0; q < 4; ++q) { const int idx = idx0 + q * cx.G * NTHR; const int row = idx >> 7, c8 = (idx & 127) * 8;
            if (idx < RG * 128) { float acc[8];
#pragma unroll
                for (int i = 0; i < 8; ++i) acc[i] = cvb[c8 + i];
#pragma unroll
                for (int j = 0; j < 4; ++j) { float xv[8]; unpack8(xw[q][j], xv);
#pragma unroll
                    for (int i = 0; i < 8; ++i) acc[i] += cvw[j * D + c8 + i] * xv[i]; }
                *(u32x4*)(XC + (size_t)row * D + c8) = pack8(acc); } }
    }
}

__device__ __forceinline__ void phase_gatefix(const Ctx cx, const Args& a, LAS unsigned char* lds) {
    bf16_t* LA = (bf16_t*)(a.ws + WS_LA); bf16_t* UU = (bf16_t*)(a.ws + WS_UU); const bf16_t* XC = (const bf16_t*)(a.ws + WS_XC); const float* GC = (const float*)(a.ws + WS_GC);
    for (int idx = cx.bid * NTHR + cx.tid; idx < 2 * RG * 128; idx += cx.G * NTHR) {
        const int dir = idx >= RG * 128, rem = idx - dir * RG * 128, row = rem >> 7, c8 = (rem & 127) * 8;
        const size_t off = (size_t)dir * RG * D + (size_t)row * D + c8;
        float r[8], ig[8], xc[8]; unpack8(*(const u32x4*)(LA + off), r); unpack8(*(const u32x4*)(UU + off), ig); unpack8(*(const u32x4*)(XC + (size_t)row * D + c8), xc);
#pragma unroll
        for (int i = 0; i < 8; ++i) { const float l = -GC[(4 + dir) * D + c8 + i] * sigmoidf_(r[i] + GC[dir * D + c8 + i]);
            const float gi = sigmoidf_(ig[i] + GC[(2 + dir) * D + c8 + i]);
            r[i] = l; ig[i] = __builtin_amdgcn_sqrtf(fmaxf(one_minus_exp(2.0f * l), 0.f)) * gi * xc[i]; }
        *(u32x4*)(LA + off) = pack8(r); *(u32x4*)(UU + off) = pack8(ig);
    }
}

__device__ __forceinline__ int img_off(int nkg, int row, int kcol) { const int ob = (row & 15) * 64 + (kcol & 31) * 2; return ((row >> 4) * nkg + (kcol >> 5)) * 1024 + (ob ^ (((ob >> 9) & 1) << 5)); }
__device__ __forceinline__ bf16x8 ldfrag(const LAS unsigned char* img, int nkg, int row, int kcol) { return *(const LAS bf16x8*)(img + img_off(nkg, row, kcol)); }
#define MFMA16(a, b, c) __builtin_amdgcn_mfma_f32_16x16x32_bf16((a), (b), (c), 0, 0, 0)

__device__ __forceinline__ void phase_gla_scan(const Ctx cx, const Args& a, int g, LAS unsigned char* lds) {
    constexpr int XB = 57344, OFF_KI = 16384, OFF_KET = 32768, OFF_VT = 49152, OFF_P = 2 * XB, OFF_ST = OFF_P + 8192, OFF_BL = OFF_ST + 2 * 16384;
    static_assert(OFF_BL + 1024 <= LDS_BYTES, "gla scan LDS");
    const int tid = cx.tid, lane = tid & 63, w = tid >> 6, fr = lane & 15, fq = lane >> 4;
    const bf16_t* QDg = (const bf16_t*)(a.ws + WS_QD); const bf16_t* KIg = (const bf16_t*)(a.ws + WS_KI); const bf16_t* KETg = (const bf16_t*)(a.ws + WS_KET);
    const bf16_t* VTg = (const bf16_t*)(a.ws + WS_VT); const float* BLg = (const float*)(a.ws + WS_BL);
    bf16_t* Og = (bf16_t*)(a.ws + WS_OFB);
    for (int item = cx.bid; item < BG * 32; item += cx.G) {
        const int dvq = item & 3, dir = (item >> 2) & 1, h = (item >> 3) & 3, b = item >> 5;
        { u32x4 z = {0u, 0u, 0u, 0u}; *(LAS u32x4*)(lds + OFF_ST + tid * 32) = z; *(LAS u32x4*)(lds + OFF_ST + tid * 32 + 16) = z; }
        f32x4 accS[4];
#pragma unroll
        for (int t = 0; t < 4; ++t) accS[t] = (f32x4){0.f, 0.f, 0.f, 0.f};
        u32x4 pq[2], pk[2], pe[2], pv; float pbl = 0.f;
#define GLA_LOAD(s_) do { const int c_ = dir == 0 ? (s_) : ((s_) < 4 ? 3 - (s_) : 39 - (s_)); \
            const size_t tb_ = (((size_t)dir * BG + b) * NCH + c_) * 4 + h; \
            if (c_ >= 4) { pq[0] = ((const u32x4*)(QDg + tb_ * 8192))[tid]; pq[1] = ((const u32x4*)(QDg + tb_ * 8192))[tid + 512]; \
                           pk[0] = ((const u32x4*)(KIg + tb_ * 8192))[tid]; pk[1] = ((const u32x4*)(KIg + tb_ * 8192))[tid + 512]; } \
            pe[0] = ((const u32x4*)(KETg + tb_ * 8192))[tid]; pe[1] = ((const u32x4*)(KETg + tb_ * 8192))[tid + 512]; \
            pv = ((const u32x4*)(VTg + ((((size_t)b * NCH + c_) * 4 + h) * 256 + dvq * 64) * 64))[tid]; \
            if (tid < 128) pbl = BLg[tb_ * 128 + tid]; } while (0)
#define GLA_STORE(buf_) do { LAS unsigned char* X_ = lds + (buf_) * XB; \
            _Pragma("unroll") for (int i_ = 0; i_ < 2; ++i_) { const int p_ = tid + 512 * i_; \
                *(LAS u32x4*)(X_ + img_off(4, p_ >> 4, (p_ & 15) * 8)) = pq[i_]; *(LAS u32x4*)(X_ + OFF_KI + img_off(4, p_ >> 4, (p_ & 15) * 8)) = pk[i_]; \
                *(LAS u32x4*)(X_ + OFF_KET + img_off(2, p_ >> 3, (p_ & 7) * 8)) = pe[i_]; } \
            *(LAS u32x4*)(X_ + OFF_VT + img_off(2, tid >> 3, (tid & 7) * 8)) = pv; \
            if (tid < 128) ((LAS float*)(lds + OFF_BL + (buf_) * 512))[tid] = pbl; } while (0)
        pq[0] = pq[1] = pk[0] = pk[1] = (u32x4){0u, 0u, 0u, 0u};
        GLA_LOAD(0); GLA_STORE(0);
        __syncthreads();
        for (int s = 0; s < NCH; ++s) {
            const int cur = s & 1; const bool lat = s >= 4;
            const LAS unsigned char* X = lds + cur * XB;
#ifndef GLA_SAFE
            if (s + 1 < NCH) GLA_LOAD(s + 1);
#endif
            if (lat) {
                const int ti = w >> 1, tj0 = (w & 1) * 2;
                f32x4 sc[2] = {(f32x4){0.f, 0.f, 0.f, 0.f}, (f32x4){0.f, 0.f, 0.f, 0.f}};
#pragma unroll
                for (int kk = 0; kk < 4; ++kk) { const bf16x8 qa = ldfrag(X, 4, 16 * ti + fr, kk * 32 + fq * 8);
#pragma unroll
                    for (int t = 0; t < 2; ++t) { const bf16x8 kb = ldfrag(X + OFF_KI, 4, 16 * (tj0 + t) + fr, kk * 32 + fq * 8); sc[t] = MFMA16(qa, kb, sc[t]); } }
#pragma unroll
                for (int t = 0; t < 2; ++t)
#pragma unroll
                    for (int jj = 0; jj < 4; ++jj) { const int i = 16 * ti + 4 * fq + jj, j = 16 * (tj0 + t) + fr;
                        const bool keep = dir == 0 ? (j <= i) : (j > i);
                        *(LAS bf16_t*)(lds + OFF_P + img_off(2, i, j)) = f2bf(keep ? sc[t][jj] : 0.f); }
            }
            __syncthreads();
            const int te = w >> 1;
            if (lat) {
                const int c = dir == 0 ? s : 39 - s;
                const LAS unsigned char* STc = lds + OFF_ST + cur * 16384;
                f32x4 oc[2] = {(f32x4){0.f, 0.f, 0.f, 0.f}, (f32x4){0.f, 0.f, 0.f, 0.f}};
#pragma unroll
                for (int kk = 0; kk < 2; ++kk) { const bf16x8 va = ldfrag(X + OFF_VT, 2, 16 * te + fr, kk * 32 + fq * 8);
#pragma unroll
                    for (int t = 0; t < 2; ++t) { const bf16x8 pb = ldfrag(lds + OFF_P, 2, 16 * ((w & 1) * 2 + t) + fr, kk * 32 + fq * 8); oc[t] = MFMA16(va, pb, oc[t]); } }
#pragma unroll
                for (int kk = 0; kk < 4; ++kk) { const bf16x8 sa = ldfrag(STc, 4, 16 * te + fr, kk * 32 + fq * 8);
#pragma unroll
                    for (int t = 0; t < 2; ++t) { const bf16x8 qb = ldfrag(X, 4, 16 * ((w & 1) * 2 + t) + fr, kk * 32 + fq * 8); oc[t] = MFMA16(sa, qb, oc[t]); } }
#pragma unroll
                for (int t = 0; t < 2; ++t) { const int i = 16 * ((w & 1) * 2 + t) + fr; const size_t row = (size_t)b * T + (size_t)(c - 4) * 64 + i;
                    u32x2 o2; o2.x = cvt_pk_bf16(oc[t][0], oc[t][1]); o2.y = cvt_pk_bf16(oc[t][2], oc[t][3]);
                    *(u32x2*)(Og + ((size_t)dir * RL + row) * D + h * 256 + dvq * 64 + 16 * te + 4 * fq) = o2; }
            }
#ifdef GLA_SAFE
            __syncthreads();
#endif
            {
                const LAS float* blp = (const LAS float*)(lds + OFF_BL + cur * 512);
                LAS unsigned char* STn = lds + OFF_ST + (cur ^ 1) * 16384;
                bf16x8 vb[2];
#pragma unroll
                for (int kk = 0; kk < 2; ++kk) vb[kk] = ldfrag(X + OFF_VT, 2, 16 * te + fr, kk * 32 + fq * 8);
#pragma unroll
                for (int t = 0; t < 4; ++t) { const int td = (w & 1) * 4 + t;
#pragma unroll
                    for (int jj = 0; jj < 4; ++jj) accS[t][jj] *= __expf(blp[16 * td + 4 * fq + jj]);
#pragma unroll
                    for (int kk = 0; kk < 2; ++kk) { const bf16x8 ka = ldfrag(X + OFF_KET, 2, 16 * td + fr, kk * 32 + fq * 8); accS[t] = MFMA16(ka, vb[kk], accS[t]); }
                    u32x2 s2; s2.x = cvt_pk_bf16(accS[t][0], accS[t][1]); s2.y = cvt_pk_bf16(accS[t][2], accS[t][3]);
                    *(LAS u32x2*)(STn + img_off(4, 16 * te + fr, 16 * td + 4 * fq)) = s2; }
            }
#ifdef GLA_SAFE
            __syncthreads();
            if (s + 1 < NCH) { GLA_LOAD(s + 1); GLA_STORE(cur ^ 1); }
#else
            if (s + 1 < NCH) GLA_STORE(cur ^ 1);
#endif
            __syncthreads();
        }
#undef GLA_LOAD
#undef GLA_STORE
    }
}

__device__ __forceinline__ void phase_lru_scan(const Ctx cx, const Args& a, int g, LAS unsigned char* lds) {
    const int lane = cx.tid & 63, w = cx.tid >> 6;
    LAS f32x2* agg = (LAS f32x2*)lds;
    const float* GC = (const float*)(a.ws + WS_GC);
    for (int item = cx.bid; item < BG * 32; item += cx.G) {
        const int cgp = item & 15, dir = (item >> 4) & 1, b = item >> 5, ch = cgp * 64 + lane;
        const bf16_t* RR = (const bf16_t*)(a.ws + WS_LA) + (size_t)dir * RG * D + ch; const bf16_t* II = (const bf16_t*)(a.ws + WS_UU) + (size_t)dir * RG * D + ch;
        const bf16_t* XCp = (const bf16_t*)(a.ws + WS_XC) + ch;
        bf16_t* Hd = (bf16_t*)(a.ws + WS_HFB) + (size_t)dir * RL * D + ch;
        const float cbr = GC[dir * D + ch], cbi = GC[(2 + dir) * D + ch], csp = GC[(4 + dir) * D + ch];
#define LRU_ROW(s_) ((s_) < CL ? RL + b * CL + (dir ? CL - 1 - (s_) : (s_)) : b * T + (dir ? T - 1 - ((s_) - CL) : (s_) - CL))
#define LRU_GATES(k_) const float l_ = -csp * sigmoidf_(bf2f(rr[k_]) + cbr); const float av = __expf(l_); \
            const float uv = __builtin_amdgcn_sqrtf(fmaxf(one_minus_exp(2.0f * l_), 0.f)) * sigmoidf_(bf2f(ii[k_]) + cbi) * bf2f(xx[k_]);
        LAS unsigned* LB = (LAS unsigned*)(lds + 4096) + lane;
        float hsc = 0.f;
        for (int sc = 0; sc < 4; ++sc) {
            const int sbase = 576 * sc + 72 * w;
            float A = 1.f, Z = 0.f;
            for (int blk = 0; blk < 3; ++blk) { const int s0 = sbase + 24 * blk; bf16_t rr[24], ii[24], xx[24];
#pragma unroll
                for (int k = 0; k < 24; ++k) { const size_t r = (size_t)LRU_ROW(s0 + k); rr[k] = RR[r * D]; ii[k] = II[r * D]; xx[k] = XCp[r * D]; }
#pragma unroll
                for (int k = 0; k < 24; ++k) { const float l_ = -csp * sigmoidf_(bf2f(rr[k]) + cbr);
                    const float u_ = __builtin_amdgcn_sqrtf(fmaxf(one_minus_exp(2.0f * l_), 0.f)) * sigmoidf_(bf2f(ii[k]) + cbi) * bf2f(xx[k]);
                    const unsigned pk = cvt_pk_bf16(l_, u_);
                    LB[(72 * w + 24 * blk + k) * 64] = pk;
                    const float av = __expf(bflo(pk)); Z = av * Z + bfhi(pk); A *= av; } }
            agg[w * 64 + lane] = (f32x2){A, Z};
            __syncthreads();
            float hst = hsc, hn = hsc;
#pragma unroll
            for (int w2 = 0; w2 < 8; ++w2) { const f32x2 p = agg[w2 * 64 + lane]; if (w2 < w) hst = p.x * hst + p.y; hn = p.x * hn + p.y; }
            for (int k = 0; k < 72; ++k) { const unsigned pk = LB[(72 * w + k) * 64]; hst = __expf(bflo(pk)) * hst + bfhi(pk);
                if (sbase + k >= CL) Hd[(size_t)LRU_ROW(sbase + k) * D] = f2bf(hst); }
            hsc = hn;
            __syncthreads();
        }
#undef LRU_ROW
#undef LRU_GATES
    }
}

__device__ __forceinline__ void phase_post(const Ctx cx, const Args& a, LAS unsigned char* lds, int g) {
    const int lane = cx.tid & 63;
    const bf16_t* PROJ = (const bf16_t*)(a.ws + WS_BIG);
    bf16_t* O0 = (bf16_t*)(a.ws + WS_OFB); const bf16_t* O1 = O0 + (size_t)RL * D;
    bf16_t* H0 = (bf16_t*)(a.ws + WS_HFB); const bf16_t* H1b = H0 + (size_t)RL * D;
    const float* gnw = AIN(I_GNW);
    for (int r = GW(); r < RL; r += NGW()) {
        const size_t off = (size_t)r * D + lane * 16;
        float o[16], t[8]; float ss = 0.f;
#pragma unroll
        for (int hf = 0; hf < 2; ++hf) { float x0[8], x1[8]; unpack8(*(const u32x4*)(O0 + off + 8 * hf), x0); unpack8(*(const u32x4*)(O1 + off + 8 * hf), x1);
#pragma unroll
            for (int i = 0; i < 8; ++i) { o[8 * hf + i] = x0[i] + x1[i]; ss += o[8 * hf + i] * o[8 * hf + i]; } }
        ss += __shfl_xor(ss, 1); ss += __shfl_xor(ss, 2); ss += __shfl_xor(ss, 4); ss += __shfl_xor(ss, 8);
        const float rstd = 1.0f / sqrtf(ss * (1.0f / 256.0f) + EPS);
#pragma unroll
        for (int hf = 0; hf < 2; ++hf) { float gg[8]; unpack8(*(const u32x4*)(PROJ + (size_t)r * PN + PGG + lane * 16 + 8 * hf), gg);
#pragma unroll
            for (int i = 0; i < 8; ++i) t[i] = o[8 * hf + i] * rstd * gnw[(lane & 15) * 16 + 8 * hf + i] * siluf_(gg[i]);
            *(u32x4*)(O0 + off + 8 * hf) = pack8(t); }
#pragma unroll
        for (int hf = 0; hf < 2; ++hf) { float x0[8], x1[8], yl[8]; unpack8(*(const u32x4*)(H0 + off + 8 * hf), x0); unpack8(*(const u32x4*)(H1b + off + 8 * hf), x1);
            unpack8(*(const u32x4*)(PROJ + (size_t)r * PN + PYL + lane * 16 + 8 * hf), yl);
#pragma unroll
            for (int i = 0; i < 8; ++i) t[i] = (x0[i] + x1[i]) * geluf_(yl[i]);
            *(u32x4*)(H0 + off + 8 * hf) = pack8(t); }
    }
}


#define XB_TMO      128
#define XB_XCNT(j)  (256  + 64 * (j))
#define XB_XSUB(j)  (1280 + 64 * (j))
#define XB_XGEN(j)  (2304 + 64 * (j))
#define XB_TOP      3328
#define XB_TOPGEN   3392
#define XCD_BAR_WORDS 3456
#define XB_SPIN_CAP (1u << 22)
__device__ __forceinline__ unsigned xb_ld(unsigned* p)              { return __hip_atomic_load(p, __ATOMIC_RELAXED, __HIP_MEMORY_SCOPE_AGENT); }
__device__ __forceinline__ unsigned xb_add(unsigned* p, unsigned v) { return __hip_atomic_fetch_add(p, v, __ATOMIC_RELAXED, __HIP_MEMORY_SCOPE_AGENT); }
__device__ __forceinline__ unsigned xb_xcc_id() { return (unsigned)__builtin_amdgcn_s_getreg((3 << 11) | 20) & 0xFu; }
#define XB_SPIN(cond, bar) do { unsigned _sp = 0; while (cond) { __builtin_amdgcn_s_sleep(1); \
    if ((++_sp & 255u) == 0u) { if (xb_ld(&(bar)[XB_TMO])) break; if (_sp > XB_SPIN_CAP) { atomicAdd(&(bar)[XB_TMO], 1u); break; } } } } while (0)
__device__ __forceinline__ void xcd_barrier_complete(unsigned* bar, unsigned x, unsigned G, unsigned& nloc, unsigned& nx) {
    unsigned sum, cnt, mine, sp = 0u;
    for (;;) {
        sum = 0u; cnt = 0u; mine = 0u;
#pragma unroll
        for (unsigned j = 0; j < 16; ++j) { const unsigned c = xb_ld(&bar[XB_XCNT(j)]); sum += c; cnt += (c > 0u) ? 1u : 0u; mine = (j == x) ? c : mine; }
        if (sum == G) break;
        __builtin_amdgcn_s_sleep(1);
        if ((++sp & 255u) == 0u) { if (xb_ld(&bar[XB_TMO])) break; if (sp > XB_SPIN_CAP) { atomicAdd(&bar[XB_TMO], 1u); break; } }
    }
    nloc = mine > 0u ? mine : 1u; nx = cnt > 0u ? cnt : 1u;
}
__device__ __forceinline__ void xcd_barrier(unsigned* bar, volatile LAS unsigned* st, int tid, unsigned G) {
    asm volatile("s_waitcnt vmcnt(0)" ::: "memory");
    __syncthreads();
    if (tid == 0) {
        __builtin_amdgcn_s_waitcnt(0);
        const unsigned x = xb_xcc_id();
        unsigned nloc = st[0], nx = st[1];
        if (nloc == 0u) { xcd_barrier_complete(bar, x, G, nloc, nx); st[0] = nloc; st[1] = nx; }
        const unsigned old = xb_add(&bar[XB_XSUB(x)], 1u);
        const unsigned gen = old / nloc;
        if (old + 1u == (gen + 1u) * nloc) {
            __builtin_amdgcn_fence(__ATOMIC_RELEASE, "agent");
            asm volatile("s_waitcnt vmcnt(0)" ::: "memory");
            const unsigned og = xb_add(&bar[XB_TOP], 1u);
            const unsigned tg = og / nx;
            if (og + 1u == (tg + 1u) * nx) xb_add(&bar[XB_TOPGEN], 1u);
            else XB_SPIN(xb_ld(&bar[XB_TOPGEN]) == tg, bar);
            __builtin_amdgcn_fence(__ATOMIC_ACQUIRE, "agent");
            xb_add(&bar[XB_XGEN(x)], 1u);
            asm volatile("s_waitcnt vmcnt(0)" ::: "memory");
        } else {
            XB_SPIN(xb_ld(&bar[XB_XGEN(x)]) == gen, bar);
            __builtin_amdgcn_fence(__ATOMIC_ACQUIRE, "agent");
            asm volatile("s_waitcnt vmcnt(0)" ::: "memory");
        }
    }
    __syncthreads();
}

constexpr int NPH = 17;
#ifndef USE_CG_ALL
#define USE_CG_ALL 0
#endif
#if ONE_LAUNCH
#define GRID_SYNC(k) do { if ((k) == 1 || USE_CG_ALL) cg::this_grid().sync(); else xcd_barrier((unsigned*)ws + 4096, (volatile LAS unsigned*)(lds + PTAB + 256), cx.tid, (unsigned)cx.G); } while (0)
#else
#define GRID_SYNC(k) do {} while (0)
#endif
#define STEP_BEGIN(k) if (a.lo <= (k) && (k) < a.hi) { \
        Ctx cx; { int t_ = wave_s * 64 + (int)__builtin_amdgcn_mbcnt_hi(~0u, __builtin_amdgcn_mbcnt_lo(~0u, 0u)), b_ = blockIdx.x, g_ = gridDim.x; asm volatile("" : "+v"(t_)); asm volatile("" : "+s"(b_), "+s"(g_)); cx.tid = t_; cx.bid = b_; cx.G = g_; } \
        const int G = cx.G, cidx = cx.bid; (void)G; (void)cidx; \
        unsigned char* ws = a.ws; asm volatile("" : "+s"(ws)); \
        if ((k) > a.lo) GRID_SYNC(k); \
        const float* MOD = (const float*)(ws + WS_MOD); float* H1 = (float*)(ws + WS_H1); bf16_t* U = (bf16_t*)(ws + WS_U); bf16_t* BIG = (bf16_t*)(ws + WS_BIG); bf16_t* XC = (bf16_t*)(ws + WS_XC); \
        (void)MOD; (void)H1; (void)U; (void)BIG; (void)XC; pg8::StaticOrder S; (void)S;
#define STEP_BEGIN_NS(k) if (a.lo <= (k) && (k) < a.hi) { \
        Ctx cx; { int t_ = wave_s * 64 + (int)__builtin_amdgcn_mbcnt_hi(~0u, __builtin_amdgcn_mbcnt_lo(~0u, 0u)), b_ = blockIdx.x, g_ = gridDim.x; asm volatile("" : "+v"(t_)); asm volatile("" : "+s"(b_), "+s"(g_)); cx.tid = t_; cx.bid = b_; cx.G = g_; } \
        const int G = cx.G, cidx = cx.bid; (void)G; (void)cidx; \
        unsigned char* ws = a.ws; asm volatile("" : "+s"(ws)); \
        asm volatile("s_waitcnt vmcnt(0)" ::: "memory"); __syncthreads(); \
        const float* MOD = (const float*)(ws + WS_MOD); float* H1 = (float*)(ws + WS_H1); bf16_t* U = (bf16_t*)(ws + WS_U); bf16_t* BIG = (bf16_t*)(ws + WS_BIG); bf16_t* XC = (bf16_t*)(ws + WS_XC); \
        (void)MOD; (void)H1; (void)U; (void)BIG; (void)XC; pg8::StaticOrder S; (void)S;
#define STEP_END }

template <int g>
__device__ __forceinline__ void run_group(const Args& a, LAS unsigned char* lds, const int wave_s) {
    constexpr int s0 = 5 + g * NPH;
    const float* H1r = (const float*)(a.ws + WS_H1); const float* H1Cr = (const float*)(a.ws + WS_H1C) + (size_t)g * RC * D;
    if (g == 0) { STEP_BEGIN(s0 + 0) if (PHON(0)) phase_normmod(cx, a, lds, AIN(I_X), nullptr, RL, RL, 0, 0); STEP_END }
    STEP_BEGIN(s0 + 1) if (PHON(1)) { pg8::Gemm gm{U, (const bf16_t*)(ws + WS_WI1), RL, 2 * FH, D, D, D, 0, 0}; S.init(RL, 2 * FH, G, cidx);
                  pg8::EpiSwiglu E{BIG, FH}; pg8::gemm_phase<pg8::EpiSwiglu, true>(cx.tid, lds, gm, S, E); } STEP_END
    STEP_BEGIN(s0 + 2) if (PHON(2)) { pg8::Gemm gm{BIG, (const bf16_t*)(ws + WS_WO1), RL, D, FH, FH, FH, 0, 0}; S.init(RL, D, G, cidx);
                  pg8::EpiResid E{AIN(I_X) + (size_t)g * RL * D, AIN(I_CTX) + (size_t)g * RC * D, H1, H1 + (size_t)RL * D,
                                  MOD + (size_t)(g * BG) * NMOD + 2 * D, MOD + (size_t)32 * NMOD + 2 * D, 0.5f, RL / 256};
                  pg8::gemm_phase<pg8::EpiResid, true>(cx.tid, lds, gm, S, E); } STEP_END
    STEP_BEGIN(s0 + 3) if (PHON(3)) phase_normmod(cx, a, lds, H1r, H1Cr, RL, RG, g * BG, 1); STEP_END
    STEP_BEGIN(s0 + 4) if (PHON(4)) { pg8::Gemm gm{U, (const bf16_t*)(ws + WS_WIN), RG, PN, D, D, D, 0, 0}; S.init(RL, PN, G, cidx); S.ext = (RC / 256) * 11; S.ext_pm0 = RL / 256;
                  pg8::EpiBf16 E{BIG, PN}; pg8::gemm_phase<pg8::EpiBf16, true>(cx.tid, lds, gm, S, E); } STEP_END
    STEP_BEGIN(s0 + 5) if (PHON(5)) phase_prep(cx, a, g, lds); STEP_END
    STEP_BEGIN(s0 + 6) if (PHON(6)) { pg8::Gemm gm{XC, (const bf16_t*)(ws + WS_WLG), RG, 4096, 128, D, 128, 1, 256}; S.init(RG, 4096, G, cidx);
                  pg8::EpiGate E{(bf16_t*)(ws + WS_LA), (bf16_t*)(ws + WS_UU)};
                  pg8::gemm_phase<pg8::EpiGate, true>(cx.tid, lds, gm, S, E); } STEP_END
    STEP_BEGIN_NS(s0 + 6) if (PHON(7)) { phase_gla_scan(cx, a, g, lds); } STEP_END
    STEP_BEGIN(s0 + 8) if (PHON(8)) phase_lru_scan(cx, a, g, lds); STEP_END
    STEP_BEGIN(s0 + 9) if (PHON(9)) phase_post(cx, a, lds, g); STEP_END
    STEP_BEGIN(s0 + 10) if (PHON(10)) { pg8::Gemm gm{(const bf16_t*)(ws + WS_OFB), (const bf16_t*)(ws + WS_WOG), RL, D, D, D, D, 0, 0}; S.init(RL, D, G, cidx);
                   pg8::EpiMix<false> E{BIG, PGA, XC}; pg8::gemm_phase<pg8::EpiMix<false>, true>(cx.tid, lds, gm, S, E); } STEP_END
    STEP_BEGIN_NS(s0 + 10) if (PHON(11)) { pg8::Gemm gm{(const bf16_t*)(ws + WS_HFB), (const bf16_t*)(ws + WS_WOL), RL, D, D, D, D, 0, 0}; S.init(RL, D, G, cidx);
                   pg8::EpiMix<true> E{BIG, PGB, XC}; pg8::gemm_phase<pg8::EpiMix<true>, true>(cx.tid, lds, gm, S, E); } STEP_END
    STEP_BEGIN(s0 + 12) if (PHON(12)) { pg8::Gemm gm{XC, (const bf16_t*)(ws + WS_WOO), RL, D, D, D, D, 0, 0}; S.init(RL, D, G, cidx);
                   pg8::EpiResid E{H1, H1, H1, H1, MOD + (size_t)(g * BG) * NMOD + 5 * D, MOD, 1.0f, RL / 256};
                   pg8::gemm_phase<pg8::EpiResid, true>(cx.tid, lds, gm, S, E); } STEP_END
    STEP_BEGIN(s0 + 13) if (PHON(13)) phase_normmod(cx, a, lds, H1r, nullptr, RL, RL, g * BG, 2); STEP_END
    STEP_BEGIN(s0 + 14) if (PHON(14)) { pg8::Gemm gm{U, (const bf16_t*)(ws + WS_WI2), RL, 2 * FH, D, D, D, 0, 0}; S.init(RL, 2 * FH, G, cidx);
                   pg8::EpiSwiglu E{BIG, FH}; pg8::gemm_phase<pg8::EpiSwiglu, true>(cx.tid, lds, gm, S, E); } STEP_END
    STEP_BEGIN(s0 + 15) if (PHON(15)) { pg8::Gemm gm{BIG, (const bf16_t*)(ws + WS_WO2), RL, D, FH, FH, FH, 0, 0}; S.init(RL, D, G, cidx);
                   float* og = a.out + (size_t)g * RL * D;
                   pg8::EpiResid E{H1, H1, og, og, MOD + (size_t)(g * BG) * NMOD + 8 * D, MOD, 0.5f, RL / 256};
                   pg8::gemm_phase<pg8::EpiResid, true>(cx.tid, lds, gm, S, E); } STEP_END
    STEP_BEGIN(s0 + 16) if (PHON(16)) { phase_final(cx, a, lds, g); if (g + 1 < NG) phase_normmod(cx, a, lds, AIN(I_X) + (size_t)(g + 1) * RL * D, nullptr, RL, RL, (g + 1) * BG, 0); } STEP_END
}

__global__ void __launch_bounds__(NTHR, 2) fwd_kernel(Args a) {
    extern __shared__ __attribute__((aligned(16))) unsigned char lds_raw[];
    LAS unsigned char* lds = (LAS unsigned char*)lds_raw;
    if (threadIdx.x < 26) ((LAS unsigned long long*)(lds + PTAB))[threadIdx.x] = (unsigned long long)a.in[threadIdx.x];
    if (threadIdx.x == 32) { ((LAS unsigned*)(lds + PTAB + 256))[0] = 0u; ((LAS unsigned*)(lds + PTAB + 256))[1] = 0u; }
#if ONE_LAUNCH
    if (threadIdx.x == 0) (void)xb_add((unsigned*)a.ws + 4096 + XB_XCNT(xb_xcc_id()), 1u);
#endif
    const int wave_s = __builtin_amdgcn_readfirstlane(threadIdx.x >> 6);
    __syncthreads();
    STEP_BEGIN(0) if (PHON(17)) phase_weights(cx, a, lds); STEP_END
    STEP_BEGIN(1) if (PHON(18)) phase_modreduce(cx, a, lds); STEP_END
    STEP_BEGIN(2) if (PHON(0)) phase_normmod(cx, a, lds, nullptr, AIN(I_CTX), 0, NB * CL, 0, 0); STEP_END
    STEP_BEGIN(3) if (PHON(1)) { pg8::Gemm gm{U, (const bf16_t*)(ws + WS_WI1), NB * CL, 2 * FH, D, D, D, 0, 0}; S.init(NB * CL, 2 * FH, G, cidx);
                  pg8::EpiSwiglu E{BIG, FH}; pg8::gemm_phase<pg8::EpiSwiglu, true>(cx.tid, lds, gm, S, E); } STEP_END
    STEP_BEGIN(4) if (PHON(2)) { pg8::Gemm gm{BIG, (const bf16_t*)(ws + WS_WO1), NB * CL, D, FH, FH, FH, 0, 0}; S.init(NB * CL, D, G, cidx);
                  float* h1c = (float*)(ws + WS_H1C);
                  pg8::EpiResid E{AIN(I_CTX), AIN(I_CTX), h1c, h1c, MOD, MOD + (size_t)32 * NMOD + 2 * D, 0.5f, 0};
                  pg8::gemm_phase<pg8::EpiResid, true>(cx.tid, lds, gm, S, E); } STEP_END
    run_group<0>(a, lds, wave_s);
    run_group<1>(a, lds, wave_s);
    run_group<2>(a, lds, wave_s);
    run_group<3>(a, lds, wave_s);
}


#ifdef PROBE_STEP
__global__ void probe_kernel(const unsigned char* ws, float* out) {
    const size_t n = (size_t)65536 * 1024, q = n / 4;
    const bf16_t* r0 = (const bf16_t*)(ws + PROBE_R0); const bf16_t* r1 = (const bf16_t*)(ws + PROBE_R1); const bf16_t* r2 = (const bf16_t*)(ws + PROBE_R2); const bf16_t* r3 = (const bf16_t*)(ws + PROBE_R3);
    for (size_t i = (size_t)blockIdx.x * blockDim.x + threadIdx.x; i < q; i += (size_t)gridDim.x * blockDim.x) {
        out[i] = bf2f(r0[i]); out[q + i] = bf2f(r1[i]); out[2 * q + i] = bf2f(r2[i]); out[3 * q + i] = bf2f(r3[i]); }
}
#endif
extern "C" void kernel_launch(void* const* d_in, const int* in_sizes, int n_in, void* d_out, int out_size, void* d_ws, size_t ws_size, hipStream_t stream) {
    static int grid = 0;
    if (grid == 0) {
        if (n_in != 26 || ws_size < WS_END) { fprintf(stderr, "kernel_launch: unexpected inputs (n_in %d, ws %zu, need %zu)\n", n_in, ws_size, (size_t)WS_END); grid = -1; return; }
        int dev = 0, cus = 0, per_cu = 0;
        hipGetDevice(&dev); hipDeviceGetAttribute(&cus, hipDeviceAttributeMultiprocessorCount, dev);
        if (hipFuncSetAttribute((const void*)fwd_kernel, hipFuncAttributeMaxDynamicSharedMemorySize, LDS_BYTES) != hipSuccess) { fprintf(stderr, "kernel_launch: hipFuncSetAttribute failed\n"); grid = -1; return; }
        hipOccupancyMaxActiveBlocksPerMultiprocessor(&per_cu, (const void*)fwd_kernel, NTHR, LDS_BYTES);
        (void)hipGetLastError();
        if (per_cu < 1) per_cu = 1;
        grid = cus * 1;
    }
    if (grid < 0) return;
    Args a{};
    for (int i = 0; i < 26; ++i) a.in[i] = (const float*)d_in[i];
    a.out = (float*)d_out; a.ws = (unsigned char*)d_ws;
    const int nsteps = 5 + NG * NPH;
#if ONE_LAUNCH
    (void)hipMemsetAsync(d_ws, 0, 65536, stream);
    a.lo = 0; a.hi = nsteps;
    void* args[] = {&a};
    hipError_t e = hipLaunchCooperativeKernel((const void*)fwd_kernel, dim3(grid), dim3(NTHR), args, LDS_BYTES, stream);
    if (e != hipSuccess) fprintf(stderr, "cooperative launch failed: %s (grid %d)\n", hipGetErrorString(e), grid);
#else
#ifdef PROBE_STEP
    for (int s = 0; s <= PROBE_STEP; ++s) { a.lo = s; a.hi = s + 1; hipLaunchKernelGGL(fwd_kernel, dim3(grid), dim3(NTHR), LDS_BYTES, stream, a); }
    hipLaunchKernelGGL(probe_kernel, dim3(2048), dim3(256), 0, stream, (const unsigned char*)d_ws, (float*)d_out);
#else
    for (int s = 0; s < nsteps; ++s) { a.lo = s; a.hi = s + 1; hipLaunchKernelGGL(fwd_kernel, dim3(grid), dim3(NTHR), LDS_BYTES, stream, a); }
#endif
#endif
}
```

```cpp
#include <hip/hip_runtime.h>
#include <hip/hip_cooperative_groups.h>
#include <cstdio>
#include <cstdint>
namespace cg = cooperative_groups;

#ifndef ONE_LAUNCH
#define ONE_LAUNCH 1
#endif

#ifndef PHMASK
#define PHMASK 0x1fffff
#endif
#define PHON(n) (((PHMASK) >> (n)) & 1)
#define LAS __attribute__((address_space(3)))
typedef unsigned short bf16_t;
typedef short bf16x8 __attribute__((ext_vector_type(8)));
typedef float f32x4 __attribute__((ext_vector_type(4)));
typedef float f32x2 __attribute__((ext_vector_type(2)));
typedef unsigned u32x4 __attribute__((ext_vector_type(4)));
typedef unsigned u32x2 __attribute__((ext_vector_type(2)));

constexpr int D = 1024, NB = 32, T = 2048, CL = 256, FH = 2816, INW = 7200, PN = 7424, NMOD = 9216;
constexpr int NG = 4, BG = NB / NG;
constexpr int RL = BG * T, RC = BG * CL, RG = RL + RC;
constexpr int NCH = 36;
constexpr float EPS = 1e-6f;
constexpr int PQ = 0, PK = 512, PV = 1024, PGG = 2048, PXL = 3072, PYL = 4096, PGA = 5120, PGB = 6144, PFD = 7168;

constexpr size_t al(size_t x) { return (x + 4095) & ~(size_t)4095; }
constexpr size_t WS_WI1 = 1 << 20;
constexpr size_t WS_WO1 = WS_WI1 + al((size_t)2 * FH * D * 2);
constexpr size_t WS_WI2 = WS_WO1 + al((size_t)D * FH * 2);
constexpr size_t WS_WO2 = WS_WI2 + al((size_t)2 * FH * D * 2);
constexpr size_t WS_WIN = WS_WO2 + al((size_t)D * FH * 2);
constexpr size_t WS_WOG = WS_WIN + al((size_t)PN * D * 2);
constexpr size_t WS_WOL = WS_WOG + al((size_t)D * D * 2);
constexpr size_t WS_WOO = WS_WOL + al((size_t)D * D * 2);
constexpr size_t WS_WLG = WS_WOO + al((size_t)D * D * 2);
constexpr size_t WS_MODP = WS_WLG + al((size_t)4096 * 128 * 2);
constexpr size_t WS_MOD = WS_MODP + al((size_t)16 * 33 * NMOD * 4);
constexpr size_t WS_GC = WS_MOD + al((size_t)33 * NMOD * 4);
constexpr size_t WS_H1 = WS_GC + al((size_t)6 * D * 4);
constexpr size_t WS_U = WS_H1 + al((size_t)RG * D * 4);
constexpr size_t WS_BIG = WS_U + al((size_t)RG * D * 2);
constexpr size_t WS_XC = WS_BIG + al((size_t)RG * PN * 2);
constexpr size_t WS_LA = WS_XC + al((size_t)RG * D * 2);
constexpr size_t WS_UU = WS_LA + al((size_t)2 * RG * D * 2);
constexpr size_t WS_HFB = WS_UU + al((size_t)2 * RG * D * 2);
constexpr size_t WS_OFB = WS_HFB + al((size_t)2 * RL * D * 2);
constexpr size_t GT = (size_t)2 * BG * NCH * 4;
constexpr size_t WS_QD = WS_OFB + al((size_t)2 * RL * D * 2);
constexpr size_t WS_KI = WS_QD + al(GT * 8192 * 2);
constexpr size_t WS_KET = WS_KI + al(GT * 8192 * 2);
constexpr size_t WS_VT = WS_KET + al(GT * 8192 * 2);
constexpr size_t WS_BL = WS_VT + al((size_t)BG * NCH * 4 * 16384 * 2);
constexpr size_t WS_H1C = WS_BL + al(GT * 128 * 4);
constexpr size_t WS_END = WS_H1C + al((size_t)NB * CL * D * 4);
static_assert(WS_END <= (size_t)1073741824, "workspace map exceeds 1 GiB");

constexpr int LDS_BYTES = 163840, PTAB = LDS_BYTES - 512;

typedef __bf16 bf16x2_t __attribute__((ext_vector_type(2)));
__device__ __forceinline__ unsigned cvt_pk_bf16(float lo, float hi) { const f32x2 v = {lo, hi}; return __builtin_bit_cast(unsigned, __builtin_convertvector(v, bf16x2_t)); }
__device__ __forceinline__ bf16_t f2bf(float f) { return (bf16_t)(cvt_pk_bf16(f, 0.f) & 0xffffu); }
__device__ __forceinline__ float bf2f(bf16_t h) { return __uint_as_float(((unsigned)h) << 16); }
__device__ __forceinline__ float bflo(unsigned w) { return __uint_as_float(w << 16); }
__device__ __forceinline__ float bfhi(unsigned w) { return __uint_as_float(w & 0xffff0000u); }
__device__ __forceinline__ float sigmoidf_(float x) { return __builtin_amdgcn_rcpf(1.0f + __expf(-x)); }
__device__ __forceinline__ float siluf_(float x) { return x * __builtin_amdgcn_rcpf(1.0f + __expf(-x)); }
__device__ __forceinline__ float geluf_(float x) { const float z = 0.7978845608028654f * (x + 0.044715f * x * x * x); return x * (1.0f - __builtin_amdgcn_rcpf(1.0f + __expf(2.0f * z))); }
__device__ __forceinline__ float logsigf_(float x) { return fminf(x, 0.f) - log1pf(__expf(-fabsf(x))); }
__device__ __forceinline__ float one_minus_exp(float x) {
    const float ser = -x * (1.0f + x * (0.5f + x * (0.16666667f + x * (0.041666668f + x * (0.0083333338f + x * (0.0013888889f + x * 0.0001984127f))))));
    return x > -0.3f ? ser : 1.0f - __expf(x);
}
__device__ __forceinline__ float wave_sum(float v) {
#pragma unroll
    for (int o = 1; o < 64; o <<= 1) v += __shfl_xor(v, o);
    return v;
}
__device__ __forceinline__ void unpack8(const u32x4 w, float (&f)[8]) {
    f[0] = bflo(w.x); f[1] = bfhi(w.x); f[2] = bflo(w.y); f[3] = bfhi(w.y); f[4] = bflo(w.z); f[5] = bfhi(w.z); f[6] = bflo(w.w); f[7] = bfhi(w.w);
}
__device__ __forceinline__ u32x4 pack8(const float (&f)[8]) {
    u32x4 w; w.x = cvt_pk_bf16(f[0], f[1]); w.y = cvt_pk_bf16(f[2], f[3]); w.z = cvt_pk_bf16(f[4], f[5]); w.w = cvt_pk_bf16(f[6], f[7]); return w;
}

namespace pg8 {
constexpr int BM = 256, BK = 64, HALF = 128, HTB = HALF * BK * 2, STAGE_BYTES = 8 * HTB, NXCD = 8, WGM = 8;
__host__ __device__ __forceinline__ int lds_byte(int r, int c) { const int st = (r >> 4) * 2 + (c >> 5), rr = r & 15, cc = c & 31, ob = rr * 64 + cc * 2; return st * 1024 + (ob ^ (((ob >> 9) & 1) << 5)); }
__host__ __device__ __forceinline__ void stage_rc(int b, int& R, int& C) { const int st = b / 1024, sb = b % 1024, swz = sb ^ (((sb >> 9) & 1) << 5); R = (st >> 1) * 16 + swz / 64; C = (st & 1) * 32 + (swz % 64) / 2; }
__host__ __device__ __forceinline__ int perm32(int rho) { const int n = rho >> 4, i = rho & 15; return 8 * (i >> 2) + 4 * n + (i & 3); }
struct Unit { int pm, pn; };
struct Gemm { const bf16_t* A; const bf16_t* Bt; int M, N, K, lda, ldb, a_pn_shift, a_pn_bytes; };
struct StaticOrder {
    int nM, nN, nwg, G, c, ext, ext_pm0;
    __device__ void init(int M, int N, int G_, int c_) { nM = M / BM; nN = N / BM; nwg = nM * nN; G = G_; c = c_; ext = 0; ext_pm0 = 0; }
    __device__ bool next(int i, Unit& u) const {
        const long L = (long)i * G + c;
        if (L >= nwg) { if (L >= nwg + ext) return false; const int idx = (int)(L - nwg), t = idx % 11; u.pm = ext_pm0 + idx / 11; u.pn = t < 6 ? t + 2 : (t < 10 ? t + 6 : 28); return true; }
        int wgid = (int)L; { const int q = nwg / NXCD, r = nwg % NXCD, xcd = wgid % NXCD, off = wgid / NXCD; wgid = (xcd < r ? xcd * (q + 1) : r * (q + 1) + (xcd - r) * q) + off; }
        const int nig = WGM * nN, gid = wgid / nig, fm = gid * WGM, gsz = (nM - fm) < WGM ? (nM - fm) : WGM;
        u.pm = fm + ((wgid % nig) % gsz); u.pn = (wgid % nig) / gsz; return true;
    }
};
template <class Epi, bool ALIGN_EPI>
__device__ __forceinline__ void gemm_phase(const int tid, LAS unsigned char* lds, const Gemm g, const StaticOrder& S, const Epi& E) {
    const int wid = __builtin_amdgcn_readfirstlane(tid >> 6), lane = tid & 63, wr = wid >> 2, wc = wid & 3, fr = lane & 15, fq = lane >> 4;
    const int K = g.K, nt = K / BK;
    unsigned voffA[2], voffB[2];
#pragma unroll
    for (int i = 0; i < 2; ++i) { int R, C; stage_rc(tid * 16 + i * 8192, R, C); const int Rb = Epi::PERM ? ((R & ~31) + perm32(R & 31)) : R;
        voffA[i] = (unsigned)(R * g.lda + C) * 2u; voffB[i] = (unsigned)(Rb * g.ldb + C) * 2u; }
    const size_t kstep = (size_t)(BK * 2);
    const size_t hstepA = (size_t)HALF * g.lda * 2, hstepB = (size_t)HALF * g.ldb * 2;
    const size_t tstepA = 2 * hstepA, tstepB = 2 * hstepB;
    const unsigned ldsw = (unsigned)wid * 1024u;
    const int aoff = lds_byte(wr * 64 + fr, fq * 8), boff = lds_byte(wc * 32 + fr, fq * 8);
#define PG8_SA(b, h) (((b) * 2 + (h)) * HTB)
#define PG8_SB(b, h) ((4 + (b) * 2 + (h)) * HTB)
#define PG8_STAGE(bufoff, gbase, voff) do { _Pragma("unroll") for (int _i = 0; _i < 2; ++_i) \
        __builtin_amdgcn_global_load_lds((const unsigned*)((const char*)(gbase) + (voff)[_i]), (LAS unsigned*)(lds + (bufoff) + ldsw + _i * 8192), 16, 0, 0); } while (0)
#define PG8_LDA(dst, b, h) do { _Pragma("unroll") for (int m = 0; m < 4; ++m) _Pragma("unroll") for (int k = 0; k < 2; ++k) dst[m][k] = *(const LAS bf16x8*)(lds + PG8_SA(b, h) + aoff + m * 2048 + k * 1024); } while (0)
#define PG8_LDB(dst, b, h) do { _Pragma("unroll") for (int n = 0; n < 2; ++n) _Pragma("unroll") for (int k = 0; k < 2; ++k) dst[n][k] = *(const LAS bf16x8*)(lds + PG8_SB(b, h) + boff + n * 2048 + k * 1024); } while (0)
#define PG8_MMA(ai, bj, At, Bt) do { __builtin_amdgcn_s_setprio(1); _Pragma("unroll") for (int m = 0; m < 4; ++m) _Pragma("unroll") for (int n = 0; n < 2; ++n) _Pragma("unroll") for (int k = 0; k < 2; ++k) \
        acc[ai][bj][m][n] = __builtin_amdgcn_mfma_f32_16x16x32_bf16(Bt[n][k], At[m][k], acc[ai][bj][m][n], 0, 0, 0); __builtin_amdgcn_s_setprio(0); } while (0)
#define PG8_WAIT_V(n) asm volatile("s_waitcnt vmcnt(" #n ")" ::: "memory")
#define PG8_WAIT_L(n) asm volatile("s_waitcnt lgkmcnt(" #n ")" ::: "memory")
#define PG8_BAR __builtin_amdgcn_s_barrier()
#define PG8_SCHED __builtin_amdgcn_sched_barrier(0)
    Unit cur, nxt; int ui = 0;
    if (!S.next(0, cur)) return;
    f32x4 acc[2][2][4][2];
#pragma unroll
    for (int a = 0; a < 2; ++a)
#pragma unroll
        for (int b = 0; b < 2; ++b)
#pragma unroll
            for (int m = 0; m < 4; ++m)
#pragma unroll
                for (int n = 0; n < 2; ++n) acc[a][b][m][n] = (f32x4){0.f, 0.f, 0.f, 0.f};
    bf16x8 At[4][2], B0[2][2], B1[2][2];
    const char* cA = (const char*)g.A + (size_t)cur.pm * tstepA + (size_t)((cur.pn >> g.a_pn_shift) * g.a_pn_bytes);
    const char* cB = (const char*)g.Bt + (size_t)cur.pn * tstepB;
    PG8_STAGE(PG8_SB(0, 0), cB, voffB); PG8_STAGE(PG8_SB(0, 1), cB + hstepB, voffB); PG8_STAGE(PG8_SA(0, 0), cA, voffA); PG8_STAGE(PG8_SA(0, 1), cA + hstepA, voffA);
    if (wr == 1) PG8_BAR;
    PG8_WAIT_V(2); PG8_BAR;
    PG8_STAGE(PG8_SB(1, 0), cB + kstep, voffB); PG8_STAGE(PG8_SA(1, 0), cA + kstep, voffA); PG8_STAGE(PG8_SB(1, 1), cB + hstepB + kstep, voffB);
    PG8_WAIT_V(6); PG8_BAR;
    for (;;) {
        const bool has_next = S.next(ui + 1, nxt);
        const char* nA = has_next ? (const char*)g.A + (size_t)nxt.pm * tstepA + (size_t)((nxt.pn >> g.a_pn_shift) * g.a_pn_bytes) : cA;
        const char* nB = has_next ? (const char*)g.Bt + (size_t)nxt.pn * tstepB : cB;
        for (int t = 0; t < nt; t += 2) {
            const bool last = (t == nt - 2);
            const char* a1 = cA + (size_t)(t + 1) * kstep;
            const char* a2 = last ? nA : cA + (size_t)(t + 2) * kstep; const char* b2 = last ? nB : cB + (size_t)(t + 2) * kstep;
            const char* a3 = a2 + kstep; const char* b3 = b2 + kstep;
            PG8_LDB(B0, 0, 0); PG8_LDB(B1, 0, 1); PG8_SCHED; PG8_LDA(At, 0, 0); PG8_STAGE(PG8_SA(1, 1), a1 + hstepA, voffA);
            PG8_WAIT_V(8); PG8_WAIT_L(0); PG8_BAR; PG8_MMA(0, 0, At, B0); PG8_MMA(0, 1, At, B1); PG8_BAR; PG8_SCHED;
            PG8_LDA(At, 0, 1); PG8_STAGE(PG8_SB(0, 0), b2, voffB); PG8_STAGE(PG8_SB(0, 1), b2 + hstepB, voffB); PG8_STAGE(PG8_SA(0, 0), a2, voffA);
            PG8_WAIT_V(8); PG8_WAIT_L(0); PG8_BAR; PG8_MMA(1, 0, At, B0); PG8_MMA(1, 1, At, B1); PG8_BAR; PG8_SCHED;
            PG8_LDB(B0, 1, 0); PG8_LDB(B1, 1, 1); PG8_SCHED; PG8_LDA(At, 1, 0); PG8_STAGE(PG8_SA(0, 1), a2 + hstepA, voffA);
            PG8_WAIT_V(8); PG8_WAIT_L(0); PG8_BAR; PG8_MMA(0, 0, At, B0); PG8_MMA(0, 1, At, B1); PG8_BAR; PG8_SCHED;
            PG8_LDA(At, 1, 1); PG8_STAGE(PG8_SB(1, 0), b3, voffB); PG8_STAGE(PG8_SB(1, 1), b3 + hstepB, voffB); PG8_STAGE(PG8_SA(1, 0), a3, voffA);
            PG8_WAIT_V(8); PG8_WAIT_L(0); PG8_BAR; PG8_MMA(1, 0, At, B0); PG8_MMA(1, 1, At, B1); PG8_BAR; PG8_SCHED;
        }
        if constexpr (ALIGN_EPI) { if (wr == 0) PG8_BAR; }
        { int fr_ = fr, fq_ = fq; asm volatile("" : "+v"(fr_), "+v"(fq_)); E(acc, cur, wr, wc, fr_, fq_); }
        if (!has_next) break;
#pragma unroll
        for (int a = 0; a < 2; ++a)
#pragma unroll
            for (int b = 0; b < 2; ++b)
#pragma unroll
                for (int m = 0; m < 4; ++m)
#pragma unroll
                    for (int n = 0; n < 2; ++n) acc[a][b][m][n] = (f32x4){0.f, 0.f, 0.f, 0.f};
        cur = nxt; cA = nA; cB = nB; ++ui;
        if constexpr (ALIGN_EPI) { if (wr == 1) PG8_BAR; }
    }
    PG8_WAIT_V(0);
    if constexpr (!ALIGN_EPI) { if (wr == 0) PG8_BAR; }
    PG8_BAR;
#undef PG8_SA
#undef PG8_SB
#undef PG8_STAGE
#undef PG8_LDA
#undef PG8_LDB
#undef PG8_MMA
#undef PG8_WAIT_V
#undef PG8_WAIT_L
#undef PG8_BAR
#undef PG8_SCHED
}

struct EpiBf16 {
    static constexpr bool PERM = true;
    bf16_t* O; int ldc;
    __device__ __forceinline__ void operator()(const f32x4 (&acc)[2][2][4][2], const Unit& u, int wr, int wc, int fr, int fq) const {
        const int row0 = u.pm * BM + wr * 64 + fr, col0 = u.pn * BM + wc * 32 + 8 * fq;
#pragma unroll
        for (int ai = 0; ai < 2; ++ai)
#pragma unroll
            for (int m = 0; m < 4; ++m) { bf16_t* rowp = O + (size_t)(row0 + ai * HALF + m * 16) * ldc + col0;
#pragma unroll
                for (int bj = 0; bj < 2; ++bj) { const f32x4 v0 = acc[ai][bj][m][0], v1 = acc[ai][bj][m][1];
                    u32x4 w; w.x = cvt_pk_bf16(v0[0], v0[1]); w.y = cvt_pk_bf16(v0[2], v0[3]); w.z = cvt_pk_bf16(v1[0], v1[1]); w.w = cvt_pk_bf16(v1[2], v1[3]);
                    *(u32x4*)(rowp + bj * HALF) = w; } }
    }
};
struct EpiSwiglu {
    static constexpr bool PERM = true;
    bf16_t* O; int ldc;
    __device__ __forceinline__ void operator()(const f32x4 (&acc)[2][2][4][2], const Unit& u, int wr, int wc, int fr, int fq) const {
        const int row0 = u.pm * BM + wr * 64 + fr, col0 = u.pn * HALF + wc * 32 + 8 * fq;
#pragma unroll
        for (int ai = 0; ai < 2; ++ai)
#pragma unroll
            for (int m = 0; m < 4; ++m) { bf16_t* rowp = O + (size_t)(row0 + ai * HALF + m * 16) * ldc + col0;
                float o[8];
#pragma unroll
                for (int n = 0; n < 2; ++n)
#pragma unroll
                    for (int j = 0; j < 4; ++j) o[4 * n + j] = siluf_(acc[ai][0][m][n][j]) * acc[ai][1][m][n][j];
                *(u32x4*)rowp = pack8(o); }
    }
};
struct EpiResid {
    static constexpr bool PERM = false;
    const float* baseL; const float* baseC; float* outL; float* outC; const float* modL; const float* modC; float scale; int nlat;
    __device__ __forceinline__ void operator()(const f32x4 (&acc)[2][2][4][2], const Unit& u, int wr, int wc, int fr, int fq) const {
        const bool lat = u.pm < nlat;
        const size_t toff = (size_t)(lat ? u.pm : u.pm - nlat) * BM * D + (size_t)(wr * 64 + fr) * D + u.pn * BM + wc * 32 + 4 * fq;
        const float* base = (lat ? baseL : baseC) + toff;
        float* out = (lat ? outL : outC) + toff;
        const float* mg = (lat ? modL + (size_t)(u.pm >> 3) * NMOD : modC) + u.pn * BM + wc * 32 + 4 * fq;
#pragma unroll
        for (int bj = 0; bj < 2; ++bj)
#pragma unroll
            for (int n = 0; n < 2; ++n) { const f32x4 gv = *(const f32x4*)(mg + bj * HALF + n * 16) * scale;
#pragma unroll
                for (int ai = 0; ai < 2; ++ai)
#pragma unroll
                    for (int m = 0; m < 4; ++m) { const size_t off = (size_t)(ai * HALF + m * 16) * D + bj * HALF + n * 16;
                        const f32x4 bs = *(const f32x4*)(base + off); *(f32x4*)(out + off) = bs + gv * acc[ai][bj][m][n]; } }
    }
};
__device__ __forceinline__ float one_minus_exp(float x) {
    const float ser = -x * (1.0f + x * (0.5f + x * (0.16666667f + x * (0.041666668f + x * (0.0083333338f + x * (0.0013888889f + x * 0.0001984127f))))));
    return x > -0.3f ? ser : 1.0f - __expf(x);
}
struct EpiGate {
    static constexpr bool PERM = true;
    bf16_t* LA; bf16_t* UU;
    __device__ __forceinline__ void operator()(const f32x4 (&acc)[2][2][4][2], const Unit& u, int wr, int wc, int fr, int fq) const {
        const int blk = u.pn >> 1, dir = u.pn & 1, ch0 = blk * HALF + wc * 32 + 8 * fq, row0 = u.pm * BM + wr * 64 + fr;
#pragma unroll
        for (int ai = 0; ai < 2; ++ai)
#pragma unroll
            for (int m = 0; m < 4; ++m) { const size_t off = (size_t)dir * RG * D + (size_t)(row0 + ai * HALF + m * 16) * D + ch0;
#pragma unroll
                for (int bj = 0; bj < 2; ++bj) { const f32x4 v0 = acc[ai][bj][m][0], v1 = acc[ai][bj][m][1];
                    u32x4 w; w.x = cvt_pk_bf16(v0[0], v0[1]); w.y = cvt_pk_bf16(v0[2], v0[3]); w.z = cvt_pk_bf16(v1[0], v1[1]); w.w = cvt_pk_bf16(v1[2], v1[3]);
                    *(u32x4*)((bj ? UU : LA) + off) = w; } }
    }
};
template <bool ACCUM> struct EpiMix {
    static constexpr bool PERM = true;
    const bf16_t* PROJ; int gcol; bf16_t* MG;
    __device__ __forceinline__ void operator()(const f32x4 (&acc)[2][2][4][2], const Unit& u, int wr, int wc, int fr, int fq) const {
        const int row0 = u.pm * BM + wr * 64 + fr, col0 = u.pn * BM + wc * 32 + 8 * fq;
#pragma unroll
        for (int ai = 0; ai < 2; ++ai)
#pragma unroll
            for (int m = 0; m < 4; ++m) { const size_t row = (size_t)(row0 + ai * HALF + m * 16);
#pragma unroll
                for (int bj = 0; bj < 2; ++bj) { float gt[8], o[8]; unpack8(*(const u32x4*)(PROJ + row * PN + gcol + col0 + bj * HALF), gt);
                    bf16_t* dst = MG + row * D + col0 + bj * HALF;
                    if (ACCUM) unpack8(*(const u32x4*)dst, o); else {
#pragma unroll
                        for (int i = 0; i < 8; ++i) o[i] = 0.f; }
#pragma unroll
                    for (int n = 0; n < 2; ++n)
#pragma unroll
                        for (int j = 0; j < 4; ++j) o[4 * n + j] += sigmoidf_(gt[4 * n + j]) * acc[ai][bj][m][n][j];
                    *(u32x4*)dst = pack8(o); } }
    }
};
}

struct Args {
    const float* in[26]; float* out; unsigned char* ws; int lo, hi;
};
enum { I_X = 0, I_C, I_CTX, I_CCTX, I_WADA, I_BADA, I_NORMW, I_F1WI, I_F1WO, I_F2WI, I_F2WO, I_WIN, I_FUP, I_FB, I_GNW, I_CONVW, I_CONVB, I_WR, I_BR, I_WI, I_BI, I_LAM, I_WOG, I_WOL, I_WOO, I_FNW };

#define NTHR 512
__device__ __forceinline__ const float* inp(const LAS unsigned char* lds, int i) { const LAS unsigned* t = (const LAS unsigned*)(lds + PTAB) + 2 * i;
    const unsigned lo = __builtin_amdgcn_readfirstlane(t[0]), hi = __builtin_amdgcn_readfirstlane(t[1]); return (const float*)(((unsigned long long)hi << 32) | lo); }
#define AIN(i) inp(lds, (i))
struct Ctx { int tid, bid, G; };
#define GW() (cx.bid * 8 + (cx.tid >> 6))
#define NGW() (cx.G * 8)

__device__ __forceinline__ void transpose_item(const float* W, int ldw, int K, int k0, int n0, bf16_t* WT, int drow, LAS float* scr, int lane) {
#pragma unroll 8
    for (int i = 0; i < 32; ++i) { const int kk = 2 * i + (lane >> 5); scr[kk * 33 + (lane & 31)] = W[(size_t)(k0 + kk) * ldw + n0 + (lane & 31)]; }
    asm volatile("s_waitcnt lgkmcnt(0)" ::: "memory");
    const int c = lane & 7;
#pragma unroll
    for (int j = 0; j < 4; ++j) { const int n = (lane >> 3) + 8 * j; const LAS float* s = scr + (8 * c) * 33 + n;
        u32x4 o; o.x = cvt_pk_bf16(s[0 * 33], s[1 * 33]); o.y = cvt_pk_bf16(s[2 * 33], s[3 * 33]); o.z = cvt_pk_bf16(s[4 * 33], s[5 * 33]); o.w = cvt_pk_bf16(s[6 * 33], s[7 * 33]);
        *(u32x4*)(WT + (size_t)(drow + n) * K + k0 + 8 * c) = o; }
    asm volatile("s_waitcnt lgkmcnt(0)" ::: "memory");
}
__device__ __forceinline__ int wi_drow(int n0) { return n0 < FH ? (n0 >> 7) * 256 + (n0 & 127) : ((n0 - FH) >> 7) * 256 + 128 + ((n0 - FH) & 127); }
__device__ __forceinline__ int win_drow(int n0) { return n0 < 3072 ? n0 : (n0 == 3072 ? PFD : n0 - 32); }

__device__ __forceinline__ void phase_weights(const Ctx cx, const Args& a, LAS unsigned char* lds) {
    const int lane = cx.tid & 63, wave = cx.tid >> 6;
    LAS float* scr = (LAS float*)(lds + wave * 16384);
    unsigned char* ws = a.ws;
    constexpr int I_WI_ = (D / 64) * (2 * FH / 32), I_WO_ = (FH / 64) * (D / 32), I_IN_ = (D / 64) * (INW / 32), I_SQ_ = (D / 64) * (D / 32), I_LG_ = 32 * 8;
    constexpr int NIT = 2 * I_WI_ + 2 * I_WO_ + I_IN_ + 3 * I_SQ_ + I_LG_;
    if (PHON(19)) for (int it = GW(); it < NIT; it += NGW()) {
        int r = it;
        if (r < 2 * I_WI_) { const int w = r / I_WI_; r %= I_WI_; const int nb = 2 * FH / 32, kb = r / nb, n0 = (r % nb) * 32;
            transpose_item(AIN(w ? I_F2WI : I_F1WI), 2 * FH, D, kb * 64, n0, (bf16_t*)(ws + (w ? WS_WI2 : WS_WI1)), wi_drow(n0), scr, lane); continue; }
        r -= 2 * I_WI_;
        if (r < 2 * I_WO_) { const int w = r / I_WO_; r %= I_WO_; const int nb = D / 32, kb = r / nb, n0 = (r % nb) * 32;
            transpose_item(AIN(w ? I_F2WO : I_F1WO), D, FH, kb * 64, n0, (bf16_t*)(ws + (w ? WS_WO2 : WS_WO1)), n0, scr, lane); continue; }
        r -= 2 * I_WO_;
        if (r < I_IN_) { const int nb = INW / 32, kb = r / nb, n0 = (r % nb) * 32;
            transpose_item(AIN(I_WIN), INW, D, kb * 64, n0, (bf16_t*)(ws + WS_WIN), win_drow(n0), scr, lane); continue; }
        r -= I_IN_;
        if (r < 3 * I_SQ_) { const int w = r / I_SQ_; r %= I_SQ_; const int nb = D / 32, kb = r / nb, n0 = (r % nb) * 32;
            transpose_item(AIN(w == 0 ? I_WOG : (w == 1 ? I_WOL : I_WOO)), D, D, kb * 64, n0, (bf16_t*)(ws + (w == 0 ? WS_WOG : (w == 1 ? WS_WOL : WS_WOO))), n0, scr, lane); continue; }
        r -= 3 * I_SQ_;
        { const int mat = r >> 3, sub = r & 7, gate = mat >> 4, dir = (mat >> 3) & 1, blk = mat & 7;
          const float* src = AIN(gate ? I_WI : I_WR) + (size_t)(dir * 8 + blk) * 128 * 128;
          const int kb = sub >> 2, n0 = (sub & 3) * 32;
          transpose_item(src, 128, 128, kb * 64, n0, (bf16_t*)(ws + WS_WLG), ((blk * 2 + dir) * 2 + gate) * 128 + n0, scr, lane); }
    }
    { u32x4* z = (u32x4*)(ws + WS_WIN + (size_t)INW * D * 2); const int n16 = (PN - INW) * D * 2 / 16;
      for (int i = cx.bid * NTHR + cx.tid; i < n16; i += cx.G * NTHR) z[i] = (u32x4){0u, 0u, 0u, 0u}; }
    __syncthreads();
    LAS float* sl = (LAS float*)lds;
    float* MODP = (float*)(ws + WS_MODP);
    if (PHON(20)) for (int item = cx.bid; item < 18 * 16; item += cx.G) {
        const int cb = item % 18, ks = item / 18, col = cb * 512 + cx.tid;
        for (int idx = cx.tid; idx < 33 * 64; idx += NTHR) { const int b = idx >> 6, k = idx & 63; const float cv = b < 32 ? AIN(I_C)[b * D + ks * 64 + k] : AIN(I_CCTX)[ks * 64 + k]; sl[idx] = siluf_(cv); }
        __syncthreads();
        float acc[33];
#pragma unroll
        for (int b = 0; b < 33; ++b) acc[b] = 0.f;
        const float* wp = AIN(I_WADA) + (size_t)(ks * 64) * NMOD + col;
#pragma unroll 4
        for (int k = 0; k < 64; ++k) { const float w = wp[(size_t)k * NMOD];
#pragma unroll
            for (int b = 0; b < 33; ++b) acc[b] += sl[b * 64 + k] * w; }
#pragma unroll
        for (int b = 0; b < 33; ++b) MODP[(size_t)(ks * 33 + b) * NMOD + col] = acc[b];
        __syncthreads();
    }
}
__device__ __forceinline__ void phase_modreduce(const Ctx cx, const Args& a, LAS unsigned char* lds) {
    const float* MODP = (const float*)(a.ws + WS_MODP); float* MOD = (float*)(a.ws + WS_MOD);
    for (int idx = cx.bid * NTHR + cx.tid; idx < 33 * NMOD; idx += cx.G * NTHR) {
        float s = AIN(I_BADA)[idx % NMOD];
#pragma unroll
        for (int ks = 0; ks < 16; ++ks) s += MODP[(size_t)ks * 33 * NMOD + idx];
        MOD[idx] = s;
    }
    float* GC = (float*)(a.ws + WS_GC);
    for (int idx = cx.bid * NTHR + cx.tid; idx < 2 * D; idx += cx.G * NTHR) { GC[idx] = AIN(I_BR)[idx]; GC[2 * D + idx] = AIN(I_BI)[idx]; GC[4 * D + idx] = 8.0f * log1pf(__expf(-AIN(I_LAM)[idx])); }
}

__device__ __forceinline__ void phase_normmod(const Ctx cx, const Args& a, LAS unsigned char* lds, const float* srcL, const float* srcC, int nL, int nrows, int mod_b0, int sub) {
    const int lane = cx.tid & 63;
    const float* MOD = (const float*)(a.ws + WS_MOD); const float* nw = AIN(I_NORMW) + sub * D;
    bf16_t* U = (bf16_t*)(a.ws + WS_U);
    for (int r0 = 2 * GW(); r0 < nrows; r0 += 2 * NGW()) {
        f32x4 v[2][4]; float ss[2];
#pragma unroll
        for (int q = 0; q < 2; ++q) { const int r = r0 + q;
            const float* src = r < nL ? srcL + (size_t)r * D : srcC + (size_t)(r - nL) * D;
            ss[q] = 0.f;
#pragma unroll
            for (int j = 0; j < 4; ++j) { v[q][j] = ((const f32x4*)src)[lane + 64 * j]; } }
#pragma unroll
        for (int q = 0; q < 2; ++q)
#pragma unroll
            for (int j = 0; j < 4; ++j) ss[q] += (v[q][j].x * v[q][j].x + v[q][j].y * v[q][j].y) + (v[q][j].z * v[q][j].z + v[q][j].w * v[q][j].w);
#pragma unroll
        for (int o = 1; o < 64; o <<= 1) { ss[0] += __shfl_xor(ss[0], o); ss[1] += __shfl_xor(ss[1], o); }
#pragma unroll
        for (int q = 0; q < 2; ++q) { const int r = r0 + q; const int mrow = r < nL ? mod_b0 + r / T : 32;
            const float* sh = MOD + (size_t)mrow * NMOD + (3 * sub) * D; const float* sc = sh + D;
            const float rstd = 1.0f / sqrtf(ss[q] * (1.0f / D) + EPS);
#pragma unroll
            for (int j = 0; j < 4; ++j) { const int c4 = lane + 64 * j; const f32x4 w = ((const f32x4*)nw)[c4], s4 = ((const f32x4*)sh)[c4], c1 = ((const f32x4*)sc)[c4];
                const f32x4 o = v[q][j] * rstd * w * (c1 + 1.0f) + s4;
                u32x2 p; p.x = cvt_pk_bf16(o.x, o.y); p.y = cvt_pk_bf16(o.z, o.w); ((u32x2*)(U + (size_t)r * D))[c4] = p; } }
    }
}
__device__ __forceinline__ void phase_final(const Ctx cx, const Args& a, LAS unsigned char* lds, int g) {
    const int lane = cx.tid & 63; const float* fw = AIN(I_FNW);
    for (int r0 = 2 * GW(); r0 < RL; r0 += 2 * NGW()) {
        float* row = a.out + ((size_t)g * RL + r0) * D;
        f32x4 v[2][4]; float ss[2] = {0.f, 0.f};
#pragma unroll
        for (int q = 0; q < 2; ++q)
#pragma unroll
            for (int j = 0; j < 4; ++j) v[q][j] = ((const f32x4*)(row + q * D))[lane + 64 * j];
#pragma unroll
        for (int q = 0; q < 2; ++q)
#pragma unroll
            for (int j = 0; j < 4; ++j) ss[q] += (v[q][j].x * v[q][j].x + v[q][j].y * v[q][j].y) + (v[q][j].z * v[q][j].z + v[q][j].w * v[q][j].w);
#pragma unroll
        for (int o = 1; o < 64; o <<= 1) { ss[0] += __shfl_xor(ss[0], o); ss[1] += __shfl_xor(ss[1], o); }
#pragma unroll
        for (int q = 0; q < 2; ++q) { const float rstd = 1.0f / sqrtf(ss[q] * (1.0f / D) + EPS);
#pragma unroll
            for (int j = 0; j < 4; ++j) { const int c4 = lane + 64 * j; ((f32x4*)(row + q * D))[c4] = v[q][j] * rstd * ((const f32x4*)fw)[c4]; } }
    }
}

__device__ __forceinline__ float logsig_fast(float x) { return fminf(x, 0.f) - __logf(1.0f + __expf(-fabsf(x))); }
__device__ __forceinline__ void phase_prep(const Ctx cx, const Args& a, int g, LAS unsigned char* lds) {
    const bf16_t* PROJ = (const bf16_t*)(a.ws + WS_BIG);
    const int tid = cx.tid;
    {
        LAS bf16_t* qs = (LAS bf16_t*)lds; LAS bf16_t* ks = (LAS bf16_t*)(lds + 16384); LAS float* fdl = (LAS float*)(lds + 32768); LAS float* part = (LAS float*)(lds + 36864);
        LAS bf16_t* qo = (LAS bf16_t*)(lds + 40960); LAS bf16_t* ko = (LAS bf16_t*)(lds + 57344);
        const int d = tid & 127, qt = tid >> 7;
        u32x4 pkr[2], pqr[2]; bf16_t pfr[2];
        float fw[16]; float fbv = 0.f; int hd_cur = -1;
#pragma unroll
        for (int r = 0; r < 16; ++r) fw[r] = 0.f;
#define PREP_LOAD(it_) do { const int h_ = (it_) & 3, dir_ = ((it_) >> 2) & 1, bc_ = (it_) >> 3, b_ = bc_ / NCH, c_ = bc_ % NCH; \
            const int row0_ = c_ < 4 ? RL + b_ * CL + c_ * 64 : b_ * T + (c_ - 4) * 64; \
            _Pragma("unroll") for (int k = 0; k < 2; ++k) { const int p = tid + 512 * k, r = p >> 4, c8 = (p & 15) * 8; \
                pkr[k] = *(const u32x4*)(PROJ + (size_t)(row0_ + r) * PN + PK + h_ * 128 + c8); \
                if (c_ >= 4) pqr[k] = *(const u32x4*)(PROJ + (size_t)(row0_ + r) * PN + PQ + h_ * 128 + c8); \
                const int idx = tid + 512 * k; pfr[k] = PROJ[(size_t)(row0_ + (idx >> 4)) * PN + PFD + dir_ * 16 + (idx & 15)]; } } while (0)
        pqr[0] = pqr[1] = (u32x4){0u, 0u, 0u, 0u};
        if (cx.bid < BG * NCH * 8) PREP_LOAD(cx.bid);
        for (int item = cx.bid; item < BG * NCH * 8; item += cx.G) {
            const int h = item & 3, dir = (item >> 2) & 1, bc = item >> 3, b = bc / NCH, c = bc % NCH;
            const bool lat = c >= 4;
#pragma unroll
            for (int k = 0; k < 2; ++k) { const int p = tid + 512 * k, r = p >> 4, c8 = (p & 15) * 8;
                *(LAS u32x4*)(ks + r * 128 + c8) = pkr[k]; *(LAS u32x4*)(qs + r * 128 + c8) = pqr[k]; fdl[tid + 512 * k] = bf2f(pfr[k]); }
            if ((item & 7) != hd_cur) { hd_cur = item & 7; const int col = h * 128 + d;
#pragma unroll
                for (int r = 0; r < 16; ++r) fw[r] = AIN(I_FUP)[(size_t)(dir * 16 + r) * 512 + col];
                fbv = AIN(I_FB)[dir * 512 + col]; }
            __syncthreads();
            if (item + cx.G < BG * NCH * 8) PREP_LOAD(item + cx.G);
            float la[16]; float psum = 0.f;
#pragma unroll
            for (int t = 0; t < 16; ++t) { const int i = 16 * qt + t; float dot = fbv;
#pragma unroll
                for (int r = 0; r < 16; ++r) dot += fdl[i * 16 + r] * fw[r];
                la[t] = logsig_fast(dot) * (1.0f / 16.0f); psum += la[t]; }
            part[qt * 128 + d] = psum;
            asm volatile("s_waitcnt lgkmcnt(0)" ::: "memory"); __builtin_amdgcn_s_barrier(); asm volatile("" ::: "memory");
            const float p0 = part[d], p1 = part[128 + d], p2 = part[256 + d], p3 = part[384 + d];
            const float tot = (p0 + p1) + (p2 + p3);
            float run = dir == 0 ? (qt > 0 ? p0 : 0.f) + (qt > 1 ? p1 : 0.f) + (qt > 2 ? p2 : 0.f)
                                 : (qt < 3 ? p3 : 0.f) + (qt < 2 ? p2 : 0.f) + (qt < 1 ? p1 : 0.f);
            float ke[16];
            if (dir == 0) {
#pragma unroll
                for (int t = 0; t < 16; ++t) { const int i = 16 * qt + t; run += la[t];
                    const float kv = bf2f(ks[i * 128 + d]); ke[t] = kv * __expf(tot - run);
                    if (lat) { qo[i * 128 + d] = f2bf(bf2f(qs[i * 128 + d]) * 0.08838834764831845f * __expf(run)); ko[i * 128 + d] = f2bf(kv * __expf(-run)); } }
            } else {
#pragma unroll
                for (int t = 15; t >= 0; --t) { const int i = 16 * qt + t; run += la[t];
                    const float kv = bf2f(ks[i * 128 + d]); ke[t] = kv * __expf(tot - run);
                    if (lat) { qo[i * 128 + d] = f2bf(bf2f(qs[i * 128 + d]) * 0.08838834764831845f * __expf(run)); ko[i * 128 + d] = f2bf(kv * __expf(-run)); } }
            }
            const size_t tb = (((size_t)dir * BG + b) * NCH + c) * 4 + h;
            bf16_t* KET = (bf16_t*)(a.ws + WS_KET) + tb * 8192 + d * 64 + 16 * qt;
            { float k0[8], k1[8];
#pragma unroll
              for (int t = 0; t < 8; ++t) { k0[t] = ke[t]; k1[t] = ke[8 + t]; }
              *(u32x4*)KET = pack8(k0); *(u32x4*)(KET + 8) = pack8(k1); }
            if (qt == 0) ((float*)(a.ws + WS_BL))[tb * 128 + d] = __expf(tot);
            asm volatile("s_waitcnt lgkmcnt(0)" ::: "memory"); __builtin_amdgcn_s_barrier(); asm volatile("" ::: "memory");
            if (lat) { bf16_t* QD = (bf16_t*)(a.ws + WS_QD) + tb * 8192; bf16_t* KI = (bf16_t*)(a.ws + WS_KI) + tb * 8192;
#pragma unroll
                for (int k = 0; k < 2; ++k) { const int p = tid + 512 * k; *(u32x4*)(QD + p * 8) = *(const LAS u32x4*)(qo + p * 8); *(u32x4*)(KI + p * 8) = *(const LAS u32x4*)(ko + p * 8); } }
        }
#undef PREP_LOAD
        __syncthreads();
    }
    {
        LAS bf16_t* vs = (LAS bf16_t*)lds;
        const int e = tid & 255, jh = tid >> 8;
        for (int item = cx.bid; item < BG * NCH * 4; item += cx.G) {
            const int h = item & 3, bc = item >> 2, b = bc / NCH, c = bc % NCH;
            const int row0 = c < 4 ? RL + b * CL + c * 64 : b * T + (c - 4) * 64;
#pragma unroll
            for (int k = 0; k < 4; ++k) { const int p = tid + 512 * k, r = p >> 5, c8 = (p & 31) * 8;
                *(LAS u32x4*)(vs + r * 256 + c8) = *(const u32x4*)(PROJ + (size_t)(row0 + r) * PN + PV + h * 256 + c8); }
            __syncthreads();
            bf16_t* VT = (bf16_t*)(a.ws + WS_VT) + ((((size_t)b * NCH + c) * 4 + h) * 256 + e) * 64 + 32 * jh;
#pragma unroll
            for (int jg = 0; jg < 4; ++jg) { float v[8];
#pragma unroll
                for (int jj = 0; jj < 8; ++jj) v[jj] = bf2f(vs[(32 * jh + 8 * jg + jj) * 256 + e]);
                *(u32x4*)(VT + 8 * jg) = pack8(v); }
            __syncthreads();
        }
    }
    bf16_t* XC = (bf16_t*)(a.ws + WS_XC);
    const float* cvb = AIN(I_CONVB); const float* cvw = AIN(I_CONVW);
    for (int idx0 = cx.bid * NTHR + cx.tid; idx0 < RG * 128; idx0 += 4 * cx.G * NTHR) {
        u32x4 xw[4][4];
#pragma unroll
        for (int q = 0; q < 4; ++q) { const int idx = idx0 + q * cx.G * NTHR; const int row = idx >> 7, c8 = (idx & 127) * 8;
            const int pos = row < RL ? (row & 63) : ((row - RL) & 255), len = row < RL ? 64 : 256;
#pragma unroll
            for (int j = 0; j < 4; ++j) { const int p = pos + j - 2; xw[q][j] = (u32x4){0u, 0u, 0u, 0u};
                if (idx < RG * 128 && p >= 0 && p < len) xw[q][j] = *(const u32x4*)(PROJ + (size_t)(row + j - 2) * PN + PXL + c8); } }
#pragma unroll
        for (int q = 0; q < 4; ++q) { const int idx = idx0 + q * cx.G * NTHR; const int row = idx >> 7, c8 = (idx & 127) * 8;
            if (idx < RG * 128) { float acc[8];
#pragma unroll
                for (int i = 0; i < 8; ++i) acc[i] = cvb[c8 + i];
#pragma unroll
                for (int j = 0; j < 4; ++j) { float xv[8]; unpack8(xw[q][j], xv);
#pragma unroll
                    for (int i = 0; i < 8; ++i) acc[i] += cvw[j * D + c8 + i] * xv[i]; }
                *(u32x4*)(XC + (size_t)row * D + c8) = pack8(acc); } }
    }
}

__device__ __forceinline__ void phase_gatefix(const Ctx cx, const Args& a, LAS unsigned char* lds) {
    bf16_t* LA = (bf16_t*)(a.ws + WS_LA); bf16_t* UU = (bf16_t*)(a.ws + WS_UU); const bf16_t* XC = (const bf16_t*)(a.ws + WS_XC); const float* GC = (const float*)(a.ws + WS_GC);
    for (int idx = cx.bid * NTHR + cx.tid; idx < 2 * RG * 128; idx += cx.G * NTHR) {
        const int dir = idx >= RG * 128, rem = idx - dir * RG * 128, row = rem >> 7, c8 = (rem & 127) * 8;
        const size_t off = (size_t)dir * RG * D + (size_t)row * D + c8;
        float r[8], ig[8], xc[8]; unpack8(*(const u32x4*)(LA + off), r); unpack8(*(const u32x4*)(UU + off), ig); unpack8(*(const u32x4*)(XC + (size_t)row * D + c8), xc);
#pragma unroll
        for (int i = 0; i < 8; ++i) { const float l = -GC[(4 + dir) * D + c8 + i] * sigmoidf_(r[i] + GC[dir * D + c8 + i]);
            const float gi = sigmoidf_(ig[i] + GC[(2 + dir) * D + c8 + i]);
            r[i] = l; ig[i] = __builtin_amdgcn_sqrtf(fmaxf(one_minus_exp(2.0f * l), 0.f)) * gi * xc[i]; }
        *(u32x4*)(LA + off) = pack8(r); *(u32x4*)(UU + off) = pack8(ig);
    }
}

__device__ __forceinline__ int img_off(int nkg, int row, int kcol) { const int ob = (row & 15) * 64 + (kcol & 31) * 2; return ((row >> 4) * nkg + (kcol >> 5)) * 1024 + (ob ^ (((ob >> 9) & 1) << 5)); }
__device__ __forceinline__ bf16x8 ldfrag(const LAS unsigned char* img, int nkg, int row, int kcol) { return *(const LAS bf16x8*)(img + img_off(nkg, row, kcol)); }
#define MFMA16(a, b, c) __builtin_amdgcn_mfma_f32_16x16x32_bf16((a), (b), (c), 0, 0, 0)

__device__ __forceinline__ void phase_gla_scan(const Ctx cx, const Args& a, int g, LAS unsigned char* lds) {
    constexpr int XB = 57344, OFF_KI = 16384, OFF_KET = 32768, OFF_VT = 49152, OFF_P = 2 * XB, OFF_ST = OFF_P + 8192, OFF_BL = OFF_ST + 2 * 16384;
    static_assert(OFF_BL + 1024 <= LDS_BYTES, "gla scan LDS");
    const int tid = cx.tid, lane = tid & 63, w = tid >> 6, fr = lane & 15, fq = lane >> 4;
    const bf16_t* QDg = (const bf16_t*)(a.ws + WS_QD); const bf16_t* KIg = (const bf16_t*)(a.ws + WS_KI); const bf16_t* KETg = (const bf16_t*)(a.ws + WS_KET);
    const bf16_t* VTg = (const bf16_t*)(a.ws + WS_VT); const float* BLg = (const float*)(a.ws + WS_BL);
    bf16_t* Og = (bf16_t*)(a.ws + WS_OFB);
    for (int item = cx.bid; item < BG * 32; item += cx.G) {
        const int dvq = item & 3, dir = (item >> 2) & 1, h = (item >> 3) & 3, b = item >> 5;
        { u32x4 z = {0u, 0u, 0u, 0u}; *(LAS u32x4*)(lds + OFF_ST + tid * 32) = z; *(LAS u32x4*)(lds + OFF_ST + tid * 32 + 16) = z; }
        f32x4 accS[4];
#pragma unroll
        for (int t = 0; t < 4; ++t) accS[t] = (f32x4){0.f, 0.f, 0.f, 0.f};
        u32x4 pq[2], pk[2], pe[2], pv; float pbl = 0.f;
#define GLA_LOAD(s_) do { const int c_ = dir == 0 ? (s_) : ((s_) < 4 ? 3 - (s_) : 39 - (s_)); \
            const size_t tb_ = (((size_t)dir * BG + b) * NCH + c_) * 4 + h; \
            if (c_ >= 4) { pq[0] = ((const u32x4*)(QDg + tb_ * 8192))[tid]; pq[1] = ((const u32x4*)(QDg + tb_ * 8192))[tid + 512]; \
                           pk[0] = ((const u32x4*)(KIg + tb_ * 8192))[tid]; pk[1] = ((const u32x4*)(KIg + tb_ * 8192))[tid + 512]; } \
            pe[0] = ((const u32x4*)(KETg + tb_ * 8192))[tid]; pe[1] = ((const u32x4*)(KETg + tb_ * 8192))[tid + 512]; \
            pv = ((const u32x4*)(VTg + ((((size_t)b * NCH + c_) * 4 + h) * 256 + dvq * 64) * 64))[tid]; \
            if (tid < 128) pbl = BLg[tb_ * 128 + tid]; } while (0)
#define GLA_STORE(buf_) do { LAS unsigned char* X_ = lds + (buf_) * XB; \
            _Pragma("unroll") for (int i_ = 0; i_ < 2; ++i_) { const int p_ = tid + 512 * i_; \
                *(LAS u32x4*)(X_ + img_off(4, p_ >> 4, (p_ & 15) * 8)) = pq[i_]; *(LAS u32x4*)(X_ + OFF_KI + img_off(4, p_ >> 4, (p_ & 15) * 8)) = pk[i_]; \
                *(LAS u32x4*)(X_ + OFF_KET + img_off(2, p_ >> 3, (p_ & 7) * 8)) = pe[i_]; } \
            *(LAS u32x4*)(X_ + OFF_VT + img_off(2, tid >> 3, (tid & 7) * 8)) = pv; \
            if (tid < 128) ((LAS float*)(lds + OFF_BL + (buf_) * 512))[tid] = pbl; } while (0)
        pq[0] = pq[1] = pk[0] = pk[1] = (u32x4){0u, 0u, 0u, 0u};
        GLA_LOAD(0); GLA_STORE(0);
        __syncthreads();
        for (int s = 0; s < NCH; ++s) {
            const int cur = s & 1; const bool lat = s >= 4;
            const LAS unsigned char* X = lds + cur * XB;
#ifndef GLA_SAFE
            if (s + 1 < NCH) GLA_LOAD(s + 1);
#endif
            if (lat) {
                const int ti = w >> 1, tj0 = (w & 1) * 2;
                f32x4 sc[2] = {(f32x4){0.f, 0.f, 0.f, 0.f}, (f32x4){0.f, 0.f, 0.f, 0.f}};
#pragma unroll
                for (int kk = 0; kk < 4; ++kk) { const bf16x8 qa = ldfrag(X, 4, 16 * ti + fr, kk * 32 + fq * 8);
#pragma unroll
                    for (int t = 0; t < 2; ++t) { const bf16x8 kb = ldfrag(X + OFF_KI, 4, 16 * (tj0 + t) + fr, kk * 32 + fq * 8); sc[t] = MFMA16(qa, kb, sc[t]); } }
#pragma unroll
                for (int t = 0; t < 2; ++t)
#pragma unroll
                    for (int jj = 0; jj < 4; ++jj) { const int i = 16 * ti + 4 * fq + jj, j = 16 * (tj0 + t) + fr;
                        const bool keep = dir == 0 ? (j <= i) : (j > i);
                        *(LAS bf16_t*)(lds + OFF_P + img_off(2, i, j)) = f2bf(keep ? sc[t][jj] : 0.f); }
            }
            __syncthreads();
            const int te = w >> 1;
            if (lat) {
                const int c = dir == 0 ? s : 39 - s;
                const LAS unsigned char* STc = lds + OFF_ST + cur * 16384;
                f32x4 oc[2] = {(f32x4){0.f, 0.f, 0.f, 0.f}, (f32x4){0.f, 0.f, 0.f, 0.f}};
#pragma unroll
                for (int kk = 0; kk < 2; ++kk) { const bf16x8 va = ldfrag(X + OFF_VT, 2, 16 * te + fr, kk * 32 + fq * 8);
#pragma unroll
                    for (int t = 0; t < 2; ++t) { const bf16x8 pb = ldfrag(lds + OFF_P, 2, 16 * ((w & 1) * 2 + t) + fr, kk * 32 + fq * 8); oc[t] = MFMA16(va, pb, oc[t]); } }
#pragma unroll
                for (int kk = 0; kk < 4; ++kk) { const bf16x8 sa = ldfrag(STc, 4, 16 * te + fr, kk * 32 + fq * 8);
#pragma unroll
                    for (int t = 0; t < 2; ++t) { const bf16x8 qb = ldfrag(X, 4, 16 * ((w & 1) * 2 + t) + fr, kk * 32 + fq * 8); oc[t] = MFMA16(sa, qb, oc[t]); } }
#pragma unroll
                for (int t = 0; t < 2; ++t) { const int i = 16 * ((w & 1) * 2 + t) + fr; const size_t row = (size_t)b * T + (size_t)(c - 4) * 64 + i;
                    u32x2 o2; o2.x = cvt_pk_bf16(oc[t][0], oc[t][1]); o2.y = cvt_pk_bf16(oc[t][2], oc[t][3]);
                    *(u32x2*)(Og + ((size_t)dir * RL + row) * D + h * 256 + dvq * 64 + 16 * te + 4 * fq) = o2; }
            }
#ifdef GLA_SAFE
            __syncthreads();
#endif
            {
                const LAS float* blp = (const LAS float*)(lds + OFF_BL + cur * 512);
                LAS unsigned char* STn = lds + OFF_ST + (cur ^ 1) * 16384;
                bf16x8 vb[2];
#pragma unroll
                for (int kk = 0; kk < 2; ++kk) vb[kk] = ldfrag(X + OFF_VT, 2, 16 * te + fr, kk * 32 + fq * 8);
#pragma unroll
                for (int t = 0; t < 4; ++t) { const int td = (w & 1) * 4 + t;
#pragma unroll
                    for (int jj = 0; jj < 4; ++jj) accS[t][jj] *= blp[16 * td + 4 * fq + jj];
#pragma unroll
                    for (int kk = 0; kk < 2; ++kk) { const bf16x8 ka = ldfrag(X + OFF_KET, 2, 16 * td + fr, kk * 32 + fq * 8); accS[t] = MFMA16(ka, vb[kk], accS[t]); }
                    u32x2 s2; s2.x = cvt_pk_bf16(accS[t][0], accS[t][1]); s2.y = cvt_pk_bf16(accS[t][2], accS[t][3]);
                    *(LAS u32x2*)(STn + img_off(4, 16 * te + fr, 16 * td + 4 * fq)) = s2; }
            }
#ifdef GLA_SAFE
            __syncthreads();
            if (s + 1 < NCH) { GLA_LOAD(s + 1); GLA_STORE(cur ^ 1); }
#else
            if (s + 1 < NCH) GLA_STORE(cur ^ 1);
#endif
            __syncthreads();
        }
#undef GLA_LOAD
#undef GLA_STORE
    }
}

__device__ __forceinline__ void phase_lru_scan(const Ctx cx, const Args& a, int g, LAS unsigned char* lds) {
    const int lane = cx.tid & 63, w = cx.tid >> 6;
    LAS f32x2* agg = (LAS f32x2*)lds;
    const float* GC = (const float*)(a.ws + WS_GC);
    for (int item = cx.bid; item < BG * 32; item += cx.G) {
        const int cgp = item & 15, dir = (item >> 4) & 1, b = item >> 5, ch = cgp * 64 + lane;
        const bf16_t* RR = (const bf16_t*)(a.ws + WS_LA) + (size_t)dir * RG * D + ch; const bf16_t* II = (const bf16_t*)(a.ws + WS_UU) + (size_t)dir * RG * D + ch;
        const bf16_t* XCp = (const bf16_t*)(a.ws + WS_XC) + ch;
        bf16_t* Hd = (bf16_t*)(a.ws + WS_HFB) + (size_t)dir * RL * D + ch;
        const float cbr = GC[dir * D + ch], cbi = GC[(2 + dir) * D + ch], csp = GC[(4 + dir) * D + ch];
#define LRU_ROW(s_) ((s_) < CL ? RL + b * CL + (dir ? CL - 1 - (s_) : (s_)) : b * T + (dir ? T - 1 - ((s_) - CL) : (s_) - CL))
#define LRU_GATES(k_) const float l_ = -csp * sigmoidf_(bf2f(rr[k_]) + cbr); const float av = __expf(l_); \
            const float uv = __builtin_amdgcn_sqrtf(fmaxf(one_minus_exp(2.0f * l_), 0.f)) * sigmoidf_(bf2f(ii[k_]) + cbi) * bf2f(xx[k_]);
        LAS unsigned* LB = (LAS unsigned*)(lds + 4096) + lane;
        float hsc = 0.f;
        for (int sc = 0; sc < 4; ++sc) {
            const int sbase = 576 * sc + 72 * w;
            float A = 1.f, Z = 0.f;
            for (int blk = 0; blk < 3; ++blk) { const int s0 = sbase + 24 * blk; bf16_t rr[24], ii[24], xx[24];
#pragma unroll
                for (int k = 0; k < 24; ++k) { const size_t r = (size_t)LRU_ROW(s0 + k); rr[k] = RR[r * D]; ii[k] = II[r * D]; xx[k] = XCp[r * D]; }
#pragma unroll
                for (int k = 0; k < 24; ++k) { const float l_ = -csp * sigmoidf_(bf2f(rr[k]) + cbr);
                    const float u_ = __builtin_amdgcn_sqrtf(fmaxf(one_minus_exp(2.0f * l_), 0.f)) * sigmoidf_(bf2f(ii[k]) + cbi) * bf2f(xx[k]);
                    const unsigned pk = cvt_pk_bf16(l_, u_);
                    LB[(72 * w + 24 * blk + k) * 64] = pk;
                    const float av = __expf(bflo(pk)); Z = av * Z + bfhi(pk); A *= av; } }
            agg[w * 64 + lane] = (f32x2){A, Z};
            __syncthreads();
            float hst = hsc, hn = hsc;
#pragma unroll
            for (int w2 = 0; w2 < 8; ++w2) { const f32x2 p = agg[w2 * 64 + lane]; if (w2 < w) hst = p.x * hst + p.y; hn = p.x * hn + p.y; }
            for (int k = 0; k < 72; ++k) { const unsigned pk = LB[(72 * w + k) * 64]; hst = __expf(bflo(pk)) * hst + bfhi(pk);
                if (sbase + k >= CL) Hd[(size_t)LRU_ROW(sbase + k) * D] = f2bf(hst); }
            hsc = hn;
            __syncthreads();
        }
#undef LRU_ROW
#undef LRU_GATES
    }
}

__device__ __forceinline__ void phase_post(const Ctx cx, const Args& a, LAS unsigned char* lds, int g) {
    const int lane = cx.tid & 63;
    const bf16_t* PROJ = (const bf16_t*)(a.ws + WS_BIG);
    bf16_t* O0 = (bf16_t*)(a.ws + WS_OFB); const bf16_t* O1 = O0 + (size_t)RL * D;
    bf16_t* H0 = (bf16_t*)(a.ws + WS_HFB); const bf16_t* H1b = H0 + (size_t)RL * D;
    const float* gnw = AIN(I_GNW);
    for (int r = GW(); r < RL; r += NGW()) {
        const size_t off = (size_t)r * D + lane * 16;
        float o[16], t[8]; float ss = 0.f;
#pragma unroll
        for (int hf = 0; hf < 2; ++hf) { float x0[8], x1[8]; unpack8(*(const u32x4*)(O0 + off + 8 * hf), x0); unpack8(*(const u32x4*)(O1 + off + 8 * hf), x1);
#pragma unroll
            for (int i = 0; i < 8; ++i) { o[8 * hf + i] = x0[i] + x1[i]; ss += o[8 * hf + i] * o[8 * hf + i]; } }
        ss += __shfl_xor(ss, 1); ss += __shfl_xor(ss, 2); ss += __shfl_xor(ss, 4); ss += __shfl_xor(ss, 8);
        const float rstd = 1.0f / sqrtf(ss * (1.0f / 256.0f) + EPS);
#pragma unroll
        for (int hf = 0; hf < 2; ++hf) { float gg[8]; unpack8(*(const u32x4*)(PROJ + (size_t)r * PN + PGG + lane * 16 + 8 * hf), gg);
#pragma unroll
            for (int i = 0; i < 8; ++i) t[i] = o[8 * hf + i] * rstd * gnw[(lane & 15) * 16 + 8 * hf + i] * siluf_(gg[i]);
            *(u32x4*)(O0 + off + 8 * hf) = pack8(t); }
#pragma unroll
        for (int hf = 0; hf < 2; ++hf) { float x0[8], x1[8], yl[8]; unpack8(*(const u32x4*)(H0 + off + 8 * hf), x0); unpack8(*(const u32x4*)(H1b + off + 8 * hf), x1);
            unpack8(*(const u32x4*)(PROJ + (size_t)r * PN + PYL + lane * 16 + 8 * hf), yl);
#pragma unroll
            for (int i = 0; i < 8; ++i) t[i] = (x0[i] + x1[i]) * geluf_(yl[i]);
            *(u32x4*)(H0 + off + 8 * hf) = pack8(t); }
    }
}


#define XB_TMO      128
#define XB_XCNT(j)  (256  + 64 * (j))
#define XB_XSUB(j)  (1280 + 64 * (j))
#define XB_XGEN(j)  (2304 + 64 * (j))
#define XB_TOP      3328
#define XB_TOPGEN   3392
#define XCD_BAR_WORDS 3456
#define XB_SPIN_CAP (1u << 22)
__device__ __forceinline__ unsigned xb_ld(unsigned* p)              { return __hip_atomic_load(p, __ATOMIC_RELAXED, __HIP_MEMORY_SCOPE_AGENT); }
__device__ __forceinline__ unsigned xb_add(unsigned* p, unsigned v) { return __hip_atomic_fetch_add(p, v, __ATOMIC_RELAXED, __HIP_MEMORY_SCOPE_AGENT); }
__device__ __forceinline__ unsigned xb_xcc_id() { return (unsigned)__builtin_amdgcn_s_getreg((3 << 11) | 20) & 0xFu; }
#define XB_SPIN(cond, bar) do { unsigned _sp = 0; while (cond) { __builtin_amdgcn_s_sleep(1); \
    if ((++_sp & 255u) == 0u) { if (xb_ld(&(bar)[XB_TMO])) break; if (_sp > XB_SPIN_CAP) { atomicAdd(&(bar)[XB_TMO], 1u); break; } } } } while (0)
__device__ __forceinline__ void xcd_barrier_complete(unsigned* bar, unsigned x, unsigned G, unsigned& nloc, unsigned& nx) {
    unsigned sum, cnt, mine, sp = 0u;
    for (;;) {
        sum = 0u; cnt = 0u; mine = 0u;
#pragma unroll
        for (unsigned j = 0; j < 16; ++j) { const unsigned c = xb_ld(&bar[XB_XCNT(j)]); sum += c; cnt += (c > 0u) ? 1u : 0u; mine = (j == x) ? c : mine; }
        if (sum == G) break;
        __builtin_amdgcn_s_sleep(1);
        if ((++sp & 255u) == 0u) { if (xb_ld(&bar[XB_TMO])) break; if (sp > XB_SPIN_CAP) { atomicAdd(&bar[XB_TMO], 1u); break; } }
    }
    nloc = mine > 0u ? mine : 1u; nx = cnt > 0u ? cnt : 1u;
}
__device__ __forceinline__ void xcd_barrier(unsigned* bar, volatile LAS unsigned* st, int tid, unsigned G) {
    asm volatile("s_waitcnt vmcnt(0)" ::: "memory");
    __syncthreads();
    if (tid == 0) {
        __builtin_amdgcn_s_waitcnt(0);
        const unsigned x = xb_xcc_id();
        unsigned nloc = st[0], nx = st[1];
        if (nloc == 0u) { xcd_barrier_complete(bar, x, G, nloc, nx); st[0] = nloc; st[1] = nx; }
        const unsigned old = xb_add(&bar[XB_XSUB(x)], 1u);
        const unsigned gen = old / nloc;
        if (old + 1u == (gen + 1u) * nloc) {
            __builtin_amdgcn_fence(__ATOMIC_RELEASE, "agent");
            asm volatile("s_waitcnt vmcnt(0)" ::: "memory");
            const unsigned og = xb_add(&bar[XB_TOP], 1u);
            const unsigned tg = og / nx;
            if (og + 1u == (tg + 1u) * nx) xb_add(&bar[XB_TOPGEN], 1u);
            else XB_SPIN(xb_ld(&bar[XB_TOPGEN]) == tg, bar);
            __builtin_amdgcn_fence(__ATOMIC_ACQUIRE, "agent");
            xb_add(&bar[XB_XGEN(x)], 1u);
            asm volatile("s_waitcnt vmcnt(0)" ::: "memory");
        } else {
            XB_SPIN(xb_ld(&bar[XB_XGEN(x)]) == gen, bar);
            __builtin_amdgcn_fence(__ATOMIC_ACQUIRE, "agent");
            asm volatile("s_waitcnt vmcnt(0)" ::: "memory");
        }
    }
    __syncthreads();
}

constexpr int NPH = 17;
#ifndef USE_CG_ALL
#define USE_CG_ALL 0
#endif
#if ONE_LAUNCH
#define GRID_SYNC(k) do { if ((k) == 1 || USE_CG_ALL) cg::this_grid().sync(); else xcd_barrier((unsigned*)ws + 4096, (volatile LAS unsigned*)(lds + PTAB + 256), cx.tid, (unsigned)cx.G); } while (0)
#else
#define GRID_SYNC(k) do {} while (0)
#endif
#define STEP_BEGIN(k) if (a.lo <= (k) && (k) < a.hi) { \
        Ctx cx; { int t_ = wave_s * 64 + (int)__builtin_amdgcn_mbcnt_hi(~0u, __builtin_amdgcn_mbcnt_lo(~0u, 0u)), b_ = blockIdx.x, g_ = gridDim.x; asm volatile("" : "+v"(t_)); asm volatile("" : "+s"(b_), "+s"(g_)); cx.tid = t_; cx.bid = b_; cx.G = g_; } \
        const int G = cx.G, cidx = cx.bid; (void)G; (void)cidx; \
        unsigned char* ws = a.ws; asm volatile("" : "+s"(ws)); \
        if ((k) > a.lo) GRID_SYNC(k); \
        const float* MOD = (const float*)(ws + WS_MOD); float* H1 = (float*)(ws + WS_H1); bf16_t* U = (bf16_t*)(ws + WS_U); bf16_t* BIG = (bf16_t*)(ws + WS_BIG); bf16_t* XC = (bf16_t*)(ws + WS_XC); \
        (void)MOD; (void)H1; (void)U; (void)BIG; (void)XC; pg8::StaticOrder S; (void)S;
#define STEP_BEGIN_NS(k) if (a.lo <= (k) && (k) < a.hi) { \
        Ctx cx; { int t_ = wave_s * 64 + (int)__builtin_amdgcn_mbcnt_hi(~0u, __builtin_amdgcn_mbcnt_lo(~0u, 0u)), b_ = blockIdx.x, g_ = gridDim.x; asm volatile("" : "+v"(t_)); asm volatile("" : "+s"(b_), "+s"(g_)); cx.tid = t_; cx.bid = b_; cx.G = g_; } \
        const int G = cx.G, cidx = cx.bid; (void)G; (void)cidx; \
        unsigned char* ws = a.ws; asm volatile("" : "+s"(ws)); \
        asm volatile("s_waitcnt vmcnt(0)" ::: "memory"); __syncthreads(); \
        const float* MOD = (const float*)(ws + WS_MOD); float* H1 = (float*)(ws + WS_H1); bf16_t* U = (bf16_t*)(ws + WS_U); bf16_t* BIG = (bf16_t*)(ws + WS_BIG); bf16_t* XC = (bf16_t*)(ws + WS_XC); \
        (void)MOD; (void)H1; (void)U; (void)BIG; (void)XC; pg8::StaticOrder S; (void)S;
#define STEP_END }

template <int g>
__device__ __forceinline__ void run_group(const Args& a, LAS unsigned char* lds, const int wave_s) {
    constexpr int s0 = 5 + g * NPH;
    const float* H1r = (const float*)(a.ws + WS_H1); const float* H1Cr = (const float*)(a.ws + WS_H1C) + (size_t)g * RC * D;
    if (g == 0) { STEP_BEGIN(s0 + 0) if (PHON(0)) phase_normmod(cx, a, lds, AIN(I_X), nullptr, RL, RL, 0, 0); STEP_END }
    STEP_BEGIN(s0 + 1) if (PHON(1)) { pg8::Gemm gm{U, (const bf16_t*)(ws + WS_WI1), RL, 2 * FH, D, D, D, 0, 0}; S.init(RL, 2 * FH, G, cidx);
                  pg8::EpiSwiglu E{BIG, FH}; pg8::gemm_phase<pg8::EpiSwiglu, true>(cx.tid, lds, gm, S, E); } STEP_END
    STEP_BEGIN(s0 + 2) if (PHON(2)) { pg8::Gemm gm{BIG, (const bf16_t*)(ws + WS_WO1), RL, D, FH, FH, FH, 0, 0}; S.init(RL, D, G, cidx);
                  pg8::EpiResid E{AIN(I_X) + (size_t)g * RL * D, AIN(I_CTX) + (size_t)g * RC * D, H1, H1 + (size_t)RL * D,
                                  MOD + (size_t)(g * BG) * NMOD + 2 * D, MOD + (size_t)32 * NMOD + 2 * D, 0.5f, RL / 256};
                  pg8::gemm_phase<pg8::EpiResid, true>(cx.tid, lds, gm, S, E); } STEP_END
    STEP_BEGIN(s0 + 3) if (PHON(3)) phase_normmod(cx, a, lds, H1r, H1Cr, RL, RG, g * BG, 1); STEP_END
    STEP_BEGIN(s0 + 4) if (PHON(4)) { pg8::Gemm gm{U, (const bf16_t*)(ws + WS_WIN), RG, PN, D, D, D, 0, 0}; S.init(RL, PN, G, cidx); S.ext = (RC / 256) * 11; S.ext_pm0 = RL / 256;
                  pg8::EpiBf16 E{BIG, PN}; pg8::gemm_phase<pg8::EpiBf16, true>(cx.tid, lds, gm, S, E); } STEP_END
    STEP_BEGIN(s0 + 5) if (PHON(5)) phase_prep(cx, a, g, lds); STEP_END
    STEP_BEGIN(s0 + 6) if (PHON(6)) { pg8::Gemm gm{XC, (const bf16_t*)(ws + WS_WLG), RG, 4096, 128, D, 128, 1, 256}; S.init(RG, 4096, G, cidx);
                  pg8::EpiGate E{(bf16_t*)(ws + WS_LA), (bf16_t*)(ws + WS_UU)};
                  pg8::gemm_phase<pg8::EpiGate, true>(cx.tid, lds, gm, S, E); } STEP_END
    STEP_BEGIN_NS(s0 + 6) if (PHON(7)) { phase_gla_scan(cx, a, g, lds); } STEP_END
    STEP_BEGIN(s0 + 8) if (PHON(8)) phase_lru_scan(cx, a, g, lds); STEP_END
    STEP_BEGIN(s0 + 9) if (PHON(9)) phase_post(cx, a, lds, g); STEP_END
    STEP_BEGIN(s0 + 10) if (PHON(10)) { pg8::Gemm gm{(const bf16_t*)(ws + WS_OFB), (const bf16_t*)(ws + WS_WOG), RL, D, D, D, D, 0, 0}; S.init(RL, D, G, cidx);
                   pg8::EpiMix<false> E{BIG, PGA, XC}; pg8::gemm_phase<pg8::EpiMix<false>, true>(cx.tid, lds, gm, S, E); } STEP_END
    STEP_BEGIN_NS(s0 + 10) if (PHON(11)) { pg8::Gemm gm{(const bf16_t*)(ws + WS_HFB), (const bf16_t*)(ws + WS_WOL), RL, D, D, D, D, 0, 0}; S.init(RL, D, G, cidx);
                   pg8::EpiMix<true> E{BIG, PGB, XC}; pg8::gemm_phase<pg8::EpiMix<true>, true>(cx.tid, lds, gm, S, E); } STEP_END
    STEP_BEGIN(s0 + 12) if (PHON(12)) { pg8::Gemm gm{XC, (const bf16_t*)(ws + WS_WOO), RL, D, D, D, D, 0, 0}; S.init(RL, D, G, cidx);
                   pg8::EpiResid E{H1, H1, H1, H1, MOD + (size_t)(g * BG) * NMOD + 5 * D, MOD, 1.0f, RL / 256};
                   pg8::gemm_phase<pg8::EpiResid, true>(cx.tid, lds, gm, S, E); } STEP_END
    STEP_BEGIN(s0 + 13) if (PHON(13)) phase_normmod(cx, a, lds, H1r, nullptr, RL, RL, g * BG, 2); STEP_END
    STEP_BEGIN(s0 + 14) if (PHON(14)) { pg8::Gemm gm{U, (const bf16_t*)(ws + WS_WI2), RL, 2 * FH, D, D, D, 0, 0}; S.init(RL, 2 * FH, G, cidx);
                   pg8::EpiSwiglu E{BIG, FH}; pg8::gemm_phase<pg8::EpiSwiglu, true>(cx.tid, lds, gm, S, E); } STEP_END
    STEP_BEGIN(s0 + 15) if (PHON(15)) { pg8::Gemm gm{BIG, (const bf16_t*)(ws + WS_WO2), RL, D, FH, FH, FH, 0, 0}; S.init(RL, D, G, cidx);
                   float* og = a.out + (size_t)g * RL * D;
                   pg8::EpiResid E{H1, H1, og, og, MOD + (size_t)(g * BG) * NMOD + 8 * D, MOD, 0.5f, RL / 256};
                   pg8::gemm_phase<pg8::EpiResid, true>(cx.tid, lds, gm, S, E); } STEP_END
    STEP_BEGIN(s0 + 16) if (PHON(16)) { phase_final(cx, a, lds, g); if (g + 1 < NG) phase_normmod(cx, a, lds, AIN(I_X) + (size_t)(g + 1) * RL * D, nullptr, RL, RL, (g + 1) * BG, 0); } STEP_END
}

__global__ void __launch_bounds__(NTHR, 2) fwd_kernel(Args a) {
    extern __shared__ __attribute__((aligned(16))) unsigned char lds_raw[];
    LAS unsigned char* lds = (LAS unsigned char*)lds_raw;
    if (threadIdx.x < 26) ((LAS unsigned long long*)(lds + PTAB))[threadIdx.x] = (unsigned long long)a.in[threadIdx.x];
    if (threadIdx.x == 32) { ((LAS unsigned*)(lds + PTAB + 256))[0] = 0u; ((LAS unsigned*)(lds + PTAB + 256))[1] = 0u; }
#if ONE_LAUNCH
    if (threadIdx.x == 0) (void)xb_add((unsigned*)a.ws + 4096 + XB_XCNT(xb_xcc_id()), 1u);
#endif
    const int wave_s = __builtin_amdgcn_readfirstlane(threadIdx.x >> 6);
    __syncthreads();
    STEP_BEGIN(0) if (PHON(17)) phase_weights(cx, a, lds); STEP_END
    STEP_BEGIN(1) if (PHON(18)) phase_modreduce(cx, a, lds); STEP_END
    STEP_BEGIN(2) if (PHON(0)) phase_normmod(cx, a, lds, nullptr, AIN(I_CTX), 0, NB * CL, 0, 0); STEP_END
    STEP_BEGIN(3) if (PHON(1)) { pg8::Gemm gm{U, (const bf16_t*)(ws + WS_WI1), NB * CL, 2 * FH, D, D, D, 0, 0}; S.init(NB * CL, 2 * FH, G, cidx);
                  pg8::EpiSwiglu E{BIG, FH}; pg8::gemm_phase<pg8::EpiSwiglu, true>(cx.tid, lds, gm, S, E); } STEP_END
    STEP_BEGIN(4) if (PHON(2)) { pg8::Gemm gm{BIG, (const bf16_t*)(ws + WS_WO1), NB * CL, D, FH, FH, FH, 0, 0}; S.init(NB * CL, D, G, cidx);
                  float* h1c = (float*)(ws + WS_H1C);
                  pg8::EpiResid E{AIN(I_CTX), AIN(I_CTX), h1c, h1c, MOD, MOD + (size_t)32 * NMOD + 2 * D, 0.5f, 0};
                  pg8::gemm_phase<pg8::EpiResid, true>(cx.tid, lds, gm, S, E); } STEP_END
    run_group<0>(a, lds, wave_s);
    run_group<1>(a, lds, wave_s);
    run_group<2>(a, lds, wave_s);
    run_group<3>(a, lds, wave_s);
}


#ifdef PROBE_STEP
__global__ void probe_kernel(const unsigned char* ws, float* out) {
    const size_t n = (size_t)65536 * 1024, q = n / 4;
    const bf16_t* r0 = (const bf16_t*)(ws + PROBE_R0); const bf16_t* r1 = (const bf16_t*)(ws + PROBE_R1); const bf16_t* r2 = (const bf16_t*)(ws + PROBE_R2); const bf16_t* r3 = (const bf16_t*)(ws + PROBE_R3);
    for (size_t i = (size_t)blockIdx.x * blockDim.x + threadIdx.x; i < q; i += (size_t)gridDim.x * blockDim.x) {
        out[i] = bf2f(r0[i]); out[q + i] = bf2f(r1[i]); out[2 * q + i] = bf2f(r2[i]); out[3 * q + i] = bf2f(r3[i]); }
}
#endif
extern "C" void kernel_launch(void* const* d_in, const int* in_sizes, int n_in, void* d_out, int out_size, void* d_ws, size_t ws_size, hipStream_t stream) {
    static int grid = 0;
    if (grid == 0) {
        if (n_in != 26 || ws_size < WS_END) { fprintf(stderr, "kernel_launch: unexpected inputs (n_in %d, ws %zu, need %zu)\n", n_in, ws_size, (size_t)WS_END); grid = -1; return; }
        int dev = 0, cus = 0, per_cu = 0;
        hipGetDevice(&dev); hipDeviceGetAttribute(&cus, hipDeviceAttributeMultiprocessorCount, dev);
        if (hipFuncSetAttribute((const void*)fwd_kernel, hipFuncAttributeMaxDynamicSharedMemorySize, LDS_BYTES) != hipSuccess) { fprintf(stderr, "kernel_launch: hipFuncSetAttribute failed\n"); grid = -1; return; }
        hipOccupancyMaxActiveBlocksPerMultiprocessor(&per_cu, (const void*)fwd_kernel, NTHR, LDS_BYTES);
        (void)hipGetLastError();
        if (per_cu < 1) per_cu = 1;
        grid = cus * 1;
    }
    if (grid < 0) return;
    Args a{};
    for (int i = 0; i < 26; ++i) a.in[i] = (const float*)d_in[i];
    a.out = (float*)d_out; a.ws = (unsigned char*)d_ws;
    const int nsteps = 5 + NG * NPH;
#if ONE_LAUNCH
    (void)hipMemsetAsync(d_ws, 0, 65536, stream);
    a.lo = 0; a.hi = nsteps;
    void* args[] = {&a};
    hipError_t e = hipLaunchCooperativeKernel((const void*)fwd_kernel, dim3(grid), dim3(NTHR), args, LDS_BYTES, stream);
    if (e != hipSuccess) fprintf(stderr, "cooperative launch failed: %s (grid %d)\n", hipGetErrorString(e), grid);
#else
#ifdef PROBE_STEP
    for (int s = 0; s <= PROBE_STEP; ++s) { a.lo = s; a.hi = s + 1; hipLaunchKernelGGL(fwd_kernel, dim3(grid), dim3(NTHR), LDS_BYTES, stream, a); }
    hipLaunchKernelGGL(probe_kernel, dim3(2048), dim3(256), 0, stream, (const unsigned char*)d_ws, (float*)d_out);
#else
    for (int s = 0; s < nsteps; ++s) { a.lo = s; a.hi = s + 1; hipLaunchKernelGGL(fwd_kernel, dim3(grid), dim3(NTHR), LDS_BYTES, stream, a); }
#endif
#endif
}
```
